# Optimizing an MI355X kernel written in HIP

```python
import math
import jax, jax.numpy as jnp
from jax import lax
import numpy as np

D_MODEL = 1024
BATCH = 8
SEQ = 2048
DEPTH = 1

D_MIX = D_MODEL
CONV_WIDTH = D_MIX // 2
CONV_GROUPS = 8
CONV_KERNEL = 31
GDN_WIDTH = D_MIX - CONV_WIDTH
GDN_HEAD_DIM = 128
GDN_HEADS = GDN_WIDTH // GDN_HEAD_DIM
GDN_SHORT_CONV = 4
GDN_CHUNK = 64
N_IN = 2 * CONV_WIDTH + 4 * GDN_WIDTH + 2 * GDN_HEADS
D_FF = -(-8 * D_MODEL // (3 * 256)) * 256
N_MOD = 6
EPS = 1e-6

kernel_name = "hybrid_conformer_gdn_adaln_block"


def rms_norm(x, w):
    xf = x.astype(jnp.float32)
    y = xf * lax.rsqrt(jnp.mean(xf * xf, axis=-1, keepdims=True) + EPS)
    return (y * w.astype(jnp.float32)).astype(x.dtype)


def modulate(h, shift, scale):
    return h * (1 + scale[:, None, :]) + shift[:, None, :]


def causal_depthwise_conv(x, w):
    k_len, ch = w.shape
    return lax.conv_general_dilated(
        x, w[:, None, :].astype(x.dtype), window_strides=(1,), padding=((k_len - 1, 0),),
        dimension_numbers=("NWC", "WIO", "NWC"), feature_group_count=ch)


def l2norm(t):
    return t * lax.rsqrt(jnp.sum(t * t, axis=-1, keepdims=True) + EPS)


def conformer_conv_group(a, gate, w_dw, b_dw, gn_w, gn_b):
    u = a * jax.nn.sigmoid(gate)
    u = causal_depthwise_conv(u, w_dw) + b_dw
    bsz, seq, ch = u.shape
    uf = u.astype(jnp.float32).reshape(bsz, seq, CONV_GROUPS, ch // CONV_GROUPS)
    mu = jnp.mean(uf, axis=-1, keepdims=True)
    var = jnp.mean(jnp.square(uf - mu), axis=-1, keepdims=True)
    un = ((uf - mu) * lax.rsqrt(var + EPS)).reshape(bsz, seq, ch)
    un = un * gn_w.astype(jnp.float32) + gn_b.astype(jnp.float32)
    return jax.nn.silu(un).astype(a.dtype)


def chunk_gated_delta_rule(q, k, v, g, beta):
    bsz, seq, nh, dk = q.shape
    dv = v.shape[-1]
    cl = GDN_CHUNK
    nc = seq // cl
    q = q * (dk ** -0.5)

    def to_chunks(t):
        return t.reshape(bsz, nc, cl, nh, -1).transpose(1, 0, 3, 2, 4)

    qc, kc, vc = to_chunks(q), to_chunks(k), to_chunks(v)
    gc = g.reshape(bsz, nc, cl, nh).transpose(1, 0, 3, 2)
    bc = beta.reshape(bsz, nc, cl, nh).transpose(1, 0, 3, 2)
    gcum = jnp.cumsum(gc, axis=-1)
    causal = jnp.tril(jnp.ones((cl, cl), dtype=bool))
    strict = jnp.tril(jnp.ones((cl, cl), dtype=bool), -1)
    diff = gcum[..., :, None] - gcum[..., None, :]
    decay = jnp.where(causal, jnp.exp(jnp.where(causal, diff, 0.0)), 0.0)

    k_beta = kc * bc[..., None]
    a_mat = jnp.where(strict, jnp.einsum("nbhcd,nbhed->nbhce", k_beta, kc) * decay, 0.0)
    eye = jnp.eye(cl, dtype=q.dtype)
    t_mat = lax.linalg.triangular_solve(eye + a_mat, jnp.broadcast_to(eye, a_mat.shape),
                                        left_side=True, lower=True, unit_diagonal=True)
    u = jnp.einsum("nbhce,nbhev->nbhcv", t_mat, vc * bc[..., None])
    w = jnp.einsum("nbhce,nbhek->nbhck", t_mat, k_beta * jnp.exp(gcum)[..., None])
    qk = jnp.where(causal, jnp.einsum("nbhcd,nbhed->nbhce", qc, kc) * decay, 0.0)
    q_dec = qc * jnp.exp(gcum)[..., None]
    k_dec = kc * jnp.exp(gcum[..., -1:] - gcum)[..., None]
    chunk_decay = jnp.exp(gcum[..., -1])

    def step(state, inp):
        q_i, k_i, w_i, u_i, qk_i, cd_i = inp
        v_new = u_i - jnp.einsum("bhck,bhkv->bhcv", w_i, state)
        o_i = jnp.einsum("bhck,bhkv->bhcv", q_i, state) + jnp.einsum("bhce,bhev->bhcv", qk_i, v_new)
        state = state * cd_i[..., None, None] + jnp.einsum("bhck,bhcv->bhkv", k_i, v_new)
        return state, o_i

    state0 = jnp.zeros((bsz, nh, dk, dv), dtype=q.dtype)
    _, o = lax.scan(step, state0, (q_dec, k_dec, w, u, qk, chunk_decay))
    return o.transpose(1, 0, 3, 2, 4).reshape(bsz, seq, nh, dv)


def gated_deltanet_group(q, k, v, z, beta_logit, alpha_logit, w_sc, a_log, dt_bias, norm_w):
    bsz, seq, _ = q.shape
    out_dtype = q.dtype
    qkv = jax.nn.silu(causal_depthwise_conv(jnp.concatenate([q, k, v], axis=-1), w_sc))
    q, k, v = jnp.split(qkv.astype(jnp.float32), 3, axis=-1)
    shp = (bsz, seq, GDN_HEADS, GDN_HEAD_DIM)
    q = l2norm(q.reshape(shp))
    k = l2norm(k.reshape(shp))
    v = v.reshape(shp)
    beta = jax.nn.sigmoid(beta_logit.astype(jnp.float32))
    g = -jnp.exp(a_log.astype(jnp.float32)) * jax.nn.softplus(
        alpha_logit.astype(jnp.float32) + dt_bias.astype(jnp.float32))
    o = chunk_gated_delta_rule(q, k, v, g, beta)
    o = o * lax.rsqrt(jnp.mean(o * o, axis=-1, keepdims=True) + EPS) * norm_w.astype(jnp.float32)
    o = o * jax.nn.silu(z.astype(jnp.float32).reshape(shp))
    return o.reshape(bsz, seq, GDN_WIDTH).astype(out_dtype)


def setup_inputs(seed: int = 0) -> dict:
    key = jax.random.key(seed)
    ks = jax.random.split(key, 24)
    f32 = jnp.float32
    nrm = lambda k, shp, s: jax.random.normal(k, shp, f32) * s
    dt = jnp.exp(jax.random.uniform(ks[12], (DEPTH, GDN_HEADS), f32,
                                    minval=math.log(1e-3), maxval=math.log(0.1)))
    return {
        "x": nrm(ks[0], (BATCH, SEQ, D_MODEL), 1.0),
        "c": nrm(ks[1], (BATCH, D_MODEL), 1.0),
        "w_ada": nrm(ks[2], (DEPTH, D_MODEL, N_MOD * D_MODEL), 0.5 * D_MODEL ** -0.5),
        "b_ada": nrm(ks[3], (DEPTH, N_MOD * D_MODEL), 0.02),
        "norm_mix_w": 1.0 + nrm(ks[4], (DEPTH, D_MODEL), 0.02),
        "w_in": nrm(ks[5], (DEPTH, D_MODEL, N_IN), D_MODEL ** -0.5),
        "conv_w": nrm(ks[6], (DEPTH, CONV_KERNEL, CONV_WIDTH), CONV_KERNEL ** -0.5),
        "conv_b": nrm(ks[7], (DEPTH, CONV_WIDTH), 0.02),
        "conv_gn_w": 1.0 + nrm(ks[8], (DEPTH, CONV_WIDTH), 0.02),
        "conv_gn_b": nrm(ks[9], (DEPTH, CONV_WIDTH), 0.02),
        "gdn_conv_w": nrm(ks[10], (DEPTH, GDN_SHORT_CONV, 3 * GDN_WIDTH), GDN_SHORT_CONV ** -0.5),
        "gdn_a_log": jnp.log(jax.random.uniform(ks[11], (DEPTH, GDN_HEADS), f32, minval=1.0, maxval=16.0)),
        "gdn_dt_bias": dt + jnp.log(-jnp.expm1(-dt)),
        "gdn_norm_w": 1.0 + nrm(ks[13], (DEPTH, GDN_HEAD_DIM), 0.02),
        "w_out": nrm(ks[14], (DEPTH, D_MIX, D_MODEL), D_MIX ** -0.5),
        "norm_ffn_w": 1.0 + nrm(ks[15], (DEPTH, D_MODEL), 0.02),
        "w_ffn_in": nrm(ks[16], (DEPTH, D_MODEL, 2 * D_FF), D_MODEL ** -0.5),
        "w_ffn_out": nrm(ks[17], (DEPTH, D_FF, D_MODEL), D_FF ** -0.5),
        "norm_final_w": 1.0 + nrm(ks[18], (D_MODEL,), 0.02),
    }


def reference(x, c, w_ada, b_ada, norm_mix_w, w_in, conv_w, conv_b, conv_gn_w, conv_gn_b,
              gdn_conv_w, gdn_a_log, gdn_dt_bias, gdn_norm_w, w_out, norm_ffn_w,
              w_ffn_in, w_ffn_out, norm_final_w):
    split_at = list(np.cumsum([CONV_WIDTH, CONV_WIDTH, GDN_WIDTH, GDN_WIDTH, GDN_WIDTH, GDN_WIDTH, GDN_HEADS]))
    c_act = jax.nn.silu(c)
    for layer in range(DEPTH):
        mod = c_act @ w_ada[layer] + b_ada[layer]
        sh1, sc1, gt1, sh2, sc2, gt2 = jnp.split(mod, N_MOD, axis=-1)

        h = modulate(rms_norm(x, norm_mix_w[layer]), sh1, sc1)
        p = h @ w_in[layer]
        a_in, a_gate, q, k, v, z, beta_logit, alpha_logit = jnp.split(p, split_at, axis=-1)
        out_a = conformer_conv_group(a_in, a_gate, conv_w[layer], conv_b[layer],
                                     conv_gn_w[layer], conv_gn_b[layer])
        out_b = gated_deltanet_group(q, k, v, z, beta_logit, alpha_logit, gdn_conv_w[layer],
                                     gdn_a_log[layer], gdn_dt_bias[layer], gdn_norm_w[layer])
        mix = jnp.concatenate([out_a, out_b], axis=-1) @ w_out[layer]
        x = x + gt1[:, None, :] * mix

        h = modulate(rms_norm(x, norm_ffn_w[layer]), sh2, sc2)
        f_gate, f_up = jnp.split(h @ w_ffn_in[layer], 2, axis=-1)
        ffn = (jax.nn.silu(f_gate) * f_up) @ w_ffn_out[layer]
        x = x + gt2[:, None, :] * ffn
    return rms_norm(x, norm_final_w)
```

```cpp
#include <hip/hip_runtime.h>
#include <cstdio>
#include <cstdint>
namespace pg8 {
#define PG8_LAS __attribute__((address_space(3)))
typedef unsigned short bf16_t;
typedef short bf16x8 __attribute__((ext_vector_type(8)));
typedef float f32x4 __attribute__((ext_vector_type(4)));
typedef unsigned u32x4 __attribute__((ext_vector_type(4)));
constexpr int BM = 256, BK = 64, HALF = 128, HTB = HALF * BK * 2  , STAGE_BYTES = 8 * HTB, NXCD = 8, WGM = 8;

__host__ __device__ __forceinline__ int lds_byte(int r, int c) { const int st = (r >> 4) * 2 + (c >> 5), rr = r & 15, cc = c & 31, ob = rr * 64 + cc * 2; return st * 1024 + (ob ^ (((ob >> 9) & 1) << 5)); }
__host__ __device__ __forceinline__ void stage_rc(int b, int& R, int& C) { const int st = b / 1024, sb = b % 1024, swz = sb ^ (((sb >> 9) & 1) << 5); R = (st >> 1) * 16 + swz / 64; C = (st & 1) * 32 + (swz % 64) / 2; }
__host__ __device__ __forceinline__ int perm32(int rho) { const int n = rho >> 4, i = rho & 15; return 8 * (i >> 2) + 4 * n + (i & 3); }

struct Unit { int pm, pn; };
struct Gemm { const bf16_t* A; const bf16_t* Bt; int M, N, K; };

struct StaticOrder {
    int nM, nN, nwg, G, c;
    __host__ __device__ void init(int M, int N, int G_, int c_) { nM = M / BM; nN = N / BM; nwg = nM * nN; G = G_; c = c_; }
    __host__ __device__ bool next(int i, Unit& u) const {
        const long L = (long)i * G + c; if (L >= nwg) return false;
        int wgid = (int)L; { const int q = nwg / NXCD, r = nwg % NXCD, xcd = wgid % NXCD, off = wgid / NXCD; wgid = (xcd < r ? xcd * (q + 1) : r * (q + 1) + (xcd - r) * q) + off; }
        const int nig = WGM * nN, gid = wgid / nig, fm = gid * WGM, gsz = (nM - fm) < WGM ? (nM - fm) : WGM;
        u.pm = fm + ((wgid % nig) % gsz); u.pn = (wgid % nig) / gsz; return true;
    }
    __device__ __forceinline__ void a_ready(const Unit&) const {}
    __device__ __forceinline__ void done(const Unit&) const {}
};

__device__ __forceinline__ unsigned cvt_pk_bf16(float lo, float hi) { unsigned r; asm volatile("v_cvt_pk_bf16_f32 %0, %1, %2" : "=v"(r) : "v"(lo), "v"(hi)); return r; }
typedef float f32x2 __attribute__((ext_vector_type(2)));
__device__ __forceinline__ f32x2 gelu_pk(f32x2 v) {
    const f32x2 av = __builtin_elementwise_abs(v), d = av * 0.2316418882f + 1.0f;
    f32x2 t; t.x = __builtin_amdgcn_rcpf(d.x); t.y = __builtin_amdgcn_rcpf(d.y);
    f32x2 q = t * 0.5307027145f + (-0.7265760135f); q = q * t + 0.7107068705f; q = q * t + (-0.142248368f); q = q * t + 0.127414796f; q = q * t;
    const f32x2 s = (v * v) * (-0.72134752044f);
    f32x2 e; e.x = __builtin_amdgcn_exp2f(s.x); e.y = __builtin_amdgcn_exp2f(s.y);
    const f32x2 m = v * (q * e), r = v - m;
    f32x2 o; o.x = v.x < 0.f ? m.x : r.x; o.y = v.y < 0.f ? m.y : r.y; return o;
}

template <int ACT  > struct EpiBf16 {
    static constexpr bool PERM = true, AFTER_DRAIN = false; static_assert(ACT == 0 || ACT == 1, "EpiBf16: ACT is 0 (none) or 1 (gelu_pk)");
    bf16_t* O; int ldc; const float* bias; int split_cols; size_t split_stride; float scale0;
    __device__ __forceinline__ void operator()(const f32x4 (&acc)[2][2][4][2], const Unit& u, int wr, int wc, int fr, int fq) const {
        const int row0 = u.pm * BM + wr * 64 + fr; int colt = u.pn * BM; bf16_t* base = O;
        float sc = 1.f; if (split_cols) { const int t = colt / split_cols; base += (size_t)t * split_stride; colt -= t * split_cols; if (t == 0) sc = scale0; }
        const int col0 = colt + wc * 32 + 8 * fq, bcol0 = u.pn * BM + wc * 32 + 8 * fq;
        f32x4 bv[2][2];
#pragma unroll
        for (int bj = 0; bj < 2; ++bj)
#pragma unroll
            for (int n = 0; n < 2; ++n) bv[bj][n] = bias ? *(const f32x4*)(bias + bcol0 + bj * HALF + 4 * n) : (f32x4){0.f, 0.f, 0.f, 0.f};
#pragma unroll
        for (int ai = 0; ai < 2; ++ai)
#pragma unroll
            for (int m = 0; m < 4; ++m) { bf16_t* rowp = base + (size_t)(row0 + ai * HALF + m * 16) * ldc + col0;
#pragma unroll
                for (int bj = 0; bj < 2; ++bj) { f32x4 v0 = acc[ai][bj][m][0] + bv[bj][0], v1 = acc[ai][bj][m][1] + bv[bj][1];
                    if (ACT == 1) { f32x2 a = gelu_pk((f32x2){v0[0], v0[1]}), b = gelu_pk((f32x2){v0[2], v0[3]}), c = gelu_pk((f32x2){v1[0], v1[1]}), d = gelu_pk((f32x2){v1[2], v1[3]});
                        v0 = (f32x4){a.x, a.y, b.x, b.y}; v1 = (f32x4){c.x, c.y, d.x, d.y}; }
                    v0 = v0 * sc; v1 = v1 * sc; u32x4 w; w.x = cvt_pk_bf16(v0[0], v0[1]); w.y = cvt_pk_bf16(v0[2], v0[3]); w.z = cvt_pk_bf16(v1[0], v1[1]); w.w = cvt_pk_bf16(v1[2], v1[3]);
                    *(u32x4*)(rowp + bj * HALF) = w; } }
    }
};

struct PanelStats {
    unsigned* xbuf;
    unsigned* cnt;
    unsigned* tmo;
    int ntn; float eps;
    unsigned code;
    __device__ __forceinline__ bool run(const f32x4 (&v)[2][2][4][2], const Unit& u, int wr, int wc, int fr, int fq, PG8_LAS unsigned char* lds, int wid, int lane) const {
        typedef float f32x2v __attribute__((ext_vector_type(2)));
        PG8_LAS f32x2v* P = (PG8_LAS f32x2v*)lds;
        PG8_LAS f32x2v* S = (PG8_LAS f32x2v*)(lds + 8192);
        PG8_LAS unsigned* flag = (PG8_LAS unsigned*)(lds + 8192 + 2048);
#pragma unroll
        for (int ai = 0; ai < 2; ++ai)
#pragma unroll
            for (int m = 0; m < 4; ++m) {
                float s = 0.f;
#pragma unroll
                for (int bj = 0; bj < 2; ++bj)
#pragma unroll
                    for (int n = 0; n < 2; ++n) { const f32x4 x = v[ai][bj][m][n]; s += (x[0] + x[1]) + (x[2] + x[3]); }
                s += __shfl_xor(s, 16); s += __shfl_xor(s, 32);
                const float mw = s * (1.0f / 64.0f); float q = 0.f;
#pragma unroll
                for (int bj = 0; bj < 2; ++bj)
#pragma unroll
                    for (int n = 0; n < 2; ++n) { const f32x4 d = v[ai][bj][m][n] - mw; q += (d[0] * d[0] + d[1] * d[1]) + (d[2] * d[2] + d[3] * d[3]); }
                q += __shfl_xor(q, 16); q += __shfl_xor(q, 32);
                if (fq == 0) P[(ai * HALF + wr * 64 + m * 16 + fr) * 4 + wc] = (f32x2v){mw, q};
            }
        asm volatile("s_waitcnt lgkmcnt(0)" ::: "memory"); __builtin_amdgcn_s_barrier(); asm volatile("" ::: "memory");
#if defined(BROKEN_EXCHANGE_NO_WAIT)
#warning BROKEN CONTROL BUILD: the row-statistics exchange does not wait; results are wrong by design
        if (blockIdx.x >= 64) { const long long t0_ = clock64(); while (clock64() - t0_ < 60000) __builtin_amdgcn_s_sleep(8); }
#endif
        const int row = wid * 32 + (lane & 31);
        if (lane < 32) {
            const f32x2v a = P[row * 4 + 0], b = P[row * 4 + 1], c = P[row * 4 + 2], d = P[row * 4 + 3];
            const float mt = (a.x + b.x + c.x + d.x) * 0.25f;
            const float da = a.x - mt, db = b.x - mt, dc = c.x - mt, dd = d.x - mt;
            const float m2 = (a.y + b.y) + (c.y + d.y) + 64.0f * ((da * da + db * db) + (dc * dc + dd * dd));
            unsigned long long* slot = (unsigned long long*)xbuf + ((size_t)(u.pm * BM + row) * 4 + u.pn);
            __hip_atomic_store(slot, ((unsigned long long)__float_as_uint(m2) << 32) | __float_as_uint(mt), __ATOMIC_RELAXED, __HIP_MEMORY_SCOPE_AGENT);
        }
        asm volatile("s_waitcnt vmcnt(0)" ::: "memory");
        if (lane == 0) __hip_atomic_fetch_add(cnt + 64 * u.pm, 1u, __ATOMIC_RELAXED, __HIP_MEMORY_SCOPE_AGENT);
        if (wid == 0) {
            bool dead = false; const unsigned long long t0 = __builtin_amdgcn_s_memrealtime(); const unsigned want = 8u * (unsigned)ntn;
            for (;;) {
#if defined(BROKEN_EXCHANGE_NO_WAIT)
                break;
#endif
                if ((unsigned)__builtin_amdgcn_readfirstlane(__hip_atomic_load(cnt + 64 * u.pm, __ATOMIC_RELAXED, __HIP_MEMORY_SCOPE_AGENT)) >= want) break;
                if (__builtin_amdgcn_s_memrealtime() - t0 > 2000000ull) {
                    if (lane == 0) { unsigned expect = 0u; __hip_atomic_compare_exchange_strong(tmo + 1, &expect, code | (unsigned)(u.pm & 0xff), __ATOMIC_RELAXED, __ATOMIC_RELAXED, __HIP_MEMORY_SCOPE_AGENT);
                                     __hip_atomic_store(tmo, 1u, __ATOMIC_RELAXED, __HIP_MEMORY_SCOPE_AGENT); }
                    dead = true; break; }
                __builtin_amdgcn_s_sleep(2);
            }
            __builtin_amdgcn_fence(__ATOMIC_ACQUIRE, "agent");
            if (lane == 0) flag[0] = dead ? 1u : 0u;
        }
        asm volatile("s_waitcnt vmcnt(0) lgkmcnt(0)" ::: "memory"); __builtin_amdgcn_s_barrier(); asm volatile("" ::: "memory");
        const bool bad = flag[0] != 0u;
        if (lane < 32) {
            const unsigned long long* slot = (const unsigned long long*)xbuf + (size_t)(u.pm * BM + row) * 4; float mt[4], m2[4]; float ms = 0.f;
#pragma unroll
            for (int t = 0; t < 4; ++t) { if (t < ntn) { const unsigned long long w = __hip_atomic_load(slot + t, __ATOMIC_RELAXED, __HIP_MEMORY_SCOPE_AGENT); mt[t] = __uint_as_float((unsigned)w); m2[t] = __uint_as_float((unsigned)(w >> 32)); } else { mt[t] = 0.f; m2[t] = 0.f; } ms += mt[t]; }
            const float mean = ms / (float)ntn; float q = 0.f;
#pragma unroll
            for (int t = 0; t < 4; ++t) if (t < ntn) { const float dm = mt[t] - mean; q += m2[t] + 256.0f * dm * dm; }
            S[row] = (f32x2v){mean, 1.0f / sqrtf(q / (256.0f * (float)ntn) + eps)};
        }
        asm volatile("s_waitcnt lgkmcnt(0)" ::: "memory"); __builtin_amdgcn_s_barrier(); asm volatile("" ::: "memory");
        return bad;
    }
};
struct EpiLnRes {
    static constexpr bool PERM = false, AFTER_DRAIN = true;
    const float* base; float* out; int ldc; const float* bias; PanelStats st; unsigned poison;
    __device__ __forceinline__ void fused(f32x4 (&acc)[2][2][4][2], const Unit& u, int wr, int wc, int fr, int fq, PG8_LAS unsigned char* lds, int wid, int lane) const {
        typedef float f32x2v __attribute__((ext_vector_type(2)));
        const PG8_LAS f32x2v* S = (const PG8_LAS f32x2v*)(lds + 8192);
        const int col0 = u.pn * BM + wc * 32 + 4 * fq;
#pragma unroll
        for (int bj = 0; bj < 2; ++bj)
#pragma unroll
            for (int n = 0; n < 2; ++n) { const f32x4 bv = bias ? *(const f32x4*)(bias + col0 + bj * HALF + n * 16) : (f32x4){0.f, 0.f, 0.f, 0.f};
#pragma unroll
                for (int ai = 0; ai < 2; ++ai)
#pragma unroll
                    for (int m = 0; m < 4; ++m) acc[ai][bj][m][n] += bv; }
        f32x4 pre[4][2][2];
#pragma unroll
        for (int m = 0; m < 4; ++m) { const size_t off = (size_t)(u.pm * BM + wr * 64 + m * 16 + fr) * ldc + col0;
#pragma unroll
            for (int bj = 0; bj < 2; ++bj)
#pragma unroll
                for (int n = 0; n < 2; ++n) pre[m][bj][n] = *(const f32x4*)(base + off + bj * HALF + n * 16); }
        const bool bad = st.run(acc, u, wr, wc, fr, fq, lds, wid, lane) || poison != 0u;
        const float qnan = __builtin_nanf("");
#pragma unroll
        for (int ai = 0; ai < 2; ++ai)
#pragma unroll
            for (int m = 0; m < 4; ++m) { const int r = ai * HALF + wr * 64 + m * 16 + fr; const f32x2v sr = S[r]; const size_t off = (size_t)(u.pm * BM + r) * ldc + col0;
#pragma unroll
                for (int bj = 0; bj < 2; ++bj)
#pragma unroll
                    for (int n = 0; n < 2; ++n) { const f32x4 bs = ai == 0 ? pre[m][bj][n] : *(const f32x4*)(base + off + bj * HALF + n * 16); f32x4 o = bs + (acc[ai][bj][m][n] - sr.x) * sr.y;
                        if (bad) o = (f32x4){qnan, qnan, qnan, qnan}; *(f32x4*)(out + off + bj * HALF + n * 16) = o; }
                if (m & 1) asm volatile("" ::: "memory"); }
    }
};
struct EpiLnResLn {
    static constexpr bool PERM = false, AFTER_DRAIN = true;
    const float* base; float* out; bf16_t* xn; int ldc; const float* bias; PanelStats st1, st2; unsigned poison;
    __device__ __forceinline__ void fused(f32x4 (&acc)[2][2][4][2], const Unit& u, int wr, int wc, int fr, int fq, PG8_LAS unsigned char* lds, int wid, int lane) const {
        typedef float f32x2v __attribute__((ext_vector_type(2))); typedef unsigned u32x2v __attribute__((ext_vector_type(2)));
        const PG8_LAS f32x2v* S = (const PG8_LAS f32x2v*)(lds + 8192);
        const int col0 = u.pn * BM + wc * 32 + 4 * fq;
#pragma unroll
        for (int bj = 0; bj < 2; ++bj)
#pragma unroll
            for (int n = 0; n < 2; ++n) { const f32x4 bv = bias ? *(const f32x4*)(bias + col0 + bj * HALF + n * 16) : (f32x4){0.f, 0.f, 0.f, 0.f};
#pragma unroll
                for (int ai = 0; ai < 2; ++ai)
#pragma unroll
                    for (int m = 0; m < 4; ++m) acc[ai][bj][m][n] += bv; }
        bool bad = st1.run(acc, u, wr, wc, fr, fq, lds, wid, lane) || poison != 0u;
        const float qnan = __builtin_nanf("");
#pragma unroll
        for (int ai = 0; ai < 2; ++ai)
#pragma unroll
            for (int m = 0; m < 4; ++m) { const int r = ai * HALF + wr * 64 + m * 16 + fr; const f32x2v sr = S[r]; const size_t off = (size_t)(u.pm * BM + r) * ldc + col0;
#pragma unroll
                for (int bj = 0; bj < 2; ++bj)
#pragma unroll
                    for (int n = 0; n < 2; ++n) { const f32x4 bs = *(const f32x4*)(base + off + bj * HALF + n * 16); acc[ai][bj][m][n] = bs + (acc[ai][bj][m][n] - sr.x) * sr.y; }
                asm volatile("" : "+v"(acc[ai][0][m][0]), "+v"(acc[ai][0][m][1]), "+v"(acc[ai][1][m][0]), "+v"(acc[ai][1][m][1]));
                if (m & 1) asm volatile("" ::: "memory"); }
        const bool bad1 = bad;
        bad = st2.run(acc, u, wr, wc, fr, fq, lds, wid, lane) || bad;
#pragma unroll
        for (int ai = 0; ai < 2; ++ai)
#pragma unroll
            for (int m = 0; m < 4; ++m) { const int r = ai * HALF + wr * 64 + m * 16 + fr; const f32x2v sr = S[r]; const size_t off = (size_t)(u.pm * BM + r) * ldc + col0;
#pragma unroll
                for (int bj = 0; bj < 2; ++bj)
#pragma unroll
                    for (int n = 0; n < 2; ++n) { const f32x4 x1 = acc[ai][bj][m][n]; *(f32x4*)(out + off + bj * HALF + n * 16) = bad1 ? (f32x4){qnan, qnan, qnan, qnan} : x1;
                        const f32x4 o = (x1 - sr.x) * sr.y; u32x2v w; w.x = cvt_pk_bf16(o[0], o[1]); w.y = cvt_pk_bf16(o[2], o[3]);
                        if (bad) { w.x = 0x7fc07fc0u; w.y = 0x7fc07fc0u; } *(u32x2v*)(xn + off + bj * HALF + n * 16) = w; }
                asm volatile("" ::: "memory"); }
    }
};

template <class Epi, class Sched, bool ALIGN_EPI = false, bool SP2 = false>
__device__ __forceinline__ void gemm_phase(PG8_LAS unsigned char* lds, const Gemm g, const Sched& S, const Epi& E) {
    const int tid = threadIdx.x, wid = __builtin_amdgcn_readfirstlane(tid >> 6), lane = tid & 63, wr = wid >> 2, wc = wid & 3, fr = lane & 15, fq = lane >> 4;
    const int K = g.K, nt = K / BK;
    unsigned voffA[2], voffB[2];
#pragma unroll
    for (int i = 0; i < 2; ++i) { int R, C; stage_rc(tid * 16 + i * 8192, R, C); const int Rb = Epi::PERM ? ((R & ~31) + perm32(R & 31)) : R;
        voffA[i] = (unsigned)(R * K + C) * 2u; voffB[i] = (unsigned)(Rb * K + C) * 2u; }
    const size_t kstep = (size_t)(BK * 2);
    const size_t hstep = (size_t)HALF * K * 2;
    const size_t tstep = 2 * hstep;
    const unsigned ldsw = (unsigned)wid * 1024u;
    const int aoff = lds_byte(wr * 64 + fr, fq * 8), boff = lds_byte(wc * 32 + fr, fq * 8);
#define PG8_SA(b, h) (((b) * 2 + (h)) * HTB)
#define PG8_SB(b, h) ((4 + (b) * 2 + (h)) * HTB)
#define PG8_STAGE(bufoff, gbase, voff) do { _Pragma("unroll") for (int _i = 0; _i < 2; ++_i) \
        __builtin_amdgcn_global_load_lds((const unsigned*)((const char*)(gbase) + (voff)[_i]), (PG8_LAS unsigned*)(lds + (bufoff) + ldsw + _i * 8192), 16, 0, 0); } while (0)
#define PG8_LDA(dst, b, h) do { _Pragma("unroll") for (int m = 0; m < 4; ++m) _Pragma("unroll") for (int k = 0; k < 2; ++k) dst[m][k] = *(const PG8_LAS bf16x8*)(lds + PG8_SA(b, h) + aoff + m * 2048 + k * 1024); } while (0)
#define PG8_LDB(dst, b, h) do { _Pragma("unroll") for (int n = 0; n < 2; ++n) _Pragma("unroll") for (int k = 0; k < 2; ++k) dst[n][k] = *(const PG8_LAS bf16x8*)(lds + PG8_SB(b, h) + boff + n * 2048 + k * 1024); } while (0)
#define PG8_MMA(ai, bj, At, Bt) do { __builtin_amdgcn_s_setprio(1); _Pragma("unroll") for (int m = 0; m < 4; ++m) _Pragma("unroll") for (int n = 0; n < 2; ++n) _Pragma("unroll") for (int k = 0; k < 2; ++k) \
        acc[ai][bj][m][n] = __builtin_amdgcn_mfma_f32_16x16x32_bf16(Bt[n][k], At[m][k], acc[ai][bj][m][n], 0, 0, 0); __builtin_amdgcn_s_setprio(0); } while (0)
#define PG8_WAIT_V(n) asm volatile("s_waitcnt vmcnt(" #n ")" ::: "memory")
#define PG8_WAIT_L(n) asm volatile("s_waitcnt lgkmcnt(" #n ")" ::: "memory")
#define PG8_BAR __builtin_amdgcn_s_barrier()
#define PG8_SCHED __builtin_amdgcn_sched_barrier(0)
    Unit cur, nxt; int ui = 0;
    if (!S.next(0, cur)) return;
    f32x4 acc[2][2][4][2];
#pragma unroll
    for (int a = 0; a < 2; ++a)
#pragma unroll
        for (int b = 0; b < 2; ++b)
#pragma unroll
            for (int m = 0; m < 4; ++m)
#pragma unroll
                for (int n = 0; n < 2; ++n) acc[a][b][m][n] = (f32x4){0.f, 0.f, 0.f, 0.f};
    bf16x8 At[4][2], B0[2][2], B1[2][2];
    const char* cA = (const char*)g.A + (size_t)cur.pm * tstep; const char* cB = (const char*)g.Bt + (size_t)cur.pn * tstep;
    S.a_ready(cur);
    if constexpr (SP2) {
        PG8_STAGE(PG8_SB(0, 0), cB, voffB); PG8_STAGE(PG8_SB(0, 1), cB + hstep, voffB); PG8_STAGE(PG8_SA(0, 0), cA, voffA); PG8_STAGE(PG8_SA(0, 1), cA + hstep, voffA);
        if (wr == 1) PG8_BAR;
        PG8_WAIT_V(2); PG8_BAR;
        PG8_STAGE(PG8_SB(1, 0), cB + kstep, voffB); PG8_STAGE(PG8_SA(1, 0), cA + kstep, voffA); PG8_STAGE(PG8_SB(1, 1), cB + hstep + kstep, voffB);
        PG8_WAIT_V(6); PG8_BAR;
    } else {
        PG8_STAGE(PG8_SB(0, 0), cB, voffB); PG8_STAGE(PG8_SA(0, 0), cA, voffA); PG8_STAGE(PG8_SB(0, 1), cB + hstep, voffB); PG8_STAGE(PG8_SA(0, 1), cA + hstep, voffA);
        if (wr == 1) PG8_BAR;
        PG8_WAIT_V(4); PG8_BAR;
        PG8_STAGE(PG8_SB(1, 0), cB + kstep, voffB); PG8_STAGE(PG8_SA(1, 0), cA + kstep, voffA); PG8_STAGE(PG8_SB(1, 1), cB + hstep + kstep, voffB);
        PG8_WAIT_V(6); PG8_BAR;
    }
    for (;;) {
        const bool has_next = S.next(ui + 1, nxt);
        const char* nA = has_next ? (const char*)g.A + (size_t)nxt.pm * tstep : cA; const char* nB = has_next ? (const char*)g.Bt + (size_t)nxt.pn * tstep : cB;
        for (int t = 0; t < nt; t += 2) {
            const bool last = (t == nt - 2);
            const char* a1 = cA + (size_t)(t + 1) * kstep;
            const char* a2 = last ? nA : cA + (size_t)(t + 2) * kstep; const char* b2 = last ? nB : cB + (size_t)(t + 2) * kstep;
            const char* a3 = a2 + kstep; const char* b3 = b2 + kstep;
            if (last && has_next) S.a_ready(nxt);
            if constexpr (SP2) {
            PG8_LDB(B0, 0, 0); PG8_LDB(B1, 0, 1); PG8_SCHED; PG8_LDA(At, 0, 0); PG8_STAGE(PG8_SA(1, 1), a1 + hstep, voffA);
            PG8_WAIT_V(8); PG8_WAIT_L(0); PG8_BAR; PG8_MMA(0, 0, At, B0); PG8_MMA(0, 1, At, B1); PG8_BAR; PG8_SCHED;
            PG8_LDA(At, 0, 1); PG8_STAGE(PG8_SB(0, 0), b2, voffB); PG8_STAGE(PG8_SB(0, 1), b2 + hstep, voffB); PG8_STAGE(PG8_SA(0, 0), a2, voffA);
            PG8_WAIT_V(8); PG8_WAIT_L(0); PG8_BAR; PG8_MMA(1, 0, At, B0); PG8_MMA(1, 1, At, B1); PG8_BAR; PG8_SCHED;
            PG8_LDB(B0, 1, 0); PG8_LDB(B1, 1, 1); PG8_SCHED; PG8_LDA(At, 1, 0); PG8_STAGE(PG8_SA(0, 1), a2 + hstep, voffA);
            PG8_WAIT_V(8); PG8_WAIT_L(0); PG8_BAR; PG8_MMA(0, 0, At, B0); PG8_MMA(0, 1, At, B1); PG8_BAR; PG8_SCHED;
            PG8_LDA(At, 1, 1); PG8_STAGE(PG8_SB(1, 0), b3, voffB); PG8_STAGE(PG8_SB(1, 1), b3 + hstep, voffB); PG8_STAGE(PG8_SA(1, 0), a3, voffA);
            PG8_WAIT_V(8); PG8_WAIT_L(0); PG8_BAR; PG8_MMA(1, 0, At, B0); PG8_MMA(1, 1, At, B1); PG8_BAR; PG8_SCHED;
            } else {
            PG8_LDB(B0, 0, 0); PG8_SCHED; PG8_LDA(At, 0, 0); PG8_STAGE(PG8_SA(1, 1), a1 + hstep, voffA);
            PG8_WAIT_L(8); PG8_BAR; PG8_WAIT_L(0); PG8_MMA(0, 0, At, B0); PG8_BAR; PG8_SCHED;
            PG8_LDB(B1, 0, 1); PG8_STAGE(PG8_SB(0, 0), b2, voffB);
            PG8_BAR; PG8_WAIT_L(0); PG8_MMA(0, 1, At, B1); PG8_BAR;
            PG8_LDA(At, 0, 1); PG8_STAGE(PG8_SA(0, 0), a2, voffA);
            PG8_BAR; PG8_WAIT_L(0); PG8_MMA(1, 0, At, B0); PG8_BAR; PG8_SCHED;
            PG8_STAGE(PG8_SB(0, 1), b2 + hstep, voffB);
            PG8_WAIT_V(6); PG8_BAR; PG8_MMA(1, 1, At, B1); PG8_BAR;
            PG8_LDB(B0, 1, 0); PG8_SCHED; PG8_LDA(At, 1, 0); PG8_STAGE(PG8_SA(0, 1), a2 + hstep, voffA);
            PG8_WAIT_L(8); PG8_BAR; PG8_WAIT_L(0); PG8_MMA(0, 0, At, B0); PG8_BAR; PG8_SCHED;
            PG8_LDB(B1, 1, 1); PG8_STAGE(PG8_SB(1, 0), b3, voffB);
            PG8_BAR; PG8_WAIT_L(0); PG8_MMA(0, 1, At, B1); PG8_BAR;
            PG8_LDA(At, 1, 1); PG8_STAGE(PG8_SA(1, 0), a3, voffA);
            PG8_BAR; PG8_WAIT_L(0); PG8_MMA(1, 0, At, B0); PG8_BAR; PG8_SCHED;
            PG8_STAGE(PG8_SB(1, 1), b3 + hstep, voffB);
            PG8_WAIT_V(6); PG8_BAR; PG8_MMA(1, 1, At, B1); PG8_BAR;
            }
        }
        if constexpr (ALIGN_EPI) { if (wr == 0) PG8_BAR; }
        if constexpr (!Epi::AFTER_DRAIN) { E(acc, cur, wr, wc, fr, fq); S.done(cur); }
        if (!has_next) break;
#pragma unroll
        for (int a = 0; a < 2; ++a)
#pragma unroll
            for (int b = 0; b < 2; ++b)
#pragma unroll
                for (int m = 0; m < 4; ++m)
#pragma unroll
                    for (int n = 0; n < 2; ++n) acc[a][b][m][n] = (f32x4){0.f, 0.f, 0.f, 0.f};
        cur = nxt; cA = nA; cB = nB; ++ui;
        if constexpr (ALIGN_EPI) { if (wr == 1) PG8_BAR; }
    }
    PG8_WAIT_V(0);
    if constexpr (!ALIGN_EPI) { if (wr == 0) PG8_BAR; }
    PG8_BAR;
    if constexpr (Epi::AFTER_DRAIN) { E.fused(acc, cur, wr, wc, fr, fq, lds, wid, lane); S.done(cur); }
#undef PG8_SA
#undef PG8_SB
#undef PG8_STAGE
#undef PG8_LDA
#undef PG8_LDB
#undef PG8_MMA
#undef PG8_WAIT_V
#undef PG8_WAIT_L
#undef PG8_BAR
#undef PG8_SCHED
}
}
namespace pg8 {
__device__ __forceinline__ float fast_silu(float x) { return x * __builtin_amdgcn_rcpf(1.0f + __builtin_amdgcn_exp2f(-1.44269504089f * x)); }
struct EpiResGate {
    static constexpr bool PERM = false, AFTER_DRAIN = false;
    const float* base; float* out; int ldc; const float* gate; int gate_ld; int tiles_per_batch;
    __device__ __forceinline__ void operator()(const f32x4 (&acc)[2][2][4][2], const Unit& u, int wr, int wc, int fr, int fq) const {
        const int row0 = u.pm * BM + wr * 64 + fr, col0 = u.pn * BM + wc * 32 + 4 * fq;
        const float* gp = gate + (size_t)(u.pm / tiles_per_batch) * gate_ld + col0;
        f32x4 gv[2][2];
#pragma unroll
        for (int bj = 0; bj < 2; ++bj)
#pragma unroll
            for (int n = 0; n < 2; ++n) gv[bj][n] = *(const f32x4*)(gp + bj * HALF + n * 16);
#pragma unroll
        for (int ai = 0; ai < 2; ++ai)
#pragma unroll
            for (int m = 0; m < 4; ++m) { const size_t off = (size_t)(row0 + ai * HALF + m * 16) * ldc + col0;
#pragma unroll
                for (int bj = 0; bj < 2; ++bj)
#pragma unroll
                    for (int n = 0; n < 2; ++n) { const f32x4 b = *(const f32x4*)(base + off + bj * HALF + n * 16); *(f32x4*)(out + off + bj * HALF + n * 16) = b + gv[bj][n] * acc[ai][bj][m][n]; } }
    }
};
struct EpiSwiGLU {
    static constexpr bool PERM = true, AFTER_DRAIN = false;
    bf16_t* O; int ldc;
    __device__ __forceinline__ void operator()(const f32x4 (&acc)[2][2][4][2], const Unit& u, int wr, int wc, int fr, int fq) const {
        const int row0 = u.pm * BM + wr * 64 + fr, col0 = u.pn * HALF + wc * 32 + 8 * fq;
#pragma unroll
        for (int ai = 0; ai < 2; ++ai)
#pragma unroll
            for (int m = 0; m < 4; ++m) { bf16_t* rowp = O + (size_t)(row0 + ai * HALF + m * 16) * ldc + col0;
                const f32x4 g0 = acc[ai][0][m][0], g1 = acc[ai][0][m][1], u0 = acc[ai][1][m][0], u1 = acc[ai][1][m][1];
                u32x4 w; w.x = cvt_pk_bf16(fast_silu(g0[0]) * u0[0], fast_silu(g0[1]) * u0[1]); w.y = cvt_pk_bf16(fast_silu(g0[2]) * u0[2], fast_silu(g0[3]) * u0[3]);
                w.z = cvt_pk_bf16(fast_silu(g1[0]) * u1[0], fast_silu(g1[1]) * u1[1]); w.w = cvt_pk_bf16(fast_silu(g1[2]) * u1[2], fast_silu(g1[3]) * u1[3]);
                *(u32x4*)rowp = w; }
    }
};
}
#ifndef PG8_SP2
#define PG8_SP2 true
#endif
#ifndef PG8_ALIGN
#define PG8_ALIGN true
#endif
constexpr int NWAVES = 8;
#ifndef MK_ONE_LAUNCH
#define MK_ONE_LAUNCH 0
#endif
constexpr int N_PHASES = 10;

constexpr int BATCH = 8, SEQ = 2048, D = 1024, M = BATCH * SEQ;
constexpr int CW = 512, GW = 512, NH = 4, HD = 128, NIN = 3080, NIN_G = 3072, FF = 2816, NMOD = 6;
constexpr int CONVK = 31, CL = 64;
constexpr float EPS = 1e-6f;
constexpr int PC_A = 0, PC_GATE = 512, PC_Q = 1024, PC_K = 1536, PC_V = 2048, PC_Z = 2560;

constexpr size_t MiB = 1u << 20;
constexpr size_t WS_CTL = 0, CTL_ZERO_BYTES = 1 * MiB;
constexpr size_t WS_MOD = 1 * MiB;
constexpr size_t WS_BG = 1 * MiB + 512 * 1024;
constexpr size_t WS_WIN = 2 * MiB, WS_WOUT = 8 * MiB, WS_WFI = 10 * MiB, WS_WFO = 21 * MiB;
constexpr size_t WS_XN = 28 * MiB;
constexpr size_t WS_P = 60 * MiB;
constexpr size_t WS_HID = 60 * MiB;
constexpr size_t WS_MIXIN = 156 * MiB;
constexpr size_t WS_QN = 188 * MiB, WS_KN = 220 * MiB, WS_VN = 28 * MiB;
constexpr size_t WS_END = 256 * MiB;
constexpr int CW_BAR = 4096;

constexpr int RING_OFF = 0, RING_BYTES = 131072;
constexpr int EXTRA_OFF = RING_BYTES, EXTRA_BYTES = 16384;
constexpr int LDSCTL_OFF = EXTRA_OFF + EXTRA_BYTES, MISC_OFF = LDSCTL_OFF + 320;
constexpr int LDS_BYTES = 163840;
static_assert(MISC_OFF + 128 <= LDS_BYTES, "LDS map");
#define GAS __attribute__((address_space(1)))
#define LAS __attribute__((address_space(3)))
typedef unsigned short bf16;
typedef unsigned v4u __attribute__((ext_vector_type(4)));
typedef float f32x4 __attribute__((ext_vector_type(4)));
typedef short bf16x8 __attribute__((ext_vector_type(8)));
typedef GAS unsigned gu32;
typedef GAS unsigned long long gu64;
#define RLX_AGENT __ATOMIC_RELAXED, __HIP_MEMORY_SCOPE_AGENT
#define LDS_WAIT() asm volatile("s_waitcnt lgkmcnt(0)" ::: "memory")
#define VM_WAIT() asm volatile("s_waitcnt vmcnt(0)" ::: "memory")
__device__ __forceinline__ unsigned long long rt() { return __builtin_amdgcn_s_memrealtime(); }
__device__ __forceinline__ unsigned f2bf(float f) { unsigned u = __builtin_bit_cast(unsigned, f); return (u + 0x7fffu + ((u >> 16) & 1u)) >> 16; }
__device__ __forceinline__ unsigned pk2(float lo, float hi) { return f2bf(lo) | (f2bf(hi) << 16); }

#define XB_TMO      128
#define XB_XCNT(j)  (256  + 64 * (j))
#define XB_XSUB(j)  (1280 + 64 * (j))
#define XB_XGEN(j)  (2304 + 64 * (j))
#define XB_TOP      3328
#define XB_TOPGEN   3392
#define XCD_BAR_WORDS 3456
#define XB_SPIN_CAP (1u << 18)

__device__ __forceinline__ unsigned xb_ld(unsigned* p)              { return __hip_atomic_load(p, __ATOMIC_RELAXED, __HIP_MEMORY_SCOPE_AGENT); }
__device__ __forceinline__ unsigned xb_add(unsigned* p, unsigned v) { return __hip_atomic_fetch_add(p, v, __ATOMIC_RELAXED, __HIP_MEMORY_SCOPE_AGENT); }
__device__ __forceinline__ unsigned xb_xcc_id() { return (unsigned)__builtin_amdgcn_s_getreg((3 << 11) | 20) & 0xFu; }
#define XB_SPIN(cond, bar) do { unsigned _sp = 0; while (cond) { __builtin_amdgcn_s_sleep(1); \
    if ((++_sp & 255u) == 0u) { if (xb_ld(&(bar)[XB_TMO])) break; if (_sp > XB_SPIN_CAP) { atomicAdd(&(bar)[XB_TMO], 1u); break; } } } } while (0)

struct XcdBarrier {
    unsigned* bar; unsigned x;
    volatile LAS unsigned* st;
};

__device__ __forceinline__ XcdBarrier xcd_barrier_post(unsigned* bar, volatile LAS unsigned* st) {
    XcdBarrier b; b.bar = bar; b.x = xb_xcc_id(); b.st = st;
    if (threadIdx.x == 0) (void)xb_add(&bar[XB_XCNT(b.x)], 1u);
    return b;
}
__device__ __forceinline__ void xcd_barrier_complete(unsigned* bar, unsigned x, unsigned& nloc, unsigned& nx) {
    const unsigned G = gridDim.x * gridDim.y * gridDim.z;
    unsigned sum, cnt, mine, sp = 0u;
    for (;;) {
        sum = 0u; cnt = 0u; mine = 0u;
#pragma unroll
        for (unsigned j = 0; j < 16; ++j) { const unsigned c = xb_ld(&bar[XB_XCNT(j)]); sum += c; cnt += (c > 0u) ? 1u : 0u; mine = (j == x) ? c : mine; }
        if (sum == G) break;
        __builtin_amdgcn_s_sleep(1);
        if ((++sp & 255u) == 0u) { if (xb_ld(&bar[XB_TMO])) break; if (sp > XB_SPIN_CAP) { atomicAdd(&bar[XB_TMO], 1u); break; } }
    }
    nloc = mine > 0u ? mine : 1u; nx = cnt > 0u ? cnt : 1u;
}

__device__ __forceinline__ void xcd_barrier(const XcdBarrier& b) {
    asm volatile("s_waitcnt vmcnt(0)" ::: "memory");
    __syncthreads();
    if (threadIdx.x == 0) {
        unsigned* bar = b.bar;
        __builtin_amdgcn_s_waitcnt(0);
        unsigned nloc = b.st[0], nx = b.st[1];
        if (nloc == 0u) { xcd_barrier_complete(bar, b.x, nloc, nx); b.st[0] = nloc; b.st[1] = nx; }
        const unsigned old = xb_add(&bar[XB_XSUB(b.x)], 1u);
        const unsigned gen = old / nloc;
        if (old + 1u == (gen + 1u) * nloc) {
            __builtin_amdgcn_fence(__ATOMIC_RELEASE, "agent");
            asm volatile("s_waitcnt vmcnt(0)" ::: "memory");
            const unsigned og = xb_add(&bar[XB_TOP], 1u);
            const unsigned tg = og / nx;
            if (og + 1u == (tg + 1u) * nx) xb_add(&bar[XB_TOPGEN], 1u);
            else XB_SPIN(xb_ld(&bar[XB_TOPGEN]) == tg, bar);
            __builtin_amdgcn_fence(__ATOMIC_ACQUIRE, "agent");
            xb_add(&bar[XB_XGEN(b.x)], 1u);
            asm volatile("s_waitcnt vmcnt(0)" ::: "memory");
        } else {
            XB_SPIN(xb_ld(&bar[XB_XGEN(b.x)]) == gen, bar);
            __builtin_amdgcn_fence(__ATOMIC_ACQUIRE, "agent");
            asm volatile("s_waitcnt vmcnt(0)" ::: "memory");
        }
    }
    __syncthreads();
}
struct Frame {
    LAS unsigned char* lds;
    volatile LAS unsigned* MISC;
    gu32* ctl;
    int tid, lane, wave;
    int vcu, G;
    const float* in[19]; float* out; unsigned char* ws;
};
typedef float f32x2 __attribute__((ext_vector_type(2)));
__device__ __forceinline__ float wave_sum(float v) {
#pragma unroll
    for (int o = 1; o < 64; o <<= 1) v += __shfl_xor(v, o);
    return v;
}
__device__ __forceinline__ float bf_lo(unsigned u) { return __builtin_bit_cast(float, u << 16); }
__device__ __forceinline__ float bf_hi(unsigned u) { return __builtin_bit_cast(float, u & 0xffff0000u); }
__device__ __forceinline__ float sigmoidf_(float x) { return 1.0f / (1.0f + __expf(-x)); }
__device__ __forceinline__ float siluf_(float x) { return x / (1.0f + __expf(-x)); }

__device__ __forceinline__ void transpose_item(const float* W, int ldw, int k0, int n_src, bf16* WT, int K, int n_dst, LAS float* scr, int lane) {
#pragma unroll 8
    for (int i = 0; i < 32; ++i) { const int kk = 2 * i + (lane >> 5); scr[kk * 33 + (lane & 31)] = W[(size_t)(k0 + kk) * ldw + n_src + (lane & 31)]; }
    LDS_WAIT(); asm volatile("" ::: "memory");
    const int c = lane & 7;
#pragma unroll
    for (int j = 0; j < 4; ++j) { const int n = (lane >> 3) + 8 * j; const LAS float* s = scr + (8 * c) * 33 + n;
        v4u o; o.x = pk2(s[0 * 33], s[1 * 33]); o.y = pk2(s[2 * 33], s[3 * 33]); o.z = pk2(s[4 * 33], s[5 * 33]); o.w = pk2(s[6 * 33], s[7 * 33]);
        *(GAS v4u*)(WT + (size_t)(n_dst + n) * K + k0 + 8 * c) = o; }
    LDS_WAIT(); asm volatile("" ::: "memory");
}
__device__ __forceinline__ void p0_prologue(Frame& F) {
    const float* c = F.in[1]; const float* w_ada = F.in[2]; const float* b_ada = F.in[3];
    float* MOD = (float*)(F.ws + WS_MOD);
    for (int item = blockIdx.x; item < (NMOD * D) / 32; item += F.G) {
        LAS float* cs = (LAS float*)(F.lds + RING_OFF);
        LAS float* red = (LAS float*)(F.lds + RING_OFF + 32768);
        for (int i = F.tid; i < BATCH * D; i += NWAVES * 64) cs[i] = siluf_(c[i]);
        __syncthreads();
        const int n0 = 32 * item, col = F.lane & 31, kp = F.lane >> 5;
        float acc[8];
#pragma unroll
        for (int b = 0; b < 8; ++b) acc[b] = 0.f;
#pragma unroll 8
        for (int i = 0; i < 64; ++i) { const int k = 128 * F.wave + 2 * i + kp; const float wv = w_ada[(size_t)k * (NMOD * D) + n0 + col];
#pragma unroll
            for (int b = 0; b < 8; ++b) acc[b] += cs[b * D + k] * wv; }
#pragma unroll
        for (int b = 0; b < 8; ++b) { acc[b] += __shfl_xor(acc[b], 32); if (F.lane < 32) red[(F.wave * 8 + b) * 32 + col] = acc[b]; }
        __syncthreads();
        if (F.tid < 256) { const int b = F.tid >> 5, cc = F.tid & 31; float s = b_ada[n0 + cc];
#pragma unroll
            for (int w = 0; w < 8; ++w) s += red[(w * 8 + b) * 32 + cc];
            MOD[b * (NMOD * D) + n0 + cc] = s; }
        __syncthreads();
    }
    LAS float* scr = (LAS float*)(F.lds + RING_OFF + F.wave * 16384);
    const int gw = F.vcu * NWAVES + F.wave, NGW = F.G * NWAVES;
    constexpr int I_IN = (D / 64) * (NIN_G / 32), I_OUT = (D / 64) * (D / 32), I_FI = (D / 64) * (2 * FF / 32), I_FO = (FF / 64) * (D / 32);
    constexpr int NITEMS = I_IN + I_OUT + I_FI + I_FO;
    bf16* WIN = (bf16*)(F.ws + WS_WIN); bf16* WOUT = (bf16*)(F.ws + WS_WOUT); bf16* WFI = (bf16*)(F.ws + WS_WFI); bf16* WFO = (bf16*)(F.ws + WS_WFO);
    for (int it = gw; it < NITEMS; it += NGW) {
        int r = it;
        if (r < I_IN) { const int nblk = NIN_G / 32, kb = r / nblk, nb = r % nblk; transpose_item(F.in[5], NIN, 64 * kb, 32 * nb, WIN, D, 32 * nb, scr, F.lane); continue; } r -= I_IN;
        if (r < I_OUT) { const int nblk = D / 32, kb = r / nblk, nb = r % nblk; transpose_item(F.in[14], D, 64 * kb, 32 * nb, WOUT, D, 32 * nb, scr, F.lane); continue; } r -= I_OUT;
        if (r < I_FI) { const int nblk = 2 * FF / 32, kb = r / nblk, nb = r % nblk; const int nd = 32 * nb, t = nd >> 8, rr = nd & 255;
            const int ns = rr < 128 ? t * 128 + rr : FF + t * 128 + (rr - 128);
            transpose_item(F.in[16], 2 * FF, 64 * kb, ns, WFI, D, nd, scr, F.lane); continue; } r -= I_FI;
        { const int nblk = D / 32, kb = r / nblk, nb = r % nblk; transpose_item(F.in[17], D, 64 * kb, 32 * nb, WFO, FF, 32 * nb, scr, F.lane); }
    }
}

template <bool WITH_BA>
__device__ __forceinline__ void norm_mod_phase(Frame& F, const float* src, const float* nw, const float* shift, const float* scale, bf16* dst) {
    const int gw = F.vcu * NWAVES + F.wave, NGW = F.G * NWAVES;
    constexpr int RPW = 8;
    f32x4 w8a[WITH_BA ? 16 : 1], w8b[WITH_BA ? 16 : 1];
    if (WITH_BA) {
        const float* w_in = F.in[5];
#pragma unroll
        for (int j = 0; j < 4; ++j)
#pragma unroll
            for (int e = 0; e < 4; ++e) { const int k = 4 * F.lane + 256 * j + e; w8a[j * 4 + e] = *(const f32x4*)(w_in + (size_t)k * NIN + NIN_G); w8b[j * 4 + e] = *(const f32x4*)(w_in + (size_t)k * NIN + NIN_G + 4); }
    }
    for (int it = gw; it < M / RPW; it += NGW) {
        const int m0 = it * RPW, b = m0 / SEQ;
        f32x4 wv[4], sv[4];
#pragma unroll
        for (int j = 0; j < 4; ++j) { const int cidx = 4 * F.lane + 256 * j; const f32x4 n4 = *(const f32x4*)(nw + cidx), sc = *(const f32x4*)(scale + (size_t)b * (NMOD * D) + cidx);
            wv[j] = n4 * (sc + 1.0f); sv[j] = *(const f32x4*)(shift + (size_t)b * (NMOD * D) + cidx); }
        for (int r = 0; r < RPW; ++r) {
            const int m = m0 + r;
            const GAS f32x4* xr = (const GAS f32x4*)(src + (size_t)m * D) + F.lane;
            f32x4 v[4]; float s = 0.f;
#pragma unroll
            for (int j = 0; j < 4; ++j) { v[j] = xr[64 * j]; s += (v[j].x * v[j].x + v[j].y * v[j].y) + (v[j].z * v[j].z + v[j].w * v[j].w); }
            const float rstd = 1.0f / sqrtf(wave_sum(s) * (1.f / D) + EPS);
            GAS unsigned long long* o8 = (GAS unsigned long long*)(dst + (size_t)m * D) + F.lane;
#pragma unroll
            for (int j = 0; j < 4; ++j) { v[j] = v[j] * rstd * wv[j] + sv[j];
                o8[64 * j] = (unsigned long long)pk2(v[j].x, v[j].y) | ((unsigned long long)pk2(v[j].z, v[j].w) << 32); }
            if (WITH_BA) {
                f32x4 pa = {0.f, 0.f, 0.f, 0.f}, pb = {0.f, 0.f, 0.f, 0.f};
#pragma unroll
                for (int j = 0; j < 4; ++j) { pa += w8a[j * 4 + 0] * v[j].x + w8a[j * 4 + 1] * v[j].y + w8a[j * 4 + 2] * v[j].z + w8a[j * 4 + 3] * v[j].w;
                    pb += w8b[j * 4 + 0] * v[j].x + w8b[j * 4 + 1] * v[j].y + w8b[j * 4 + 2] * v[j].z + w8b[j * 4 + 3] * v[j].w; }
                float p[8] = {pa.x, pa.y, pa.z, pa.w, pb.x, pb.y, pb.z, pb.w};
#pragma unroll
                for (int q = 0; q < 8; ++q) p[q] = wave_sum(p[q]);
                const int l = F.lane & 7, h = l & 3;
                float mine = p[0];
#pragma unroll
                for (int q = 1; q < 8; ++q) mine = (l == q) ? p[q] : mine;
                const float a_log = F.in[11][h], dtb = F.in[12][h];
                const float xx = mine + dtb; const float sp = xx > 20.f ? xx : log1pf(expf(xx));
                const float val = (l < 4) ? 1.0f / (1.0f + expf(-mine)) : -expf(a_log) * sp;
                if (F.lane < 8) ((float*)(F.ws + WS_BG))[(size_t)m * 8 + l] = val;
            }
        }
    }
}

__device__ __forceinline__ void final_norm_phase(Frame& F, float* io, const float* nw) {
    const int gw = F.vcu * NWAVES + F.wave, NGW = F.G * NWAVES;
    f32x4 wv[4];
#pragma unroll
    for (int j = 0; j < 4; ++j) wv[j] = *(const f32x4*)(nw + 4 * F.lane + 256 * j);
    for (int m = gw; m < M; m += NGW) {
        GAS f32x4* xr = (GAS f32x4*)(io + (size_t)m * D) + F.lane;
        f32x4 v[4]; float s = 0.f;
#pragma unroll
        for (int j = 0; j < 4; ++j) { v[j] = xr[64 * j]; s += (v[j].x * v[j].x + v[j].y * v[j].y) + (v[j].z * v[j].z + v[j].w * v[j].w); }
        const float rstd = 1.0f / sqrtf(wave_sum(s) * (1.f / D) + EPS);
#pragma unroll
        for (int j = 0; j < 4; ++j) xr[64 * j] = v[j] * rstd * wv[j];
    }
}

__device__ __forceinline__ void conformer_phase(Frame& F) {
    const bf16* P = (const bf16*)(F.ws + WS_P); bf16* MIX = (bf16*)(F.ws + WS_MIXIN);
    const float* conv_w = F.in[6]; const float* conv_b = F.in[7]; const float* gn_w = F.in[8]; const float* gn_b = F.in[9];
    LAS float* ub = (LAS float*)(F.lds + RING_OFF);
    constexpr int NR = CL + CONVK - 1;
    for (int item = F.vcu; item < (M / CL) * 8; item += F.G) {
        const int tt = item >> 3, g = item & 7, m0 = tt * CL, t0 = m0 % SEQ;
        for (int idx = F.tid; idx < NR * 32; idx += NWAVES * 64) { const int r = idx >> 5, cp = idx & 31; const int t = t0 - (CONVK - 1) + r;
            float u0 = 0.f, u1 = 0.f;
            if (t >= 0) { const size_t off = (size_t)(m0 - (CONVK - 1) + r) * NIN_G + g * 64 + 2 * cp;
                const unsigned a2 = *(const unsigned*)(P + off + PC_A), g2 = *(const unsigned*)(P + off + PC_GATE);
                u0 = bf_lo(a2) * sigmoidf_(bf_lo(g2)); u1 = bf_hi(a2) * sigmoidf_(bf_hi(g2)); }
            *(LAS f32x2*)(ub + r * 64 + 2 * cp) = (f32x2){u0, u1}; }
        const int c = F.tid & 63, tb = F.tid >> 6, ch = g * 64 + c;
        float w[CONVK];
#pragma unroll
        for (int k = 0; k < CONVK; ++k) w[k] = conv_w[k * CW + ch];
        const float bias = conv_b[ch], gw_ = gn_w[ch], gb_ = gn_b[ch];
        __syncthreads();
        float acc[8];
#pragma unroll
        for (int i = 0; i < 8; ++i) acc[i] = bias;
#pragma unroll
        for (int k = 0; k < 8 + CONVK - 1; ++k) { const float uv = ub[(8 * tb + k) * 64 + c];
#pragma unroll
            for (int i = 0; i < 8; ++i) { const int tap = k - i; if (tap >= 0 && tap < CONVK) acc[i] += w[tap] * uv; } }
#pragma unroll
        for (int i = 0; i < 8; ++i) { const float mu = wave_sum(acc[i]) * (1.f / 64.f), d = acc[i] - mu, var = wave_sum(d * d) * (1.f / 64.f);
            const float y = d * (1.0f / sqrtf(var + EPS)) * gw_ + gb_;
            MIX[(size_t)(m0 + 8 * tb + i) * D + ch] = (bf16)f2bf(siluf_(y)); }
        __syncthreads();
    }
}

__device__ __forceinline__ void gdn_prep_simple(Frame& F) {
    const bf16* P = (const bf16*)(F.ws + WS_P); const float* cw = F.in[10];
    float* QN = (float*)(F.ws + WS_QN); float* KN = (float*)(F.ws + WS_KN); float* VN = (float*)(F.ws + WS_VN);
    const int gw = F.vcu * NWAVES + F.wave, NGW = F.G * NWAVES;
    for (int m = gw; m < M; m += NGW) {
        const int t = m % SEQ;
#pragma unroll
        for (int i = 0; i < 12; ++i) {
            const int ch = 128 * i + 2 * F.lane;
            float y0 = 0.f, y1 = 0.f;
#pragma unroll
            for (int j = 0; j < 4; ++j) { const int tj = t - 3 + j; if (tj >= 0) { const unsigned pv = *(const unsigned*)(P + (size_t)(m - 3 + j) * NIN_G + PC_Q + ch);
                    const f32x2 wj = *(const f32x2*)(cw + j * (3 * GW) + ch); y0 += wj.x * bf_lo(pv); y1 += wj.y * bf_hi(pv); } }
            y0 = siluf_(y0); y1 = siluf_(y1);
            if (i < 8) { const float ss = wave_sum(y0 * y0 + y1 * y1); float r = 1.0f / sqrtf(ss + EPS); if (i < 4) r *= 0.08838834764831845f; y0 *= r; y1 *= r; }
            float* dstp = (i < 4) ? QN + (size_t)m * GW + ch : (i < 8) ? KN + (size_t)m * GW + (ch - 512) : VN + (size_t)m * GW + (ch - 1024);
            *(f32x2*)dstp = (f32x2){y0, y1};
        }
    }
}
__device__ __forceinline__ void gdn_recurrent_simple(Frame& F) {
    const bf16* P = (const bf16*)(F.ws + WS_P); bf16* MIX = (bf16*)(F.ws + WS_MIXIN);
    const float* QN = (const float*)(F.ws + WS_QN); const float* KN = (const float*)(F.ws + WS_KN); const float* VN = (const float*)(F.ws + WS_VN);
    const float* BG = (const float*)(F.ws + WS_BG); const float* nw = F.in[13];
    LAS float* QS = (LAS float*)(F.lds + RING_OFF); LAS float* KS = QS + CL * HD; LAS float* VS = KS + CL * HD; LAS float* OS = VS + CL * HD;
    LAS float* BS = (LAS float*)(F.lds + EXTRA_OFF);
    for (int item = blockIdx.x; item < BATCH * NH; item += F.G) {
        const int b = item / NH, h = item % NH;
        const int col = 16 * F.wave + (F.lane & 15), qd = F.lane >> 4;
        float S[32];
#pragma unroll
        for (int i = 0; i < 32; ++i) S[i] = 0.f;
        for (int ch = 0; ch < SEQ / CL; ++ch) {
            const int m0 = b * SEQ + ch * CL;
            for (int idx = F.tid; idx < CL * HD / 4; idx += NWAVES * 64) { const int r = idx >> 5, c4 = idx & 31; const size_t off = (size_t)(m0 + r) * GW + h * HD + 4 * c4;
                *(LAS f32x4*)(QS + r * HD + 4 * c4) = *(const f32x4*)(QN + off); *(LAS f32x4*)(KS + r * HD + 4 * c4) = *(const f32x4*)(KN + off); *(LAS f32x4*)(VS + r * HD + 4 * c4) = *(const f32x4*)(VN + off); }
            if (F.tid < 64) { BS[F.tid] = BG[(size_t)(m0 + F.tid) * 8 + h]; BS[64 + F.tid] = expf(BG[(size_t)(m0 + F.tid) * 8 + 4 + h]); }
            __syncthreads();
            for (int t = 0; t < CL; ++t) {
                float kv[32], qv[32];
#pragma unroll
                for (int i = 0; i < 8; ++i) { const f32x4 k4 = *(const LAS f32x4*)(KS + t * HD + 32 * qd + 4 * i), q4 = *(const LAS f32x4*)(QS + t * HD + 32 * qd + 4 * i);
                    kv[4 * i] = k4.x; kv[4 * i + 1] = k4.y; kv[4 * i + 2] = k4.z; kv[4 * i + 3] = k4.w; qv[4 * i] = q4.x; qv[4 * i + 1] = q4.y; qv[4 * i + 2] = q4.z; qv[4 * i + 3] = q4.w; }
                const float beta = BS[t], eg = BS[64 + t], vv = VS[t * HD + col];
                float ks = 0.f;
#pragma unroll
                for (int i = 0; i < 32; ++i) ks += kv[i] * S[i];
                ks += __shfl_xor(ks, 16); ks += __shfl_xor(ks, 32);
                const float dd = beta * (vv - eg * ks);
                float o = 0.f;
#pragma unroll
                for (int i = 0; i < 32; ++i) { S[i] = eg * S[i] + kv[i] * dd; o += qv[i] * S[i]; }
                o += __shfl_xor(o, 16); o += __shfl_xor(o, 32);
                if (qd == 0) OS[t * HD + col] = o;
            }
            __syncthreads();
#pragma unroll
            for (int r = 0; r < 8; ++r) { const int t = 8 * F.wave + r; const f32x2 o2 = *(const LAS f32x2*)(OS + t * HD + 2 * F.lane);
                const float ss = wave_sum(o2.x * o2.x + o2.y * o2.y); const float rr = 1.0f / sqrtf(ss * (1.f / HD) + EPS);
                const unsigned z2 = *(const unsigned*)(P + (size_t)(m0 + t) * NIN_G + PC_Z + h * HD + 2 * F.lane);
                const f32x2 n2 = *(const f32x2*)(nw + 2 * F.lane);
                const float y0 = o2.x * rr * n2.x * siluf_(bf_lo(z2)), y1 = o2.y * rr * n2.y * siluf_(bf_hi(z2));
                *(unsigned*)(MIX + (size_t)(m0 + t) * D + GW + h * HD + 2 * F.lane) = pk2(y0, y1); }
            __syncthreads();
        }
    }
}
struct Args { const float* in[19]; float* out; unsigned char* ws; int ph_lo, ph_hi; };
__global__ void __launch_bounds__(NWAVES * 64, 2) fwd_kernel(Args args) {
    extern __shared__ __attribute__((aligned(16))) unsigned char lds[];
    Frame F;
    F.lds = (LAS unsigned char*)lds;
    F.MISC = (volatile LAS unsigned*)(F.lds + MISC_OFF);
    F.tid = threadIdx.x; F.lane = F.tid & 63; F.wave = __builtin_amdgcn_readfirstlane(F.tid >> 6);
    F.G = gridDim.x; { const int bx = blockIdx.x; F.vcu = (F.G % 8 == 0) ? (bx % 8) * (F.G / 8) + bx / 8 : bx; }
#pragma unroll
    for (int i = 0; i < 19; ++i) F.in[i] = args.in[i];
    F.out = args.out; F.ws = args.ws;
    F.ctl = (gu32*)(F.ws + WS_CTL);
    for (int u = F.tid; u < (LDS_BYTES - LDSCTL_OFF) / 4; u += NWAVES * 64) ((LAS unsigned*)(F.lds + LDSCTL_OFF))[u] = 0u;
    __syncthreads();
    XcdBarrier bar; bar.bar = (unsigned*)(F.ctl + CW_BAR); bar.x = 0; bar.st = nullptr;
    if (MK_ONE_LAUNCH) bar = xcd_barrier_post((unsigned*)(F.ctl + CW_BAR), F.MISC + 8);
#define GRID_BAR() do { if (MK_ONE_LAUNCH) xcd_barrier(bar); } while (0)
    const int lo = args.ph_lo, hi = args.ph_hi;
#define IN(k) (lo <= (k) && (k) < hi)
#define BOTH(k) (IN(k) && IN((k) + 1))
    float* MOD = (float*)(F.ws + WS_MOD);
    bf16* XN = (bf16*)(F.ws + WS_XN); bf16* Pb = (bf16*)(F.ws + WS_P); bf16* MIX = (bf16*)(F.ws + WS_MIXIN); bf16* HID = (bf16*)(F.ws + WS_HID);

    if (IN(0)) { p0_prologue(F); if (BOTH(0)) GRID_BAR(); }
    if (IN(1)) { norm_mod_phase<true>(F, F.in[0], F.in[4], MOD + 0 * D, MOD + 1 * D, XN); if (BOTH(1)) GRID_BAR(); }
    if (IN(2)) {
        pg8::Gemm g{XN, (const bf16*)(F.ws + WS_WIN), M, NIN_G, D}; pg8::StaticOrder S; S.init(M, NIN_G, F.G, (int)blockIdx.x);
        pg8::EpiBf16<0> E{Pb, NIN_G, nullptr, 0, 0, 1.f};
        pg8::gemm_phase<pg8::EpiBf16<0>, pg8::StaticOrder, PG8_ALIGN, PG8_SP2>(F.lds + RING_OFF, g, S, E);
        if (BOTH(2)) GRID_BAR();
    }
    if (IN(3)) { conformer_phase(F); gdn_prep_simple(F); if (BOTH(3)) GRID_BAR(); }
    if (IN(4)) { gdn_recurrent_simple(F); if (BOTH(4)) GRID_BAR(); }
    if (IN(5)) {
        pg8::Gemm g{MIX, (const bf16*)(F.ws + WS_WOUT), M, D, D}; pg8::StaticOrder S; S.init(M, D, F.G, (int)blockIdx.x);
        pg8::EpiResGate E{F.in[0], F.out, D, MOD + 2 * D, NMOD * D, SEQ / 256};
        pg8::gemm_phase<pg8::EpiResGate, pg8::StaticOrder, PG8_ALIGN, PG8_SP2>(F.lds + RING_OFF, g, S, E);
        if (BOTH(5)) GRID_BAR();
    }
    if (IN(6)) { norm_mod_phase<false>(F, F.out, F.in[15], MOD + 3 * D, MOD + 4 * D, XN); if (BOTH(6)) GRID_BAR(); }
    if (IN(7)) {
        pg8::Gemm g{XN, (const bf16*)(F.ws + WS_WFI), M, 2 * FF, D}; pg8::StaticOrder S; S.init(M, 2 * FF, F.G, (int)blockIdx.x);
        pg8::EpiSwiGLU E{HID, FF};
        pg8::gemm_phase<pg8::EpiSwiGLU, pg8::StaticOrder, PG8_ALIGN, PG8_SP2>(F.lds + RING_OFF, g, S, E);
        if (BOTH(7)) GRID_BAR();
    }
    if (IN(8)) {
        pg8::Gemm g{HID, (const bf16*)(F.ws + WS_WFO), M, D, FF}; pg8::StaticOrder S; S.init(M, D, F.G, (int)blockIdx.x);
        pg8::EpiResGate E{F.out, F.out, D, MOD + 5 * D, NMOD * D, SEQ / 256};
        pg8::gemm_phase<pg8::EpiResGate, pg8::StaticOrder, PG8_ALIGN, PG8_SP2>(F.lds + RING_OFF, g, S, E);
        if (BOTH(8)) GRID_BAR();
    }
    if (IN(9)) { final_norm_phase(F, F.out, F.in[18]); }
#undef IN
#undef BOTH
}

extern "C" void kernel_launch(void* const* d_in, const int* in_sizes, int n_in, void* d_out, int out_size, void* d_ws, size_t ws_size, hipStream_t stream) {
    static int grid = 0;
    if (grid == 0) {
        if (n_in != 19 || in_sizes[0] != M * D || out_size != M * D || ws_size < WS_END) { fprintf(stderr, "kernel_launch: unexpected shapes (n_in %d, in0 %d, out %d, ws %zu); nothing launched\n", n_in, n_in > 0 ? in_sizes[0] : -1, out_size, ws_size); grid = -1; return; }
        int dev = 0, cus = 0, per_cu = 0;
        if (hipGetDevice(&dev) != hipSuccess || hipDeviceGetAttribute(&cus, hipDeviceAttributeMultiprocessorCount, dev) != hipSuccess) { grid = -1; return; }
        if (hipFuncSetAttribute((const void*)fwd_kernel, hipFuncAttributeMaxDynamicSharedMemorySize, LDS_BYTES) != hipSuccess) { fprintf(stderr, "kernel_launch: hipFuncSetAttribute failed\n"); grid = -1; return; }
        if (hipOccupancyMaxActiveBlocksPerMultiprocessor(&per_cu, (const void*)fwd_kernel, NWAVES * 64, LDS_BYTES) != hipSuccess || per_cu < 1) { fprintf(stderr, "kernel_launch: occupancy query says %d blocks per CU\n", per_cu); per_cu = 1; }
        (void)hipGetLastError();
        grid = cus;
    }
    if (grid < 0) return;
    (void)hipMemsetAsync((char*)d_ws + WS_CTL, 0, CTL_ZERO_BYTES, stream);
    Args a{};
    for (int i = 0; i < 19; ++i) a.in[i] = (const float*)d_in[i];
    a.out = (float*)d_out; a.ws = (unsigned char*)d_ws;
#if MK_ONE_LAUNCH
    a.ph_lo = 0; a.ph_hi = N_PHASES;
    hipLaunchKernelGGL(fwd_kernel, dim3(grid), dim3(NWAVES * 64), LDS_BYTES, stream, a);
#else
    for (int p = 0; p < N_PHASES; ++p) { a.ph_lo = p; a.ph_hi = p + 1; hipLaunchKernelGGL(fwd_kernel, dim3(grid), dim3(NWAVES * 64), LDS_BYTES, stream, a); }
#endif
}
```

```cpp
#include <hip/hip_runtime.h>
#include <cstdio>
#include <cstdint>
namespace pg8 {
#define PG8_LAS __attribute__((address_space(3)))
typedef unsigned short bf16_t;
typedef short bf16x8 __attribute__((ext_vector_type(8)));
typedef float f32x4 __attribute__((ext_vector_type(4)));
typedef unsigned u32x4 __attribute__((ext_vector_type(4)));
constexpr int BM = 256, BK = 64, HALF = 128, HTB = HALF * BK * 2  , STAGE_BYTES = 8 * HTB, NXCD = 8, WGM = 8;

__host__ __device__ __forceinline__ int lds_byte(int r, int c) { const int st = (r >> 4) * 2 + (c >> 5), rr = r & 15, cc = c & 31, ob = rr * 64 + cc * 2; return st * 1024 + (ob ^ (((ob >> 9) & 1) << 5)); }
__host__ __device__ __forceinline__ void stage_rc(int b, int& R, int& C) { const int st = b / 1024, sb = b % 1024, swz = sb ^ (((sb >> 9) & 1) << 5); R = (st >> 1) * 16 + swz / 64; C = (st & 1) * 32 + (swz % 64) / 2; }
__host__ __device__ __forceinline__ int perm32(int rho) { const int n = rho >> 4, i = rho & 15; return 8 * (i >> 2) + 4 * n + (i & 3); }

struct Unit { int pm, pn; };
struct Gemm { const bf16_t* A; const bf16_t* Bt; int M, N, K; };

struct StaticOrder {
    int nM, nN, nwg, G, c;
    __host__ __device__ void init(int M, int N, int G_, int c_) { nM = M / BM; nN = N / BM; nwg = nM * nN; G = G_; c = c_; }
    __host__ __device__ bool next(int i, Unit& u) const {
        const long L = (long)i * G + c; if (L >= nwg) return false;
        int wgid = (int)L; { const int q = nwg / NXCD, r = nwg % NXCD, xcd = wgid % NXCD, off = wgid / NXCD; wgid = (xcd < r ? xcd * (q + 1) : r * (q + 1) + (xcd - r) * q) + off; }
        const int nig = WGM * nN, gid = wgid / nig, fm = gid * WGM, gsz = (nM - fm) < WGM ? (nM - fm) : WGM;
        u.pm = fm + ((wgid % nig) % gsz); u.pn = (wgid % nig) / gsz; return true;
    }
    __device__ __forceinline__ void a_ready(const Unit&) const {}
    __device__ __forceinline__ void done(const Unit&) const {}
};

__device__ __forceinline__ unsigned cvt_pk_bf16(float lo, float hi) { unsigned r; asm volatile("v_cvt_pk_bf16_f32 %0, %1, %2" : "=v"(r) : "v"(lo), "v"(hi)); return r; }
typedef float f32x2 __attribute__((ext_vector_type(2)));
__device__ __forceinline__ f32x2 gelu_pk(f32x2 v) {
    const f32x2 av = __builtin_elementwise_abs(v), d = av * 0.2316418882f + 1.0f;
    f32x2 t; t.x = __builtin_amdgcn_rcpf(d.x); t.y = __builtin_amdgcn_rcpf(d.y);
    f32x2 q = t * 0.5307027145f + (-0.7265760135f); q = q * t + 0.7107068705f; q = q * t + (-0.142248368f); q = q * t + 0.127414796f; q = q * t;
    const f32x2 s = (v * v) * (-0.72134752044f);
    f32x2 e; e.x = __builtin_amdgcn_exp2f(s.x); e.y = __builtin_amdgcn_exp2f(s.y);
    const f32x2 m = v * (q * e), r = v - m;
    f32x2 o; o.x = v.x < 0.f ? m.x : r.x; o.y = v.y < 0.f ? m.y : r.y; return o;
}

template <int ACT  > struct EpiBf16 {
    static constexpr bool PERM = true, AFTER_DRAIN = false; static_assert(ACT == 0 || ACT == 1, "EpiBf16: ACT is 0 (none) or 1 (gelu_pk)");
    bf16_t* O; int ldc; const float* bias; int split_cols; size_t split_stride; float scale0;
    __device__ __forceinline__ void operator()(const f32x4 (&acc)[2][2][4][2], const Unit& u, int wr, int wc, int fr, int fq) const {
        const int row0 = u.pm * BM + wr * 64 + fr; int colt = u.pn * BM; bf16_t* base = O;
        float sc = 1.f; if (split_cols) { const int t = colt / split_cols; base += (size_t)t * split_stride; colt -= t * split_cols; if (t == 0) sc = scale0; }
        const int col0 = colt + wc * 32 + 8 * fq, bcol0 = u.pn * BM + wc * 32 + 8 * fq;
        f32x4 bv[2][2];
#pragma unroll
        for (int bj = 0; bj < 2; ++bj)
#pragma unroll
            for (int n = 0; n < 2; ++n) bv[bj][n] = bias ? *(const f32x4*)(bias + bcol0 + bj * HALF + 4 * n) : (f32x4){0.f, 0.f, 0.f, 0.f};
#pragma unroll
        for (int ai = 0; ai < 2; ++ai)
#pragma unroll
            for (int m = 0; m < 4; ++m) { bf16_t* rowp = base + (size_t)(row0 + ai * HALF + m * 16) * ldc + col0;
#pragma unroll
                for (int bj = 0; bj < 2; ++bj) { f32x4 v0 = acc[ai][bj][m][0] + bv[bj][0], v1 = acc[ai][bj][m][1] + bv[bj][1];
                    if (ACT == 1) { f32x2 a = gelu_pk((f32x2){v0[0], v0[1]}), b = gelu_pk((f32x2){v0[2], v0[3]}), c = gelu_pk((f32x2){v1[0], v1[1]}), d = gelu_pk((f32x2){v1[2], v1[3]});
                        v0 = (f32x4){a.x, a.y, b.x, b.y}; v1 = (f32x4){c.x, c.y, d.x, d.y}; }
                    v0 = v0 * sc; v1 = v1 * sc; u32x4 w; w.x = cvt_pk_bf16(v0[0], v0[1]); w.y = cvt_pk_bf16(v0[2], v0[3]); w.z = cvt_pk_bf16(v1[0], v1[1]); w.w = cvt_pk_bf16(v1[2], v1[3]);
                    *(u32x4*)(rowp + bj * HALF) = w; } }
    }
};

struct PanelStats {
    unsigned* xbuf;
    unsigned* cnt;
    unsigned* tmo;
    int ntn; float eps;
    unsigned code;
    __device__ __forceinline__ bool run(const f32x4 (&v)[2][2][4][2], const Unit& u, int wr, int wc, int fr, int fq, PG8_LAS unsigned char* lds, int wid, int lane) const {
        typedef float f32x2v __attribute__((ext_vector_type(2)));
        PG8_LAS f32x2v* P = (PG8_LAS f32x2v*)lds;
        PG8_LAS f32x2v* S = (PG8_LAS f32x2v*)(lds + 8192);
        PG8_LAS unsigned* flag = (PG8_LAS unsigned*)(lds + 8192 + 2048);
#pragma unroll
        for (int ai = 0; ai < 2; ++ai)
#pragma unroll
            for (int m = 0; m < 4; ++m) {
                float s = 0.f;
#pragma unroll
                for (int bj = 0; bj < 2; ++bj)
#pragma unroll
                    for (int n = 0; n < 2; ++n) { const f32x4 x = v[ai][bj][m][n]; s += (x[0] + x[1]) + (x[2] + x[3]); }
                s += __shfl_xor(s, 16); s += __shfl_xor(s, 32);
                const float mw = s * (1.0f / 64.0f); float q = 0.f;
#pragma unroll
                for (int bj = 0; bj < 2; ++bj)
#pragma unroll
                    for (int n = 0; n < 2; ++n) { const f32x4 d = v[ai][bj][m][n] - mw; q += (d[0] * d[0] + d[1] * d[1]) + (d[2] * d[2] + d[3] * d[3]); }
                q += __shfl_xor(q, 16); q += __shfl_xor(q, 32);
                if (fq == 0) P[(ai * HALF + wr * 64 + m * 16 + fr) * 4 + wc] = (f32x2v){mw, q};
            }
        asm volatile("s_waitcnt lgkmcnt(0)" ::: "memory"); __builtin_amdgcn_s_barrier(); asm volatile("" ::: "memory");
#if defined(BROKEN_EXCHANGE_NO_WAIT)
#warning BROKEN CONTROL BUILD: the row-statistics exchange does not wait; results are wrong by design
        if (blockIdx.x >= 64) { const long long t0_ = clock64(); while (clock64() - t0_ < 60000) __builtin_amdgcn_s_sleep(8); }
#endif
        const int row = wid * 32 + (lane & 31);
        if (lane < 32) {
            const f32x2v a = P[row * 4 + 0], b = P[row * 4 + 1], c = P[row * 4 + 2], d = P[row * 4 + 3];
            const float mt = (a.x + b.x + c.x + d.x) * 0.25f;
            const float da = a.x - mt, db = b.x - mt, dc = c.x - mt, dd = d.x - mt;
            const float m2 = (a.y + b.y) + (c.y + d.y) + 64.0f * ((da * da + db * db) + (dc * dc + dd * dd));
            unsigned long long* slot = (unsigned long long*)xbuf + ((size_t)(u.pm * BM + row) * 4 + u.pn);
            __hip_atomic_store(slot, ((unsigned long long)__float_as_uint(m2) << 32) | __float_as_uint(mt), __ATOMIC_RELAXED, __HIP_MEMORY_SCOPE_AGENT);
        }
        asm volatile("s_waitcnt vmcnt(0)" ::: "memory");
        if (lane == 0) __hip_atomic_fetch_add(cnt + 64 * u.pm, 1u, __ATOMIC_RELAXED, __HIP_MEMORY_SCOPE_AGENT);
        if (wid == 0) {
            bool dead = false; const unsigned long long t0 = __builtin_amdgcn_s_memrealtime(); const unsigned want = 8u * (unsigned)ntn;
            for (;;) {
#if defined(BROKEN_EXCHANGE_NO_WAIT)
                break;
#endif
                if ((unsigned)__builtin_amdgcn_readfirstlane(__hip_atomic_load(cnt + 64 * u.pm, __ATOMIC_RELAXED, __HIP_MEMORY_SCOPE_AGENT)) >= want) break;
                if (__builtin_amdgcn_s_memrealtime() - t0 > 2000000ull) {
                    if (lane == 0) { unsigned expect = 0u; __hip_atomic_compare_exchange_strong(tmo + 1, &expect, code | (unsigned)(u.pm & 0xff), __ATOMIC_RELAXED, __ATOMIC_RELAXED, __HIP_MEMORY_SCOPE_AGENT);
                                     __hip_atomic_store(tmo, 1u, __ATOMIC_RELAXED, __HIP_MEMORY_SCOPE_AGENT); }
                    dead = true; break; }
                __builtin_amdgcn_s_sleep(2);
            }
            __builtin_amdgcn_fence(__ATOMIC_ACQUIRE, "agent");
            if (lane == 0) flag[0] = dead ? 1u : 0u;
        }
        asm volatile("s_waitcnt vmcnt(0) lgkmcnt(0)" ::: "memory"); __builtin_amdgcn_s_barrier(); asm volatile("" ::: "memory");
        const bool bad = flag[0] != 0u;
        if (lane < 32) {
            const unsigned long long* slot = (const unsigned long long*)xbuf + (size_t)(u.pm * BM + row) * 4; float mt[4], m2[4]; float ms = 0.f;
#pragma unroll
            for (int t = 0; t < 4; ++t) { if (t < ntn) { const unsigned long long w = __hip_atomic_load(slot + t, __ATOMIC_RELAXED, __HIP_MEMORY_SCOPE_AGENT); mt[t] = __uint_as_float((unsigned)w); m2[t] = __uint_as_float((unsigned)(w >> 32)); } else { mt[t] = 0.f; m2[t] = 0.f; } ms += mt[t]; }
            const float mean = ms / (float)ntn; float q = 0.f;
#pragma unroll
            for (int t = 0; t < 4; ++t) if (t < ntn) { const float dm = mt[t] - mean; q += m2[t] + 256.0f * dm * dm; }
            S[row] = (f32x2v){mean, 1.0f / sqrtf(q / (256.0f * (float)ntn) + eps)};
        }
        asm volatile("s_waitcnt lgkmcnt(0)" ::: "memory"); __builtin_amdgcn_s_barrier(); asm volatile("" ::: "memory");
        return bad;
    }
};
struct EpiLnRes {
    static constexpr bool PERM = false, AFTER_DRAIN = true;
    const float* base; float* out; int ldc; const float* bias; PanelStats st; unsigned poison;
    __device__ __forceinline__ void fused(f32x4 (&acc)[2][2][4][2], const Unit& u, int wr, int wc, int fr, int fq, PG8_LAS unsigned char* lds, int wid, int lane) const {
        typedef float f32x2v __attribute__((ext_vector_type(2)));
        const PG8_LAS f32x2v* S = (const PG8_LAS f32x2v*)(lds + 8192);
        const int col0 = u.pn * BM + wc * 32 + 4 * fq;
#pragma unroll
        for (int bj = 0; bj < 2; ++bj)
#pragma unroll
            for (int n = 0; n < 2; ++n) { const f32x4 bv = bias ? *(const f32x4*)(bias + col0 + bj * HALF + n * 16) : (f32x4){0.f, 0.f, 0.f, 0.f};
#pragma unroll
                for (int ai = 0; ai < 2; ++ai)
#pragma unroll
                    for (int m = 0; m < 4; ++m) acc[ai][bj][m][n] += bv; }
        f32x4 pre[4][2][2];
#pragma unroll
        for (int m = 0; m < 4; ++m) { const size_t off = (size_t)(u.pm * BM + wr * 64 + m * 16 + fr) * ldc + col0;
#pragma unroll
            for (int bj = 0; bj < 2; ++bj)
#pragma unroll
                for (int n = 0; n < 2; ++n) pre[m][bj][n] = *(const f32x4*)(base + off + bj * HALF + n * 16); }
        const bool bad = st.run(acc, u, wr, wc, fr, fq, lds, wid, lane) || poison != 0u;
        const float qnan = __builtin_nanf("");
#pragma unroll
        for (int ai = 0; ai < 2; ++ai)
#pragma unroll
            for (int m = 0; m < 4; ++m) { const int r = ai * HALF + wr * 64 + m * 16 + fr; const f32x2v sr = S[r]; const size_t off = (size_t)(u.pm * BM + r) * ldc + col0;
#pragma unroll
                for (int bj = 0; bj < 2; ++bj)
#pragma unroll
                    for (int n = 0; n < 2; ++n) { const f32x4 bs = ai == 0 ? pre[m][bj][n] : *(const f32x4*)(base + off + bj * HALF + n * 16); f32x4 o = bs + (acc[ai][bj][m][n] - sr.x) * sr.y;
                        if (bad) o = (f32x4){qnan, qnan, qnan, qnan}; *(f32x4*)(out + off + bj * HALF + n * 16) = o; }
                if (m & 1) asm volatile("" ::: "memory"); }
    }
};
struct EpiLnResLn {
    static constexpr bool PERM = false, AFTER_DRAIN = true;
    const float* base; float* out; bf16_t* xn; int ldc; const float* bias; PanelStats st1, st2; unsigned poison;
    __device__ __forceinline__ void fused(f32x4 (&acc)[2][2][4][2], const Unit& u, int wr, int wc, int fr, int fq, PG8_LAS unsigned char* lds, int wid, int lane) const {
        typedef float f32x2v __attribute__((ext_vector_type(2))); typedef unsigned u32x2v __attribute__((ext_vector_type(2)));
        const PG8_LAS f32x2v* S = (const PG8_LAS f32x2v*)(lds + 8192);
        const int col0 = u.pn * BM + wc * 32 + 4 * fq;
#pragma unroll
        for (int bj = 0; bj < 2; ++bj)
#pragma unroll
            for (int n = 0; n < 2; ++n) { const f32x4 bv = bias ? *(const f32x4*)(bias + col0 + bj * HALF + n * 16) : (f32x4){0.f, 0.f, 0.f, 0.f};
#pragma unroll
                for (int ai = 0; ai < 2; ++ai)
#pragma unroll
                    for (int m = 0; m < 4; ++m) acc[ai][bj][m][n] += bv; }
        bool bad = st1.run(acc, u, wr, wc, fr, fq, lds, wid, lane) || poison != 0u;
        const float qnan = __builtin_nanf("");
#pragma unroll
        for (int ai = 0; ai < 2; ++ai)
#pragma unroll
            for (int m = 0; m < 4; ++m) { const int r = ai * HALF + wr * 64 + m * 16 + fr; const f32x2v sr = S[r]; const size_t off = (size_t)(u.pm * BM + r) * ldc + col0;
#pragma unroll
                for (int bj = 0; bj < 2; ++bj)
#pragma unroll
                    for (int n = 0; n < 2; ++n) { const f32x4 bs = *(const f32x4*)(base + off + bj * HALF + n * 16); acc[ai][bj][m][n] = bs + (acc[ai][bj][m][n] - sr.x) * sr.y; }
                asm volatile("" : "+v"(acc[ai][0][m][0]), "+v"(acc[ai][0][m][1]), "+v"(acc[ai][1][m][0]), "+v"(acc[ai][1][m][1]));
                if (m & 1) asm volatile("" ::: "memory"); }
        const bool bad1 = bad;
        bad = st2.run(acc, u, wr, wc, fr, fq, lds, wid, lane) || bad;
#pragma unroll
        for (int ai = 0; ai < 2; ++ai)
#pragma unroll
            for (int m = 0; m < 4; ++m) { const int r = ai * HALF + wr * 64 + m * 16 + fr; const f32x2v sr = S[r]; const size_t off = (size_t)(u.pm * BM + r) * ldc + col0;
#pragma unroll
                for (int bj = 0; bj < 2; ++bj)
#pragma unroll
                    for (int n = 0; n < 2; ++n) { const f32x4 x1 = acc[ai][bj][m][n]; *(f32x4*)(out + off + bj * HALF + n * 16) = bad1 ? (f32x4){qnan, qnan, qnan, qnan} : x1;
                        const f32x4 o = (x1 - sr.x) * sr.y; u32x2v w; w.x = cvt_pk_bf16(o[0], o[1]); w.y = cvt_pk_bf16(o[2], o[3]);
                        if (bad) { w.x = 0x7fc07fc0u; w.y = 0x7fc07fc0u; } *(u32x2v*)(xn + off + bj * HALF + n * 16) = w; }
                asm volatile("" ::: "memory"); }
    }
};

template <class Epi, class Sched, bool ALIGN_EPI = false, bool SP2 = false>
__device__ __forceinline__ void gemm_phase(PG8_LAS unsigned char* lds, const Gemm g, const Sched& S, const Epi& E) {
    const int tid = threadIdx.x, wid = __builtin_amdgcn_readfirstlane(tid >> 6), lane = tid & 63, wr = wid >> 2, wc = wid & 3, fr = lane & 15, fq = lane >> 4;
    const int K = g.K, nt = K / BK;
    unsigned voffA[2], voffB[2];
#pragma unroll
    for (int i = 0; i < 2; ++i) { int R, C; stage_rc(tid * 16 + i * 8192, R, C); const int Rb = Epi::PERM ? ((R & ~31) + perm32(R & 31)) : R;
        voffA[i] = (unsigned)(R * K + C) * 2u; voffB[i] = (unsigned)(Rb * K + C) * 2u; }
    const size_t kstep = (size_t)(BK * 2);
    const size_t hstep = (size_t)HALF * K * 2;
    const size_t tstep = 2 * hstep;
    const unsigned ldsw = (unsigned)wid * 1024u;
    const int aoff = lds_byte(wr * 64 + fr, fq * 8), boff = lds_byte(wc * 32 + fr, fq * 8);
#define PG8_SA(b, h) (((b) * 2 + (h)) * HTB)
#define PG8_SB(b, h) ((4 + (b) * 2 + (h)) * HTB)
#define PG8_STAGE(bufoff, gbase, voff) do { _Pragma("unroll") for (int _i = 0; _i < 2; ++_i) \
        __builtin_amdgcn_global_load_lds((const unsigned*)((const char*)(gbase) + (voff)[_i]), (PG8_LAS unsigned*)(lds + (bufoff) + ldsw + _i * 8192), 16, 0, 0); } while (0)
#define PG8_LDA(dst, b, h) do { _Pragma("unroll") for (int m = 0; m < 4; ++m) _Pragma("unroll") for (int k = 0; k < 2; ++k) dst[m][k] = *(const PG8_LAS bf16x8*)(lds + PG8_SA(b, h) + aoff + m * 2048 + k * 1024); } while (0)
#define PG8_LDB(dst, b, h) do { _Pragma("unroll") for (int n = 0; n < 2; ++n) _Pragma("unroll") for (int k = 0; k < 2; ++k) dst[n][k] = *(const PG8_LAS bf16x8*)(lds + PG8_SB(b, h) + boff + n * 2048 + k * 1024); } while (0)
#define PG8_MMA(ai, bj, At, Bt) do { __builtin_amdgcn_s_setprio(1); _Pragma("unroll") for (int m = 0; m < 4; ++m) _Pragma("unroll") for (int n = 0; n < 2; ++n) _Pragma("unroll") for (int k = 0; k < 2; ++k) \
        acc[ai][bj][m][n] = __builtin_amdgcn_mfma_f32_16x16x32_bf16(Bt[n][k], At[m][k], acc[ai][bj][m][n], 0, 0, 0); __builtin_amdgcn_s_setprio(0); } while (0)
#define PG8_WAIT_V(n) asm volatile("s_waitcnt vmcnt(" #n ")" ::: "memory")
#define PG8_WAIT_L(n) asm volatile("s_waitcnt lgkmcnt(" #n ")" ::: "memory")
#define PG8_BAR __builtin_amdgcn_s_barrier()
#define PG8_SCHED __builtin_amdgcn_sched_barrier(0)
    Unit cur, nxt; int ui = 0;
    if (!S.next(0, cur)) return;
    f32x4 acc[2][2][4][2];
#pragma unroll
    for (int a = 0; a < 2; ++a)
#pragma unroll
        for (int b = 0; b < 2; ++b)
#pragma unroll
            for (int m = 0; m < 4; ++m)
#pragma unroll
                for (int n = 0; n < 2; ++n) acc[a][b][m][n] = (f32x4){0.f, 0.f, 0.f, 0.f};
    bf16x8 At[4][2], B0[2][2], B1[2][2];
    const char* cA = (const char*)g.A + (size_t)cur.pm * tstep; const char* cB = (const char*)g.Bt + (size_t)cur.pn * tstep;
    S.a_ready(cur);
    if constexpr (SP2) {
        PG8_STAGE(PG8_SB(0, 0), cB, voffB); PG8_STAGE(PG8_SB(0, 1), cB + hstep, voffB); PG8_STAGE(PG8_SA(0, 0), cA, voffA); PG8_STAGE(PG8_SA(0, 1), cA + hstep, voffA);
        if (wr == 1) PG8_BAR;
        PG8_WAIT_V(2); PG8_BAR;
        PG8_STAGE(PG8_SB(1, 0), cB + kstep, voffB); PG8_STAGE(PG8_SA(1, 0), cA + kstep, voffA); PG8_STAGE(PG8_SB(1, 1), cB + hstep + kstep, voffB);
        PG8_WAIT_V(6); PG8_BAR;
    } else {
        PG8_STAGE(PG8_SB(0, 0), cB, voffB); PG8_STAGE(PG8_SA(0, 0), cA, voffA); PG8_STAGE(PG8_SB(0, 1), cB + hstep, voffB); PG8_STAGE(PG8_SA(0, 1), cA + hstep, voffA);
        if (wr == 1) PG8_BAR;
        PG8_WAIT_V(4); PG8_BAR;
        PG8_STAGE(PG8_SB(1, 0), cB + kstep, voffB); PG8_STAGE(PG8_SA(1, 0), cA + kstep, voffA); PG8_STAGE(PG8_SB(1, 1), cB + hstep + kstep, voffB);
        PG8_WAIT_V(6); PG8_BAR;
    }
    for (;;) {
        const bool has_next = S.next(ui + 1, nxt);
        const char* nA = has_next ? (const char*)g.A + (size_t)nxt.pm * tstep : cA; const char* nB = has_next ? (const char*)g.Bt + (size_t)nxt.pn * tstep : cB;
        for (int t = 0; t < nt; t += 2) {
            const bool last = (t == nt - 2);
            const char* a1 = cA + (size_t)(t + 1) * kstep;
            const char* a2 = last ? nA : cA + (size_t)(t + 2) * kstep; const char* b2 = last ? nB : cB + (size_t)(t + 2) * kstep;
            const char* a3 = a2 + kstep; const char* b3 = b2 + kstep;
            if (last && has_next) S.a_ready(nxt);
            if constexpr (SP2) {
            PG8_LDB(B0, 0, 0); PG8_LDB(B1, 0, 1); PG8_SCHED; PG8_LDA(At, 0, 0); PG8_STAGE(PG8_SA(1, 1), a1 + hstep, voffA);
            PG8_WAIT_V(8); PG8_WAIT_L(0); PG8_BAR; PG8_MMA(0, 0, At, B0); PG8_MMA(0, 1, At, B1); PG8_BAR; PG8_SCHED;
            PG8_LDA(At, 0, 1); PG8_STAGE(PG8_SB(0, 0), b2, voffB); PG8_STAGE(PG8_SB(0, 1), b2 + hstep, voffB); PG8_STAGE(PG8_SA(0, 0), a2, voffA);
            PG8_WAIT_V(8); PG8_WAIT_L(0); PG8_BAR; PG8_MMA(1, 0, At, B0); PG8_MMA(1, 1, At, B1); PG8_BAR; PG8_SCHED;
            PG8_LDB(B0, 1, 0); PG8_LDB(B1, 1, 1); PG8_SCHED; PG8_LDA(At, 1, 0); PG8_STAGE(PG8_SA(0, 1), a2 + hstep, voffA);
            PG8_WAIT_V(8); PG8_WAIT_L(0); PG8_BAR; PG8_MMA(0, 0, At, B0); PG8_MMA(0, 1, At, B1); PG8_BAR; PG8_SCHED;
            PG8_LDA(At, 1, 1); PG8_STAGE(PG8_SB(1, 0), b3, voffB); PG8_STAGE(PG8_SB(1, 1), b3 + hstep, voffB); PG8_STAGE(PG8_SA(1, 0), a3, voffA);
            PG8_WAIT_V(8); PG8_WAIT_L(0); PG8_BAR; PG8_MMA(1, 0, At, B0); PG8_MMA(1, 1, At, B1); PG8_BAR; PG8_SCHED;
            } else {
            PG8_LDB(B0, 0, 0); PG8_SCHED; PG8_LDA(At, 0, 0); PG8_STAGE(PG8_SA(1, 1), a1 + hstep, voffA);
            PG8_WAIT_L(8); PG8_BAR; PG8_WAIT_L(0); PG8_MMA(0, 0, At, B0); PG8_BAR; PG8_SCHED;
            PG8_LDB(B1, 0, 1); PG8_STAGE(PG8_SB(0, 0), b2, voffB);
            PG8_BAR; PG8_WAIT_L(0); PG8_MMA(0, 1, At, B1); PG8_BAR;
            PG8_LDA(At, 0, 1); PG8_STAGE(PG8_SA(0, 0), a2, voffA);
            PG8_BAR; PG8_WAIT_L(0); PG8_MMA(1, 0, At, B0); PG8_BAR; PG8_SCHED;
            PG8_STAGE(PG8_SB(0, 1), b2 + hstep, voffB);
            PG8_WAIT_V(6); PG8_BAR; PG8_MMA(1, 1, At, B1); PG8_BAR;
            PG8_LDB(B0, 1, 0); PG8_SCHED; PG8_LDA(At, 1, 0); PG8_STAGE(PG8_SA(0, 1), a2 + hstep, voffA);
            PG8_WAIT_L(8); PG8_BAR; PG8_WAIT_L(0); PG8_MMA(0, 0, At, B0); PG8_BAR; PG8_SCHED;
            PG8_LDB(B1, 1, 1); PG8_STAGE(PG8_SB(1, 0), b3, voffB);
            PG8_BAR; PG8_WAIT_L(0); PG8_MMA(0, 1, At, B1); PG8_BAR;
            PG8_LDA(At, 1, 1); PG8_STAGE(PG8_SA(1, 0), a3, voffA);
            PG8_BAR; PG8_WAIT_L(0); PG8_MMA(1, 0, At, B0); PG8_BAR; PG8_SCHED;
            PG8_STAGE(PG8_SB(1, 1), b3 + hstep, voffB);
            PG8_WAIT_V(6); PG8_BAR; PG8_MMA(1, 1, At, B1); PG8_BAR;
            }
        }
        if constexpr (ALIGN_EPI) { if (wr == 0) PG8_BAR; }
        if constexpr (!Epi::AFTER_DRAIN) { E(acc, cur, wr, wc, fr, fq); S.done(cur); }
        if (!has_next) break;
#pragma unroll
        for (int a = 0; a < 2; ++a)
#pragma unroll
            for (int b = 0; b < 2; ++b)
#pragma unroll
                for (int m = 0; m < 4; ++m)
#pragma unroll
                    for (int n = 0; n < 2; ++n) acc[a][b][m][n] = (f32x4){0.f, 0.f, 0.f, 0.f};
        cur = nxt; cA = nA; cB = nB; ++ui;
        if constexpr (ALIGN_EPI) { if (wr == 1) PG8_BAR; }
    }
    PG8_WAIT_V(0);
    if constexpr (!ALIGN_EPI) { if (wr == 0) PG8_BAR; }
    PG8_BAR;
    if constexpr (Epi::AFTER_DRAIN) { E.fused(acc, cur, wr, wc, fr, fq, lds, wid, lane); S.done(cur); }
#undef PG8_SA
#undef PG8_SB
#undef PG8_STAGE
#undef PG8_LDA
#undef PG8_LDB
#undef PG8_MMA
#undef PG8_WAIT_V
#undef PG8_WAIT_L
#undef PG8_BAR
#undef PG8_SCHED
}
}
namespace pg8 {
__device__ __forceinline__ float fast_silu(float x) { return x * __builtin_amdgcn_rcpf(1.0f + __builtin_amdgcn_exp2f(-1.44269504089f * x)); }
struct EpiResGate {
    static constexpr bool PERM = false, AFTER_DRAIN = false;
    const float* base; float* out; int ldc; const float* gate; int gate_ld; int tiles_per_batch;
    __device__ __forceinline__ void operator()(const f32x4 (&acc)[2][2][4][2], const Unit& u, int wr, int wc, int fr, int fq) const {
        const int row0 = u.pm * BM + wr * 64 + fr, col0 = u.pn * BM + wc * 32 + 4 * fq;
        const float* gp = gate + (size_t)(u.pm / tiles_per_batch) * gate_ld + col0;
        f32x4 gv[2][2];
#pragma unroll
        for (int bj = 0; bj < 2; ++bj)
#pragma unroll
            for (int n = 0; n < 2; ++n) gv[bj][n] = *(const f32x4*)(gp + bj * HALF + n * 16);
#pragma unroll
        for (int ai = 0; ai < 2; ++ai)
#pragma unroll
            for (int m = 0; m < 4; ++m) { const size_t off = (size_t)(row0 + ai * HALF + m * 16) * ldc + col0;
#pragma unroll
                for (int bj = 0; bj < 2; ++bj)
#pragma unroll
                    for (int n = 0; n < 2; ++n) { const f32x4 b = *(const f32x4*)(base + off + bj * HALF + n * 16); *(f32x4*)(out + off + bj * HALF + n * 16) = b + gv[bj][n] * acc[ai][bj][m][n]; } }
    }
};
struct EpiSwiGLU {
    static constexpr bool PERM = true, AFTER_DRAIN = false;
    bf16_t* O; int ldc;
    __device__ __forceinline__ void operator()(const f32x4 (&acc)[2][2][4][2], const Unit& u, int wr, int wc, int fr, int fq) const {
        const int row0 = u.pm * BM + wr * 64 + fr, col0 = u.pn * HALF + wc * 32 + 8 * fq;
#pragma unroll
        for (int ai = 0; ai < 2; ++ai)
#pragma unroll
            for (int m = 0; m < 4; ++m) { bf16_t* rowp = O + (size_t)(row0 + ai * HALF + m * 16) * ldc + col0;
                const f32x4 g0 = acc[ai][0][m][0], g1 = acc[ai][0][m][1], u0 = acc[ai][1][m][0], u1 = acc[ai][1][m][1];
                u32x4 w; w.x = cvt_pk_bf16(fast_silu(g0[0]) * u0[0], fast_silu(g0[1]) * u0[1]); w.y = cvt_pk_bf16(fast_silu(g0[2]) * u0[2], fast_silu(g0[3]) * u0[3]);
                w.z = cvt_pk_bf16(fast_silu(g1[0]) * u1[0], fast_silu(g1[1]) * u1[1]); w.w = cvt_pk_bf16(fast_silu(g1[2]) * u1[2], fast_silu(g1[3]) * u1[3]);
                *(u32x4*)rowp = w; }
    }
};
}
#ifndef PG8_SP2
#define PG8_SP2 true
#endif
#ifndef PG8_ALIGN
#define PG8_ALIGN true
#endif
constexpr int NWAVES = 8;
#ifndef MK_ONE_LAUNCH
#define MK_ONE_LAUNCH 1
#endif
constexpr int N_PHASES = 10;

constexpr int BATCH = 8, SEQ = 2048, D = 1024, M = BATCH * SEQ;
constexpr int CW = 512, GW = 512, NH = 4, HD = 128, NIN = 3080, NIN_G = 3072, FF = 2816, NMOD = 6;
constexpr int CONVK = 31, CL = 64;
constexpr float EPS = 1e-6f;
constexpr int PC_A = 0, PC_GATE = 512, PC_Q = 1024, PC_K = 1536, PC_V = 2048, PC_Z = 2560;

constexpr size_t MiB = 1u << 20;
constexpr size_t WS_CTL = 0, CTL_ZERO_BYTES = 1 * MiB;
constexpr size_t WS_MOD = 1 * MiB;
constexpr size_t WS_BG = 1 * MiB + 512 * 1024;
constexpr size_t WS_WIN = 2 * MiB, WS_WOUT = 8 * MiB, WS_WFI = 10 * MiB, WS_WFO = 21 * MiB;
constexpr size_t WS_XN = 28 * MiB;
constexpr size_t WS_P = 60 * MiB;
constexpr size_t WS_HID = 60 * MiB;
constexpr size_t WS_MIXIN = 156 * MiB;
constexpr size_t WS_QN = 188 * MiB, WS_KN = 220 * MiB, WS_VN = 28 * MiB;
constexpr size_t WS_END = 256 * MiB;
constexpr int CW_BAR = 4096;

constexpr int RING_OFF = 0, RING_BYTES = 131072;
constexpr int EXTRA_OFF = RING_BYTES, EXTRA_BYTES = 16384;
constexpr int LDSCTL_OFF = EXTRA_OFF + EXTRA_BYTES, MISC_OFF = LDSCTL_OFF + 320;
constexpr int LDS_BYTES = 163840;
static_assert(MISC_OFF + 128 <= LDS_BYTES, "LDS map");
#define GAS __attribute__((address_space(1)))
#define LAS __attribute__((address_space(3)))
typedef unsigned short bf16;
typedef unsigned v4u __attribute__((ext_vector_type(4)));
typedef float f32x4 __attribute__((ext_vector_type(4)));
typedef short bf16x8 __attribute__((ext_vector_type(8)));
typedef GAS unsigned gu32;
typedef GAS unsigned long long gu64;
#define RLX_AGENT __ATOMIC_RELAXED, __HIP_MEMORY_SCOPE_AGENT
#define LDS_WAIT() asm volatile("s_waitcnt lgkmcnt(0)" ::: "memory")
#define VM_WAIT() asm volatile("s_waitcnt vmcnt(0)" ::: "memory")
__device__ __forceinline__ unsigned long long rt() { return __builtin_amdgcn_s_memrealtime(); }
__device__ __forceinline__ unsigned f2bf(float f) { unsigned u = __builtin_bit_cast(unsigned, f); return (u + 0x7fffu + ((u >> 16) & 1u)) >> 16; }
__device__ __forceinline__ unsigned pk2(float lo, float hi) { return f2bf(lo) | (f2bf(hi) << 16); }

#define XB_TMO      128
#define XB_XCNT(j)  (256  + 64 * (j))
#define XB_XSUB(j)  (1280 + 64 * (j))
#define XB_XGEN(j)  (2304 + 64 * (j))
#define XB_TOP      3328
#define XB_TOPGEN   3392
#define XCD_BAR_WORDS 3456
#define XB_SPIN_CAP (1u << 18)

__device__ __forceinline__ unsigned xb_ld(unsigned* p)              { return __hip_atomic_load(p, __ATOMIC_RELAXED, __HIP_MEMORY_SCOPE_AGENT); }
__device__ __forceinline__ unsigned xb_add(unsigned* p, unsigned v) { return __hip_atomic_fetch_add(p, v, __ATOMIC_RELAXED, __HIP_MEMORY_SCOPE_AGENT); }
__device__ __forceinline__ unsigned xb_xcc_id() { return (unsigned)__builtin_amdgcn_s_getreg((3 << 11) | 20) & 0xFu; }
#define XB_SPIN(cond, bar) do { unsigned _sp = 0; while (cond) { __builtin_amdgcn_s_sleep(1); \
    if ((++_sp & 255u) == 0u) { if (xb_ld(&(bar)[XB_TMO])) break; if (_sp > XB_SPIN_CAP) { atomicAdd(&(bar)[XB_TMO], 1u); break; } } } } while (0)

struct XcdBarrier {
    unsigned* bar; unsigned x;
    volatile LAS unsigned* st;
};

__device__ __forceinline__ XcdBarrier xcd_barrier_post(unsigned* bar, volatile LAS unsigned* st) {
    XcdBarrier b; b.bar = bar; b.x = xb_xcc_id(); b.st = st;
    if (threadIdx.x == 0) (void)xb_add(&bar[XB_XCNT(b.x)], 1u);
    return b;
}
__device__ __forceinline__ void xcd_barrier_complete(unsigned* bar, unsigned x, unsigned& nloc, unsigned& nx) {
    const unsigned G = gridDim.x * gridDim.y * gridDim.z;
    unsigned sum, cnt, mine, sp = 0u;
    for (;;) {
        sum = 0u; cnt = 0u; mine = 0u;
#pragma unroll
        for (unsigned j = 0; j < 16; ++j) { const unsigned c = xb_ld(&bar[XB_XCNT(j)]); sum += c; cnt += (c > 0u) ? 1u : 0u; mine = (j == x) ? c : mine; }
        if (sum == G) break;
        __builtin_amdgcn_s_sleep(1);
        if ((++sp & 255u) == 0u) { if (xb_ld(&bar[XB_TMO])) break; if (sp > XB_SPIN_CAP) { atomicAdd(&bar[XB_TMO], 1u); break; } }
    }
    nloc = mine > 0u ? mine : 1u; nx = cnt > 0u ? cnt : 1u;
}

__device__ __forceinline__ void xcd_barrier(const XcdBarrier& b) {
    asm volatile("s_waitcnt vmcnt(0)" ::: "memory");
    __syncthreads();
    if (threadIdx.x == 0) {
        unsigned* bar = b.bar;
        __builtin_amdgcn_s_waitcnt(0);
        unsigned nloc = b.st[0], nx = b.st[1];
        if (nloc == 0u) { xcd_barrier_complete(bar, b.x, nloc, nx); b.st[0] = nloc; b.st[1] = nx; }
        const unsigned old = xb_add(&bar[XB_XSUB(b.x)], 1u);
        const unsigned gen = old / nloc;
        if (old + 1u == (gen + 1u) * nloc) {
            __builtin_amdgcn_fence(__ATOMIC_RELEASE, "agent");
            asm volatile("s_waitcnt vmcnt(0)" ::: "memory");
            const unsigned og = xb_add(&bar[XB_TOP], 1u);
            const unsigned tg = og / nx;
            if (og + 1u == (tg + 1u) * nx) xb_add(&bar[XB_TOPGEN], 1u);
            else XB_SPIN(xb_ld(&bar[XB_TOPGEN]) == tg, bar);
            __builtin_amdgcn_fence(__ATOMIC_ACQUIRE, "agent");
            xb_add(&bar[XB_XGEN(b.x)], 1u);
            asm volatile("s_waitcnt vmcnt(0)" ::: "memory");
        } else {
            XB_SPIN(xb_ld(&bar[XB_XGEN(b.x)]) == gen, bar);
            __builtin_amdgcn_fence(__ATOMIC_ACQUIRE, "agent");
            asm volatile("s_waitcnt vmcnt(0)" ::: "memory");
        }
    }
    __syncthreads();
}
struct Frame {
    LAS unsigned char* lds;
    volatile LAS unsigned* MISC;
    gu32* ctl;
    int tid, lane, wave;
    int vcu, G;
    const float* in[19]; float* out; unsigned char* ws;
};
typedef float f32x2 __attribute__((ext_vector_type(2)));
__device__ __forceinline__ float wave_sum(float v) {
#pragma unroll
    for (int o = 1; o < 64; o <<= 1) v += __shfl_xor(v, o);
    return v;
}
__device__ __forceinline__ float bf_lo(unsigned u) { return __builtin_bit_cast(float, u << 16); }
__device__ __forceinline__ float bf_hi(unsigned u) { return __builtin_bit_cast(float, u & 0xffff0000u); }
__device__ __forceinline__ float sigmoidf_(float x) { return 1.0f / (1.0f + __expf(-x)); }
__device__ __forceinline__ float siluf_(float x) { return x / (1.0f + __expf(-x)); }

__device__ __forceinline__ void transpose_item(const float* W, int ldw, int k0, int n_src, bf16* WT, int K, int n_dst, LAS float* scr, int lane) {
#pragma unroll 8
    for (int i = 0; i < 32; ++i) { const int kk = 2 * i + (lane >> 5); scr[kk * 33 + (lane & 31)] = W[(size_t)(k0 + kk) * ldw + n_src + (lane & 31)]; }
    LDS_WAIT(); asm volatile("" ::: "memory");
    const int c = lane & 7;
#pragma unroll
    for (int j = 0; j < 4; ++j) { const int n = (lane >> 3) + 8 * j; const LAS float* s = scr + (8 * c) * 33 + n;
        v4u o; o.x = pk2(s[0 * 33], s[1 * 33]); o.y = pk2(s[2 * 33], s[3 * 33]); o.z = pk2(s[4 * 33], s[5 * 33]); o.w = pk2(s[6 * 33], s[7 * 33]);
        *(GAS v4u*)(WT + (size_t)(n_dst + n) * K + k0 + 8 * c) = o; }
    LDS_WAIT(); asm volatile("" ::: "memory");
}
__device__ __forceinline__ void p0_prologue(Frame& F) {
    const float* c = F.in[1]; const float* w_ada = F.in[2]; const float* b_ada = F.in[3];
    float* MOD = (float*)(F.ws + WS_MOD);
    for (int item = blockIdx.x; item < (NMOD * D) / 32; item += F.G) {
        LAS float* cs = (LAS float*)(F.lds + RING_OFF);
        LAS float* red = (LAS float*)(F.lds + RING_OFF + 32768);
        for (int i = F.tid; i < BATCH * D; i += NWAVES * 64) cs[i] = siluf_(c[i]);
        __syncthreads();
        const int n0 = 32 * item, col = F.lane & 31, kp = F.lane >> 5;
        float acc[8];
#pragma unroll
        for (int b = 0; b < 8; ++b) acc[b] = 0.f;
#pragma unroll 8
        for (int i = 0; i < 64; ++i) { const int k = 128 * F.wave + 2 * i + kp; const float wv = w_ada[(size_t)k * (NMOD * D) + n0 + col];
#pragma unroll
            for (int b = 0; b < 8; ++b) acc[b] += cs[b * D + k] * wv; }
#pragma unroll
        for (int b = 0; b < 8; ++b) { acc[b] += __shfl_xor(acc[b], 32); if (F.lane < 32) red[(F.wave * 8 + b) * 32 + col] = acc[b]; }
        __syncthreads();
        if (F.tid < 256) { const int b = F.tid >> 5, cc = F.tid & 31; float s = b_ada[n0 + cc];
#pragma unroll
            for (int w = 0; w < 8; ++w) s += red[(w * 8 + b) * 32 + cc];
            MOD[b * (NMOD * D) + n0 + cc] = s; }
        __syncthreads();
    }
    LAS float* scr = (LAS float*)(F.lds + RING_OFF + F.wave * 16384);
    const int gw = F.vcu * NWAVES + F.wave, NGW = F.G * NWAVES;
    constexpr int I_IN = (D / 64) * (NIN_G / 32), I_OUT = (D / 64) * (D / 32), I_FI = (D / 64) * (2 * FF / 32), I_FO = (FF / 64) * (D / 32);
    constexpr int NITEMS = I_IN + I_OUT + I_FI + I_FO;
    bf16* WIN = (bf16*)(F.ws + WS_WIN); bf16* WOUT = (bf16*)(F.ws + WS_WOUT); bf16* WFI = (bf16*)(F.ws + WS_WFI); bf16* WFO = (bf16*)(F.ws + WS_WFO);
    for (int it = gw; it < NITEMS; it += NGW) {
        int r = it;
        if (r < I_IN) { const int nblk = NIN_G / 32, kb = r / nblk, nb = r % nblk; transpose_item(F.in[5], NIN, 64 * kb, 32 * nb, WIN, D, 32 * nb, scr, F.lane); continue; } r -= I_IN;
        if (r < I_OUT) { const int nblk = D / 32, kb = r / nblk, nb = r % nblk; transpose_item(F.in[14], D, 64 * kb, 32 * nb, WOUT, D, 32 * nb, scr, F.lane); continue; } r -= I_OUT;
        if (r < I_FI) { const int nblk = 2 * FF / 32, kb = r / nblk, nb = r % nblk; const int nd = 32 * nb, t = nd >> 8, rr = nd & 255;
            const int ns = rr < 128 ? t * 128 + rr : FF + t * 128 + (rr - 128);
            transpose_item(F.in[16], 2 * FF, 64 * kb, ns, WFI, D, nd, scr, F.lane); continue; } r -= I_FI;
        { const int nblk = D / 32, kb = r / nblk, nb = r % nblk; transpose_item(F.in[17], D, 64 * kb, 32 * nb, WFO, FF, 32 * nb, scr, F.lane); }
    }
}

template <bool WITH_BA>
__device__ __forceinline__ void norm_mod_phase(Frame& F, const float* src, const float* nw, const float* shift, const float* scale, bf16* dst) {
    const int gw = F.vcu * NWAVES + F.wave, NGW = F.G * NWAVES;
    constexpr int RPW = 8;
    f32x4 w8a[WITH_BA ? 16 : 1], w8b[WITH_BA ? 16 : 1];
    if (WITH_BA) {
        const float* w_in = F.in[5];
#pragma unroll
        for (int j = 0; j < 4; ++j)
#pragma unroll
            for (int e = 0; e < 4; ++e) { const int k = 4 * F.lane + 256 * j + e; w8a[j * 4 + e] = *(const f32x4*)(w_in + (size_t)k * NIN + NIN_G); w8b[j * 4 + e] = *(const f32x4*)(w_in + (size_t)k * NIN + NIN_G + 4); }
    }
    for (int it = gw; it < M / RPW; it += NGW) {
        const int m0 = it * RPW, b = m0 / SEQ;
        f32x4 wv[4], sv[4];
#pragma unroll
        for (int j = 0; j < 4; ++j) { const int cidx = 4 * F.lane + 256 * j; const f32x4 n4 = *(const f32x4*)(nw + cidx), sc = *(const f32x4*)(scale + (size_t)b * (NMOD * D) + cidx);
            wv[j] = n4 * (sc + 1.0f); sv[j] = *(const f32x4*)(shift + (size_t)b * (NMOD * D) + cidx); }
        for (int r = 0; r < RPW; ++r) {
            const int m = m0 + r;
            const GAS f32x4* xr = (const GAS f32x4*)(src + (size_t)m * D) + F.lane;
            f32x4 v[4]; float s = 0.f;
#pragma unroll
            for (int j = 0; j < 4; ++j) { v[j] = xr[64 * j]; s += (v[j].x * v[j].x + v[j].y * v[j].y) + (v[j].z * v[j].z + v[j].w * v[j].w); }
            const float rstd = 1.0f / sqrtf(wave_sum(s) * (1.f / D) + EPS);
            GAS unsigned long long* o8 = (GAS unsigned long long*)(dst + (size_t)m * D) + F.lane;
#pragma unroll
            for (int j = 0; j < 4; ++j) { v[j] = v[j] * rstd * wv[j] + sv[j];
                o8[64 * j] = (unsigned long long)pk2(v[j].x, v[j].y) | ((unsigned long long)pk2(v[j].z, v[j].w) << 32); }
            if (WITH_BA) {
                f32x4 pa = {0.f, 0.f, 0.f, 0.f}, pb = {0.f, 0.f, 0.f, 0.f};
#pragma unroll
                for (int j = 0; j < 4; ++j) { pa += w8a[j * 4 + 0] * v[j].x + w8a[j * 4 + 1] * v[j].y + w8a[j * 4 + 2] * v[j].z + w8a[j * 4 + 3] * v[j].w;
                    pb += w8b[j * 4 + 0] * v[j].x + w8b[j * 4 + 1] * v[j].y + w8b[j * 4 + 2] * v[j].z + w8b[j * 4 + 3] * v[j].w; }
                float p[8] = {pa.x, pa.y, pa.z, pa.w, pb.x, pb.y, pb.z, pb.w};
#pragma unroll
                for (int q = 0; q < 8; ++q) p[q] = wave_sum(p[q]);
                const int l = F.lane & 7, h = l & 3;
                float mine = p[0];
#pragma unroll
                for (int q = 1; q < 8; ++q) mine = (l == q) ? p[q] : mine;
                const float a_log = F.in[11][h], dtb = F.in[12][h];
                const float xx = mine + dtb; const float sp = xx > 20.f ? xx : log1pf(expf(xx));
                const float val = (l < 4) ? 1.0f / (1.0f + expf(-mine)) : -expf(a_log) * sp;
                if (F.lane < 8) ((float*)(F.ws + WS_BG))[(size_t)m * 8 + l] = val;
            }
        }
    }
}

__device__ __forceinline__ void final_norm_phase(Frame& F, float* io, const float* nw) {
    const int gw = F.vcu * NWAVES + F.wave, NGW = F.G * NWAVES;
    f32x4 wv[4];
#pragma unroll
    for (int j = 0; j < 4; ++j) wv[j] = *(const f32x4*)(nw + 4 * F.lane + 256 * j);
    for (int m = gw; m < M; m += NGW) {
        GAS f32x4* xr = (GAS f32x4*)(io + (size_t)m * D) + F.lane;
        f32x4 v[4]; float s = 0.f;
#pragma unroll
        for (int j = 0; j < 4; ++j) { v[j] = xr[64 * j]; s += (v[j].x * v[j].x + v[j].y * v[j].y) + (v[j].z * v[j].z + v[j].w * v[j].w); }
        const float rstd = 1.0f / sqrtf(wave_sum(s) * (1.f / D) + EPS);
#pragma unroll
        for (int j = 0; j < 4; ++j) xr[64 * j] = v[j] * rstd * wv[j];
    }
}

__device__ __forceinline__ void conformer_phase(Frame& F) {
    const bf16* P = (const bf16*)(F.ws + WS_P); bf16* MIX = (bf16*)(F.ws + WS_MIXIN);
    const float* conv_w = F.in[6]; const float* conv_b = F.in[7]; const float* gn_w = F.in[8]; const float* gn_b = F.in[9];
    LAS float* ub = (LAS float*)(F.lds + RING_OFF);
    constexpr int NR = CL + CONVK - 1;
    for (int item = F.vcu; item < (M / CL) * 8; item += F.G) {
        const int tt = item >> 3, g = item & 7, m0 = tt * CL, t0 = m0 % SEQ;
        for (int idx = F.tid; idx < NR * 32; idx += NWAVES * 64) { const int r = idx >> 5, cp = idx & 31; const int t = t0 - (CONVK - 1) + r;
            float u0 = 0.f, u1 = 0.f;
            if (t >= 0) { const size_t off = (size_t)(m0 - (CONVK - 1) + r) * NIN_G + g * 64 + 2 * cp;
                const unsigned a2 = *(const unsigned*)(P + off + PC_A), g2 = *(const unsigned*)(P + off + PC_GATE);
                u0 = bf_lo(a2) * sigmoidf_(bf_lo(g2)); u1 = bf_hi(a2) * sigmoidf_(bf_hi(g2)); }
            *(LAS f32x2*)(ub + r * 64 + 2 * cp) = (f32x2){u0, u1}; }
        const int c = F.tid & 63, tb = F.tid >> 6, ch = g * 64 + c;
        float w[CONVK];
#pragma unroll
        for (int k = 0; k < CONVK; ++k) w[k] = conv_w[k * CW + ch];
        const float bias = conv_b[ch], gw_ = gn_w[ch], gb_ = gn_b[ch];
        __syncthreads();
        float acc[8];
#pragma unroll
        for (int i = 0; i < 8; ++i) acc[i] = bias;
#pragma unroll
        for (int k = 0; k < 8 + CONVK - 1; ++k) { const float uv = ub[(8 * tb + k) * 64 + c];
#pragma unroll
            for (int i = 0; i < 8; ++i) { const int tap = k - i; if (tap >= 0 && tap < CONVK) acc[i] += w[tap] * uv; } }
#pragma unroll
        for (int i = 0; i < 8; ++i) { const float mu = wave_sum(acc[i]) * (1.f / 64.f), d = acc[i] - mu, var = wave_sum(d * d) * (1.f / 64.f);
            const float y = d * (1.0f / sqrtf(var + EPS)) * gw_ + gb_;
            MIX[(size_t)(m0 + 8 * tb + i) * D + ch] = (bf16)f2bf(siluf_(y)); }
        __syncthreads();
    }
}

__device__ __forceinline__ void gdn_prep_simple(Frame& F) {
    const bf16* P = (const bf16*)(F.ws + WS_P); const float* cw = F.in[10];
    float* QN = (float*)(F.ws + WS_QN); float* KN = (float*)(F.ws + WS_KN); float* VN = (float*)(F.ws + WS_VN);
    const int gw = F.vcu * NWAVES + F.wave, NGW = F.G * NWAVES;
    for (int m = gw; m < M; m += NGW) {
        const int t = m % SEQ;
#pragma unroll
        for (int i = 0; i < 12; ++i) {
            const int ch = 128 * i + 2 * F.lane;
            float y0 = 0.f, y1 = 0.f;
#pragma unroll
            for (int j = 0; j < 4; ++j) { const int tj = t - 3 + j; if (tj >= 0) { const unsigned pv = *(const unsigned*)(P + (size_t)(m - 3 + j) * NIN_G + PC_Q + ch);
                    const f32x2 wj = *(const f32x2*)(cw + j * (3 * GW) + ch); y0 += wj.x * bf_lo(pv); y1 += wj.y * bf_hi(pv); } }
            y0 = siluf_(y0); y1 = siluf_(y1);
            if (i < 8) { const float ss = wave_sum(y0 * y0 + y1 * y1); float r = 1.0f / sqrtf(ss + EPS); if (i < 4) r *= 0.08838834764831845f; y0 *= r; y1 *= r; }
            float* dstp = (i < 4) ? QN + (size_t)m * GW + ch : (i < 8) ? KN + (size_t)m * GW + (ch - 512) : VN + (size_t)m * GW + (ch - 1024);
            *(f32x2*)dstp = (f32x2){y0, y1};
        }
    }
}
__device__ __forceinline__ void gdn_recurrent_simple(Frame& F) {
    const bf16* P = (const bf16*)(F.ws + WS_P); bf16* MIX = (bf16*)(F.ws + WS_MIXIN);
    const float* QN = (const float*)(F.ws + WS_QN); const float* KN = (const float*)(F.ws + WS_KN); const float* VN = (const float*)(F.ws + WS_VN);
    const float* BG = (const float*)(F.ws + WS_BG); const float* nw = F.in[13];
    LAS float* QS = (LAS float*)(F.lds + RING_OFF); LAS float* KS = QS + CL * HD; LAS float* VS = KS + CL * HD; LAS float* OS = VS + CL * HD;
    LAS float* BS = (LAS float*)(F.lds + EXTRA_OFF);
    for (int item = blockIdx.x; item < BATCH * NH; item += F.G) {
        const int b = item / NH, h = item % NH;
        const int col = 16 * F.wave + (F.lane & 15), qd = F.lane >> 4;
        float S[32];
#pragma unroll
        for (int i = 0; i < 32; ++i) S[i] = 0.f;
        for (int ch = 0; ch < SEQ / CL; ++ch) {
            const int m0 = b * SEQ + ch * CL;
            for (int idx = F.tid; idx < CL * HD / 4; idx += NWAVES * 64) { const int r = idx >> 5, c4 = idx & 31; const size_t off = (size_t)(m0 + r) * GW + h * HD + 4 * c4;
                *(LAS f32x4*)(QS + r * HD + 4 * c4) = *(const f32x4*)(QN + off); *(LAS f32x4*)(KS + r * HD + 4 * c4) = *(const f32x4*)(KN + off); *(LAS f32x4*)(VS + r * HD + 4 * c4) = *(const f32x4*)(VN + off); }
            if (F.tid < 64) { BS[F.tid] = BG[(size_t)(m0 + F.tid) * 8 + h]; BS[64 + F.tid] = expf(BG[(size_t)(m0 + F.tid) * 8 + 4 + h]); }
            __syncthreads();
            for (int t = 0; t < CL; ++t) {
                float kv[32], qv[32];
#pragma unroll
                for (int i = 0; i < 8; ++i) { const f32x4 k4 = *(const LAS f32x4*)(KS + t * HD + 32 * qd + 4 * i), q4 = *(const LAS f32x4*)(QS + t * HD + 32 * qd + 4 * i);
                    kv[4 * i] = k4.x; kv[4 * i + 1] = k4.y; kv[4 * i + 2] = k4.z; kv[4 * i + 3] = k4.w; qv[4 * i] = q4.x; qv[4 * i + 1] = q4.y; qv[4 * i + 2] = q4.z; qv[4 * i + 3] = q4.w; }
                const float beta = BS[t], eg = BS[64 + t], vv = VS[t * HD + col];
                float ks = 0.f;
#pragma unroll
                for (int i = 0; i < 32; ++i) ks += kv[i] * S[i];
                ks += __shfl_xor(ks, 16); ks += __shfl_xor(ks, 32);
                const float dd = beta * (vv - eg * ks);
                float o = 0.f;
#pragma unroll
                for (int i = 0; i < 32; ++i) { S[i] = eg * S[i] + kv[i] * dd; o += qv[i] * S[i]; }
                o += __shfl_xor(o, 16); o += __shfl_xor(o, 32);
                if (qd == 0) OS[t * HD + col] = o;
            }
            __syncthreads();
#pragma unroll
            for (int r = 0; r < 8; ++r) { const int t = 8 * F.wave + r; const f32x2 o2 = *(const LAS f32x2*)(OS + t * HD + 2 * F.lane);
                const float ss = wave_sum(o2.x * o2.x + o2.y * o2.y); const float rr = 1.0f / sqrtf(ss * (1.f / HD) + EPS);
                const unsigned z2 = *(const unsigned*)(P + (size_t)(m0 + t) * NIN_G + PC_Z + h * HD + 2 * F.lane);
                const f32x2 n2 = *(const f32x2*)(nw + 2 * F.lane);
                const float y0 = o2.x * rr * n2.x * siluf_(bf_lo(z2)), y1 = o2.y * rr * n2.y * siluf_(bf_hi(z2));
                *(unsigned*)(MIX + (size_t)(m0 + t) * D + GW + h * HD + 2 * F.lane) = pk2(y0, y1); }
            __syncthreads();
        }
    }
}
struct Args { const float* in[19]; float* out; unsigned char* ws; int ph_lo, ph_hi; };
__global__ void __launch_bounds__(NWAVES * 64, 2) fwd_kernel(Args args) {
    extern __shared__ __attribute__((aligned(16))) unsigned char lds[];
    Frame F;
    F.lds = (LAS unsigned char*)lds;
    F.MISC = (volatile LAS unsigned*)(F.lds + MISC_OFF);
    F.tid = threadIdx.x; F.lane = F.tid & 63; F.wave = __builtin_amdgcn_readfirstlane(F.tid >> 6);
    F.G = gridDim.x; { const int bx = blockIdx.x; F.vcu = (F.G % 8 == 0) ? (bx % 8) * (F.G / 8) + bx / 8 : bx; }
#pragma unroll
    for (int i = 0; i < 19; ++i) F.in[i] = args.in[i];
    F.out = args.out; F.ws = args.ws;
    F.ctl = (gu32*)(F.ws + WS_CTL);
    for (int u = F.tid; u < (LDS_BYTES - LDSCTL_OFF) / 4; u += NWAVES * 64) ((LAS unsigned*)(F.lds + LDSCTL_OFF))[u] = 0u;
    __syncthreads();
    XcdBarrier bar; bar.bar = (unsigned*)(F.ctl + CW_BAR); bar.x = 0; bar.st = nullptr;
    if (MK_ONE_LAUNCH) bar = xcd_barrier_post((unsigned*)(F.ctl + CW_BAR), F.MISC + 8);
#define GRID_BAR() do { if (MK_ONE_LAUNCH) xcd_barrier(bar); } while (0)
    const int lo = args.ph_lo, hi = args.ph_hi;
#define IN(k) (lo <= (k) && (k) < hi)
#define BOTH(k) (IN(k) && IN((k) + 1))
    float* MOD = (float*)(F.ws + WS_MOD);
    bf16* XN = (bf16*)(F.ws + WS_XN); bf16* Pb = (bf16*)(F.ws + WS_P); bf16* MIX = (bf16*)(F.ws + WS_MIXIN); bf16* HID = (bf16*)(F.ws + WS_HID);

    if (IN(0)) { p0_prologue(F); if (BOTH(0)) GRID_BAR(); }
    if (IN(1)) { norm_mod_phase<true>(F, F.in[0], F.in[4], MOD + 0 * D, MOD + 1 * D, XN); if (BOTH(1)) GRID_BAR(); }
    if (IN(2)) {
        pg8::Gemm g{XN, (const bf16*)(F.ws + WS_WIN), M, NIN_G, D}; pg8::StaticOrder S; S.init(M, NIN_G, F.G, (int)blockIdx.x);
        pg8::EpiBf16<0> E{Pb, NIN_G, nullptr, 0, 0, 1.f};
        pg8::gemm_phase<pg8::EpiBf16<0>, pg8::StaticOrder, PG8_ALIGN, PG8_SP2>(F.lds + RING_OFF, g, S, E);
        if (BOTH(2)) GRID_BAR();
    }
    if (IN(3)) { conformer_phase(F); gdn_prep_simple(F); if (BOTH(3)) GRID_BAR(); }
    if (IN(4)) { gdn_recurrent_simple(F); if (BOTH(4)) GRID_BAR(); }
    if (IN(5)) {
        pg8::Gemm g{MIX, (const bf16*)(F.ws + WS_WOUT), M, D, D}; pg8::StaticOrder S; S.init(M, D, F.G, (int)blockIdx.x);
        pg8::EpiResGate E{F.in[0], F.out, D, MOD + 2 * D, NMOD * D, SEQ / 256};
        pg8::gemm_phase<pg8::EpiResGate, pg8::StaticOrder, PG8_ALIGN, PG8_SP2>(F.lds + RING_OFF, g, S, E);
        if (BOTH(5)) GRID_BAR();
    }
    if (IN(6)) { norm_mod_phase<false>(F, F.out, F.in[15], MOD + 3 * D, MOD + 4 * D, XN); if (BOTH(6)) GRID_BAR(); }
    if (IN(7)) {
        pg8::Gemm g{XN, (const bf16*)(F.ws + WS_WFI), M, 2 * FF, D}; pg8::StaticOrder S; S.init(M, 2 * FF, F.G, (int)blockIdx.x);
        pg8::EpiSwiGLU E{HID, FF};
        pg8::gemm_phase<pg8::EpiSwiGLU, pg8::StaticOrder, PG8_ALIGN, PG8_SP2>(F.lds + RING_OFF, g, S, E);
        if (BOTH(7)) GRID_BAR();
    }
    if (IN(8)) {
        pg8::Gemm g{HID, (const bf16*)(F.ws + WS_WFO), M, D, FF}; pg8::StaticOrder S; S.init(M, D, F.G, (int)blockIdx.x);
        pg8::EpiResGate E{F.out, F.out, D, MOD + 5 * D, NMOD * D, SEQ / 256};
        pg8::gemm_phase<pg8::EpiResGate, pg8::StaticOrder, PG8_ALIGN, PG8_SP2>(F.lds + RING_OFF, g, S, E);
        if (BOTH(8)) GRID_BAR();
    }
    if (IN(9)) { final_norm_phase(F, F.out, F.in[18]); }
#undef IN
#undef BOTH
}

extern "C" void kernel_launch(void* const* d_in, const int* in_sizes, int n_in, void* d_out, int out_size, void* d_ws, size_t ws_size, hipStream_t stream) {
    static int grid = 0;
    if (grid == 0) {
        if (n_in != 19 || in_sizes[0] != M * D || out_size != M * D || ws_size < WS_END) { fprintf(stderr, "kernel_launch: unexpected shapes (n_in %d, in0 %d, out %d, ws %zu); nothing launched\n", n_in, n_in > 0 ? in_sizes[0] : -1, out_size, ws_size); grid = -1; return; }
        int dev = 0, cus = 0, per_cu = 0;
        if (hipGetDevice(&dev) != hipSuccess || hipDeviceGetAttribute(&cus, hipDeviceAttributeMultiprocessorCount, dev) != hipSuccess) { grid = -1; return; }
        if (hipFuncSetAttribute((const void*)fwd_kernel, hipFuncAttributeMaxDynamicSharedMemorySize, LDS_BYTES) != hipSuccess) { fprintf(stderr, "kernel_launch: hipFuncSetAttribute failed\n"); grid = -1; return; }
        if (hipOccupancyMaxActiveBlocksPerMultiprocessor(&per_cu, (const void*)fwd_kernel, NWAVES * 64, LDS_BYTES) != hipSuccess || per_cu < 1) { fprintf(stderr, "kernel_launch: occupancy query says %d blocks per CU\n", per_cu); per_cu = 1; }
        (void)hipGetLastError();
        grid = cus;
    }
    if (grid < 0) return;
    (void)hipMemsetAsync((char*)d_ws + WS_CTL, 0, CTL_ZERO_BYTES, stream);
    Args a{};
    for (int i = 0; i < 19; ++i) a.in[i] = (const float*)d_in[i];
    a.out = (float*)d_out; a.ws = (unsigned char*)d_ws;
#if MK_ONE_LAUNCH
    a.ph_lo = 0; a.ph_hi = N_PHASES;
    hipLaunchKernelGGL(fwd_kernel, dim3(grid), dim3(NWAVES * 64), LDS_BYTES, stream, a);
#else
    for (int p = 0; p < N_PHASES; ++p) { a.ph_lo = p; a.ph_hi = p + 1; hipLaunchKernelGGL(fwd_kernel, dim3(grid), dim3(NWAVES * 64), LDS_BYTES, stream, a); }
#endif
}
```

```cpp
#include <hip/hip_runtime.h>
#include <cstdio>
#include <cstdint>
namespace pg8 {
#define PG8_LAS __attribute__((address_space(3)))
typedef unsigned short bf16_t;
typedef short bf16x8 __attribute__((ext_vector_type(8)));
typedef float f32x4 __attribute__((ext_vector_type(4)));
typedef unsigned u32x4 __attribute__((ext_vector_type(4)));
constexpr int BM = 256, BK = 64, HALF = 128, HTB = HALF * BK * 2  , STAGE_BYTES = 8 * HTB, NXCD = 8, WGM = 8;

__host__ __device__ __forceinline__ int lds_byte(int r, int c) { const int st = (r >> 4) * 2 + (c >> 5), rr = r & 15, cc = c & 31, ob = rr * 64 + cc * 2; return st * 1024 + (ob ^ (((ob >> 9) & 1) << 5)); }
__host__ __device__ __forceinline__ void stage_rc(int b, int& R, int& C) { const int st = b / 1024, sb = b % 1024, swz = sb ^ (((sb >> 9) & 1) << 5); R = (st >> 1) * 16 + swz / 64; C = (st & 1) * 32 + (swz % 64) / 2; }
__host__ __device__ __forceinline__ int perm32(int rho) { const int n = rho >> 4, i = rho & 15; return 8 * (i >> 2) + 4 * n + (i & 3); }

struct Unit { int pm, pn; };
struct Gemm { const bf16_t* A; const bf16_t* Bt; int M, N, K; };

struct StaticOrder {
    int nM, nN, nwg, G, c;
    __host__ __device__ void init(int M, int N, int G_, int c_) { nM = M / BM; nN = N / BM; nwg = nM * nN; G = G_; c = c_; }
    __host__ __device__ bool next(int i, Unit& u) const {
        const long L = (long)i * G + c; if (L >= nwg) return false;
        int wgid = (int)L; { const int q = nwg / NXCD, r = nwg % NXCD, xcd = wgid % NXCD, off = wgid / NXCD; wgid = (xcd < r ? xcd * (q + 1) : r * (q + 1) + (xcd - r) * q) + off; }
        const int nig = WGM * nN, gid = wgid / nig, fm = gid * WGM, gsz = (nM - fm) < WGM ? (nM - fm) : WGM;
        u.pm = fm + ((wgid % nig) % gsz); u.pn = (wgid % nig) / gsz; return true;
    }
    __device__ __forceinline__ void a_ready(const Unit&) const {}
    __device__ __forceinline__ void done(const Unit&) const {}
};

__device__ __forceinline__ unsigned cvt_pk_bf16(float lo, float hi) { unsigned r; asm volatile("v_cvt_pk_bf16_f32 %0, %1, %2" : "=v"(r) : "v"(lo), "v"(hi)); return r; }
typedef float f32x2 __attribute__((ext_vector_type(2)));
__device__ __forceinline__ f32x2 gelu_pk(f32x2 v) {
    const f32x2 av = __builtin_elementwise_abs(v), d = av * 0.2316418882f + 1.0f;
    f32x2 t; t.x = __builtin_amdgcn_rcpf(d.x); t.y = __builtin_amdgcn_rcpf(d.y);
    f32x2 q = t * 0.5307027145f + (-0.7265760135f); q = q * t + 0.7107068705f; q = q * t + (-0.142248368f); q = q * t + 0.127414796f; q = q * t;
    const f32x2 s = (v * v) * (-0.72134752044f);
    f32x2 e; e.x = __builtin_amdgcn_exp2f(s.x); e.y = __builtin_amdgcn_exp2f(s.y);
    const f32x2 m = v * (q * e), r = v - m;
    f32x2 o; o.x = v.x < 0.f ? m.x : r.x; o.y = v.y < 0.f ? m.y : r.y; return o;
}

template <int ACT  > struct EpiBf16 {
    static constexpr bool PERM = true, AFTER_DRAIN = false; static_assert(ACT == 0 || ACT == 1, "EpiBf16: ACT is 0 (none) or 1 (gelu_pk)");
    bf16_t* O; int ldc; const float* bias; int split_cols; size_t split_stride; float scale0;
    __device__ __forceinline__ void operator()(const f32x4 (&acc)[2][2][4][2], const Unit& u, int wr, int wc, int fr, int fq) const {
        const int row0 = u.pm * BM + wr * 64 + fr; int colt = u.pn * BM; bf16_t* base = O;
        float sc = 1.f; if (split_cols) { const int t = colt / split_cols; base += (size_t)t * split_stride; colt -= t * split_cols; if (t == 0) sc = scale0; }
        const int col0 = colt + wc * 32 + 8 * fq, bcol0 = u.pn * BM + wc * 32 + 8 * fq;
        f32x4 bv[2][2];
#pragma unroll
        for (int bj = 0; bj < 2; ++bj)
#pragma unroll
            for (int n = 0; n < 2; ++n) bv[bj][n] = bias ? *(const f32x4*)(bias + bcol0 + bj * HALF + 4 * n) : (f32x4){0.f, 0.f, 0.f, 0.f};
#pragma unroll
        for (int ai = 0; ai < 2; ++ai)
#pragma unroll
            for (int m = 0; m < 4; ++m) { bf16_t* rowp = base + (size_t)(row0 + ai * HALF + m * 16) * ldc + col0;
#pragma unroll
                for (int bj = 0; bj < 2; ++bj) { f32x4 v0 = acc[ai][bj][m][0] + bv[bj][0], v1 = acc[ai][bj][m][1] + bv[bj][1];
                    if (ACT == 1) { f32x2 a = gelu_pk((f32x2){v0[0], v0[1]}), b = gelu_pk((f32x2){v0[2], v0[3]}), c = gelu_pk((f32x2){v1[0], v1[1]}), d = gelu_pk((f32x2){v1[2], v1[3]});
                        v0 = (f32x4){a.x, a.y, b.x, b.y}; v1 = (f32x4){c.x, c.y, d.x, d.y}; }
                    v0 = v0 * sc; v1 = v1 * sc; u32x4 w; w.x = cvt_pk_bf16(v0[0], v0[1]); w.y = cvt_pk_bf16(v0[2], v0[3]); w.z = cvt_pk_bf16(v1[0], v1[1]); w.w = cvt_pk_bf16(v1[2], v1[3]);
                    *(u32x4*)(rowp + bj * HALF) = w; } }
    }
};

struct PanelStats {
    unsigned* xbuf;
    unsigned* cnt;
    unsigned* tmo;
    int ntn; float eps;
    unsigned code;
    __device__ __forceinline__ bool run(const f32x4 (&v)[2][2][4][2], const Unit& u, int wr, int wc, int fr, int fq, PG8_LAS unsigned char* lds, int wid, int lane) const {
        typedef float f32x2v __attribute__((ext_vector_type(2)));
        PG8_LAS f32x2v* P = (PG8_LAS f32x2v*)lds;
        PG8_LAS f32x2v* S = (PG8_LAS f32x2v*)(lds + 8192);
        PG8_LAS unsigned* flag = (PG8_LAS unsigned*)(lds + 8192 + 2048);
#pragma unroll
        for (int ai = 0; ai < 2; ++ai)
#pragma unroll
            for (int m = 0; m < 4; ++m) {
                float s = 0.f;
#pragma unroll
                for (int bj = 0; bj < 2; ++bj)
#pragma unroll
                    for (int n = 0; n < 2; ++n) { const f32x4 x = v[ai][bj][m][n]; s += (x[0] + x[1]) + (x[2] + x[3]); }
                s += __shfl_xor(s, 16); s += __shfl_xor(s, 32);
                const float mw = s * (1.0f / 64.0f); float q = 0.f;
#pragma unroll
                for (int bj = 0; bj < 2; ++bj)
#pragma unroll
                    for (int n = 0; n < 2; ++n) { const f32x4 d = v[ai][bj][m][n] - mw; q += (d[0] * d[0] + d[1] * d[1]) + (d[2] * d[2] + d[3] * d[3]); }
                q += __shfl_xor(q, 16); q += __shfl_xor(q, 32);
                if (fq == 0) P[(ai * HALF + wr * 64 + m * 16 + fr) * 4 + wc] = (f32x2v){mw, q};
            }
        asm volatile("s_waitcnt lgkmcnt(0)" ::: "memory"); __builtin_amdgcn_s_barrier(); asm volatile("" ::: "memory");
#if defined(BROKEN_EXCHANGE_NO_WAIT)
#warning BROKEN CONTROL BUILD: the row-statistics exchange does not wait; results are wrong by design
        if (blockIdx.x >= 64) { const long long t0_ = clock64(); while (clock64() - t0_ < 60000) __builtin_amdgcn_s_sleep(8); }
#endif
        const int row = wid * 32 + (lane & 31);
        if (lane < 32) {
            const f32x2v a = P[row * 4 + 0], b = P[row * 4 + 1], c = P[row * 4 + 2], d = P[row * 4 + 3];
            const float mt = (a.x + b.x + c.x + d.x) * 0.25f;
            const float da = a.x - mt, db = b.x - mt, dc = c.x - mt, dd = d.x - mt;
            const float m2 = (a.y + b.y) + (c.y + d.y) + 64.0f * ((da * da + db * db) + (dc * dc + dd * dd));
            unsigned long long* slot = (unsigned long long*)xbuf + ((size_t)(u.pm * BM + row) * 4 + u.pn);
            __hip_atomic_store(slot, ((unsigned long long)__float_as_uint(m2) << 32) | __float_as_uint(mt), __ATOMIC_RELAXED, __HIP_MEMORY_SCOPE_AGENT);
        }
        asm volatile("s_waitcnt vmcnt(0)" ::: "memory");
        if (lane == 0) __hip_atomic_fetch_add(cnt + 64 * u.pm, 1u, __ATOMIC_RELAXED, __HIP_MEMORY_SCOPE_AGENT);
        if (wid == 0) {
            bool dead = false; const unsigned long long t0 = __builtin_amdgcn_s_memrealtime(); const unsigned want = 8u * (unsigned)ntn;
            for (;;) {
#if defined(BROKEN_EXCHANGE_NO_WAIT)
                break;
#endif
                if ((unsigned)__builtin_amdgcn_readfirstlane(__hip_atomic_load(cnt + 64 * u.pm, __ATOMIC_RELAXED, __HIP_MEMORY_SCOPE_AGENT)) >= want) break;
                if (__builtin_amdgcn_s_memrealtime() - t0 > 2000000ull) {
                    if (lane == 0) { unsigned expect = 0u; __hip_atomic_compare_exchange_strong(tmo + 1, &expect, code | (unsigned)(u.pm & 0xff), __ATOMIC_RELAXED, __ATOMIC_RELAXED, __HIP_MEMORY_SCOPE_AGENT);
                                     __hip_atomic_store(tmo, 1u, __ATOMIC_RELAXED, __HIP_MEMORY_SCOPE_AGENT); }
                    dead = true; break; }
                __builtin_amdgcn_s_sleep(2);
            }
            __builtin_amdgcn_fence(__ATOMIC_ACQUIRE, "agent");
            if (lane == 0) flag[0] = dead ? 1u : 0u;
        }
        asm volatile("s_waitcnt vmcnt(0) lgkmcnt(0)" ::: "memory"); __builtin_amdgcn_s_barrier(); asm volatile("" ::: "memory");
        const bool bad = flag[0] != 0u;
        if (lane < 32) {
            const unsigned long long* slot = (const unsigned long long*)xbuf + (size_t)(u.pm * BM + row) * 4; float mt[4], m2[4]; float ms = 0.f;
#pragma unroll
            for (int t = 0; t < 4; ++t) { if (t < ntn) { const unsigned long long w = __hip_atomic_load(slot + t, __ATOMIC_RELAXED, __HIP_MEMORY_SCOPE_AGENT); mt[t] = __uint_as_float((unsigned)w); m2[t] = __uint_as_float((unsigned)(w >> 32)); } else { mt[t] = 0.f; m2[t] = 0.f; } ms += mt[t]; }
            const float mean = ms / (float)ntn; float q = 0.f;
#pragma unroll
            for (int t = 0; t < 4; ++t) if (t < ntn) { const float dm = mt[t] - mean; q += m2[t] + 256.0f * dm * dm; }
            S[row] = (f32x2v){mean, 1.0f / sqrtf(q / (256.0f * (float)ntn) + eps)};
        }
        asm volatile("s_waitcnt lgkmcnt(0)" ::: "memory"); __builtin_amdgcn_s_barrier(); asm volatile("" ::: "memory");
        return bad;
    }
};
struct EpiLnRes {
    static constexpr bool PERM = false, AFTER_DRAIN = true;
    const float* base; float* out; int ldc; const float* bias; PanelStats st; unsigned poison;
    __device__ __forceinline__ void fused(f32x4 (&acc)[2][2][4][2], const Unit& u, int wr, int wc, int fr, int fq, PG8_LAS unsigned char* lds, int wid, int lane) const {
        typedef float f32x2v __attribute__((ext_vector_type(2)));
        const PG8_LAS f32x2v* S = (const PG8_LAS f32x2v*)(lds + 8192);
        const int col0 = u.pn * BM + wc * 32 + 4 * fq;
#pragma unroll
        for (int bj = 0; bj < 2; ++bj)
#pragma unroll
            for (int n = 0; n < 2; ++n) { const f32x4 bv = bias ? *(const f32x4*)(bias + col0 + bj * HALF + n * 16) : (f32x4){0.f, 0.f, 0.f, 0.f};
#pragma unroll
                for (int ai = 0; ai < 2; ++ai)
#pragma unroll
                    for (int m = 0; m < 4; ++m) acc[ai][bj][m][n] += bv; }
        f32x4 pre[4][2][2];
#pragma unroll
        for (int m = 0; m < 4; ++m) { const size_t off = (size_t)(u.pm * BM + wr * 64 + m * 16 + fr) * ldc + col0;
#pragma unroll
            for (int bj = 0; bj < 2; ++bj)
#pragma unroll
                for (int n = 0; n < 2; ++n) pre[m][bj][n] = *(const f32x4*)(base + off + bj * HALF + n * 16); }
        const bool bad = st.run(acc, u, wr, wc, fr, fq, lds, wid, lane) || poison != 0u;
        const float qnan = __builtin_nanf("");
#pragma unroll
        for (int ai = 0; ai < 2; ++ai)
#pragma unroll
            for (int m = 0; m < 4; ++m) { const int r = ai * HALF + wr * 64 + m * 16 + fr; const f32x2v sr = S[r]; const size_t off = (size_t)(u.pm * BM + r) * ldc + col0;
#pragma unroll
                for (int bj = 0; bj < 2; ++bj)
#pragma unroll
                    for (int n = 0; n < 2; ++n) { const f32x4 bs = ai == 0 ? pre[m][bj][n] : *(const f32x4*)(base + off + bj * HALF + n * 16); f32x4 o = bs + (acc[ai][bj][m][n] - sr.x) * sr.y;
                        if (bad) o = (f32x4){qnan, qnan, qnan, qnan}; *(f32x4*)(out + off + bj * HALF + n * 16) = o; }
                if (m & 1) asm volatile("" ::: "memory"); }
    }
};
struct EpiLnResLn {
    static constexpr bool PERM = false, AFTER_DRAIN = true;
    const float* base; float* out; bf16_t* xn; int ldc; const float* bias; PanelStats st1, st2; unsigned poison;
    __device__ __forceinline__ void fused(f32x4 (&acc)[2][2][4][2], const Unit& u, int wr, int wc, int fr, int fq, PG8_LAS unsigned char* lds, int wid, int lane) const {
        typedef float f32x2v __attribute__((ext_vector_type(2))); typedef unsigned u32x2v __attribute__((ext_vector_type(2)));
        const PG8_LAS f32x2v* S = (const PG8_LAS f32x2v*)(lds + 8192);
        const int col0 = u.pn * BM + wc * 32 + 4 * fq;
#pragma unroll
        for (int bj = 0; bj < 2; ++bj)
#pragma unroll
            for (int n = 0; n < 2; ++n) { const f32x4 bv = bias ? *(const f32x4*)(bias + col0 + bj * HALF + n * 16) : (f32x4){0.f, 0.f, 0.f, 0.f};
#pragma unroll
                for (int ai = 0; ai < 2; ++ai)
#pragma unroll
                    for (int m = 0; m < 4; ++m) acc[ai][bj][m][n] += bv; }
        bool bad = st1.run(acc, u, wr, wc, fr, fq, lds, wid, lane) || poison != 0u;
        const float qnan = __builtin_nanf("");
#pragma unroll
        for (int ai = 0; ai < 2; ++ai)
#pragma unroll
            for (int m = 0; m < 4; ++m) { const int r = ai * HALF + wr * 64 + m * 16 + fr; const f32x2v sr = S[r]; const size_t off = (size_t)(u.pm * BM + r) * ldc + col0;
#pragma unroll
                for (int bj = 0; bj < 2; ++bj)
#pragma unroll
                    for (int n = 0; n < 2; ++n) { const f32x4 bs = *(const f32x4*)(base + off + bj * HALF + n * 16); acc[ai][bj][m][n] = bs + (acc[ai][bj][m][n] - sr.x) * sr.y; }
                asm volatile("" : "+v"(acc[ai][0][m][0]), "+v"(acc[ai][0][m][1]), "+v"(acc[ai][1][m][0]), "+v"(acc[ai][1][m][1]));
                if (m & 1) asm volatile("" ::: "memory"); }
        const bool bad1 = bad;
        bad = st2.run(acc, u, wr, wc, fr, fq, lds, wid, lane) || bad;
#pragma unroll
        for (int ai = 0; ai < 2; ++ai)
#pragma unroll
            for (int m = 0; m < 4; ++m) { const int r = ai * HALF + wr * 64 + m * 16 + fr; const f32x2v sr = S[r]; const size_t off = (size_t)(u.pm * BM + r) * ldc + col0;
#pragma unroll
                for (int bj = 0; bj < 2; ++bj)
#pragma unroll
                    for (int n = 0; n < 2; ++n) { const f32x4 x1 = acc[ai][bj][m][n]; *(f32x4*)(out + off + bj * HALF + n * 16) = bad1 ? (f32x4){qnan, qnan, qnan, qnan} : x1;
                        const f32x4 o = (x1 - sr.x) * sr.y; u32x2v w; w.x = cvt_pk_bf16(o[0], o[1]); w.y = cvt_pk_bf16(o[2], o[3]);
                        if (bad) { w.x = 0x7fc07fc0u; w.y = 0x7fc07fc0u; } *(u32x2v*)(xn + off + bj * HALF + n * 16) = w; }
                asm volatile("" ::: "memory"); }
    }
};

template <class Epi, class Sched, bool ALIGN_EPI = false, bool SP2 = false>
__device__ __forceinline__ void gemm_phase(PG8_LAS unsigned char* lds, const Gemm g, const Sched& S, const Epi& E) {
    const int tid = threadIdx.x, wid = __builtin_amdgcn_readfirstlane(tid >> 6), lane = tid & 63, wr = wid >> 2, wc = wid & 3, fr = lane & 15, fq = lane >> 4;
    const int K = g.K, nt = K / BK;
    unsigned voffA[2], voffB[2];
#pragma unroll
    for (int i = 0; i < 2; ++i) { int R, C; stage_rc(tid * 16 + i * 8192, R, C); const int Rb = Epi::PERM ? ((R & ~31) + perm32(R & 31)) : R;
        voffA[i] = (unsigned)(R * K + C) * 2u; voffB[i] = (unsigned)(Rb * K + C) * 2u; }
    const size_t kstep = (size_t)(BK * 2);
    const size_t hstep = (size_t)HALF * K * 2;
    const size_t tstep = 2 * hstep;
    const unsigned ldsw = (unsigned)wid * 1024u;
    const int aoff = lds_byte(wr * 64 + fr, fq * 8), boff = lds_byte(wc * 32 + fr, fq * 8);
#define PG8_SA(b, h) (((b) * 2 + (h)) * HTB)
#define PG8_SB(b, h) ((4 + (b) * 2 + (h)) * HTB)
#define PG8_STAGE(bufoff, gbase, voff) do { _Pragma("unroll") for (int _i = 0; _i < 2; ++_i) \
        __builtin_amdgcn_global_load_lds((const unsigned*)((const char*)(gbase) + (voff)[_i]), (PG8_LAS unsigned*)(lds + (bufoff) + ldsw + _i * 8192), 16, 0, 0); } while (0)
#define PG8_LDA(dst, b, h) do { _Pragma("unroll") for (int m = 0; m < 4; ++m) _Pragma("unroll") for (int k = 0; k < 2; ++k) dst[m][k] = *(const PG8_LAS bf16x8*)(lds + PG8_SA(b, h) + aoff + m * 2048 + k * 1024); } while (0)
#define PG8_LDB(dst, b, h) do { _Pragma("unroll") for (int n = 0; n < 2; ++n) _Pragma("unroll") for (int k = 0; k < 2; ++k) dst[n][k] = *(const PG8_LAS bf16x8*)(lds + PG8_SB(b, h) + boff + n * 2048 + k * 1024); } while (0)
#define PG8_MMA(ai, bj, At, Bt) do { __builtin_amdgcn_s_setprio(1); _Pragma("unroll") for (int m = 0; m < 4; ++m) _Pragma("unroll") for (int n = 0; n < 2; ++n) _Pragma("unroll") for (int k = 0; k < 2; ++k) \
        acc[ai][bj][m][n] = __builtin_amdgcn_mfma_f32_16x16x32_bf16(Bt[n][k], At[m][k], acc[ai][bj][m][n], 0, 0, 0); __builtin_amdgcn_s_setprio(0); } while (0)
#define PG8_WAIT_V(n) asm volatile("s_waitcnt vmcnt(" #n ")" ::: "memory")
#define PG8_WAIT_L(n) asm volatile("s_waitcnt lgkmcnt(" #n ")" ::: "memory")
#define PG8_BAR __builtin_amdgcn_s_barrier()
#define PG8_SCHED __builtin_amdgcn_sched_barrier(0)
    Unit cur, nxt; int ui = 0;
    if (!S.next(0, cur)) return;
    f32x4 acc[2][2][4][2];
#pragma unroll
    for (int a = 0; a < 2; ++a)
#pragma unroll
        for (int b = 0; b < 2; ++b)
#pragma unroll
            for (int m = 0; m < 4; ++m)
#pragma unroll
                for (int n = 0; n < 2; ++n) acc[a][b][m][n] = (f32x4){0.f, 0.f, 0.f, 0.f};
    bf16x8 At[4][2], B0[2][2], B1[2][2];
    const char* cA = (const char*)g.A + (size_t)cur.pm * tstep; const char* cB = (const char*)g.Bt + (size_t)cur.pn * tstep;
    S.a_ready(cur);
    if constexpr (SP2) {
        PG8_STAGE(PG8_SB(0, 0), cB, voffB); PG8_STAGE(PG8_SB(0, 1), cB + hstep, voffB); PG8_STAGE(PG8_SA(0, 0), cA, voffA); PG8_STAGE(PG8_SA(0, 1), cA + hstep, voffA);
        if (wr == 1) PG8_BAR;
        PG8_WAIT_V(2); PG8_BAR;
        PG8_STAGE(PG8_SB(1, 0), cB + kstep, voffB); PG8_STAGE(PG8_SA(1, 0), cA + kstep, voffA); PG8_STAGE(PG8_SB(1, 1), cB + hstep + kstep, voffB);
        PG8_WAIT_V(6); PG8_BAR;
    } else {
        PG8_STAGE(PG8_SB(0, 0), cB, voffB); PG8_STAGE(PG8_SA(0, 0), cA, voffA); PG8_STAGE(PG8_SB(0, 1), cB + hstep, voffB); PG8_STAGE(PG8_SA(0, 1), cA + hstep, voffA);
        if (wr == 1) PG8_BAR;
        PG8_WAIT_V(4); PG8_BAR;
        PG8_STAGE(PG8_SB(1, 0), cB + kstep, voffB); PG8_STAGE(PG8_SA(1, 0), cA + kstep, voffA); PG8_STAGE(PG8_SB(1, 1), cB + hstep + kstep, voffB);
        PG8_WAIT_V(6); PG8_BAR;
    }
    for (;;) {
        const bool has_next = S.next(ui + 1, nxt);
        const char* nA = has_next ? (const char*)g.A + (size_t)nxt.pm * tstep : cA; const char* nB = has_next ? (const char*)g.Bt + (size_t)nxt.pn * tstep : cB;
        for (int t = 0; t < nt; t += 2) {
            const bool last = (t == nt - 2);
            const char* a1 = cA + (size_t)(t + 1) * kstep;
            const char* a2 = last ? nA : cA + (size_t)(t + 2) * kstep; const char* b2 = last ? nB : cB + (size_t)(t + 2) * kstep;
            const char* a3 = a2 + kstep; const char* b3 = b2 + kstep;
            if (last && has_next) S.a_ready(nxt);
            if constexpr (SP2) {
            PG8_LDB(B0, 0, 0); PG8_LDB(B1, 0, 1); PG8_SCHED; PG8_LDA(At, 0, 0); PG8_STAGE(PG8_SA(1, 1), a1 + hstep, voffA);
            PG8_WAIT_V(8); PG8_WAIT_L(0); PG8_BAR; PG8_MMA(0, 0, At, B0); PG8_MMA(0, 1, At, B1); PG8_BAR; PG8_SCHED;
            PG8_LDA(At, 0, 1); PG8_STAGE(PG8_SB(0, 0), b2, voffB); PG8_STAGE(PG8_SB(0, 1), b2 + hstep, voffB); PG8_STAGE(PG8_SA(0, 0), a2, voffA);
            PG8_WAIT_V(8); PG8_WAIT_L(0); PG8_BAR; PG8_MMA(1, 0, At, B0); PG8_MMA(1, 1, At, B1); PG8_BAR; PG8_SCHED;
            PG8_LDB(B0, 1, 0); PG8_LDB(B1, 1, 1); PG8_SCHED; PG8_LDA(At, 1, 0); PG8_STAGE(PG8_SA(0, 1), a2 + hstep, voffA);
            PG8_WAIT_V(8); PG8_WAIT_L(0); PG8_BAR; PG8_MMA(0, 0, At, B0); PG8_MMA(0, 1, At, B1); PG8_BAR; PG8_SCHED;
            PG8_LDA(At, 1, 1); PG8_STAGE(PG8_SB(1, 0), b3, voffB); PG8_STAGE(PG8_SB(1, 1), b3 + hstep, voffB); PG8_STAGE(PG8_SA(1, 0), a3, voffA);
            PG8_WAIT_V(8); PG8_WAIT_L(0); PG8_BAR; PG8_MMA(1, 0, At, B0); PG8_MMA(1, 1, At, B1); PG8_BAR; PG8_SCHED;
            } else {
            PG8_LDB(B0, 0, 0); PG8_SCHED; PG8_LDA(At, 0, 0); PG8_STAGE(PG8_SA(1, 1), a1 + hstep, voffA);
            PG8_WAIT_L(8); PG8_BAR; PG8_WAIT_L(0); PG8_MMA(0, 0, At, B0); PG8_BAR; PG8_SCHED;
            PG8_LDB(B1, 0, 1); PG8_STAGE(PG8_SB(0, 0), b2, voffB);
            PG8_BAR; PG8_WAIT_L(0); PG8_MMA(0, 1, At, B1); PG8_BAR;
            PG8_LDA(At, 0, 1); PG8_STAGE(PG8_SA(0, 0), a2, voffA);
            PG8_BAR; PG8_WAIT_L(0); PG8_MMA(1, 0, At, B0); PG8_BAR; PG8_SCHED;
            PG8_STAGE(PG8_SB(0, 1), b2 + hstep, voffB);
            PG8_WAIT_V(6); PG8_BAR; PG8_MMA(1, 1, At, B1); PG8_BAR;
            PG8_LDB(B0, 1, 0); PG8_SCHED; PG8_LDA(At, 1, 0); PG8_STAGE(PG8_SA(0, 1), a2 + hstep, voffA);
            PG8_WAIT_L(8); PG8_BAR; PG8_WAIT_L(0); PG8_MMA(0, 0, At, B0); PG8_BAR; PG8_SCHED;
            PG8_LDB(B1, 1, 1); PG8_STAGE(PG8_SB(1, 0), b3, voffB);
            PG8_BAR; PG8_WAIT_L(0); PG8_MMA(0, 1, At, B1); PG8_BAR;
            PG8_LDA(At, 1, 1); PG8_STAGE(PG8_SA(1, 0), a3, voffA);
            PG8_BAR; PG8_WAIT_L(0); PG8_MMA(1, 0, At, B0); PG8_BAR; PG8_SCHED;
            PG8_STAGE(PG8_SB(1, 1), b3 + hstep, voffB);
            PG8_WAIT_V(6); PG8_BAR; PG8_MMA(1, 1, At, B1); PG8_BAR;
            }
        }
        if constexpr (ALIGN_EPI) { if (wr == 0) PG8_BAR; }
        if constexpr (!Epi::AFTER_DRAIN) { E(acc, cur, wr, wc, fr, fq); S.done(cur); }
        if (!has_next) break;
#pragma unroll
        for (int a = 0; a < 2; ++a)
#pragma unroll
            for (int b = 0; b < 2; ++b)
#pragma unroll
                for (int m = 0; m < 4; ++m)
#pragma unroll
                    for (int n = 0; n < 2; ++n) acc[a][b][m][n] = (f32x4){0.f, 0.f, 0.f, 0.f};
        cur = nxt; cA = nA; cB = nB; ++ui;
        if constexpr (ALIGN_EPI) { if (wr == 1) PG8_BAR; }
    }
    PG8_WAIT_V(0);
    if constexpr (!ALIGN_EPI) { if (wr == 0) PG8_BAR; }
    PG8_BAR;
    if constexpr (Epi::AFTER_DRAIN) { E.fused(acc, cur, wr, wc, fr, fq, lds, wid, lane); S.done(cur); }
#undef PG8_SA
#undef PG8_SB
#undef PG8_STAGE
#undef PG8_LDA
#undef PG8_LDB
#undef PG8_MMA
#undef PG8_WAIT_V
#undef PG8_WAIT_L
#undef PG8_BAR
#undef PG8_SCHED
}
}
namespace pg8 {
__device__ __forceinline__ float fast_silu(float x) { return x * __builtin_amdgcn_rcpf(1.0f + __builtin_amdgcn_exp2f(-1.44269504089f * x)); }
struct EpiResGate {
    static constexpr bool PERM = false, AFTER_DRAIN = false;
    const float* base; float* out; int ldc; const float* gate; int gate_ld; int tiles_per_batch;
    __device__ __forceinline__ void operator()(const f32x4 (&acc)[2][2][4][2], const Unit& u, int wr, int wc, int fr, int fq) const {
        const int row0 = u.pm * BM + wr * 64 + fr, col0 = u.pn * BM + wc * 32 + 4 * fq;
        const float* gp = gate + (size_t)(u.pm / tiles_per_batch) * gate_ld + col0;
        f32x4 gv[2][2];
#pragma unroll
        for (int bj = 0; bj < 2; ++bj)
#pragma unroll
            for (int n = 0; n < 2; ++n) gv[bj][n] = *(const f32x4*)(gp + bj * HALF + n * 16);
#pragma unroll
        for (int ai = 0; ai < 2; ++ai)
#pragma unroll
            for (int m = 0; m < 4; ++m) { const size_t off = (size_t)(row0 + ai * HALF + m * 16) * ldc + col0;
#pragma unroll
                for (int bj = 0; bj < 2; ++bj)
#pragma unroll
                    for (int n = 0; n < 2; ++n) { const f32x4 b = *(const f32x4*)(base + off + bj * HALF + n * 16); *(f32x4*)(out + off + bj * HALF + n * 16) = b + gv[bj][n] * acc[ai][bj][m][n]; } }
    }
};
struct EpiSwiGLU {
    static constexpr bool PERM = true, AFTER_DRAIN = false;
    bf16_t* O; int ldc;
    __device__ __forceinline__ void operator()(const f32x4 (&acc)[2][2][4][2], const Unit& u, int wr, int wc, int fr, int fq) const {
        const int row0 = u.pm * BM + wr * 64 + fr, col0 = u.pn * HALF + wc * 32 + 8 * fq;
#pragma unroll
        for (int ai = 0; ai < 2; ++ai)
#pragma unroll
            for (int m = 0; m < 4; ++m) { bf16_t* rowp = O + (size_t)(row0 + ai * HALF + m * 16) * ldc + col0;
                const f32x4 g0 = acc[ai][0][m][0], g1 = acc[ai][0][m][1], u0 = acc[ai][1][m][0], u1 = acc[ai][1][m][1];
                u32x4 w; w.x = cvt_pk_bf16(fast_silu(g0[0]) * u0[0], fast_silu(g0[1]) * u0[1]); w.y = cvt_pk_bf16(fast_silu(g0[2]) * u0[2], fast_silu(g0[3]) * u0[3]);
                w.z = cvt_pk_bf16(fast_silu(g1[0]) * u1[0], fast_silu(g1[1]) * u1[1]); w.w = cvt_pk_bf16(fast_silu(g1[2]) * u1[2], fast_silu(g1[3]) * u1[3]);
                *(u32x4*)rowp = w; }
    }
};
}
#ifndef PG8_SP2
#define PG8_SP2 true
#endif
#ifndef PG8_ALIGN
#define PG8_ALIGN true
#endif
constexpr int NWAVES = 8;
#ifndef MK_ONE_LAUNCH
#define MK_ONE_LAUNCH 1
#endif
#ifndef GDN_SIMPLE
#define GDN_SIMPLE 0
#endif
constexpr int N_PHASES = 10;

constexpr int BATCH = 8, SEQ = 2048, D = 1024, M = BATCH * SEQ;
constexpr int CW = 512, GW = 512, NH = 4, HD = 128, NIN = 3080, NIN_G = 3072, FF = 2816, NMOD = 6;
constexpr int CONVK = 31, CL = 64;
constexpr float EPS = 1e-6f;
constexpr int PC_A = 0, PC_GATE = 512, PC_Q = 1024, PC_K = 1536, PC_V = 2048, PC_Z = 2560;

constexpr size_t MiB = 1u << 20;
constexpr size_t WS_CTL = 0, CTL_ZERO_BYTES = 1 * MiB;
constexpr size_t WS_MOD = 1 * MiB;
constexpr size_t WS_BG = 1 * MiB + 512 * 1024;
constexpr size_t WS_WIN = 2 * MiB, WS_WOUT = 8 * MiB, WS_WFI = 10 * MiB, WS_WFO = 21 * MiB;
constexpr size_t WS_XN = 28 * MiB;
constexpr size_t WS_P = 60 * MiB;
constexpr size_t WS_HID = 60 * MiB;
constexpr size_t WS_MIXIN = 156 * MiB;
constexpr size_t WS_QN = 188 * MiB, WS_KN = 220 * MiB, WS_VN = 28 * MiB;
constexpr size_t WS_END = 256 * MiB;
constexpr int CW_BAR = 4096;

constexpr int RING_OFF = 0, RING_BYTES = 131072;
constexpr int EXTRA_OFF = RING_BYTES, EXTRA_BYTES = 16384;
constexpr int LDSCTL_OFF = EXTRA_OFF + EXTRA_BYTES, MISC_OFF = LDSCTL_OFF + 320;
constexpr int LDS_BYTES = 163840;
static_assert(MISC_OFF + 128 <= LDS_BYTES, "LDS map");
#define GAS __attribute__((address_space(1)))
#define LAS __attribute__((address_space(3)))
typedef unsigned short bf16;
typedef unsigned v4u __attribute__((ext_vector_type(4)));
typedef float f32x4 __attribute__((ext_vector_type(4)));
typedef short bf16x8 __attribute__((ext_vector_type(8)));
typedef GAS unsigned gu32;
typedef GAS unsigned long long gu64;
#define RLX_AGENT __ATOMIC_RELAXED, __HIP_MEMORY_SCOPE_AGENT
#define LDS_WAIT() asm volatile("s_waitcnt lgkmcnt(0)" ::: "memory")
#define VM_WAIT() asm volatile("s_waitcnt vmcnt(0)" ::: "memory")
__device__ __forceinline__ unsigned long long rt() { return __builtin_amdgcn_s_memrealtime(); }
__device__ __forceinline__ unsigned f2bf(float f) { unsigned u = __builtin_bit_cast(unsigned, f); return (u + 0x7fffu + ((u >> 16) & 1u)) >> 16; }
__device__ __forceinline__ unsigned pk2(float lo, float hi) { return f2bf(lo) | (f2bf(hi) << 16); }

#define XB_TMO      128
#define XB_XCNT(j)  (256  + 64 * (j))
#define XB_XSUB(j)  (1280 + 64 * (j))
#define XB_XGEN(j)  (2304 + 64 * (j))
#define XB_TOP      3328
#define XB_TOPGEN   3392
#define XCD_BAR_WORDS 3456
#define XB_SPIN_CAP (1u << 18)

__device__ __forceinline__ unsigned xb_ld(unsigned* p)              { return __hip_atomic_load(p, __ATOMIC_RELAXED, __HIP_MEMORY_SCOPE_AGENT); }
__device__ __forceinline__ unsigned xb_add(unsigned* p, unsigned v) { return __hip_atomic_fetch_add(p, v, __ATOMIC_RELAXED, __HIP_MEMORY_SCOPE_AGENT); }
__device__ __forceinline__ unsigned xb_xcc_id() { return (unsigned)__builtin_amdgcn_s_getreg((3 << 11) | 20) & 0xFu; }
#define XB_SPIN(cond, bar) do { unsigned _sp = 0; while (cond) { __builtin_amdgcn_s_sleep(1); \
    if ((++_sp & 255u) == 0u) { if (xb_ld(&(bar)[XB_TMO])) break; if (_sp > XB_SPIN_CAP) { atomicAdd(&(bar)[XB_TMO], 1u); break; } } } } while (0)

struct XcdBarrier {
    unsigned* bar; unsigned x;
    volatile LAS unsigned* st;
};

__device__ __forceinline__ XcdBarrier xcd_barrier_post(unsigned* bar, volatile LAS unsigned* st) {
    XcdBarrier b; b.bar = bar; b.x = xb_xcc_id(); b.st = st;
    if (threadIdx.x == 0) (void)xb_add(&bar[XB_XCNT(b.x)], 1u);
    return b;
}
__device__ __forceinline__ void xcd_barrier_complete(unsigned* bar, unsigned x, unsigned& nloc, unsigned& nx) {
    const unsigned G = gridDim.x * gridDim.y * gridDim.z;
    unsigned sum, cnt, mine, sp = 0u;
    for (;;) {
        sum = 0u; cnt = 0u; mine = 0u;
#pragma unroll
        for (unsigned j = 0; j < 16; ++j) { const unsigned c = xb_ld(&bar[XB_XCNT(j)]); sum += c; cnt += (c > 0u) ? 1u : 0u; mine = (j == x) ? c : mine; }
        if (sum == G) break;
        __builtin_amdgcn_s_sleep(1);
        if ((++sp & 255u) == 0u) { if (xb_ld(&bar[XB_TMO])) break; if (sp > XB_SPIN_CAP) { atomicAdd(&bar[XB_TMO], 1u); break; } }
    }
    nloc = mine > 0u ? mine : 1u; nx = cnt > 0u ? cnt : 1u;
}

__device__ __forceinline__ void xcd_barrier(const XcdBarrier& b) {
    asm volatile("s_waitcnt vmcnt(0)" ::: "memory");
    __syncthreads();
    if (threadIdx.x == 0) {
        unsigned* bar = b.bar;
        __builtin_amdgcn_s_waitcnt(0);
        unsigned nloc = b.st[0], nx = b.st[1];
        if (nloc == 0u) { xcd_barrier_complete(bar, b.x, nloc, nx); b.st[0] = nloc; b.st[1] = nx; }
        const unsigned old = xb_add(&bar[XB_XSUB(b.x)], 1u);
        const unsigned gen = old / nloc;
        if (old + 1u == (gen + 1u) * nloc) {
            __builtin_amdgcn_fence(__ATOMIC_RELEASE, "agent");
            asm volatile("s_waitcnt vmcnt(0)" ::: "memory");
            const unsigned og = xb_add(&bar[XB_TOP], 1u);
            const unsigned tg = og / nx;
            if (og + 1u == (tg + 1u) * nx) xb_add(&bar[XB_TOPGEN], 1u);
            else XB_SPIN(xb_ld(&bar[XB_TOPGEN]) == tg, bar);
            __builtin_amdgcn_fence(__ATOMIC_ACQUIRE, "agent");
            xb_add(&bar[XB_XGEN(b.x)], 1u);
            asm volatile("s_waitcnt vmcnt(0)" ::: "memory");
        } else {
            XB_SPIN(xb_ld(&bar[XB_XGEN(b.x)]) == gen, bar);
            __builtin_amdgcn_fence(__ATOMIC_ACQUIRE, "agent");
            asm volatile("s_waitcnt vmcnt(0)" ::: "memory");
        }
    }
    __syncthreads();
}
struct Frame {
    LAS unsigned char* lds;
    volatile LAS unsigned* MISC;
    gu32* ctl;
    int tid, lane, wave;
    int vcu, G;
    const float* in[19]; float* out; unsigned char* ws;
};
typedef float f32x2 __attribute__((ext_vector_type(2)));
__device__ __forceinline__ float wave_sum(float v) {
#pragma unroll
    for (int o = 1; o < 64; o <<= 1) v += __shfl_xor(v, o);
    return v;
}
__device__ __forceinline__ float bf_lo(unsigned u) { return __builtin_bit_cast(float, u << 16); }
__device__ __forceinline__ float bf_hi(unsigned u) { return __builtin_bit_cast(float, u & 0xffff0000u); }
__device__ __forceinline__ float sigmoidf_(float x) { return 1.0f / (1.0f + __expf(-x)); }
__device__ __forceinline__ float siluf_(float x) { return x / (1.0f + __expf(-x)); }

__device__ __forceinline__ void transpose_item(const float* W, int ldw, int k0, int n_src, bf16* WT, int K, int n_dst, LAS float* scr, int lane) {
#pragma unroll 8
    for (int i = 0; i < 32; ++i) { const int kk = 2 * i + (lane >> 5); scr[kk * 33 + (lane & 31)] = W[(size_t)(k0 + kk) * ldw + n_src + (lane & 31)]; }
    LDS_WAIT(); asm volatile("" ::: "memory");
    const int c = lane & 7;
#pragma unroll
    for (int j = 0; j < 4; ++j) { const int n = (lane >> 3) + 8 * j; const LAS float* s = scr + (8 * c) * 33 + n;
        v4u o; o.x = pk2(s[0 * 33], s[1 * 33]); o.y = pk2(s[2 * 33], s[3 * 33]); o.z = pk2(s[4 * 33], s[5 * 33]); o.w = pk2(s[6 * 33], s[7 * 33]);
        *(GAS v4u*)(WT + (size_t)(n_dst + n) * K + k0 + 8 * c) = o; }
    LDS_WAIT(); asm volatile("" ::: "memory");
}
__device__ __forceinline__ void p0_prologue(Frame& F) {
    const float* c = F.in[1]; const float* w_ada = F.in[2]; const float* b_ada = F.in[3];
    float* MOD = (float*)(F.ws + WS_MOD);
    for (int item = blockIdx.x; item < (NMOD * D) / 32; item += F.G) {
        LAS float* cs = (LAS float*)(F.lds + RING_OFF);
        LAS float* red = (LAS float*)(F.lds + RING_OFF + 32768);
        for (int i = F.tid; i < BATCH * D; i += NWAVES * 64) cs[i] = siluf_(c[i]);
        __syncthreads();
        const int n0 = 32 * item, col = F.lane & 31, kp = F.lane >> 5;
        float acc[8];
#pragma unroll
        for (int b = 0; b < 8; ++b) acc[b] = 0.f;
#pragma unroll 8
        for (int i = 0; i < 64; ++i) { const int k = 128 * F.wave + 2 * i + kp; const float wv = w_ada[(size_t)k * (NMOD * D) + n0 + col];
#pragma unroll
            for (int b = 0; b < 8; ++b) acc[b] += cs[b * D + k] * wv; }
#pragma unroll
        for (int b = 0; b < 8; ++b) { acc[b] += __shfl_xor(acc[b], 32); if (F.lane < 32) red[(F.wave * 8 + b) * 32 + col] = acc[b]; }
        __syncthreads();
        if (F.tid < 256) { const int b = F.tid >> 5, cc = F.tid & 31; float s = b_ada[n0 + cc];
#pragma unroll
            for (int w = 0; w < 8; ++w) s += red[(w * 8 + b) * 32 + cc];
            MOD[b * (NMOD * D) + n0 + cc] = s; }
        __syncthreads();
    }
    LAS float* scr = (LAS float*)(F.lds + RING_OFF + F.wave * 16384);
    const int gw = F.vcu * NWAVES + F.wave, NGW = F.G * NWAVES;
    constexpr int I_IN = (D / 64) * (NIN_G / 32), I_OUT = (D / 64) * (D / 32), I_FI = (D / 64) * (2 * FF / 32), I_FO = (FF / 64) * (D / 32);
    constexpr int NITEMS = I_IN + I_OUT + I_FI + I_FO;
    bf16* WIN = (bf16*)(F.ws + WS_WIN); bf16* WOUT = (bf16*)(F.ws + WS_WOUT); bf16* WFI = (bf16*)(F.ws + WS_WFI); bf16* WFO = (bf16*)(F.ws + WS_WFO);
    for (int it = gw; it < NITEMS; it += NGW) {
        int r = it;
        if (r < I_IN) { const int nblk = NIN_G / 32, kb = r / nblk, nb = r % nblk; transpose_item(F.in[5], NIN, 64 * kb, 32 * nb, WIN, D, 32 * nb, scr, F.lane); continue; } r -= I_IN;
        if (r < I_OUT) { const int nblk = D / 32, kb = r / nblk, nb = r % nblk; transpose_item(F.in[14], D, 64 * kb, 32 * nb, WOUT, D, 32 * nb, scr, F.lane); continue; } r -= I_OUT;
        if (r < I_FI) { const int nblk = 2 * FF / 32, kb = r / nblk, nb = r % nblk; const int nd = 32 * nb, t = nd >> 8, rr = nd & 255;
            const int ns = rr < 128 ? t * 128 + rr : FF + t * 128 + (rr - 128);
            transpose_item(F.in[16], 2 * FF, 64 * kb, ns, WFI, D, nd, scr, F.lane); continue; } r -= I_FI;
        { const int nblk = D / 32, kb = r / nblk, nb = r % nblk; transpose_item(F.in[17], D, 64 * kb, 32 * nb, WFO, FF, 32 * nb, scr, F.lane); }
    }
}

template <bool WITH_BA>
__device__ __forceinline__ void norm_mod_phase(Frame& F, const float* src, const float* nw, const float* shift, const float* scale, bf16* dst) {
    const int gw = F.vcu * NWAVES + F.wave, NGW = F.G * NWAVES;
    constexpr int RPW = 8;
    f32x4 w8a[WITH_BA ? 16 : 1], w8b[WITH_BA ? 16 : 1];
    if (WITH_BA) {
        const float* w_in = F.in[5];
#pragma unroll
        for (int j = 0; j < 4; ++j)
#pragma unroll
            for (int e = 0; e < 4; ++e) { const int k = 4 * F.lane + 256 * j + e; w8a[j * 4 + e] = *(const f32x4*)(w_in + (size_t)k * NIN + NIN_G); w8b[j * 4 + e] = *(const f32x4*)(w_in + (size_t)k * NIN + NIN_G + 4); }
    }
    for (int it = gw; it < M / RPW; it += NGW) {
        const int m0 = it * RPW, b = m0 / SEQ;
        f32x4 wv[4], sv[4];
#pragma unroll
        for (int j = 0; j < 4; ++j) { const int cidx = 4 * F.lane + 256 * j; const f32x4 n4 = *(const f32x4*)(nw + cidx), sc = *(const f32x4*)(scale + (size_t)b * (NMOD * D) + cidx);
            wv[j] = n4 * (sc + 1.0f); sv[j] = *(const f32x4*)(shift + (size_t)b * (NMOD * D) + cidx); }
        for (int r = 0; r < RPW; ++r) {
            const int m = m0 + r;
            const GAS f32x4* xr = (const GAS f32x4*)(src + (size_t)m * D) + F.lane;
            f32x4 v[4]; float s = 0.f;
#pragma unroll
            for (int j = 0; j < 4; ++j) { v[j] = xr[64 * j]; s += (v[j].x * v[j].x + v[j].y * v[j].y) + (v[j].z * v[j].z + v[j].w * v[j].w); }
            const float rstd = 1.0f / sqrtf(wave_sum(s) * (1.f / D) + EPS);
            GAS unsigned long long* o8 = (GAS unsigned long long*)(dst + (size_t)m * D) + F.lane;
#pragma unroll
            for (int j = 0; j < 4; ++j) { v[j] = v[j] * rstd * wv[j] + sv[j];
                o8[64 * j] = (unsigned long long)pk2(v[j].x, v[j].y) | ((unsigned long long)pk2(v[j].z, v[j].w) << 32); }
            if (WITH_BA) {
                f32x4 pa = {0.f, 0.f, 0.f, 0.f}, pb = {0.f, 0.f, 0.f, 0.f};
#pragma unroll
                for (int j = 0; j < 4; ++j) { pa += w8a[j * 4 + 0] * v[j].x + w8a[j * 4 + 1] * v[j].y + w8a[j * 4 + 2] * v[j].z + w8a[j * 4 + 3] * v[j].w;
                    pb += w8b[j * 4 + 0] * v[j].x + w8b[j * 4 + 1] * v[j].y + w8b[j * 4 + 2] * v[j].z + w8b[j * 4 + 3] * v[j].w; }
                float p[8] = {pa.x, pa.y, pa.z, pa.w, pb.x, pb.y, pb.z, pb.w};
#pragma unroll
                for (int q = 0; q < 8; ++q) p[q] = wave_sum(p[q]);
                const int l = F.lane & 7, h = l & 3;
                float mine = p[0];
#pragma unroll
                for (int q = 1; q < 8; ++q) mine = (l == q) ? p[q] : mine;
                const float a_log = F.in[11][h], dtb = F.in[12][h];
                const float xx = mine + dtb; const float sp = xx > 20.f ? xx : log1pf(expf(xx));
                const float val = (l < 4) ? 1.0f / (1.0f + expf(-mine)) : -expf(a_log) * sp;
                if (F.lane < 8) ((float*)(F.ws + WS_BG))[(size_t)m * 8 + l] = val;
            }
        }
    }
}

__device__ __forceinline__ void final_norm_phase(Frame& F, float* io, const float* nw) {
    const int gw = F.vcu * NWAVES + F.wave, NGW = F.G * NWAVES;
    f32x4 wv[4];
#pragma unroll
    for (int j = 0; j < 4; ++j) wv[j] = *(const f32x4*)(nw + 4 * F.lane + 256 * j);
    for (int m = gw; m < M; m += NGW) {
        GAS f32x4* xr = (GAS f32x4*)(io + (size_t)m * D) + F.lane;
        f32x4 v[4]; float s = 0.f;
#pragma unroll
        for (int j = 0; j < 4; ++j) { v[j] = xr[64 * j]; s += (v[j].x * v[j].x + v[j].y * v[j].y) + (v[j].z * v[j].z + v[j].w * v[j].w); }
        const float rstd = 1.0f / sqrtf(wave_sum(s) * (1.f / D) + EPS);
#pragma unroll
        for (int j = 0; j < 4; ++j) xr[64 * j] = v[j] * rstd * wv[j];
    }
}

__device__ __forceinline__ void conformer_phase(Frame& F) {
    const bf16* P = (const bf16*)(F.ws + WS_P); bf16* MIX = (bf16*)(F.ws + WS_MIXIN);
    const float* conv_w = F.in[6]; const float* conv_b = F.in[7]; const float* gn_w = F.in[8]; const float* gn_b = F.in[9];
    LAS float* ub = (LAS float*)(F.lds + RING_OFF);
    constexpr int NR = CL + CONVK - 1;
    for (int item = F.vcu; item < (M / CL) * 8; item += F.G) {
        const int tt = item >> 3, g = item & 7, m0 = tt * CL, t0 = m0 % SEQ;
        for (int idx = F.tid; idx < NR * 32; idx += NWAVES * 64) { const int r = idx >> 5, cp = idx & 31; const int t = t0 - (CONVK - 1) + r;
            float u0 = 0.f, u1 = 0.f;
            if (t >= 0) { const size_t off = (size_t)(m0 - (CONVK - 1) + r) * NIN_G + g * 64 + 2 * cp;
                const unsigned a2 = *(const unsigned*)(P + off + PC_A), g2 = *(const unsigned*)(P + off + PC_GATE);
                u0 = bf_lo(a2) * sigmoidf_(bf_lo(g2)); u1 = bf_hi(a2) * sigmoidf_(bf_hi(g2)); }
            *(LAS f32x2*)(ub + r * 64 + 2 * cp) = (f32x2){u0, u1}; }
        const int c = F.tid & 63, tb = F.tid >> 6, ch = g * 64 + c;
        float w[CONVK];
#pragma unroll
        for (int k = 0; k < CONVK; ++k) w[k] = conv_w[k * CW + ch];
        const float bias = conv_b[ch], gw_ = gn_w[ch], gb_ = gn_b[ch];
        __syncthreads();
        float acc[8];
#pragma unroll
        for (int i = 0; i < 8; ++i) acc[i] = bias;
#pragma unroll
        for (int k = 0; k < 8 + CONVK - 1; ++k) { const float uv = ub[(8 * tb + k) * 64 + c];
#pragma unroll
            for (int i = 0; i < 8; ++i) { const int tap = k - i; if (tap >= 0 && tap < CONVK) acc[i] += w[tap] * uv; } }
#pragma unroll
        for (int i = 0; i < 8; ++i) { const float mu = wave_sum(acc[i]) * (1.f / 64.f), d = acc[i] - mu, var = wave_sum(d * d) * (1.f / 64.f);
            const float y = d * (1.0f / sqrtf(var + EPS)) * gw_ + gb_;
            MIX[(size_t)(m0 + 8 * tb + i) * D + ch] = (bf16)f2bf(siluf_(y)); }
        __syncthreads();
    }
}

__device__ __forceinline__ void gdn_prep_simple(Frame& F) {
    const bf16* P = (const bf16*)(F.ws + WS_P); const float* cw = F.in[10];
    float* QN = (float*)(F.ws + WS_QN); float* KN = (float*)(F.ws + WS_KN); float* VN = (float*)(F.ws + WS_VN);
    const int gw = F.vcu * NWAVES + F.wave, NGW = F.G * NWAVES;
    for (int m = gw; m < M; m += NGW) {
        const int t = m % SEQ;
#pragma unroll
        for (int i = 0; i < 12; ++i) {
            const int ch = 128 * i + 2 * F.lane;
            float y0 = 0.f, y1 = 0.f;
#pragma unroll
            for (int j = 0; j < 4; ++j) { const int tj = t - 3 + j; if (tj >= 0) { const unsigned pv = *(const unsigned*)(P + (size_t)(m - 3 + j) * NIN_G + PC_Q + ch);
                    const f32x2 wj = *(const f32x2*)(cw + j * (3 * GW) + ch); y0 += wj.x * bf_lo(pv); y1 += wj.y * bf_hi(pv); } }
            y0 = siluf_(y0); y1 = siluf_(y1);
            if (i < 8) { const float ss = wave_sum(y0 * y0 + y1 * y1); float r = 1.0f / sqrtf(ss + EPS); if (i < 4) r *= 0.08838834764831845f; y0 *= r; y1 *= r; }
            float* dstp = (i < 4) ? QN + (size_t)m * GW + ch : (i < 8) ? KN + (size_t)m * GW + (ch - 512) : VN + (size_t)m * GW + (ch - 1024);
            *(f32x2*)dstp = (f32x2){y0, y1};
        }
    }
}
__device__ __forceinline__ void gdn_recurrent_simple(Frame& F) {
    const bf16* P = (const bf16*)(F.ws + WS_P); bf16* MIX = (bf16*)(F.ws + WS_MIXIN);
    const float* QN = (const float*)(F.ws + WS_QN); const float* KN = (const float*)(F.ws + WS_KN); const float* VN = (const float*)(F.ws + WS_VN);
    const float* BG = (const float*)(F.ws + WS_BG); const float* nw = F.in[13];
    LAS float* QS = (LAS float*)(F.lds + RING_OFF); LAS float* KS = QS + CL * HD; LAS float* VS = KS + CL * HD; LAS float* OS = VS + CL * HD;
    LAS float* BS = (LAS float*)(F.lds + EXTRA_OFF);
    for (int item = blockIdx.x; item < BATCH * NH; item += F.G) {
        const int b = item / NH, h = item % NH;
        const int col = 16 * F.wave + (F.lane & 15), qd = F.lane >> 4;
        float S[32];
#pragma unroll
        for (int i = 0; i < 32; ++i) S[i] = 0.f;
        for (int ch = 0; ch < SEQ / CL; ++ch) {
            const int m0 = b * SEQ + ch * CL;
            for (int idx = F.tid; idx < CL * HD / 4; idx += NWAVES * 64) { const int r = idx >> 5, c4 = idx & 31; const size_t off = (size_t)(m0 + r) * GW + h * HD + 4 * c4;
                *(LAS f32x4*)(QS + r * HD + 4 * c4) = *(const f32x4*)(QN + off); *(LAS f32x4*)(KS + r * HD + 4 * c4) = *(const f32x4*)(KN + off); *(LAS f32x4*)(VS + r * HD + 4 * c4) = *(const f32x4*)(VN + off); }
            if (F.tid < 64) { BS[F.tid] = BG[(size_t)(m0 + F.tid) * 8 + h]; BS[64 + F.tid] = expf(BG[(size_t)(m0 + F.tid) * 8 + 4 + h]); }
            __syncthreads();
            for (int t = 0; t < CL; ++t) {
                float kv[32], qv[32];
#pragma unroll
                for (int i = 0; i < 8; ++i) { const f32x4 k4 = *(const LAS f32x4*)(KS + t * HD + 32 * qd + 4 * i), q4 = *(const LAS f32x4*)(QS + t * HD + 32 * qd + 4 * i);
                    kv[4 * i] = k4.x; kv[4 * i + 1] = k4.y; kv[4 * i + 2] = k4.z; kv[4 * i + 3] = k4.w; qv[4 * i] = q4.x; qv[4 * i + 1] = q4.y; qv[4 * i + 2] = q4.z; qv[4 * i + 3] = q4.w; }
                const float beta = BS[t], eg = BS[64 + t], vv = VS[t * HD + col];
                float ks = 0.f;
#pragma unroll
                for (int i = 0; i < 32; ++i) ks += kv[i] * S[i];
                ks += __shfl_xor(ks, 16); ks += __shfl_xor(ks, 32);
                const float dd = beta * (vv - eg * ks);
                float o = 0.f;
#pragma unroll
                for (int i = 0; i < 32; ++i) { S[i] = eg * S[i] + kv[i] * dd; o += qv[i] * S[i]; }
                o += __shfl_xor(o, 16); o += __shfl_xor(o, 32);
                if (qd == 0) OS[t * HD + col] = o;
            }
            __syncthreads();
#pragma unroll
            for (int r = 0; r < 8; ++r) { const int t = 8 * F.wave + r; const f32x2 o2 = *(const LAS f32x2*)(OS + t * HD + 2 * F.lane);
                const float ss = wave_sum(o2.x * o2.x + o2.y * o2.y); const float rr = 1.0f / sqrtf(ss * (1.f / HD) + EPS);
                const unsigned z2 = *(const unsigned*)(P + (size_t)(m0 + t) * NIN_G + PC_Z + h * HD + 2 * F.lane);
                const f32x2 n2 = *(const f32x2*)(nw + 2 * F.lane);
                const float y0 = o2.x * rr * n2.x * siluf_(bf_lo(z2)), y1 = o2.y * rr * n2.y * siluf_(bf_hi(z2));
                *(unsigned*)(MIX + (size_t)(m0 + t) * D + GW + h * HD + 2 * F.lane) = pk2(y0, y1); }
            __syncthreads();
        }
    }
}
typedef float f32x16 __attribute__((ext_vector_type(16)));
typedef unsigned u32x2 __attribute__((ext_vector_type(2)));
#define MFMA32(a, b, c) __builtin_amdgcn_mfma_f32_32x32x16_bf16((a), (b), (c), 0, 0, 0)
constexpr size_t WS_WIMG = 188 * MiB, WS_QIMG = 204 * MiB, WS_KTIMG = 220 * MiB, WS_UT = 236 * MiB, WS_QKIMG = 28 * MiB;
constexpr size_t WS_CD = 1 * MiB + 256 * 1024;
__device__ __forceinline__ int perm16(int x) { const int o = x & 15; return (x & ~15) | (8 * ((o >> 2) & 1) + 4 * (o >> 3) + (o & 3)); }
typedef __bf16 bf16x2_t __attribute__((ext_vector_type(2)));
__device__ __forceinline__ unsigned cvtpk(float lo, float hi) { const f32x2 v = {lo, hi}; return __builtin_bit_cast(unsigned, __builtin_convertvector(v, bf16x2_t)); }
__device__ __forceinline__ bf16x8 pack8(float a0, float a1, float a2, float a3, float a4, float a5, float a6, float a7) {
    v4u u; u.x = cvtpk(a0, a1); u.y = cvtpk(a2, a3); u.z = cvtpk(a4, a5); u.w = cvtpk(a6, a7); return __builtin_bit_cast(bf16x8, u); }

constexpr int PL_KR = 0, PL_KBR = 17408, PL_QR = 34816, PL_KBGT = 52224, PL_VBT = 70656, PL_AB = 89088, PL_TB = 105472, PL_GC = 114688;
constexpr int RP = 272, TP = 144;

__device__ __forceinline__ void gdn_prep_phase(Frame& F) {
    const bf16* P = (const bf16*)(F.ws + WS_P); const float* BG = (const float*)(F.ws + WS_BG); const float* cw = F.in[10];
    const int w = F.wave;
    LAS unsigned char* L = F.lds + RING_OFF;
    LAS float* GC = (LAS float*)(L + PL_GC); LAS float* AB = (LAS float*)(L + PL_AB);
    for (int item = F.vcu; item < BATCH * NH * (SEQ / CL); item += F.G) {
        int lane = F.lane; asm volatile("" : "+v"(lane));
        const int l31 = lane & 31, hh = lane >> 5;
        const int b = item >> 7, h = (item >> 5) & 3, n = item & 31, m0 = b * SEQ + n * CL, t0 = n * CL;
        unsigned char* Wimg = F.ws + WS_WIMG + (size_t)item * 16384; unsigned char* Qimg = F.ws + WS_QIMG + (size_t)item * 16384;
        unsigned char* KTimg = F.ws + WS_KTIMG + (size_t)item * 16384; unsigned char* QKimg = F.ws + WS_QKIMG + (size_t)item * 8192; unsigned char* UT = F.ws + WS_UT + (size_t)item * 16384;
        float gc = BG[(size_t)(m0 + lane) * 8 + 4 + h]; const float btl = BG[(size_t)(m0 + lane) * 8 + h];
#pragma unroll
        for (int o = 1; o < 64; o <<= 1) { const float t = __shfl_up(gc, o); if (lane >= o) gc += t; }
        const float glast = __shfl(gc, 63);
        if (w == 0) { GC[lane] = gc; if (lane == 0) ((float*)(F.ws + WS_CD))[item] = __expf(glast); }
        unsigned xq[11], xk[11], xv[11];
#pragma unroll
        for (int r = 0; r < 11; ++r) { const int tok = 8 * w - 3 + r; xq[r] = 0u; xk[r] = 0u; xv[r] = 0u;
            if (t0 + tok >= 0) { const bf16* base = P + (size_t)(m0 + tok) * NIN_G + h * HD + 2 * lane; xq[r] = *(const unsigned*)(base + PC_Q); xk[r] = *(const unsigned*)(base + PC_K); xv[r] = *(const unsigned*)(base + PC_V); } }
        f32x2 wq[4], wk[4], wvv[4];
#pragma unroll
        for (int j = 0; j < 4; ++j) { const float* cj = cw + j * (3 * GW) + h * HD + 2 * lane; wq[j] = *(const f32x2*)cj; wk[j] = *(const f32x2*)(cj + GW); wvv[j] = *(const f32x2*)(cj + 2 * GW); }
        float kbg0[8], kbg1[8], vb0[8], vb1[8], kd0[8], kd1[8];
#pragma unroll
        for (int i = 0; i < 8; ++i) {
            float q0 = 0.f, q1 = 0.f, k0 = 0.f, k1 = 0.f, v0 = 0.f, v1 = 0.f;
#pragma unroll
            for (int j = 0; j < 4; ++j) { q0 += wq[j].x * bf_lo(xq[i + j]); q1 += wq[j].y * bf_hi(xq[i + j]); k0 += wk[j].x * bf_lo(xk[i + j]); k1 += wk[j].y * bf_hi(xk[i + j]);
                v0 += wvv[j].x * bf_lo(xv[i + j]); v1 += wvv[j].y * bf_hi(xv[i + j]); }
            q0 = siluf_(q0); q1 = siluf_(q1); k0 = siluf_(k0); k1 = siluf_(k1); v0 = siluf_(v0); v1 = siluf_(v1);
            const float rq = 0.08838834764831845f / sqrtf(wave_sum(q0 * q0 + q1 * q1) + EPS), rk = 1.0f / sqrtf(wave_sum(k0 * k0 + k1 * k1) + EPS);
            q0 *= rq; q1 *= rq; k0 *= rk; k1 *= rk;
            const int tok = 8 * w + i;
            const float gci = __shfl(gc, tok), bti = __shfl(btl, tok), eg = __expf(gci), egl = __expf(glast - gci);
            *(LAS unsigned*)(L + PL_KR + tok * RP + 4 * lane) = cvtpk(k0, k1);
            *(LAS unsigned*)(L + PL_KBR + tok * RP + 4 * lane) = cvtpk(k0 * bti, k1 * bti);
            *(LAS unsigned*)(L + PL_QR + tok * RP + 4 * lane) = cvtpk(q0, q1);
            { const int pos = perm16(2 * lane), chunk = pos >> 3; *(unsigned*)(Qimg + tok * 256 + ((chunk ^ (tok & 15)) << 4) + (pos & 7) * 2) = cvtpk(q0 * eg, q1 * eg); }
            kbg0[i] = -k0 * bti * eg; kbg1[i] = -k1 * bti * eg; vb0[i] = v0 * bti; vb1[i] = v1 * bti; kd0[i] = k0 * egl; kd1[i] = k1 * egl;
        }
        { const int c0 = 2 * lane, c1 = 2 * lane + 1;
          *(LAS bf16x8*)(L + PL_KBGT + c0 * TP + 16 * w) = pack8(kbg0[0], kbg0[1], kbg0[2], kbg0[3], kbg0[4], kbg0[5], kbg0[6], kbg0[7]);
          *(LAS bf16x8*)(L + PL_KBGT + c1 * TP + 16 * w) = pack8(kbg1[0], kbg1[1], kbg1[2], kbg1[3], kbg1[4], kbg1[5], kbg1[6], kbg1[7]);
          *(LAS bf16x8*)(L + PL_VBT + c0 * TP + 16 * w) = pack8(vb0[0], vb0[1], vb0[2], vb0[3], vb0[4], vb0[5], vb0[6], vb0[7]);
          *(LAS bf16x8*)(L + PL_VBT + c1 * TP + 16 * w) = pack8(vb1[0], vb1[1], vb1[2], vb1[3], vb1[4], vb1[5], vb1[6], vb1[7]);
          const int chA = 2 * (w >> 1), ob = 8 * (w & 1);
          { const int sw = (c0 >> 1) & 7; u32x2 a, bq; a.x = cvtpk(kd0[0], kd0[1]); a.y = cvtpk(kd0[2], kd0[3]); bq.x = cvtpk(kd0[4], kd0[5]); bq.y = cvtpk(kd0[6], kd0[7]);
            *(u32x2*)(KTimg + c0 * 128 + ((chA ^ sw) << 4) + ob) = a; *(u32x2*)(KTimg + c0 * 128 + (((chA + 1) ^ sw) << 4) + ob) = bq; }
          { const int sw = (c1 >> 1) & 7; u32x2 a, bq; a.x = cvtpk(kd1[0], kd1[1]); a.y = cvtpk(kd1[2], kd1[3]); bq.x = cvtpk(kd1[4], kd1[5]); bq.y = cvtpk(kd1[6], kd1[7]);
            *(u32x2*)(KTimg + c1 * 128 + ((chA ^ sw) << 4) + ob) = a; *(u32x2*)(KTimg + c1 * 128 + (((chA + 1) ^ sw) << 4) + ob) = bq; } }
        __syncthreads();
        { const int tc = (w >> 1) & 1, te = w & 1; const bool isqk = w >= 4;
          f32x16 acc;
#pragma unroll
          for (int r = 0; r < 16; ++r) acc[r] = 0.f;
          if (!(tc == 0 && te == 1)) {
              const LAS unsigned char* ap = L + PL_KR + (32 * te + l31) * RP + hh * 16; const LAS unsigned char* bp = L + (isqk ? PL_QR : PL_KBR) + (32 * tc + l31) * RP + hh * 16;
#pragma unroll
              for (int s = 0; s < 8; ++s) acc = MFMA32(*(const LAS bf16x8*)(ap + 32 * s), *(const LAS bf16x8*)(bp + 32 * s), acc);
          }
          const int c = 32 * tc + l31; const float gcc = GC[c]; const int sw = (c >> 1) & 7;
#pragma unroll
          for (int g = 0; g < 4; ++g) { float v[4];
#pragma unroll
              for (int i = 0; i < 4; ++i) { const int e = 32 * te + 8 * g + 4 * hh + i; const bool keep = isqk ? (c >= e) : (c > e); const float dv_ = acc[4 * g + i] * __expf(fminf(gcc - GC[e], 0.f)); v[i] = keep ? dv_ : 0.f; }
              if (isqk) { const int chunk = 4 * te + 2 * (g >> 1) + hh; u32x2 o; o.x = cvtpk(v[0], v[1]); o.y = cvtpk(v[2], v[3]);
                  *(u32x2*)(QKimg + c * 128 + ((chunk ^ sw) << 4) + 8 * (g & 1)) = o; }
              else {
#pragma unroll
                  for (int i = 0; i < 4; ++i) AB[(32 * te + 8 * g + 4 * hh + i) * 64 + c] = v[i]; } } }
        __syncthreads();
        if (w == 0) {
            float T[64];
#pragma unroll
            for (int i = 0; i < 64; ++i) T[i] = (lane == i) ? 1.f : 0.f;
            f32x4 a0, a1, a2, a3, a4, a5, a6, a7;
            a0 = *(const LAS f32x4*)(AB + 0);
            a1 = *(const LAS f32x4*)(AB + 4);
            a2 = *(const LAS f32x4*)(AB + 8);
            a3 = *(const LAS f32x4*)(AB + 12);
            a4 = *(const LAS f32x4*)(AB + 16);
            a5 = *(const LAS f32x4*)(AB + 20);
            a6 = *(const LAS f32x4*)(AB + 24);
            a7 = *(const LAS f32x4*)(AB + 28);
            asm volatile("" ::: "memory"); T[1] -= a0.y * T[0]; T[2] -= a0.z * T[0]; T[3] -= a0.w * T[0]; a0 = *(const LAS f32x4*)(AB + 32);
            asm volatile("" ::: "memory"); T[4] -= a1.x * T[0]; T[5] -= a1.y * T[0]; T[6] -= a1.z * T[0]; T[7] -= a1.w * T[0]; a1 = *(const LAS f32x4*)(AB + 36);
            asm volatile("" ::: "memory"); T[8] -= a2.x * T[0]; T[9] -= a2.y * T[0]; T[10] -= a2.z * T[0]; T[11] -= a2.w * T[0]; a2 = *(const LAS f32x4*)(AB + 40);
            asm volatile("" ::: "memory"); T[12] -= a3.x * T[0]; T[13] -= a3.y * T[0]; T[14] -= a3.z * T[0]; T[15] -= a3.w * T[0]; a3 = *(const LAS f32x4*)(AB + 44);
            asm volatile("" ::: "memory"); T[16] -= a4.x * T[0]; T[17] -= a4.y * T[0]; T[18] -= a4.z * T[0]; T[19] -= a4.w * T[0]; a4 = *(const LAS f32x4*)(AB + 48);
            asm volatile("" ::: "memory"); T[20] -= a5.x * T[0]; T[21] -= a5.y * T[0]; T[22] -= a5.z * T[0]; T[23] -= a5.w * T[0]; a5 = *(const LAS f32x4*)(AB + 52);
            asm volatile("" ::: "memory"); T[24] -= a6.x * T[0]; T[25] -= a6.y * T[0]; T[26] -= a6.z * T[0]; T[27] -= a6.w * T[0]; a6 = *(const LAS f32x4*)(AB + 56);
            asm volatile("" ::: "memory"); T[28] -= a7.x * T[0]; T[29] -= a7.y * T[0]; T[30] -= a7.z * T[0]; T[31] -= a7.w * T[0]; a7 = *(const LAS f32x4*)(AB + 60);
            asm volatile("" ::: "memory"); T[32] -= a0.x * T[0]; T[33] -= a0.y * T[0]; T[34] -= a0.z * T[0]; T[35] -= a0.w * T[0]; a0 = *(const LAS f32x4*)(AB + 64);
            asm volatile("" ::: "memory"); T[36] -= a1.x * T[0]; T[37] -= a1.y * T[0]; T[38] -= a1.z * T[0]; T[39] -= a1.w * T[0]; a1 = *(const LAS f32x4*)(AB + 68);
            asm volatile("" ::: "memory"); T[40] -= a2.x * T[0]; T[41] -= a2.y * T[0]; T[42] -= a2.z * T[0]; T[43] -= a2.w * T[0]; a2 = *(const LAS f32x4*)(AB + 72);
            asm volatile("" ::: "memory"); T[44] -= a3.x * T[0]; T[45] -= a3.y * T[0]; T[46] -= a3.z * T[0]; T[47] -= a3.w * T[0]; a3 = *(const LAS f32x4*)(AB + 76);
            asm volatile("" ::: "memory"); T[48] -= a4.x * T[0]; T[49] -= a4.y * T[0]; T[50] -= a4.z * T[0]; T[51] -= a4.w * T[0]; a4 = *(const LAS f32x4*)(AB + 80);
            asm volatile("" ::: "memory"); T[52] -= a5.x * T[0]; T[53] -= a5.y * T[0]; T[54] -= a5.z * T[0]; T[55] -= a5.w * T[0]; a5 = *(const LAS f32x4*)(AB + 84);
            asm volatile("" ::: "memory"); T[56] -= a6.x * T[0]; T[57] -= a6.y * T[0]; T[58] -= a6.z * T[0]; T[59] -= a6.w * T[0]; a6 = *(const LAS f32x4*)(AB + 88);
            asm volatile("" ::: "memory"); T[60] -= a7.x * T[0]; T[61] -= a7.y * T[0]; T[62] -= a7.z * T[0]; T[63] -= a7.w * T[0]; a7 = *(const LAS f32x4*)(AB + 92);
            asm volatile("" ::: "memory"); T[2] -= a0.z * T[1]; T[3] -= a0.w * T[1]; a0 = *(const LAS f32x4*)(AB + 96);
            asm volatile("" ::: "memory"); T[4] -= a1.x * T[1]; T[5] -= a1.y * T[1]; T[6] -= a1.z * T[1]; T[7] -= a1.w * T[1]; a1 = *(const LAS f32x4*)(AB + 100);
            asm volatile("" ::: "memory"); T[8] -= a2.x * T[1]; T[9] -= a2.y * T[1]; T[10] -= a2.z * T[1]; T[11] -= a2.w * T[1]; a2 = *(const LAS f32x4*)(AB + 104);
            asm volatile("" ::: "memory"); T[12] -= a3.x * T[1]; T[13] -= a3.y * T[1]; T[14] -= a3.z * T[1]; T[15] -= a3.w * T[1]; a3 = *(const LAS f32x4*)(AB + 108);
            asm volatile("" ::: "memory"); T[16] -= a4.x * T[1]; T[17] -= a4.y * T[1]; T[18] -= a4.z * T[1]; T[19] -= a4.w * T[1]; a4 = *(const LAS f32x4*)(AB + 112);
            asm volatile("" ::: "memory"); T[20] -= a5.x * T[1]; T[21] -= a5.y * T[1]; T[22] -= a5.z * T[1]; T[23] -= a5.w * T[1]; a5 = *(const LAS f32x4*)(AB + 116);
            asm volatile("" ::: "memory"); T[24] -= a6.x * T[1]; T[25] -= a6.y * T[1]; T[26] -= a6.z * T[1]; T[27] -= a6.w * T[1]; a6 = *(const LAS f32x4*)(AB + 120);
            asm volatile("" ::: "memory"); T[28] -= a7.x * T[1]; T[29] -= a7.y * T[1]; T[30] -= a7.z * T[1]; T[31] -= a7.w * T[1]; a7 = *(const LAS f32x4*)(AB + 124);
            asm volatile("" ::: "memory"); T[32] -= a0.x * T[1]; T[33] -= a0.y * T[1]; T[34] -= a0.z * T[1]; T[35] -= a0.w * T[1]; a0 = *(const LAS f32x4*)(AB + 128);
            asm volatile("" ::: "memory"); T[36] -= a1.x * T[1]; T[37] -= a1.y * T[1]; T[38] -= a1.z * T[1]; T[39] -= a1.w * T[1]; a1 = *(const LAS f32x4*)(AB + 132);
            asm volatile("" ::: "memory"); T[40] -= a2.x * T[1]; T[41] -= a2.y * T[1]; T[42] -= a2.z * T[1]; T[43] -= a2.w * T[1]; a2 = *(const LAS f32x4*)(AB + 136);
            asm volatile("" ::: "memory"); T[44] -= a3.x * T[1]; T[45] -= a3.y * T[1]; T[46] -= a3.z * T[1]; T[47] -= a3.w * T[1]; a3 = *(const LAS f32x4*)(AB + 140);
            asm volatile("" ::: "memory"); T[48] -= a4.x * T[1]; T[49] -= a4.y * T[1]; T[50] -= a4.z * T[1]; T[51] -= a4.w * T[1]; a4 = *(const LAS f32x4*)(AB + 144);
            asm volatile("" ::: "memory"); T[52] -= a5.x * T[1]; T[53] -= a5.y * T[1]; T[54] -= a5.z * T[1]; T[55] -= a5.w * T[1]; a5 = *(const LAS f32x4*)(AB + 148);
            asm volatile("" ::: "memory"); T[56] -= a6.x * T[1]; T[57] -= a6.y * T[1]; T[58] -= a6.z * T[1]; T[59] -= a6.w * T[1]; a6 = *(const LAS f32x4*)(AB + 152);
            asm volatile("" ::: "memory"); T[60] -= a7.x * T[1]; T[61] -= a7.y * T[1]; T[62] -= a7.z * T[1]; T[63] -= a7.w * T[1]; a7 = *(const LAS f32x4*)(AB + 156);
            asm volatile("" ::: "memory"); T[3] -= a0.w * T[2]; a0 = *(const LAS f32x4*)(AB + 160);
            asm volatile("" ::: "memory"); T[4] -= a1.x * T[2]; T[5] -= a1.y * T[2]; T[6] -= a1.z * T[2]; T[7] -= a1.w * T[2]; a1 = *(const LAS f32x4*)(AB + 164);
            asm volatile("" ::: "memory"); T[8] -= a2.x * T[2]; T[9] -= a2.y * T[2]; T[10] -= a2.z * T[2]; T[11] -= a2.w * T[2]; a2 = *(const LAS f32x4*)(AB + 168);
            asm volatile("" ::: "memory"); T[12] -= a3.x * T[2]; T[13] -= a3.y * T[2]; T[14] -= a3.z * T[2]; T[15] -= a3.w * T[2]; a3 = *(const LAS f32x4*)(AB + 172);
            asm volatile("" ::: "memory"); T[16] -= a4.x * T[2]; T[17] -= a4.y * T[2]; T[18] -= a4.z * T[2]; T[19] -= a4.w * T[2]; a4 = *(const LAS f32x4*)(AB + 176);
            asm volatile("" ::: "memory"); T[20] -= a5.x * T[2]; T[21] -= a5.y * T[2]; T[22] -= a5.z * T[2]; T[23] -= a5.w * T[2]; a5 = *(const LAS f32x4*)(AB + 180);
            asm volatile("" ::: "memory"); T[24] -= a6.x * T[2]; T[25] -= a6.y * T[2]; T[26] -= a6.z * T[2]; T[27] -= a6.w * T[2]; a6 = *(const LAS f32x4*)(AB + 184);
            asm volatile("" ::: "memory"); T[28] -= a7.x * T[2]; T[29] -= a7.y * T[2]; T[30] -= a7.z * T[2]; T[31] -= a7.w * T[2]; a7 = *(const LAS f32x4*)(AB + 188);
            asm volatile("" ::: "memory"); T[32] -= a0.x * T[2]; T[33] -= a0.y * T[2]; T[34] -= a0.z * T[2]; T[35] -= a0.w * T[2]; a0 = *(const LAS f32x4*)(AB + 196);
            asm volatile("" ::: "memory"); T[36] -= a1.x * T[2]; T[37] -= a1.y * T[2]; T[38] -= a1.z * T[2]; T[39] -= a1.w * T[2]; a1 = *(const LAS f32x4*)(AB + 200);
            asm volatile("" ::: "memory"); T[40] -= a2.x * T[2]; T[41] -= a2.y * T[2]; T[42] -= a2.z * T[2]; T[43] -= a2.w * T[2]; a2 = *(const LAS f32x4*)(AB + 204);
            asm volatile("" ::: "memory"); T[44] -= a3.x * T[2]; T[45] -= a3.y * T[2]; T[46] -= a3.z * T[2]; T[47] -= a3.w * T[2]; a3 = *(const LAS f32x4*)(AB + 208);
            asm volatile("" ::: "memory"); T[48] -= a4.x * T[2]; T[49] -= a4.y * T[2]; T[50] -= a4.z * T[2]; T[51] -= a4.w * T[2]; a4 = *(const LAS f32x4*)(AB + 212);
            asm volatile("" ::: "memory"); T[52] -= a5.x * T[2]; T[53] -= a5.y * T[2]; T[54] -= a5.z * T[2]; T[55] -= a5.w * T[2]; a5 = *(const LAS f32x4*)(AB + 216);
            asm volatile("" ::: "memory"); T[56] -= a6.x * T[2]; T[57] -= a6.y * T[2]; T[58] -= a6.z * T[2]; T[59] -= a6.w * T[2]; a6 = *(const LAS f32x4*)(AB + 220);
            asm volatile("" ::: "memory"); T[60] -= a7.x * T[2]; T[61] -= a7.y * T[2]; T[62] -= a7.z * T[2]; T[63] -= a7.w * T[2]; a7 = *(const LAS f32x4*)(AB + 224);
            asm volatile("" ::: "memory"); T[4] -= a0.x * T[3]; T[5] -= a0.y * T[3]; T[6] -= a0.z * T[3]; T[7] -= a0.w * T[3]; a0 = *(const LAS f32x4*)(AB + 228);
            asm volatile("" ::: "memory"); T[8] -= a1.x * T[3]; T[9] -= a1.y * T[3]; T[10] -= a1.z * T[3]; T[11] -= a1.w * T[3]; a1 = *(const LAS f32x4*)(AB + 232);
            asm volatile("" ::: "memory"); T[12] -= a2.x * T[3]; T[13] -= a2.y * T[3]; T[14] -= a2.z * T[3]; T[15] -= a2.w * T[3]; a2 = *(const LAS f32x4*)(AB + 236);
            asm volatile("" ::: "memory"); T[16] -= a3.x * T[3]; T[17] -= a3.y * T[3]; T[18] -= a3.z * T[3]; T[19] -= a3.w * T[3]; a3 = *(const LAS f32x4*)(AB + 240);
            asm volatile("" ::: "memory"); T[20] -= a4.x * T[3]; T[21] -= a4.y * T[3]; T[22] -= a4.z * T[3]; T[23] -= a4.w * T[3]; a4 = *(const LAS f32x4*)(AB + 244);
            asm volatile("" ::: "memory"); T[24] -= a5.x * T[3]; T[25] -= a5.y * T[3]; T[26] -= a5.z * T[3]; T[27] -= a5.w * T[3]; a5 = *(const LAS f32x4*)(AB + 248);
            asm volatile("" ::: "memory"); T[28] -= a6.x * T[3]; T[29] -= a6.y * T[3]; T[30] -= a6.z * T[3]; T[31] -= a6.w * T[3]; a6 = *(const LAS f32x4*)(AB + 252);
            asm volatile("" ::: "memory"); T[32] -= a7.x * T[3]; T[33] -= a7.y * T[3]; T[34] -= a7.z * T[3]; T[35] -= a7.w * T[3]; a7 = *(const LAS f32x4*)(AB + 260);
            asm volatile("" ::: "memory"); T[36] -= a0.x * T[3]; T[37] -= a0.y * T[3]; T[38] -= a0.z * T[3]; T[39] -= a0.w * T[3]; a0 = *(const LAS f32x4*)(AB + 264);
            asm volatile("" ::: "memory"); T[40] -= a1.x * T[3]; T[41] -= a1.y * T[3]; T[42] -= a1.z * T[3]; T[43] -= a1.w * T[3]; a1 = *(const LAS f32x4*)(AB + 268);
            asm volatile("" ::: "memory"); T[44] -= a2.x * T[3]; T[45] -= a2.y * T[3]; T[46] -= a2.z * T[3]; T[47] -= a2.w * T[3]; a2 = *(const LAS f32x4*)(AB + 272);
            asm volatile("" ::: "memory"); T[48] -= a3.x * T[3]; T[49] -= a3.y * T[3]; T[50] -= a3.z * T[3]; T[51] -= a3.w * T[3]; a3 = *(const LAS f32x4*)(AB + 276);
            asm volatile("" ::: "memory"); T[52] -= a4.x * T[3]; T[53] -= a4.y * T[3]; T[54] -= a4.z * T[3]; T[55] -= a4.w * T[3]; a4 = *(const LAS f32x4*)(AB + 280);
            asm volatile("" ::: "memory"); T[56] -= a5.x * T[3]; T[57] -= a5.y * T[3]; T[58] -= a5.z * T[3]; T[59] -= a5.w * T[3]; a5 = *(const LAS f32x4*)(AB + 284);
            asm volatile("" ::: "memory"); T[60] -= a6.x * T[3]; T[61] -= a6.y * T[3]; T[62] -= a6.z * T[3]; T[63] -= a6.w * T[3]; a6 = *(const LAS f32x4*)(AB + 288);
            asm volatile("" ::: "memory"); T[5] -= a7.y * T[4]; T[6] -= a7.z * T[4]; T[7] -= a7.w * T[4]; a7 = *(const LAS f32x4*)(AB + 292);
            asm volatile("" ::: "memory"); T[8] -= a0.x * T[4]; T[9] -= a0.y * T[4]; T[10] -= a0.z * T[4]; T[11] -= a0.w * T[4]; a0 = *(const LAS f32x4*)(AB + 296);
            asm volatile("" ::: "memory"); T[12] -= a1.x * T[4]; T[13] -= a1.y * T[4]; T[14] -= a1.z * T[4]; T[15] -= a1.w * T[4]; a1 = *(const LAS f32x4*)(AB + 300);
            asm volatile("" ::: "memory"); T[16] -= a2.x * T[4]; T[17] -= a2.y * T[4]; T[18] -= a2.z * T[4]; T[19] -= a2.w * T[4]; a2 = *(const LAS f32x4*)(AB + 304);
            asm volatile("" ::: "memory"); T[20] -= a3.x * T[4]; T[21] -= a3.y * T[4]; T[22] -= a3.z * T[4]; T[23] -= a3.w * T[4]; a3 = *(const LAS f32x4*)(AB + 308);
            asm volatile("" ::: "memory"); T[24] -= a4.x * T[4]; T[25] -= a4.y * T[4]; T[26] -= a4.z * T[4]; T[27] -= a4.w * T[4]; a4 = *(const LAS f32x4*)(AB + 312);
            asm volatile("" ::: "memory"); T[28] -= a5.x * T[4]; T[29] -= a5.y * T[4]; T[30] -= a5.z * T[4]; T[31] -= a5.w * T[4]; a5 = *(const LAS f32x4*)(AB + 316);
            asm volatile("" ::: "memory"); T[32] -= a6.x * T[4]; T[33] -= a6.y * T[4]; T[34] -= a6.z * T[4]; T[35] -= a6.w * T[4]; a6 = *(const LAS f32x4*)(AB + 324);
            asm volatile("" ::: "memory"); T[36] -= a7.x * T[4]; T[37] -= a7.y * T[4]; T[38] -= a7.z * T[4]; T[39] -= a7.w * T[4]; a7 = *(const LAS f32x4*)(AB + 328);
            asm volatile("" ::: "memory"); T[40] -= a0.x * T[4]; T[41] -= a0.y * T[4]; T[42] -= a0.z * T[4]; T[43] -= a0.w * T[4]; a0 = *(const LAS f32x4*)(AB + 332);
            asm volatile("" ::: "memory"); T[44] -= a1.x * T[4]; T[45] -= a1.y * T[4]; T[46] -= a1.z * T[4]; T[47] -= a1.w * T[4]; a1 = *(const LAS f32x4*)(AB + 336);
            asm volatile("" ::: "memory"); T[48] -= a2.x * T[4]; T[49] -= a2.y * T[4]; T[50] -= a2.z * T[4]; T[51] -= a2.w * T[4]; a2 = *(const LAS f32x4*)(AB + 340);
            asm volatile("" ::: "memory"); T[52] -= a3.x * T[4]; T[53] -= a3.y * T[4]; T[54] -= a3.z * T[4]; T[55] -= a3.w * T[4]; a3 = *(const LAS f32x4*)(AB + 344);
            asm volatile("" ::: "memory"); T[56] -= a4.x * T[4]; T[57] -= a4.y * T[4]; T[58] -= a4.z * T[4]; T[59] -= a4.w * T[4]; a4 = *(const LAS f32x4*)(AB + 348);
            asm volatile("" ::: "memory"); T[60] -= a5.x * T[4]; T[61] -= a5.y * T[4]; T[62] -= a5.z * T[4]; T[63] -= a5.w * T[4]; a5 = *(const LAS f32x4*)(AB + 352);
            asm volatile("" ::: "memory"); T[6] -= a6.z * T[5]; T[7] -= a6.w * T[5]; a6 = *(const LAS f32x4*)(AB + 356);
            asm volatile("" ::: "memory"); T[8] -= a7.x * T[5]; T[9] -= a7.y * T[5]; T[10] -= a7.z * T[5]; T[11] -= a7.w * T[5]; a7 = *(const LAS f32x4*)(AB + 360);
            asm volatile("" ::: "memory"); T[12] -= a0.x * T[5]; T[13] -= a0.y * T[5]; T[14] -= a0.z * T[5]; T[15] -= a0.w * T[5]; a0 = *(const LAS f32x4*)(AB + 364);
            asm volatile("" ::: "memory"); T[16] -= a1.x * T[5]; T[17] -= a1.y * T[5]; T[18] -= a1.z * T[5]; T[19] -= a1.w * T[5]; a1 = *(const LAS f32x4*)(AB + 368);
            asm volatile("" ::: "memory"); T[20] -= a2.x * T[5]; T[21] -= a2.y * T[5]; T[22] -= a2.z * T[5]; T[23] -= a2.w * T[5]; a2 = *(const LAS f32x4*)(AB + 372);
            asm volatile("" ::: "memory"); T[24] -= a3.x * T[5]; T[25] -= a3.y * T[5]; T[26] -= a3.z * T[5]; T[27] -= a3.w * T[5]; a3 = *(const LAS f32x4*)(AB + 376);
            asm volatile("" ::: "memory"); T[28] -= a4.x * T[5]; T[29] -= a4.y * T[5]; T[30] -= a4.z * T[5]; T[31] -= a4.w * T[5]; a4 = *(const LAS f32x4*)(AB + 380);
            asm volatile("" ::: "memory"); T[32] -= a5.x * T[5]; T[33] -= a5.y * T[5]; T[34] -= a5.z * T[5]; T[35] -= a5.w * T[5]; a5 = *(const LAS f32x4*)(AB + 388);
            asm volatile("" ::: "memory"); T[36] -= a6.x * T[5]; T[37] -= a6.y * T[5]; T[38] -= a6.z * T[5]; T[39] -= a6.w * T[5]; a6 = *(const LAS f32x4*)(AB + 392);
            asm volatile("" ::: "memory"); T[40] -= a7.x * T[5]; T[41] -= a7.y * T[5]; T[42] -= a7.z * T[5]; T[43] -= a7.w * T[5]; a7 = *(const LAS f32x4*)(AB + 396);
            asm volatile("" ::: "memory"); T[44] -= a0.x * T[5]; T[45] -= a0.y * T[5]; T[46] -= a0.z * T[5]; T[47] -= a0.w * T[5]; a0 = *(const LAS f32x4*)(AB + 400);
            asm volatile("" ::: "memory"); T[48] -= a1.x * T[5]; T[49] -= a1.y * T[5]; T[50] -= a1.z * T[5]; T[51] -= a1.w * T[5]; a1 = *(const LAS f32x4*)(AB + 404);
            asm volatile("" ::: "memory"); T[52] -= a2.x * T[5]; T[53] -= a2.y * T[5]; T[54] -= a2.z * T[5]; T[55] -= a2.w * T[5]; a2 = *(const LAS f32x4*)(AB + 408);
            asm volatile("" ::: "memory"); T[56] -= a3.x * T[5]; T[57] -= a3.y * T[5]; T[58] -= a3.z * T[5]; T[59] -= a3.w * T[5]; a3 = *(const LAS f32x4*)(AB + 412);
            asm volatile("" ::: "memory"); T[60] -= a4.x * T[5]; T[61] -= a4.y * T[5]; T[62] -= a4.z * T[5]; T[63] -= a4.w * T[5]; a4 = *(const LAS f32x4*)(AB + 416);
            asm volatile("" ::: "memory"); T[7] -= a5.w * T[6]; a5 = *(const LAS f32x4*)(AB + 420);
            asm volatile("" ::: "memory"); T[8] -= a6.x * T[6]; T[9] -= a6.y * T[6]; T[10] -= a6.z * T[6]; T[11] -= a6.w * T[6]; a6 = *(const LAS f32x4*)(AB + 424);
            asm volatile("" ::: "memory"); T[12] -= a7.x * T[6]; T[13] -= a7.y * T[6]; T[14] -= a7.z * T[6]; T[15] -= a7.w * T[6]; a7 = *(const LAS f32x4*)(AB + 428);
            asm volatile("" ::: "memory"); T[16] -= a0.x * T[6]; T[17] -= a0.y * T[6]; T[18] -= a0.z * T[6]; T[19] -= a0.w * T[6]; a0 = *(const LAS f32x4*)(AB + 432);
            asm volatile("" ::: "memory"); T[20] -= a1.x * T[6]; T[21] -= a1.y * T[6]; T[22] -= a1.z * T[6]; T[23] -= a1.w * T[6]; a1 = *(const LAS f32x4*)(AB + 436);
            asm volatile("" ::: "memory"); T[24] -= a2.x * T[6]; T[25] -= a2.y * T[6]; T[26] -= a2.z * T[6]; T[27] -= a2.w * T[6]; a2 = *(const LAS f32x4*)(AB + 440);
            asm volatile("" ::: "memory"); T[28] -= a3.x * T[6]; T[29] -= a3.y * T[6]; T[30] -= a3.z * T[6]; T[31] -= a3.w * T[6]; a3 = *(const LAS f32x4*)(AB + 444);
            asm volatile("" ::: "memory"); T[32] -= a4.x * T[6]; T[33] -= a4.y * T[6]; T[34] -= a4.z * T[6]; T[35] -= a4.w * T[6]; a4 = *(const LAS f32x4*)(AB + 456);
            asm volatile("" ::: "memory"); T[36] -= a5.x * T[6]; T[37] -= a5.y * T[6]; T[38] -= a5.z * T[6]; T[39] -= a5.w * T[6]; a5 = *(const LAS f32x4*)(AB + 460);
            asm volatile("" ::: "memory"); T[40] -= a6.x * T[6]; T[41] -= a6.y * T[6]; T[42] -= a6.z * T[6]; T[43] -= a6.w * T[6]; a6 = *(const LAS f32x4*)(AB + 464);
            asm volatile("" ::: "memory"); T[44] -= a7.x * T[6]; T[45] -= a7.y * T[6]; T[46] -= a7.z * T[6]; T[47] -= a7.w * T[6]; a7 = *(const LAS f32x4*)(AB + 468);
            asm volatile("" ::: "memory"); T[48] -= a0.x * T[6]; T[49] -= a0.y * T[6]; T[50] -= a0.z * T[6]; T[51] -= a0.w * T[6]; a0 = *(const LAS f32x4*)(AB + 472);
            asm volatile("" ::: "memory"); T[52] -= a1.x * T[6]; T[53] -= a1.y * T[6]; T[54] -= a1.z * T[6]; T[55] -= a1.w * T[6]; a1 = *(const LAS f32x4*)(AB + 476);
            asm volatile("" ::: "memory"); T[56] -= a2.x * T[6]; T[57] -= a2.y * T[6]; T[58] -= a2.z * T[6]; T[59] -= a2.w * T[6]; a2 = *(const LAS f32x4*)(AB + 480);
            asm volatile("" ::: "memory"); T[60] -= a3.x * T[6]; T[61] -= a3.y * T[6]; T[62] -= a3.z * T[6]; T[63] -= a3.w * T[6]; a3 = *(const LAS f32x4*)(AB + 484);
            asm volatile("" ::: "memory"); T[8] -= a4.x * T[7]; T[9] -= a4.y * T[7]; T[10] -= a4.z * T[7]; T[11] -= a4.w * T[7]; a4 = *(const LAS f32x4*)(AB + 488);
            asm volatile("" ::: "memory"); T[12] -= a5.x * T[7]; T[13] -= a5.y * T[7]; T[14] -= a5.z * T[7]; T[15] -= a5.w * T[7]; a5 = *(const LAS f32x4*)(AB + 492);
            asm volatile("" ::: "memory"); T[16] -= a6.x * T[7]; T[17] -= a6.y * T[7]; T[18] -= a6.z * T[7]; T[19] -= a6.w * T[7]; a6 = *(const LAS f32x4*)(AB + 496);
            asm volatile("" ::: "memory"); T[20] -= a7.x * T[7]; T[21] -= a7.y * T[7]; T[22] -= a7.z * T[7]; T[23] -= a7.w * T[7]; a7 = *(const LAS f32x4*)(AB + 500);
            asm volatile("" ::: "memory"); T[24] -= a0.x * T[7]; T[25] -= a0.y * T[7]; T[26] -= a0.z * T[7]; T[27] -= a0.w * T[7]; a0 = *(const LAS f32x4*)(AB + 504);
            asm volatile("" ::: "memory"); T[28] -= a1.x * T[7]; T[29] -= a1.y * T[7]; T[30] -= a1.z * T[7]; T[31] -= a1.w * T[7]; a1 = *(const LAS f32x4*)(AB + 508);
            asm volatile("" ::: "memory"); T[32] -= a2.x * T[7]; T[33] -= a2.y * T[7]; T[34] -= a2.z * T[7]; T[35] -= a2.w * T[7]; a2 = *(const LAS f32x4*)(AB + 520);
            asm volatile("" ::: "memory"); T[36] -= a3.x * T[7]; T[37] -= a3.y * T[7]; T[38] -= a3.z * T[7]; T[39] -= a3.w * T[7]; a3 = *(const LAS f32x4*)(AB + 524);
            asm volatile("" ::: "memory"); T[40] -= a4.x * T[7]; T[41] -= a4.y * T[7]; T[42] -= a4.z * T[7]; T[43] -= a4.w * T[7]; a4 = *(const LAS f32x4*)(AB + 528);
            asm volatile("" ::: "memory"); T[44] -= a5.x * T[7]; T[45] -= a5.y * T[7]; T[46] -= a5.z * T[7]; T[47] -= a5.w * T[7]; a5 = *(const LAS f32x4*)(AB + 532);
            asm volatile("" ::: "memory"); T[48] -= a6.x * T[7]; T[49] -= a6.y * T[7]; T[50] -= a6.z * T[7]; T[51] -= a6.w * T[7]; a6 = *(const LAS f32x4*)(AB + 536);
            asm volatile("" ::: "memory"); T[52] -= a7.x * T[7]; T[53] -= a7.y * T[7]; T[54] -= a7.z * T[7]; T[55] -= a7.w * T[7]; a7 = *(const LAS f32x4*)(AB + 540);
            asm volatile("" ::: "memory"); T[56] -= a0.x * T[7]; T[57] -= a0.y * T[7]; T[58] -= a0.z * T[7]; T[59] -= a0.w * T[7]; a0 = *(const LAS f32x4*)(AB + 544);
            asm volatile("" ::: "memory"); T[60] -= a1.x * T[7]; T[61] -= a1.y * T[7]; T[62] -= a1.z * T[7]; T[63] -= a1.w * T[7]; a1 = *(const LAS f32x4*)(AB + 548);
            asm volatile("" ::: "memory"); T[9] -= a2.y * T[8]; T[10] -= a2.z * T[8]; T[11] -= a2.w * T[8]; a2 = *(const LAS f32x4*)(AB + 552);
            asm volatile("" ::: "memory"); T[12] -= a3.x * T[8]; T[13] -= a3.y * T[8]; T[14] -= a3.z * T[8]; T[15] -= a3.w * T[8]; a3 = *(const LAS f32x4*)(AB + 556);
            asm volatile("" ::: "memory"); T[16] -= a4.x * T[8]; T[17] -= a4.y * T[8]; T[18] -= a4.z * T[8]; T[19] -= a4.w * T[8]; a4 = *(const LAS f32x4*)(AB + 560);
            asm volatile("" ::: "memory"); T[20] -= a5.x * T[8]; T[21] -= a5.y * T[8]; T[22] -= a5.z * T[8]; T[23] -= a5.w * T[8]; a5 = *(const LAS f32x4*)(AB + 564);
            asm volatile("" ::: "memory"); T[24] -= a6.x * T[8]; T[25] -= a6.y * T[8]; T[26] -= a6.z * T[8]; T[27] -= a6.w * T[8]; a6 = *(const LAS f32x4*)(AB + 568);
            asm volatile("" ::: "memory"); T[28] -= a7.x * T[8]; T[29] -= a7.y * T[8]; T[30] -= a7.z * T[8]; T[31] -= a7.w * T[8]; a7 = *(const LAS f32x4*)(AB + 572);
            asm volatile("" ::: "memory"); T[32] -= a0.x * T[8]; T[33] -= a0.y * T[8]; T[34] -= a0.z * T[8]; T[35] -= a0.w * T[8]; a0 = *(const LAS f32x4*)(AB + 584);
            asm volatile("" ::: "memory"); T[36] -= a1.x * T[8]; T[37] -= a1.y * T[8]; T[38] -= a1.z * T[8]; T[39] -= a1.w * T[8]; a1 = *(const LAS f32x4*)(AB + 588);
            asm volatile("" ::: "memory"); T[40] -= a2.x * T[8]; T[41] -= a2.y * T[8]; T[42] -= a2.z * T[8]; T[43] -= a2.w * T[8]; a2 = *(const LAS f32x4*)(AB + 592);
            asm volatile("" ::: "memory"); T[44] -= a3.x * T[8]; T[45] -= a3.y * T[8]; T[46] -= a3.z * T[8]; T[47] -= a3.w * T[8]; a3 = *(const LAS f32x4*)(AB + 596);
            asm volatile("" ::: "memory"); T[48] -= a4.x * T[8]; T[49] -= a4.y * T[8]; T[50] -= a4.z * T[8]; T[51] -= a4.w * T[8]; a4 = *(const LAS f32x4*)(AB + 600);
            asm volatile("" ::: "memory"); T[52] -= a5.x * T[8]; T[53] -= a5.y * T[8]; T[54] -= a5.z * T[8]; T[55] -= a5.w * T[8]; a5 = *(const LAS f32x4*)(AB + 604);
            asm volatile("" ::: "memory"); T[56] -= a6.x * T[8]; T[57] -= a6.y * T[8]; T[58] -= a6.z * T[8]; T[59] -= a6.w * T[8]; a6 = *(const LAS f32x4*)(AB + 608);
            asm volatile("" ::: "memory"); T[60] -= a7.x * T[8]; T[61] -= a7.y * T[8]; T[62] -= a7.z * T[8]; T[63] -= a7.w * T[8]; a7 = *(const LAS f32x4*)(AB + 612);
            asm volatile("" ::: "memory"); T[10] -= a0.z * T[9]; T[11] -= a0.w * T[9]; a0 = *(const LAS f32x4*)(AB + 616);
            asm volatile("" ::: "memory"); T[12] -= a1.x * T[9]; T[13] -= a1.y * T[9]; T[14] -= a1.z * T[9]; T[15] -= a1.w * T[9]; a1 = *(const LAS f32x4*)(AB + 620);
            asm volatile("" ::: "memory"); T[16] -= a2.x * T[9]; T[17] -= a2.y * T[9]; T[18] -= a2.z * T[9]; T[19] -= a2.w * T[9]; a2 = *(const LAS f32x4*)(AB + 624);
            asm volatile("" ::: "memory"); T[20] -= a3.x * T[9]; T[21] -= a3.y * T[9]; T[22] -= a3.z * T[9]; T[23] -= a3.w * T[9]; a3 = *(const LAS f32x4*)(AB + 628);
            asm volatile("" ::: "memory"); T[24] -= a4.x * T[9]; T[25] -= a4.y * T[9]; T[26] -= a4.z * T[9]; T[27] -= a4.w * T[9]; a4 = *(const LAS f32x4*)(AB + 632);
            asm volatile("" ::: "memory"); T[28] -= a5.x * T[9]; T[29] -= a5.y * T[9]; T[30] -= a5.z * T[9]; T[31] -= a5.w * T[9]; a5 = *(const LAS f32x4*)(AB + 636);
            asm volatile("" ::: "memory"); T[32] -= a6.x * T[9]; T[33] -= a6.y * T[9]; T[34] -= a6.z * T[9]; T[35] -= a6.w * T[9]; a6 = *(const LAS f32x4*)(AB + 648);
            asm volatile("" ::: "memory"); T[36] -= a7.x * T[9]; T[37] -= a7.y * T[9]; T[38] -= a7.z * T[9]; T[39] -= a7.w * T[9]; a7 = *(const LAS f32x4*)(AB + 652);
            asm volatile("" ::: "memory"); T[40] -= a0.x * T[9]; T[41] -= a0.y * T[9]; T[42] -= a0.z * T[9]; T[43] -= a0.w * T[9]; a0 = *(const LAS f32x4*)(AB + 656);
            asm volatile("" ::: "memory"); T[44] -= a1.x * T[9]; T[45] -= a1.y * T[9]; T[46] -= a1.z * T[9]; T[47] -= a1.w * T[9]; a1 = *(const LAS f32x4*)(AB + 660);
            asm volatile("" ::: "memory"); T[48] -= a2.x * T[9]; T[49] -= a2.y * T[9]; T[50] -= a2.z * T[9]; T[51] -= a2.w * T[9]; a2 = *(const LAS f32x4*)(AB + 664);
            asm volatile("" ::: "memory"); T[52] -= a3.x * T[9]; T[53] -= a3.y * T[9]; T[54] -= a3.z * T[9]; T[55] -= a3.w * T[9]; a3 = *(const LAS f32x4*)(AB + 668);
            asm volatile("" ::: "memory"); T[56] -= a4.x * T[9]; T[57] -= a4.y * T[9]; T[58] -= a4.z * T[9]; T[59] -= a4.w * T[9]; a4 = *(const LAS f32x4*)(AB + 672);
            asm volatile("" ::: "memory"); T[60] -= a5.x * T[9]; T[61] -= a5.y * T[9]; T[62] -= a5.z * T[9]; T[63] -= a5.w * T[9]; a5 = *(const LAS f32x4*)(AB + 676);
            asm volatile("" ::: "memory"); T[11] -= a6.w * T[10]; a6 = *(const LAS f32x4*)(AB + 680);
            asm volatile("" ::: "memory"); T[12] -= a7.x * T[10]; T[13] -= a7.y * T[10]; T[14] -= a7.z * T[10]; T[15] -= a7.w * T[10]; a7 = *(const LAS f32x4*)(AB + 684);
            asm volatile("" ::: "memory"); T[16] -= a0.x * T[10]; T[17] -= a0.y * T[10]; T[18] -= a0.z * T[10]; T[19] -= a0.w * T[10]; a0 = *(const LAS f32x4*)(AB + 688);
            asm volatile("" ::: "memory"); T[20] -= a1.x * T[10]; T[21] -= a1.y * T[10]; T[22] -= a1.z * T[10]; T[23] -= a1.w * T[10]; a1 = *(const LAS f32x4*)(AB + 692);
            asm volatile("" ::: "memory"); T[24] -= a2.x * T[10]; T[25] -= a2.y * T[10]; T[26] -= a2.z * T[10]; T[27] -= a2.w * T[10]; a2 = *(const LAS f32x4*)(AB + 696);
            asm volatile("" ::: "memory"); T[28] -= a3.x * T[10]; T[29] -= a3.y * T[10]; T[30] -= a3.z * T[10]; T[31] -= a3.w * T[10]; a3 = *(const LAS f32x4*)(AB + 700);
            asm volatile("" ::: "memory"); T[32] -= a4.x * T[10]; T[33] -= a4.y * T[10]; T[34] -= a4.z * T[10]; T[35] -= a4.w * T[10]; a4 = *(const LAS f32x4*)(AB + 716);
            asm volatile("" ::: "memory"); T[36] -= a5.x * T[10]; T[37] -= a5.y * T[10]; T[38] -= a5.z * T[10]; T[39] -= a5.w * T[10]; a5 = *(const LAS f32x4*)(AB + 720);
            asm volatile("" ::: "memory"); T[40] -= a6.x * T[10]; T[41] -= a6.y * T[10]; T[42] -= a6.z * T[10]; T[43] -= a6.w * T[10]; a6 = *(const LAS f32x4*)(AB + 724);
            asm volatile("" ::: "memory"); T[44] -= a7.x * T[10]; T[45] -= a7.y * T[10]; T[46] -= a7.z * T[10]; T[47] -= a7.w * T[10]; a7 = *(const LAS f32x4*)(AB + 728);
            asm volatile("" ::: "memory"); T[48] -= a0.x * T[10]; T[49] -= a0.y * T[10]; T[50] -= a0.z * T[10]; T[51] -= a0.w * T[10]; a0 = *(const LAS f32x4*)(AB + 732);
            asm volatile("" ::: "memory"); T[52] -= a1.x * T[10]; T[53] -= a1.y * T[10]; T[54] -= a1.z * T[10]; T[55] -= a1.w * T[10]; a1 = *(const LAS f32x4*)(AB + 736);
            asm volatile("" ::: "memory"); T[56] -= a2.x * T[10]; T[57] -= a2.y * T[10]; T[58] -= a2.z * T[10]; T[59] -= a2.w * T[10]; a2 = *(const LAS f32x4*)(AB + 740);
            asm volatile("" ::: "memory"); T[60] -= a3.x * T[10]; T[61] -= a3.y * T[10]; T[62] -= a3.z * T[10]; T[63] -= a3.w * T[10]; a3 = *(const LAS f32x4*)(AB + 744);
            asm volatile("" ::: "memory"); T[12] -= a4.x * T[11]; T[13] -= a4.y * T[11]; T[14] -= a4.z * T[11]; T[15] -= a4.w * T[11]; a4 = *(const LAS f32x4*)(AB + 748);
            asm volatile("" ::: "memory"); T[16] -= a5.x * T[11]; T[17] -= a5.y * T[11]; T[18] -= a5.z * T[11]; T[19] -= a5.w * T[11]; a5 = *(const LAS f32x4*)(AB + 752);
            asm volatile("" ::: "memory"); T[20] -= a6.x * T[11]; T[21] -= a6.y * T[11]; T[22] -= a6.z * T[11]; T[23] -= a6.w * T[11]; a6 = *(const LAS f32x4*)(AB + 756);
            asm volatile("" ::: "memory"); T[24] -= a7.x * T[11]; T[25] -= a7.y * T[11]; T[26] -= a7.z * T[11]; T[27] -= a7.w * T[11]; a7 = *(const LAS f32x4*)(AB + 760);
            asm volatile("" ::: "memory"); T[28] -= a0.x * T[11]; T[29] -= a0.y * T[11]; T[30] -= a0.z * T[11]; T[31] -= a0.w * T[11]; a0 = *(const LAS f32x4*)(AB + 764);
            asm volatile("" ::: "memory"); T[32] -= a1.x * T[11]; T[33] -= a1.y * T[11]; T[34] -= a1.z * T[11]; T[35] -= a1.w * T[11]; a1 = *(const LAS f32x4*)(AB + 780);
            asm volatile("" ::: "memory"); T[36] -= a2.x * T[11]; T[37] -= a2.y * T[11]; T[38] -= a2.z * T[11]; T[39] -= a2.w * T[11]; a2 = *(const LAS f32x4*)(AB + 784);
            asm volatile("" ::: "memory"); T[40] -= a3.x * T[11]; T[41] -= a3.y * T[11]; T[42] -= a3.z * T[11]; T[43] -= a3.w * T[11]; a3 = *(const LAS f32x4*)(AB + 788);
            asm volatile("" ::: "memory"); T[44] -= a4.x * T[11]; T[45] -= a4.y * T[11]; T[46] -= a4.z * T[11]; T[47] -= a4.w * T[11]; a4 = *(const LAS f32x4*)(AB + 792);
            asm volatile("" ::: "memory"); T[48] -= a5.x * T[11]; T[49] -= a5.y * T[11]; T[50] -= a5.z * T[11]; T[51] -= a5.w * T[11]; a5 = *(const LAS f32x4*)(AB + 796);
            asm volatile("" ::: "memory"); T[52] -= a6.x * T[11]; T[53] -= a6.y * T[11]; T[54] -= a6.z * T[11]; T[55] -= a6.w * T[11]; a6 = *(const LAS f32x4*)(AB + 800);
            asm volatile("" ::: "memory"); T[56] -= a7.x * T[11]; T[57] -= a7.y * T[11]; T[58] -= a7.z * T[11]; T[59] -= a7.w * T[11]; a7 = *(const LAS f32x4*)(AB + 804);
            asm volatile("" ::: "memory"); T[60] -= a0.x * T[11]; T[61] -= a0.y * T[11]; T[62] -= a0.z * T[11]; T[63] -= a0.w * T[11]; a0 = *(const LAS f32x4*)(AB + 808);
            asm volatile("" ::: "memory"); T[13] -= a1.y * T[12]; T[14] -= a1.z * T[12]; T[15] -= a1.w * T[12]; a1 = *(const LAS f32x4*)(AB + 812);
            asm volatile("" ::: "memory"); T[16] -= a2.x * T[12]; T[17] -= a2.y * T[12]; T[18] -= a2.z * T[12]; T[19] -= a2.w * T[12]; a2 = *(const LAS f32x4*)(AB + 816);
            asm volatile("" ::: "memory"); T[20] -= a3.x * T[12]; T[21] -= a3.y * T[12]; T[22] -= a3.z * T[12]; T[23] -= a3.w * T[12]; a3 = *(const LAS f32x4*)(AB + 820);
            asm volatile("" ::: "memory"); T[24] -= a4.x * T[12]; T[25] -= a4.y * T[12]; T[26] -= a4.z * T[12]; T[27] -= a4.w * T[12]; a4 = *(const LAS f32x4*)(AB + 824);
            asm volatile("" ::: "memory"); T[28] -= a5.x * T[12]; T[29] -= a5.y * T[12]; T[30] -= a5.z * T[12]; T[31] -= a5.w * T[12]; a5 = *(const LAS f32x4*)(AB + 828);
            asm volatile("" ::: "memory"); T[32] -= a6.x * T[12]; T[33] -= a6.y * T[12]; T[34] -= a6.z * T[12]; T[35] -= a6.w * T[12]; a6 = *(const LAS f32x4*)(AB + 844);
            asm volatile("" ::: "memory"); T[36] -= a7.x * T[12]; T[37] -= a7.y * T[12]; T[38] -= a7.z * T[12]; T[39] -= a7.w * T[12]; a7 = *(const LAS f32x4*)(AB + 848);
            asm volatile("" ::: "memory"); T[40] -= a0.x * T[12]; T[41] -= a0.y * T[12]; T[42] -= a0.z * T[12]; T[43] -= a0.w * T[12]; a0 = *(const LAS f32x4*)(AB + 852);
            asm volatile("" ::: "memory"); T[44] -= a1.x * T[12]; T[45] -= a1.y * T[12]; T[46] -= a1.z * T[12]; T[47] -= a1.w * T[12]; a1 = *(const LAS f32x4*)(AB + 856);
            asm volatile("" ::: "memory"); T[48] -= a2.x * T[12]; T[49] -= a2.y * T[12]; T[50] -= a2.z * T[12]; T[51] -= a2.w * T[12]; a2 = *(const LAS f32x4*)(AB + 860);
            asm volatile("" ::: "memory"); T[52] -= a3.x * T[12]; T[53] -= a3.y * T[12]; T[54] -= a3.z * T[12]; T[55] -= a3.w * T[12]; a3 = *(const LAS f32x4*)(AB + 864);
            asm volatile("" ::: "memory"); T[56] -= a4.x * T[12]; T[57] -= a4.y * T[12]; T[58] -= a4.z * T[12]; T[59] -= a4.w * T[12]; a4 = *(const LAS f32x4*)(AB + 868);
            asm volatile("" ::: "memory"); T[60] -= a5.x * T[12]; T[61] -= a5.y * T[12]; T[62] -= a5.z * T[12]; T[63] -= a5.w * T[12]; a5 = *(const LAS f32x4*)(AB + 872);
            asm volatile("" ::: "memory"); T[14] -= a6.z * T[13]; T[15] -= a6.w * T[13]; a6 = *(const LAS f32x4*)(AB + 876);
            asm volatile("" ::: "memory"); T[16] -= a7.x * T[13]; T[17] -= a7.y * T[13]; T[18] -= a7.z * T[13]; T[19] -= a7.w * T[13]; a7 = *(const LAS f32x4*)(AB + 880);
            asm volatile("" ::: "memory"); T[20] -= a0.x * T[13]; T[21] -= a0.y * T[13]; T[22] -= a0.z * T[13]; T[23] -= a0.w * T[13]; a0 = *(const LAS f32x4*)(AB + 884);
            asm volatile("" ::: "memory"); T[24] -= a1.x * T[13]; T[25] -= a1.y * T[13]; T[26] -= a1.z * T[13]; T[27] -= a1.w * T[13]; a1 = *(const LAS f32x4*)(AB + 888);
            asm volatile("" ::: "memory"); T[28] -= a2.x * T[13]; T[29] -= a2.y * T[13]; T[30] -= a2.z * T[13]; T[31] -= a2.w * T[13]; a2 = *(const LAS f32x4*)(AB + 892);
            asm volatile("" ::: "memory"); T[32] -= a3.x * T[13]; T[33] -= a3.y * T[13]; T[34] -= a3.z * T[13]; T[35] -= a3.w * T[13]; a3 = *(const LAS f32x4*)(AB + 908);
            asm volatile("" ::: "memory"); T[36] -= a4.x * T[13]; T[37] -= a4.y * T[13]; T[38] -= a4.z * T[13]; T[39] -= a4.w * T[13]; a4 = *(const LAS f32x4*)(AB + 912);
            asm volatile("" ::: "memory"); T[40] -= a5.x * T[13]; T[41] -= a5.y * T[13]; T[42] -= a5.z * T[13]; T[43] -= a5.w * T[13]; a5 = *(const LAS f32x4*)(AB + 916);
            asm volatile("" ::: "memory"); T[44] -= a6.x * T[13]; T[45] -= a6.y * T[13]; T[46] -= a6.z * T[13]; T[47] -= a6.w * T[13]; a6 = *(const LAS f32x4*)(AB + 920);
            asm volatile("" ::: "memory"); T[48] -= a7.x * T[13]; T[49] -= a7.y * T[13]; T[50] -= a7.z * T[13]; T[51] -= a7.w * T[13]; a7 = *(const LAS f32x4*)(AB + 924);
            asm volatile("" ::: "memory"); T[52] -= a0.x * T[13]; T[53] -= a0.y * T[13]; T[54] -= a0.z * T[13]; T[55] -= a0.w * T[13]; a0 = *(const LAS f32x4*)(AB + 928);
            asm volatile("" ::: "memory"); T[56] -= a1.x * T[13]; T[57] -= a1.y * T[13]; T[58] -= a1.z * T[13]; T[59] -= a1.w * T[13]; a1 = *(const LAS f32x4*)(AB + 932);
            asm volatile("" ::: "memory"); T[60] -= a2.x * T[13]; T[61] -= a2.y * T[13]; T[62] -= a2.z * T[13]; T[63] -= a2.w * T[13]; a2 = *(const LAS f32x4*)(AB + 936);
            asm volatile("" ::: "memory"); T[15] -= a3.w * T[14]; a3 = *(const LAS f32x4*)(AB + 940);
            asm volatile("" ::: "memory"); T[16] -= a4.x * T[14]; T[17] -= a4.y * T[14]; T[18] -= a4.z * T[14]; T[19] -= a4.w * T[14]; a4 = *(const LAS f32x4*)(AB + 944);
            asm volatile("" ::: "memory"); T[20] -= a5.x * T[14]; T[21] -= a5.y * T[14]; T[22] -= a5.z * T[14]; T[23] -= a5.w * T[14]; a5 = *(const LAS f32x4*)(AB + 948);
            asm volatile("" ::: "memory"); T[24] -= a6.x * T[14]; T[25] -= a6.y * T[14]; T[26] -= a6.z * T[14]; T[27] -= a6.w * T[14]; a6 = *(const LAS f32x4*)(AB + 952);
            asm volatile("" ::: "memory"); T[28] -= a7.x * T[14]; T[29] -= a7.y * T[14]; T[30] -= a7.z * T[14]; T[31] -= a7.w * T[14]; a7 = *(const LAS f32x4*)(AB + 956);
            asm volatile("" ::: "memory"); T[32] -= a0.x * T[14]; T[33] -= a0.y * T[14]; T[34] -= a0.z * T[14]; T[35] -= a0.w * T[14]; a0 = *(const LAS f32x4*)(AB + 976);
            asm volatile("" ::: "memory"); T[36] -= a1.x * T[14]; T[37] -= a1.y * T[14]; T[38] -= a1.z * T[14]; T[39] -= a1.w * T[14]; a1 = *(const LAS f32x4*)(AB + 980);
            asm volatile("" ::: "memory"); T[40] -= a2.x * T[14]; T[41] -= a2.y * T[14]; T[42] -= a2.z * T[14]; T[43] -= a2.w * T[14]; a2 = *(const LAS f32x4*)(AB + 984);
            asm volatile("" ::: "memory"); T[44] -= a3.x * T[14]; T[45] -= a3.y * T[14]; T[46] -= a3.z * T[14]; T[47] -= a3.w * T[14]; a3 = *(const LAS f32x4*)(AB + 988);
            asm volatile("" ::: "memory"); T[48] -= a4.x * T[14]; T[49] -= a4.y * T[14]; T[50] -= a4.z * T[14]; T[51] -= a4.w * T[14]; a4 = *(const LAS f32x4*)(AB + 992);
            asm volatile("" ::: "memory"); T[52] -= a5.x * T[14]; T[53] -= a5.y * T[14]; T[54] -= a5.z * T[14]; T[55] -= a5.w * T[14]; a5 = *(const LAS f32x4*)(AB + 996);
            asm volatile("" ::: "memory"); T[56] -= a6.x * T[14]; T[57] -= a6.y * T[14]; T[58] -= a6.z * T[14]; T[59] -= a6.w * T[14]; a6 = *(const LAS f32x4*)(AB + 1000);
            asm volatile("" ::: "memory"); T[60] -= a7.x * T[14]; T[61] -= a7.y * T[14]; T[62] -= a7.z * T[14]; T[63] -= a7.w * T[14]; a7 = *(const LAS f32x4*)(AB + 1004);
            asm volatile("" ::: "memory"); T[16] -= a0.x * T[15]; T[17] -= a0.y * T[15]; T[18] -= a0.z * T[15]; T[19] -= a0.w * T[15]; a0 = *(const LAS f32x4*)(AB + 1008);
            asm volatile("" ::: "memory"); T[20] -= a1.x * T[15]; T[21] -= a1.y * T[15]; T[22] -= a1.z * T[15]; T[23] -= a1.w * T[15]; a1 = *(const LAS f32x4*)(AB + 1012);
            asm volatile("" ::: "memory"); T[24] -= a2.x * T[15]; T[25] -= a2.y * T[15]; T[26] -= a2.z * T[15]; T[27] -= a2.w * T[15]; a2 = *(const LAS f32x4*)(AB + 1016);
            asm volatile("" ::: "memory"); T[28] -= a3.x * T[15]; T[29] -= a3.y * T[15]; T[30] -= a3.z * T[15]; T[31] -= a3.w * T[15]; a3 = *(const LAS f32x4*)(AB + 1020);
            asm volatile("" ::: "memory"); T[32] -= a4.x * T[15]; T[33] -= a4.y * T[15]; T[34] -= a4.z * T[15]; T[35] -= a4.w * T[15]; a4 = *(const LAS f32x4*)(AB + 1040);
            asm volatile("" ::: "memory"); T[36] -= a5.x * T[15]; T[37] -= a5.y * T[15]; T[38] -= a5.z * T[15]; T[39] -= a5.w * T[15]; a5 = *(const LAS f32x4*)(AB + 1044);
            asm volatile("" ::: "memory"); T[40] -= a6.x * T[15]; T[41] -= a6.y * T[15]; T[42] -= a6.z * T[15]; T[43] -= a6.w * T[15]; a6 = *(const LAS f32x4*)(AB + 1048);
            asm volatile("" ::: "memory"); T[44] -= a7.x * T[15]; T[45] -= a7.y * T[15]; T[46] -= a7.z * T[15]; T[47] -= a7.w * T[15]; a7 = *(const LAS f32x4*)(AB + 1052);
            asm volatile("" ::: "memory"); T[48] -= a0.x * T[15]; T[49] -= a0.y * T[15]; T[50] -= a0.z * T[15]; T[51] -= a0.w * T[15]; a0 = *(const LAS f32x4*)(AB + 1056);
            asm volatile("" ::: "memory"); T[52] -= a1.x * T[15]; T[53] -= a1.y * T[15]; T[54] -= a1.z * T[15]; T[55] -= a1.w * T[15]; a1 = *(const LAS f32x4*)(AB + 1060);
            asm volatile("" ::: "memory"); T[56] -= a2.x * T[15]; T[57] -= a2.y * T[15]; T[58] -= a2.z * T[15]; T[59] -= a2.w * T[15]; a2 = *(const LAS f32x4*)(AB + 1064);
            asm volatile("" ::: "memory"); T[60] -= a3.x * T[15]; T[61] -= a3.y * T[15]; T[62] -= a3.z * T[15]; T[63] -= a3.w * T[15]; a3 = *(const LAS f32x4*)(AB + 1068);
            asm volatile("" ::: "memory"); T[17] -= a4.y * T[16]; T[18] -= a4.z * T[16]; T[19] -= a4.w * T[16]; a4 = *(const LAS f32x4*)(AB + 1072);
            asm volatile("" ::: "memory"); T[20] -= a5.x * T[16]; T[21] -= a5.y * T[16]; T[22] -= a5.z * T[16]; T[23] -= a5.w * T[16]; a5 = *(const LAS f32x4*)(AB + 1076);
            asm volatile("" ::: "memory"); T[24] -= a6.x * T[16]; T[25] -= a6.y * T[16]; T[26] -= a6.z * T[16]; T[27] -= a6.w * T[16]; a6 = *(const LAS f32x4*)(AB + 1080);
            asm volatile("" ::: "memory"); T[28] -= a7.x * T[16]; T[29] -= a7.y * T[16]; T[30] -= a7.z * T[16]; T[31] -= a7.w * T[16]; a7 = *(const LAS f32x4*)(AB + 1084);
            asm volatile("" ::: "memory"); T[32] -= a0.x * T[16]; T[33] -= a0.y * T[16]; T[34] -= a0.z * T[16]; T[35] -= a0.w * T[16]; a0 = *(const LAS f32x4*)(AB + 1104);
            asm volatile("" ::: "memory"); T[36] -= a1.x * T[16]; T[37] -= a1.y * T[16]; T[38] -= a1.z * T[16]; T[39] -= a1.w * T[16]; a1 = *(const LAS f32x4*)(AB + 1108);
            asm volatile("" ::: "memory"); T[40] -= a2.x * T[16]; T[41] -= a2.y * T[16]; T[42] -= a2.z * T[16]; T[43] -= a2.w * T[16]; a2 = *(const LAS f32x4*)(AB + 1112);
            asm volatile("" ::: "memory"); T[44] -= a3.x * T[16]; T[45] -= a3.y * T[16]; T[46] -= a3.z * T[16]; T[47] -= a3.w * T[16]; a3 = *(const LAS f32x4*)(AB + 1116);
            asm volatile("" ::: "memory"); T[48] -= a4.x * T[16]; T[49] -= a4.y * T[16]; T[50] -= a4.z * T[16]; T[51] -= a4.w * T[16]; a4 = *(const LAS f32x4*)(AB + 1120);
            asm volatile("" ::: "memory"); T[52] -= a5.x * T[16]; T[53] -= a5.y * T[16]; T[54] -= a5.z * T[16]; T[55] -= a5.w * T[16]; a5 = *(const LAS f32x4*)(AB + 1124);
            asm volatile("" ::: "memory"); T[56] -= a6.x * T[16]; T[57] -= a6.y * T[16]; T[58] -= a6.z * T[16]; T[59] -= a6.w * T[16]; a6 = *(const LAS f32x4*)(AB + 1128);
            asm volatile("" ::: "memory"); T[60] -= a7.x * T[16]; T[61] -= a7.y * T[16]; T[62] -= a7.z * T[16]; T[63] -= a7.w * T[16]; a7 = *(const LAS f32x4*)(AB + 1132);
            asm volatile("" ::: "memory"); T[18] -= a0.z * T[17]; T[19] -= a0.w * T[17]; a0 = *(const LAS f32x4*)(AB + 1136);
            asm volatile("" ::: "memory"); T[20] -= a1.x * T[17]; T[21] -= a1.y * T[17]; T[22] -= a1.z * T[17]; T[23] -= a1.w * T[17]; a1 = *(const LAS f32x4*)(AB + 1140);
            asm volatile("" ::: "memory"); T[24] -= a2.x * T[17]; T[25] -= a2.y * T[17]; T[26] -= a2.z * T[17]; T[27] -= a2.w * T[17]; a2 = *(const LAS f32x4*)(AB + 1144);
            asm volatile("" ::: "memory"); T[28] -= a3.x * T[17]; T[29] -= a3.y * T[17]; T[30] -= a3.z * T[17]; T[31] -= a3.w * T[17]; a3 = *(const LAS f32x4*)(AB + 1148);
            asm volatile("" ::: "memory"); T[32] -= a4.x * T[17]; T[33] -= a4.y * T[17]; T[34] -= a4.z * T[17]; T[35] -= a4.w * T[17]; a4 = *(const LAS f32x4*)(AB + 1168);
            asm volatile("" ::: "memory"); T[36] -= a5.x * T[17]; T[37] -= a5.y * T[17]; T[38] -= a5.z * T[17]; T[39] -= a5.w * T[17]; a5 = *(const LAS f32x4*)(AB + 1172);
            asm volatile("" ::: "memory"); T[40] -= a6.x * T[17]; T[41] -= a6.y * T[17]; T[42] -= a6.z * T[17]; T[43] -= a6.w * T[17]; a6 = *(const LAS f32x4*)(AB + 1176);
            asm volatile("" ::: "memory"); T[44] -= a7.x * T[17]; T[45] -= a7.y * T[17]; T[46] -= a7.z * T[17]; T[47] -= a7.w * T[17]; a7 = *(const LAS f32x4*)(AB + 1180);
            asm volatile("" ::: "memory"); T[48] -= a0.x * T[17]; T[49] -= a0.y * T[17]; T[50] -= a0.z * T[17]; T[51] -= a0.w * T[17]; a0 = *(const LAS f32x4*)(AB + 1184);
            asm volatile("" ::: "memory"); T[52] -= a1.x * T[17]; T[53] -= a1.y * T[17]; T[54] -= a1.z * T[17]; T[55] -= a1.w * T[17]; a1 = *(const LAS f32x4*)(AB + 1188);
            asm volatile("" ::: "memory"); T[56] -= a2.x * T[17]; T[57] -= a2.y * T[17]; T[58] -= a2.z * T[17]; T[59] -= a2.w * T[17]; a2 = *(const LAS f32x4*)(AB + 1192);
            asm volatile("" ::: "memory"); T[60] -= a3.x * T[17]; T[61] -= a3.y * T[17]; T[62] -= a3.z * T[17]; T[63] -= a3.w * T[17]; a3 = *(const LAS f32x4*)(AB + 1196);
            asm volatile("" ::: "memory"); T[19] -= a4.w * T[18]; a4 = *(const LAS f32x4*)(AB + 1200);
            asm volatile("" ::: "memory"); T[20] -= a5.x * T[18]; T[21] -= a5.y * T[18]; T[22] -= a5.z * T[18]; T[23] -= a5.w * T[18]; a5 = *(const LAS f32x4*)(AB + 1204);
            asm volatile("" ::: "memory"); T[24] -= a6.x * T[18]; T[25] -= a6.y * T[18]; T[26] -= a6.z * T[18]; T[27] -= a6.w * T[18]; a6 = *(const LAS f32x4*)(AB + 1208);
            asm volatile("" ::: "memory"); T[28] -= a7.x * T[18]; T[29] -= a7.y * T[18]; T[30] -= a7.z * T[18]; T[31] -= a7.w * T[18]; a7 = *(const LAS f32x4*)(AB + 1212);
            asm volatile("" ::: "memory"); T[32] -= a0.x * T[18]; T[33] -= a0.y * T[18]; T[34] -= a0.z * T[18]; T[35] -= a0.w * T[18]; a0 = *(const LAS f32x4*)(AB + 1236);
            asm volatile("" ::: "memory"); T[36] -= a1.x * T[18]; T[37] -= a1.y * T[18]; T[38] -= a1.z * T[18]; T[39] -= a1.w * T[18]; a1 = *(const LAS f32x4*)(AB + 1240);
            asm volatile("" ::: "memory"); T[40] -= a2.x * T[18]; T[41] -= a2.y * T[18]; T[42] -= a2.z * T[18]; T[43] -= a2.w * T[18]; a2 = *(const LAS f32x4*)(AB + 1244);
            asm volatile("" ::: "memory"); T[44] -= a3.x * T[18]; T[45] -= a3.y * T[18]; T[46] -= a3.z * T[18]; T[47] -= a3.w * T[18]; a3 = *(const LAS f32x4*)(AB + 1248);
            asm volatile("" ::: "memory"); T[48] -= a4.x * T[18]; T[49] -= a4.y * T[18]; T[50] -= a4.z * T[18]; T[51] -= a4.w * T[18]; a4 = *(const LAS f32x4*)(AB + 1252);
            asm volatile("" ::: "memory"); T[52] -= a5.x * T[18]; T[53] -= a5.y * T[18]; T[54] -= a5.z * T[18]; T[55] -= a5.w * T[18]; a5 = *(const LAS f32x4*)(AB + 1256);
            asm volatile("" ::: "memory"); T[56] -= a6.x * T[18]; T[57] -= a6.y * T[18]; T[58] -= a6.z * T[18]; T[59] -= a6.w * T[18]; a6 = *(const LAS f32x4*)(AB + 1260);
            asm volatile("" ::: "memory"); T[60] -= a7.x * T[18]; T[61] -= a7.y * T[18]; T[62] -= a7.z * T[18]; T[63] -= a7.w * T[18]; a7 = *(const LAS f32x4*)(AB + 1264);
            asm volatile("" ::: "memory"); T[20] -= a0.x * T[19]; T[21] -= a0.y * T[19]; T[22] -= a0.z * T[19]; T[23] -= a0.w * T[19]; a0 = *(const LAS f32x4*)(AB + 1268);
            asm volatile("" ::: "memory"); T[24] -= a1.x * T[19]; T[25] -= a1.y * T[19]; T[26] -= a1.z * T[19]; T[27] -= a1.w * T[19]; a1 = *(const LAS f32x4*)(AB + 1272);
            asm volatile("" ::: "memory"); T[28] -= a2.x * T[19]; T[29] -= a2.y * T[19]; T[30] -= a2.z * T[19]; T[31] -= a2.w * T[19]; a2 = *(const LAS f32x4*)(AB + 1276);
            asm volatile("" ::: "memory"); T[32] -= a3.x * T[19]; T[33] -= a3.y * T[19]; T[34] -= a3.z * T[19]; T[35] -= a3.w * T[19]; a3 = *(const LAS f32x4*)(AB + 1300);
            asm volatile("" ::: "memory"); T[36] -= a4.x * T[19]; T[37] -= a4.y * T[19]; T[38] -= a4.z * T[19]; T[39] -= a4.w * T[19]; a4 = *(const LAS f32x4*)(AB + 1304);
            asm volatile("" ::: "memory"); T[40] -= a5.x * T[19]; T[41] -= a5.y * T[19]; T[42] -= a5.z * T[19]; T[43] -= a5.w * T[19]; a5 = *(const LAS f32x4*)(AB + 1308);
            asm volatile("" ::: "memory"); T[44] -= a6.x * T[19]; T[45] -= a6.y * T[19]; T[46] -= a6.z * T[19]; T[47] -= a6.w * T[19]; a6 = *(const LAS f32x4*)(AB + 1312);
            asm volatile("" ::: "memory"); T[48] -= a7.x * T[19]; T[49] -= a7.y * T[19]; T[50] -= a7.z * T[19]; T[51] -= a7.w * T[19]; a7 = *(const LAS f32x4*)(AB + 1316);
            asm volatile("" ::: "memory"); T[52] -= a0.x * T[19]; T[53] -= a0.y * T[19]; T[54] -= a0.z * T[19]; T[55] -= a0.w * T[19]; a0 = *(const LAS f32x4*)(AB + 1320);
            asm volatile("" ::: "memory"); T[56] -= a1.x * T[19]; T[57] -= a1.y * T[19]; T[58] -= a1.z * T[19]; T[59] -= a1.w * T[19]; a1 = *(const LAS f32x4*)(AB + 1324);
            asm volatile("" ::: "memory"); T[60] -= a2.x * T[19]; T[61] -= a2.y * T[19]; T[62] -= a2.z * T[19]; T[63] -= a2.w * T[19]; a2 = *(const LAS f32x4*)(AB + 1328);
            asm volatile("" ::: "memory"); T[21] -= a3.y * T[20]; T[22] -= a3.z * T[20]; T[23] -= a3.w * T[20]; a3 = *(const LAS f32x4*)(AB + 1332);
            asm volatile("" ::: "memory"); T[24] -= a4.x * T[20]; T[25] -= a4.y * T[20]; T[26] -= a4.z * T[20]; T[27] -= a4.w * T[20]; a4 = *(const LAS f32x4*)(AB + 1336);
            asm volatile("" ::: "memory"); T[28] -= a5.x * T[20]; T[29] -= a5.y * T[20]; T[30] -= a5.z * T[20]; T[31] -= a5.w * T[20]; a5 = *(const LAS f32x4*)(AB + 1340);
            asm volatile("" ::: "memory"); T[32] -= a6.x * T[20]; T[33] -= a6.y * T[20]; T[34] -= a6.z * T[20]; T[35] -= a6.w * T[20]; a6 = *(const LAS f32x4*)(AB + 1364);
            asm volatile("" ::: "memory"); T[36] -= a7.x * T[20]; T[37] -= a7.y * T[20]; T[38] -= a7.z * T[20]; T[39] -= a7.w * T[20]; a7 = *(const LAS f32x4*)(AB + 1368);
            asm volatile("" ::: "memory"); T[40] -= a0.x * T[20]; T[41] -= a0.y * T[20]; T[42] -= a0.z * T[20]; T[43] -= a0.w * T[20]; a0 = *(const LAS f32x4*)(AB + 1372);
            asm volatile("" ::: "memory"); T[44] -= a1.x * T[20]; T[45] -= a1.y * T[20]; T[46] -= a1.z * T[20]; T[47] -= a1.w * T[20]; a1 = *(const LAS f32x4*)(AB + 1376);
            asm volatile("" ::: "memory"); T[48] -= a2.x * T[20]; T[49] -= a2.y * T[20]; T[50] -= a2.z * T[20]; T[51] -= a2.w * T[20]; a2 = *(const LAS f32x4*)(AB + 1380);
            asm volatile("" ::: "memory"); T[52] -= a3.x * T[20]; T[53] -= a3.y * T[20]; T[54] -= a3.z * T[20]; T[55] -= a3.w * T[20]; a3 = *(const LAS f32x4*)(AB + 1384);
            asm volatile("" ::: "memory"); T[56] -= a4.x * T[20]; T[57] -= a4.y * T[20]; T[58] -= a4.z * T[20]; T[59] -= a4.w * T[20]; a4 = *(const LAS f32x4*)(AB + 1388);
            asm volatile("" ::: "memory"); T[60] -= a5.x * T[20]; T[61] -= a5.y * T[20]; T[62] -= a5.z * T[20]; T[63] -= a5.w * T[20]; a5 = *(const LAS f32x4*)(AB + 1392);
            asm volatile("" ::: "memory"); T[22] -= a6.z * T[21]; T[23] -= a6.w * T[21]; a6 = *(const LAS f32x4*)(AB + 1396);
            asm volatile("" ::: "memory"); T[24] -= a7.x * T[21]; T[25] -= a7.y * T[21]; T[26] -= a7.z * T[21]; T[27] -= a7.w * T[21]; a7 = *(const LAS f32x4*)(AB + 1400);
            asm volatile("" ::: "memory"); T[28] -= a0.x * T[21]; T[29] -= a0.y * T[21]; T[30] -= a0.z * T[21]; T[31] -= a0.w * T[21]; a0 = *(const LAS f32x4*)(AB + 1404);
            asm volatile("" ::: "memory"); T[32] -= a1.x * T[21]; T[33] -= a1.y * T[21]; T[34] -= a1.z * T[21]; T[35] -= a1.w * T[21]; a1 = *(const LAS f32x4*)(AB + 1428);
            asm volatile("" ::: "memory"); T[36] -= a2.x * T[21]; T[37] -= a2.y * T[21]; T[38] -= a2.z * T[21]; T[39] -= a2.w * T[21]; a2 = *(const LAS f32x4*)(AB + 1432);
            asm volatile("" ::: "memory"); T[40] -= a3.x * T[21]; T[41] -= a3.y * T[21]; T[42] -= a3.z * T[21]; T[43] -= a3.w * T[21]; a3 = *(const LAS f32x4*)(AB + 1436);
            asm volatile("" ::: "memory"); T[44] -= a4.x * T[21]; T[45] -= a4.y * T[21]; T[46] -= a4.z * T[21]; T[47] -= a4.w * T[21]; a4 = *(const LAS f32x4*)(AB + 1440);
            asm volatile("" ::: "memory"); T[48] -= a5.x * T[21]; T[49] -= a5.y * T[21]; T[50] -= a5.z * T[21]; T[51] -= a5.w * T[21]; a5 = *(const LAS f32x4*)(AB + 1444);
            asm volatile("" ::: "memory"); T[52] -= a6.x * T[21]; T[53] -= a6.y * T[21]; T[54] -= a6.z * T[21]; T[55] -= a6.w * T[21]; a6 = *(const LAS f32x4*)(AB + 1448);
            asm volatile("" ::: "memory"); T[56] -= a7.x * T[21]; T[57] -= a7.y * T[21]; T[58] -= a7.z * T[21]; T[59] -= a7.w * T[21]; a7 = *(const LAS f32x4*)(AB + 1452);
            asm volatile("" ::: "memory"); T[60] -= a0.x * T[21]; T[61] -= a0.y * T[21]; T[62] -= a0.z * T[21]; T[63] -= a0.w * T[21]; a0 = *(const LAS f32x4*)(AB + 1456);
            asm volatile("" ::: "memory"); T[23] -= a1.w * T[22]; a1 = *(const LAS f32x4*)(AB + 1460);
            asm volatile("" ::: "memory"); T[24] -= a2.x * T[22]; T[25] -= a2.y * T[22]; T[26] -= a2.z * T[22]; T[27] -= a2.w * T[22]; a2 = *(const LAS f32x4*)(AB + 1464);
            asm volatile("" ::: "memory"); T[28] -= a3.x * T[22]; T[29] -= a3.y * T[22]; T[30] -= a3.z * T[22]; T[31] -= a3.w * T[22]; a3 = *(const LAS f32x4*)(AB + 1468);
            asm volatile("" ::: "memory"); T[32] -= a4.x * T[22]; T[33] -= a4.y * T[22]; T[34] -= a4.z * T[22]; T[35] -= a4.w * T[22]; a4 = *(const LAS f32x4*)(AB + 1496);
            asm volatile("" ::: "memory"); T[36] -= a5.x * T[22]; T[37] -= a5.y * T[22]; T[38] -= a5.z * T[22]; T[39] -= a5.w * T[22]; a5 = *(const LAS f32x4*)(AB + 1500);
            asm volatile("" ::: "memory"); T[40] -= a6.x * T[22]; T[41] -= a6.y * T[22]; T[42] -= a6.z * T[22]; T[43] -= a6.w * T[22]; a6 = *(const LAS f32x4*)(AB + 1504);
            asm volatile("" ::: "memory"); T[44] -= a7.x * T[22]; T[45] -= a7.y * T[22]; T[46] -= a7.z * T[22]; T[47] -= a7.w * T[22]; a7 = *(const LAS f32x4*)(AB + 1508);
            asm volatile("" ::: "memory"); T[48] -= a0.x * T[22]; T[49] -= a0.y * T[22]; T[50] -= a0.z * T[22]; T[51] -= a0.w * T[22]; a0 = *(const LAS f32x4*)(AB + 1512);
            asm volatile("" ::: "memory"); T[52] -= a1.x * T[22]; T[53] -= a1.y * T[22]; T[54] -= a1.z * T[22]; T[55] -= a1.w * T[22]; a1 = *(const LAS f32x4*)(AB + 1516);
            asm volatile("" ::: "memory"); T[56] -= a2.x * T[22]; T[57] -= a2.y * T[22]; T[58] -= a2.z * T[22]; T[59] -= a2.w * T[22]; a2 = *(const LAS f32x4*)(AB + 1520);
            asm volatile("" ::: "memory"); T[60] -= a3.x * T[22]; T[61] -= a3.y * T[22]; T[62] -= a3.z * T[22]; T[63] -= a3.w * T[22]; a3 = *(const LAS f32x4*)(AB + 1524);
            asm volatile("" ::: "memory"); T[24] -= a4.x * T[23]; T[25] -= a4.y * T[23]; T[26] -= a4.z * T[23]; T[27] -= a4.w * T[23]; a4 = *(const LAS f32x4*)(AB + 1528);
            asm volatile("" ::: "memory"); T[28] -= a5.x * T[23]; T[29] -= a5.y * T[23]; T[30] -= a5.z * T[23]; T[31] -= a5.w * T[23]; a5 = *(const LAS f32x4*)(AB + 1532);
            asm volatile("" ::: "memory"); T[32] -= a6.x * T[23]; T[33] -= a6.y * T[23]; T[34] -= a6.z * T[23]; T[35] -= a6.w * T[23]; a6 = *(const LAS f32x4*)(AB + 1560);
            asm volatile("" ::: "memory"); T[36] -= a7.x * T[23]; T[37] -= a7.y * T[23]; T[38] -= a7.z * T[23]; T[39] -= a7.w * T[23]; a7 = *(const LAS f32x4*)(AB + 1564);
            asm volatile("" ::: "memory"); T[40] -= a0.x * T[23]; T[41] -= a0.y * T[23]; T[42] -= a0.z * T[23]; T[43] -= a0.w * T[23]; a0 = *(const LAS f32x4*)(AB + 1568);
            asm volatile("" ::: "memory"); T[44] -= a1.x * T[23]; T[45] -= a1.y * T[23]; T[46] -= a1.z * T[23]; T[47] -= a1.w * T[23]; a1 = *(const LAS f32x4*)(AB + 1572);
            asm volatile("" ::: "memory"); T[48] -= a2.x * T[23]; T[49] -= a2.y * T[23]; T[50] -= a2.z * T[23]; T[51] -= a2.w * T[23]; a2 = *(const LAS f32x4*)(AB + 1576);
            asm volatile("" ::: "memory"); T[52] -= a3.x * T[23]; T[53] -= a3.y * T[23]; T[54] -= a3.z * T[23]; T[55] -= a3.w * T[23]; a3 = *(const LAS f32x4*)(AB + 1580);
            asm volatile("" ::: "memory"); T[56] -= a4.x * T[23]; T[57] -= a4.y * T[23]; T[58] -= a4.z * T[23]; T[59] -= a4.w * T[23]; a4 = *(const LAS f32x4*)(AB + 1584);
            asm volatile("" ::: "memory"); T[60] -= a5.x * T[23]; T[61] -= a5.y * T[23]; T[62] -= a5.z * T[23]; T[63] -= a5.w * T[23]; a5 = *(const LAS f32x4*)(AB + 1588);
            asm volatile("" ::: "memory"); T[25] -= a6.y * T[24]; T[26] -= a6.z * T[24]; T[27] -= a6.w * T[24]; a6 = *(const LAS f32x4*)(AB + 1592);
            asm volatile("" ::: "memory"); T[28] -= a7.x * T[24]; T[29] -= a7.y * T[24]; T[30] -= a7.z * T[24]; T[31] -= a7.w * T[24]; a7 = *(const LAS f32x4*)(AB + 1596);
            asm volatile("" ::: "memory"); T[32] -= a0.x * T[24]; T[33] -= a0.y * T[24]; T[34] -= a0.z * T[24]; T[35] -= a0.w * T[24]; a0 = *(const LAS f32x4*)(AB + 1624);
            asm volatile("" ::: "memory"); T[36] -= a1.x * T[24]; T[37] -= a1.y * T[24]; T[38] -= a1.z * T[24]; T[39] -= a1.w * T[24]; a1 = *(const LAS f32x4*)(AB + 1628);
            asm volatile("" ::: "memory"); T[40] -= a2.x * T[24]; T[41] -= a2.y * T[24]; T[42] -= a2.z * T[24]; T[43] -= a2.w * T[24]; a2 = *(const LAS f32x4*)(AB + 1632);
            asm volatile("" ::: "memory"); T[44] -= a3.x * T[24]; T[45] -= a3.y * T[24]; T[46] -= a3.z * T[24]; T[47] -= a3.w * T[24]; a3 = *(const LAS f32x4*)(AB + 1636);
            asm volatile("" ::: "memory"); T[48] -= a4.x * T[24]; T[49] -= a4.y * T[24]; T[50] -= a4.z * T[24]; T[51] -= a4.w * T[24]; a4 = *(const LAS f32x4*)(AB + 1640);
            asm volatile("" ::: "memory"); T[52] -= a5.x * T[24]; T[53] -= a5.y * T[24]; T[54] -= a5.z * T[24]; T[55] -= a5.w * T[24]; a5 = *(const LAS f32x4*)(AB + 1644);
            asm volatile("" ::: "memory"); T[56] -= a6.x * T[24]; T[57] -= a6.y * T[24]; T[58] -= a6.z * T[24]; T[59] -= a6.w * T[24]; a6 = *(const LAS f32x4*)(AB + 1648);
            asm volatile("" ::: "memory"); T[60] -= a7.x * T[24]; T[61] -= a7.y * T[24]; T[62] -= a7.z * T[24]; T[63] -= a7.w * T[24]; a7 = *(const LAS f32x4*)(AB + 1652);
            asm volatile("" ::: "memory"); T[26] -= a0.z * T[25]; T[27] -= a0.w * T[25]; a0 = *(const LAS f32x4*)(AB + 1656);
            asm volatile("" ::: "memory"); T[28] -= a1.x * T[25]; T[29] -= a1.y * T[25]; T[30] -= a1.z * T[25]; T[31] -= a1.w * T[25]; a1 = *(const LAS f32x4*)(AB + 1660);
            asm volatile("" ::: "memory"); T[32] -= a2.x * T[25]; T[33] -= a2.y * T[25]; T[34] -= a2.z * T[25]; T[35] -= a2.w * T[25]; a2 = *(const LAS f32x4*)(AB + 1688);
            asm volatile("" ::: "memory"); T[36] -= a3.x * T[25]; T[37] -= a3.y * T[25]; T[38] -= a3.z * T[25]; T[39] -= a3.w * T[25]; a3 = *(const LAS f32x4*)(AB + 1692);
            asm volatile("" ::: "memory"); T[40] -= a4.x * T[25]; T[41] -= a4.y * T[25]; T[42] -= a4.z * T[25]; T[43] -= a4.w * T[25]; a4 = *(const LAS f32x4*)(AB + 1696);
            asm volatile("" ::: "memory"); T[44] -= a5.x * T[25]; T[45] -= a5.y * T[25]; T[46] -= a5.z * T[25]; T[47] -= a5.w * T[25]; a5 = *(const LAS f32x4*)(AB + 1700);
            asm volatile("" ::: "memory"); T[48] -= a6.x * T[25]; T[49] -= a6.y * T[25]; T[50] -= a6.z * T[25]; T[51] -= a6.w * T[25]; a6 = *(const LAS f32x4*)(AB + 1704);
            asm volatile("" ::: "memory"); T[52] -= a7.x * T[25]; T[53] -= a7.y * T[25]; T[54] -= a7.z * T[25]; T[55] -= a7.w * T[25]; a7 = *(const LAS f32x4*)(AB + 1708);
            asm volatile("" ::: "memory"); T[56] -= a0.x * T[25]; T[57] -= a0.y * T[25]; T[58] -= a0.z * T[25]; T[59] -= a0.w * T[25]; a0 = *(const LAS f32x4*)(AB + 1712);
            asm volatile("" ::: "memory"); T[60] -= a1.x * T[25]; T[61] -= a1.y * T[25]; T[62] -= a1.z * T[25]; T[63] -= a1.w * T[25]; a1 = *(const LAS f32x4*)(AB + 1716);
            asm volatile("" ::: "memory"); T[27] -= a2.w * T[26]; a2 = *(const LAS f32x4*)(AB + 1720);
            asm volatile("" ::: "memory"); T[28] -= a3.x * T[26]; T[29] -= a3.y * T[26]; T[30] -= a3.z * T[26]; T[31] -= a3.w * T[26]; a3 = *(const LAS f32x4*)(AB + 1724);
            asm volatile("" ::: "memory"); T[32] -= a4.x * T[26]; T[33] -= a4.y * T[26]; T[34] -= a4.z * T[26]; T[35] -= a4.w * T[26]; a4 = *(const LAS f32x4*)(AB + 1756);
            asm volatile("" ::: "memory"); T[36] -= a5.x * T[26]; T[37] -= a5.y * T[26]; T[38] -= a5.z * T[26]; T[39] -= a5.w * T[26]; a5 = *(const LAS f32x4*)(AB + 1760);
            asm volatile("" ::: "memory"); T[40] -= a6.x * T[26]; T[41] -= a6.y * T[26]; T[42] -= a6.z * T[26]; T[43] -= a6.w * T[26]; a6 = *(const LAS f32x4*)(AB + 1764);
            asm volatile("" ::: "memory"); T[44] -= a7.x * T[26]; T[45] -= a7.y * T[26]; T[46] -= a7.z * T[26]; T[47] -= a7.w * T[26]; a7 = *(const LAS f32x4*)(AB + 1768);
            asm volatile("" ::: "memory"); T[48] -= a0.x * T[26]; T[49] -= a0.y * T[26]; T[50] -= a0.z * T[26]; T[51] -= a0.w * T[26]; a0 = *(const LAS f32x4*)(AB + 1772);
            asm volatile("" ::: "memory"); T[52] -= a1.x * T[26]; T[53] -= a1.y * T[26]; T[54] -= a1.z * T[26]; T[55] -= a1.w * T[26]; a1 = *(const LAS f32x4*)(AB + 1776);
            asm volatile("" ::: "memory"); T[56] -= a2.x * T[26]; T[57] -= a2.y * T[26]; T[58] -= a2.z * T[26]; T[59] -= a2.w * T[26]; a2 = *(const LAS f32x4*)(AB + 1780);
            asm volatile("" ::: "memory"); T[60] -= a3.x * T[26]; T[61] -= a3.y * T[26]; T[62] -= a3.z * T[26]; T[63] -= a3.w * T[26]; a3 = *(const LAS f32x4*)(AB + 1784);
            asm volatile("" ::: "memory"); T[28] -= a4.x * T[27]; T[29] -= a4.y * T[27]; T[30] -= a4.z * T[27]; T[31] -= a4.w * T[27]; a4 = *(const LAS f32x4*)(AB + 1788);
            asm volatile("" ::: "memory"); T[32] -= a5.x * T[27]; T[33] -= a5.y * T[27]; T[34] -= a5.z * T[27]; T[35] -= a5.w * T[27]; a5 = *(const LAS f32x4*)(AB + 1820);
            asm volatile("" ::: "memory"); T[36] -= a6.x * T[27]; T[37] -= a6.y * T[27]; T[38] -= a6.z * T[27]; T[39] -= a6.w * T[27]; a6 = *(const LAS f32x4*)(AB + 1824);
            asm volatile("" ::: "memory"); T[40] -= a7.x * T[27]; T[41] -= a7.y * T[27]; T[42] -= a7.z * T[27]; T[43] -= a7.w * T[27]; a7 = *(const LAS f32x4*)(AB + 1828);
            asm volatile("" ::: "memory"); T[44] -= a0.x * T[27]; T[45] -= a0.y * T[27]; T[46] -= a0.z * T[27]; T[47] -= a0.w * T[27]; a0 = *(const LAS f32x4*)(AB + 1832);
            asm volatile("" ::: "memory"); T[48] -= a1.x * T[27]; T[49] -= a1.y * T[27]; T[50] -= a1.z * T[27]; T[51] -= a1.w * T[27]; a1 = *(const LAS f32x4*)(AB + 1836);
            asm volatile("" ::: "memory"); T[52] -= a2.x * T[27]; T[53] -= a2.y * T[27]; T[54] -= a2.z * T[27]; T[55] -= a2.w * T[27]; a2 = *(const LAS f32x4*)(AB + 1840);
            asm volatile("" ::: "memory"); T[56] -= a3.x * T[27]; T[57] -= a3.y * T[27]; T[58] -= a3.z * T[27]; T[59] -= a3.w * T[27]; a3 = *(const LAS f32x4*)(AB + 1844);
            asm volatile("" ::: "memory"); T[60] -= a4.x * T[27]; T[61] -= a4.y * T[27]; T[62] -= a4.z * T[27]; T[63] -= a4.w * T[27]; a4 = *(const LAS f32x4*)(AB + 1848);
            asm volatile("" ::: "memory"); T[29] -= a5.y * T[28]; T[30] -= a5.z * T[28]; T[31] -= a5.w * T[28]; a5 = *(const LAS f32x4*)(AB + 1852);
            asm volatile("" ::: "memory"); T[32] -= a6.x * T[28]; T[33] -= a6.y * T[28]; T[34] -= a6.z * T[28]; T[35] -= a6.w * T[28]; a6 = *(const LAS f32x4*)(AB + 1884);
            asm volatile("" ::: "memory"); T[36] -= a7.x * T[28]; T[37] -= a7.y * T[28]; T[38] -= a7.z * T[28]; T[39] -= a7.w * T[28]; a7 = *(const LAS f32x4*)(AB + 1888);
            asm volatile("" ::: "memory"); T[40] -= a0.x * T[28]; T[41] -= a0.y * T[28]; T[42] -= a0.z * T[28]; T[43] -= a0.w * T[28]; a0 = *(const LAS f32x4*)(AB + 1892);
            asm volatile("" ::: "memory"); T[44] -= a1.x * T[28]; T[45] -= a1.y * T[28]; T[46] -= a1.z * T[28]; T[47] -= a1.w * T[28]; a1 = *(const LAS f32x4*)(AB + 1896);
            asm volatile("" ::: "memory"); T[48] -= a2.x * T[28]; T[49] -= a2.y * T[28]; T[50] -= a2.z * T[28]; T[51] -= a2.w * T[28]; a2 = *(const LAS f32x4*)(AB + 1900);
            asm volatile("" ::: "memory"); T[52] -= a3.x * T[28]; T[53] -= a3.y * T[28]; T[54] -= a3.z * T[28]; T[55] -= a3.w * T[28]; a3 = *(const LAS f32x4*)(AB + 1904);
            asm volatile("" ::: "memory"); T[56] -= a4.x * T[28]; T[57] -= a4.y * T[28]; T[58] -= a4.z * T[28]; T[59] -= a4.w * T[28]; a4 = *(const LAS f32x4*)(AB + 1908);
            asm volatile("" ::: "memory"); T[60] -= a5.x * T[28]; T[61] -= a5.y * T[28]; T[62] -= a5.z * T[28]; T[63] -= a5.w * T[28]; a5 = *(const LAS f32x4*)(AB + 1912);
            asm volatile("" ::: "memory"); T[30] -= a6.z * T[29]; T[31] -= a6.w * T[29]; a6 = *(const LAS f32x4*)(AB + 1916);
            asm volatile("" ::: "memory"); T[32] -= a7.x * T[29]; T[33] -= a7.y * T[29]; T[34] -= a7.z * T[29]; T[35] -= a7.w * T[29]; a7 = *(const LAS f32x4*)(AB + 1948);
            asm volatile("" ::: "memory"); T[36] -= a0.x * T[29]; T[37] -= a0.y * T[29]; T[38] -= a0.z * T[29]; T[39] -= a0.w * T[29]; a0 = *(const LAS f32x4*)(AB + 1952);
            asm volatile("" ::: "memory"); T[40] -= a1.x * T[29]; T[41] -= a1.y * T[29]; T[42] -= a1.z * T[29]; T[43] -= a1.w * T[29]; a1 = *(const LAS f32x4*)(AB + 1956);
            asm volatile("" ::: "memory"); T[44] -= a2.x * T[29]; T[45] -= a2.y * T[29]; T[46] -= a2.z * T[29]; T[47] -= a2.w * T[29]; a2 = *(const LAS f32x4*)(AB + 1960);
            asm volatile("" ::: "memory"); T[48] -= a3.x * T[29]; T[49] -= a3.y * T[29]; T[50] -= a3.z * T[29]; T[51] -= a3.w * T[29]; a3 = *(const LAS f32x4*)(AB + 1964);
            asm volatile("" ::: "memory"); T[52] -= a4.x * T[29]; T[53] -= a4.y * T[29]; T[54] -= a4.z * T[29]; T[55] -= a4.w * T[29]; a4 = *(const LAS f32x4*)(AB + 1968);
            asm volatile("" ::: "memory"); T[56] -= a5.x * T[29]; T[57] -= a5.y * T[29]; T[58] -= a5.z * T[29]; T[59] -= a5.w * T[29]; a5 = *(const LAS f32x4*)(AB + 1972);
            asm volatile("" ::: "memory"); T[60] -= a6.x * T[29]; T[61] -= a6.y * T[29]; T[62] -= a6.z * T[29]; T[63] -= a6.w * T[29]; a6 = *(const LAS f32x4*)(AB + 1976);
            asm volatile("" ::: "memory"); T[31] -= a7.w * T[30]; a7 = *(const LAS f32x4*)(AB + 1980);
            asm volatile("" ::: "memory"); T[32] -= a0.x * T[30]; T[33] -= a0.y * T[30]; T[34] -= a0.z * T[30]; T[35] -= a0.w * T[30]; a0 = *(const LAS f32x4*)(AB + 2016);
            asm volatile("" ::: "memory"); T[36] -= a1.x * T[30]; T[37] -= a1.y * T[30]; T[38] -= a1.z * T[30]; T[39] -= a1.w * T[30]; a1 = *(const LAS f32x4*)(AB + 2020);
            asm volatile("" ::: "memory"); T[40] -= a2.x * T[30]; T[41] -= a2.y * T[30]; T[42] -= a2.z * T[30]; T[43] -= a2.w * T[30]; a2 = *(const LAS f32x4*)(AB + 2024);
            asm volatile("" ::: "memory"); T[44] -= a3.x * T[30]; T[45] -= a3.y * T[30]; T[46] -= a3.z * T[30]; T[47] -= a3.w * T[30]; a3 = *(const LAS f32x4*)(AB + 2028);
            asm volatile("" ::: "memory"); T[48] -= a4.x * T[30]; T[49] -= a4.y * T[30]; T[50] -= a4.z * T[30]; T[51] -= a4.w * T[30]; a4 = *(const LAS f32x4*)(AB + 2032);
            asm volatile("" ::: "memory"); T[52] -= a5.x * T[30]; T[53] -= a5.y * T[30]; T[54] -= a5.z * T[30]; T[55] -= a5.w * T[30]; a5 = *(const LAS f32x4*)(AB + 2036);
            asm volatile("" ::: "memory"); T[56] -= a6.x * T[30]; T[57] -= a6.y * T[30]; T[58] -= a6.z * T[30]; T[59] -= a6.w * T[30]; a6 = *(const LAS f32x4*)(AB + 2040);
            asm volatile("" ::: "memory"); T[60] -= a7.x * T[30]; T[61] -= a7.y * T[30]; T[62] -= a7.z * T[30]; T[63] -= a7.w * T[30]; a7 = *(const LAS f32x4*)(AB + 2044);
            asm volatile("" ::: "memory"); T[32] -= a0.x * T[31]; T[33] -= a0.y * T[31]; T[34] -= a0.z * T[31]; T[35] -= a0.w * T[31]; a0 = *(const LAS f32x4*)(AB + 2080);
            asm volatile("" ::: "memory"); T[36] -= a1.x * T[31]; T[37] -= a1.y * T[31]; T[38] -= a1.z * T[31]; T[39] -= a1.w * T[31]; a1 = *(const LAS f32x4*)(AB + 2084);
            asm volatile("" ::: "memory"); T[40] -= a2.x * T[31]; T[41] -= a2.y * T[31]; T[42] -= a2.z * T[31]; T[43] -= a2.w * T[31]; a2 = *(const LAS f32x4*)(AB + 2088);
            asm volatile("" ::: "memory"); T[44] -= a3.x * T[31]; T[45] -= a3.y * T[31]; T[46] -= a3.z * T[31]; T[47] -= a3.w * T[31]; a3 = *(const LAS f32x4*)(AB + 2092);
            asm volatile("" ::: "memory"); T[48] -= a4.x * T[31]; T[49] -= a4.y * T[31]; T[50] -= a4.z * T[31]; T[51] -= a4.w * T[31]; a4 = *(const LAS f32x4*)(AB + 2096);
            asm volatile("" ::: "memory"); T[52] -= a5.x * T[31]; T[53] -= a5.y * T[31]; T[54] -= a5.z * T[31]; T[55] -= a5.w * T[31]; a5 = *(const LAS f32x4*)(AB + 2100);
            asm volatile("" ::: "memory"); T[56] -= a6.x * T[31]; T[57] -= a6.y * T[31]; T[58] -= a6.z * T[31]; T[59] -= a6.w * T[31]; a6 = *(const LAS f32x4*)(AB + 2104);
            asm volatile("" ::: "memory"); T[60] -= a7.x * T[31]; T[61] -= a7.y * T[31]; T[62] -= a7.z * T[31]; T[63] -= a7.w * T[31]; a7 = *(const LAS f32x4*)(AB + 2108);
            asm volatile("" ::: "memory"); T[33] -= a0.y * T[32]; T[34] -= a0.z * T[32]; T[35] -= a0.w * T[32]; a0 = *(const LAS f32x4*)(AB + 2144);
            asm volatile("" ::: "memory"); T[36] -= a1.x * T[32]; T[37] -= a1.y * T[32]; T[38] -= a1.z * T[32]; T[39] -= a1.w * T[32]; a1 = *(const LAS f32x4*)(AB + 2148);
            asm volatile("" ::: "memory"); T[40] -= a2.x * T[32]; T[41] -= a2.y * T[32]; T[42] -= a2.z * T[32]; T[43] -= a2.w * T[32]; a2 = *(const LAS f32x4*)(AB + 2152);
            asm volatile("" ::: "memory"); T[44] -= a3.x * T[32]; T[45] -= a3.y * T[32]; T[46] -= a3.z * T[32]; T[47] -= a3.w * T[32]; a3 = *(const LAS f32x4*)(AB + 2156);
            asm volatile("" ::: "memory"); T[48] -= a4.x * T[32]; T[49] -= a4.y * T[32]; T[50] -= a4.z * T[32]; T[51] -= a4.w * T[32]; a4 = *(const LAS f32x4*)(AB + 2160);
            asm volatile("" ::: "memory"); T[52] -= a5.x * T[32]; T[53] -= a5.y * T[32]; T[54] -= a5.z * T[32]; T[55] -= a5.w * T[32]; a5 = *(const LAS f32x4*)(AB + 2164);
            asm volatile("" ::: "memory"); T[56] -= a6.x * T[32]; T[57] -= a6.y * T[32]; T[58] -= a6.z * T[32]; T[59] -= a6.w * T[32]; a6 = *(const LAS f32x4*)(AB + 2168);
            asm volatile("" ::: "memory"); T[60] -= a7.x * T[32]; T[61] -= a7.y * T[32]; T[62] -= a7.z * T[32]; T[63] -= a7.w * T[32]; a7 = *(const LAS f32x4*)(AB + 2172);
            asm volatile("" ::: "memory"); T[34] -= a0.z * T[33]; T[35] -= a0.w * T[33]; a0 = *(const LAS f32x4*)(AB + 2208);
            asm volatile("" ::: "memory"); T[36] -= a1.x * T[33]; T[37] -= a1.y * T[33]; T[38] -= a1.z * T[33]; T[39] -= a1.w * T[33]; a1 = *(const LAS f32x4*)(AB + 2212);
            asm volatile("" ::: "memory"); T[40] -= a2.x * T[33]; T[41] -= a2.y * T[33]; T[42] -= a2.z * T[33]; T[43] -= a2.w * T[33]; a2 = *(const LAS f32x4*)(AB + 2216);
            asm volatile("" ::: "memory"); T[44] -= a3.x * T[33]; T[45] -= a3.y * T[33]; T[46] -= a3.z * T[33]; T[47] -= a3.w * T[33]; a3 = *(const LAS f32x4*)(AB + 2220);
            asm volatile("" ::: "memory"); T[48] -= a4.x * T[33]; T[49] -= a4.y * T[33]; T[50] -= a4.z * T[33]; T[51] -= a4.w * T[33]; a4 = *(const LAS f32x4*)(AB + 2224);
            asm volatile("" ::: "memory"); T[52] -= a5.x * T[33]; T[53] -= a5.y * T[33]; T[54] -= a5.z * T[33]; T[55] -= a5.w * T[33]; a5 = *(const LAS f32x4*)(AB + 2228);
            asm volatile("" ::: "memory"); T[56] -= a6.x * T[33]; T[57] -= a6.y * T[33]; T[58] -= a6.z * T[33]; T[59] -= a6.w * T[33]; a6 = *(const LAS f32x4*)(AB + 2232);
            asm volatile("" ::: "memory"); T[60] -= a7.x * T[33]; T[61] -= a7.y * T[33]; T[62] -= a7.z * T[33]; T[63] -= a7.w * T[33]; a7 = *(const LAS f32x4*)(AB + 2236);
            asm volatile("" ::: "memory"); T[35] -= a0.w * T[34]; a0 = *(const LAS f32x4*)(AB + 2276);
            asm volatile("" ::: "memory"); T[36] -= a1.x * T[34]; T[37] -= a1.y * T[34]; T[38] -= a1.z * T[34]; T[39] -= a1.w * T[34]; a1 = *(const LAS f32x4*)(AB + 2280);
            asm volatile("" ::: "memory"); T[40] -= a2.x * T[34]; T[41] -= a2.y * T[34]; T[42] -= a2.z * T[34]; T[43] -= a2.w * T[34]; a2 = *(const LAS f32x4*)(AB + 2284);
            asm volatile("" ::: "memory"); T[44] -= a3.x * T[34]; T[45] -= a3.y * T[34]; T[46] -= a3.z * T[34]; T[47] -= a3.w * T[34]; a3 = *(const LAS f32x4*)(AB + 2288);
            asm volatile("" ::: "memory"); T[48] -= a4.x * T[34]; T[49] -= a4.y * T[34]; T[50] -= a4.z * T[34]; T[51] -= a4.w * T[34]; a4 = *(const LAS f32x4*)(AB + 2292);
            asm volatile("" ::: "memory"); T[52] -= a5.x * T[34]; T[53] -= a5.y * T[34]; T[54] -= a5.z * T[34]; T[55] -= a5.w * T[34]; a5 = *(const LAS f32x4*)(AB + 2296);
            asm volatile("" ::: "memory"); T[56] -= a6.x * T[34]; T[57] -= a6.y * T[34]; T[58] -= a6.z * T[34]; T[59] -= a6.w * T[34]; a6 = *(const LAS f32x4*)(AB + 2300);
            asm volatile("" ::: "memory"); T[60] -= a7.x * T[34]; T[61] -= a7.y * T[34]; T[62] -= a7.z * T[34]; T[63] -= a7.w * T[34]; a7 = *(const LAS f32x4*)(AB + 2340);
            asm volatile("" ::: "memory"); T[36] -= a0.x * T[35]; T[37] -= a0.y * T[35]; T[38] -= a0.z * T[35]; T[39] -= a0.w * T[35]; a0 = *(const LAS f32x4*)(AB + 2344);
            asm volatile("" ::: "memory"); T[40] -= a1.x * T[35]; T[41] -= a1.y * T[35]; T[42] -= a1.z * T[35]; T[43] -= a1.w * T[35]; a1 = *(const LAS f32x4*)(AB + 2348);
            asm volatile("" ::: "memory"); T[44] -= a2.x * T[35]; T[45] -= a2.y * T[35]; T[46] -= a2.z * T[35]; T[47] -= a2.w * T[35]; a2 = *(const LAS f32x4*)(AB + 2352);
            asm volatile("" ::: "memory"); T[48] -= a3.x * T[35]; T[49] -= a3.y * T[35]; T[50] -= a3.z * T[35]; T[51] -= a3.w * T[35]; a3 = *(const LAS f32x4*)(AB + 2356);
            asm volatile("" ::: "memory"); T[52] -= a4.x * T[35]; T[53] -= a4.y * T[35]; T[54] -= a4.z * T[35]; T[55] -= a4.w * T[35]; a4 = *(const LAS f32x4*)(AB + 2360);
            asm volatile("" ::: "memory"); T[56] -= a5.x * T[35]; T[57] -= a5.y * T[35]; T[58] -= a5.z * T[35]; T[59] -= a5.w * T[35]; a5 = *(const LAS f32x4*)(AB + 2364);
            asm volatile("" ::: "memory"); T[60] -= a6.x * T[35]; T[61] -= a6.y * T[35]; T[62] -= a6.z * T[35]; T[63] -= a6.w * T[35]; a6 = *(const LAS f32x4*)(AB + 2404);
            asm volatile("" ::: "memory"); T[37] -= a7.y * T[36]; T[38] -= a7.z * T[36]; T[39] -= a7.w * T[36]; a7 = *(const LAS f32x4*)(AB + 2408);
            asm volatile("" ::: "memory"); T[40] -= a0.x * T[36]; T[41] -= a0.y * T[36]; T[42] -= a0.z * T[36]; T[43] -= a0.w * T[36]; a0 = *(const LAS f32x4*)(AB + 2412);
            asm volatile("" ::: "memory"); T[44] -= a1.x * T[36]; T[45] -= a1.y * T[36]; T[46] -= a1.z * T[36]; T[47] -= a1.w * T[36]; a1 = *(const LAS f32x4*)(AB + 2416);
            asm volatile("" ::: "memory"); T[48] -= a2.x * T[36]; T[49] -= a2.y * T[36]; T[50] -= a2.z * T[36]; T[51] -= a2.w * T[36]; a2 = *(const LAS f32x4*)(AB + 2420);
            asm volatile("" ::: "memory"); T[52] -= a3.x * T[36]; T[53] -= a3.y * T[36]; T[54] -= a3.z * T[36]; T[55] -= a3.w * T[36]; a3 = *(const LAS f32x4*)(AB + 2424);
            asm volatile("" ::: "memory"); T[56] -= a4.x * T[36]; T[57] -= a4.y * T[36]; T[58] -= a4.z * T[36]; T[59] -= a4.w * T[36]; a4 = *(const LAS f32x4*)(AB + 2428);
            asm volatile("" ::: "memory"); T[60] -= a5.x * T[36]; T[61] -= a5.y * T[36]; T[62] -= a5.z * T[36]; T[63] -= a5.w * T[36]; a5 = *(const LAS f32x4*)(AB + 2468);
            asm volatile("" ::: "memory"); T[38] -= a6.z * T[37]; T[39] -= a6.w * T[37]; a6 = *(const LAS f32x4*)(AB + 2472);
            asm volatile("" ::: "memory"); T[40] -= a7.x * T[37]; T[41] -= a7.y * T[37]; T[42] -= a7.z * T[37]; T[43] -= a7.w * T[37]; a7 = *(const LAS f32x4*)(AB + 2476);
            asm volatile("" ::: "memory"); T[44] -= a0.x * T[37]; T[45] -= a0.y * T[37]; T[46] -= a0.z * T[37]; T[47] -= a0.w * T[37]; a0 = *(const LAS f32x4*)(AB + 2480);
            asm volatile("" ::: "memory"); T[48] -= a1.x * T[37]; T[49] -= a1.y * T[37]; T[50] -= a1.z * T[37]; T[51] -= a1.w * T[37]; a1 = *(const LAS f32x4*)(AB + 2484);
            asm volatile("" ::: "memory"); T[52] -= a2.x * T[37]; T[53] -= a2.y * T[37]; T[54] -= a2.z * T[37]; T[55] -= a2.w * T[37]; a2 = *(const LAS f32x4*)(AB + 2488);
            asm volatile("" ::: "memory"); T[56] -= a3.x * T[37]; T[57] -= a3.y * T[37]; T[58] -= a3.z * T[37]; T[59] -= a3.w * T[37]; a3 = *(const LAS f32x4*)(AB + 2492);
            asm volatile("" ::: "memory"); T[60] -= a4.x * T[37]; T[61] -= a4.y * T[37]; T[62] -= a4.z * T[37]; T[63] -= a4.w * T[37]; a4 = *(const LAS f32x4*)(AB + 2536);
            asm volatile("" ::: "memory"); T[39] -= a5.w * T[38]; a5 = *(const LAS f32x4*)(AB + 2540);
            asm volatile("" ::: "memory"); T[40] -= a6.x * T[38]; T[41] -= a6.y * T[38]; T[42] -= a6.z * T[38]; T[43] -= a6.w * T[38]; a6 = *(const LAS f32x4*)(AB + 2544);
            asm volatile("" ::: "memory"); T[44] -= a7.x * T[38]; T[45] -= a7.y * T[38]; T[46] -= a7.z * T[38]; T[47] -= a7.w * T[38]; a7 = *(const LAS f32x4*)(AB + 2548);
            asm volatile("" ::: "memory"); T[48] -= a0.x * T[38]; T[49] -= a0.y * T[38]; T[50] -= a0.z * T[38]; T[51] -= a0.w * T[38]; a0 = *(const LAS f32x4*)(AB + 2552);
            asm volatile("" ::: "memory"); T[52] -= a1.x * T[38]; T[53] -= a1.y * T[38]; T[54] -= a1.z * T[38]; T[55] -= a1.w * T[38]; a1 = *(const LAS f32x4*)(AB + 2556);
            asm volatile("" ::: "memory"); T[56] -= a2.x * T[38]; T[57] -= a2.y * T[38]; T[58] -= a2.z * T[38]; T[59] -= a2.w * T[38]; a2 = *(const LAS f32x4*)(AB + 2600);
            asm volatile("" ::: "memory"); T[60] -= a3.x * T[38]; T[61] -= a3.y * T[38]; T[62] -= a3.z * T[38]; T[63] -= a3.w * T[38]; a3 = *(const LAS f32x4*)(AB + 2604);
            asm volatile("" ::: "memory"); T[40] -= a4.x * T[39]; T[41] -= a4.y * T[39]; T[42] -= a4.z * T[39]; T[43] -= a4.w * T[39]; a4 = *(const LAS f32x4*)(AB + 2608);
            asm volatile("" ::: "memory"); T[44] -= a5.x * T[39]; T[45] -= a5.y * T[39]; T[46] -= a5.z * T[39]; T[47] -= a5.w * T[39]; a5 = *(const LAS f32x4*)(AB + 2612);
            asm volatile("" ::: "memory"); T[48] -= a6.x * T[39]; T[49] -= a6.y * T[39]; T[50] -= a6.z * T[39]; T[51] -= a6.w * T[39]; a6 = *(const LAS f32x4*)(AB + 2616);
            asm volatile("" ::: "memory"); T[52] -= a7.x * T[39]; T[53] -= a7.y * T[39]; T[54] -= a7.z * T[39]; T[55] -= a7.w * T[39]; a7 = *(const LAS f32x4*)(AB + 2620);
            asm volatile("" ::: "memory"); T[56] -= a0.x * T[39]; T[57] -= a0.y * T[39]; T[58] -= a0.z * T[39]; T[59] -= a0.w * T[39]; a0 = *(const LAS f32x4*)(AB + 2664);
            asm volatile("" ::: "memory"); T[60] -= a1.x * T[39]; T[61] -= a1.y * T[39]; T[62] -= a1.z * T[39]; T[63] -= a1.w * T[39]; a1 = *(const LAS f32x4*)(AB + 2668);
            asm volatile("" ::: "memory"); T[41] -= a2.y * T[40]; T[42] -= a2.z * T[40]; T[43] -= a2.w * T[40]; a2 = *(const LAS f32x4*)(AB + 2672);
            asm volatile("" ::: "memory"); T[44] -= a3.x * T[40]; T[45] -= a3.y * T[40]; T[46] -= a3.z * T[40]; T[47] -= a3.w * T[40]; a3 = *(const LAS f32x4*)(AB + 2676);
            asm volatile("" ::: "memory"); T[48] -= a4.x * T[40]; T[49] -= a4.y * T[40]; T[50] -= a4.z * T[40]; T[51] -= a4.w * T[40]; a4 = *(const LAS f32x4*)(AB + 2680);
            asm volatile("" ::: "memory"); T[52] -= a5.x * T[40]; T[53] -= a5.y * T[40]; T[54] -= a5.z * T[40]; T[55] -= a5.w * T[40]; a5 = *(const LAS f32x4*)(AB + 2684);
            asm volatile("" ::: "memory"); T[56] -= a6.x * T[40]; T[57] -= a6.y * T[40]; T[58] -= a6.z * T[40]; T[59] -= a6.w * T[40]; a6 = *(const LAS f32x4*)(AB + 2728);
            asm volatile("" ::: "memory"); T[60] -= a7.x * T[40]; T[61] -= a7.y * T[40]; T[62] -= a7.z * T[40]; T[63] -= a7.w * T[40]; a7 = *(const LAS f32x4*)(AB + 2732);
            asm volatile("" ::: "memory"); T[42] -= a0.z * T[41]; T[43] -= a0.w * T[41]; a0 = *(const LAS f32x4*)(AB + 2736);
            asm volatile("" ::: "memory"); T[44] -= a1.x * T[41]; T[45] -= a1.y * T[41]; T[46] -= a1.z * T[41]; T[47] -= a1.w * T[41]; a1 = *(const LAS f32x4*)(AB + 2740);
            asm volatile("" ::: "memory"); T[48] -= a2.x * T[41]; T[49] -= a2.y * T[41]; T[50] -= a2.z * T[41]; T[51] -= a2.w * T[41]; a2 = *(const LAS f32x4*)(AB + 2744);
            asm volatile("" ::: "memory"); T[52] -= a3.x * T[41]; T[53] -= a3.y * T[41]; T[54] -= a3.z * T[41]; T[55] -= a3.w * T[41]; a3 = *(const LAS f32x4*)(AB + 2748);
            asm volatile("" ::: "memory"); T[56] -= a4.x * T[41]; T[57] -= a4.y * T[41]; T[58] -= a4.z * T[41]; T[59] -= a4.w * T[41]; a4 = *(const LAS f32x4*)(AB + 2796);
            asm volatile("" ::: "memory"); T[60] -= a5.x * T[41]; T[61] -= a5.y * T[41]; T[62] -= a5.z * T[41]; T[63] -= a5.w * T[41]; a5 = *(const LAS f32x4*)(AB + 2800);
            asm volatile("" ::: "memory"); T[43] -= a6.w * T[42]; a6 = *(const LAS f32x4*)(AB + 2804);
            asm volatile("" ::: "memory"); T[44] -= a7.x * T[42]; T[45] -= a7.y * T[42]; T[46] -= a7.z * T[42]; T[47] -= a7.w * T[42]; a7 = *(const LAS f32x4*)(AB + 2808);
            asm volatile("" ::: "memory"); T[48] -= a0.x * T[42]; T[49] -= a0.y * T[42]; T[50] -= a0.z * T[42]; T[51] -= a0.w * T[42]; a0 = *(const LAS f32x4*)(AB + 2812);
            asm volatile("" ::: "memory"); T[52] -= a1.x * T[42]; T[53] -= a1.y * T[42]; T[54] -= a1.z * T[42]; T[55] -= a1.w * T[42]; a1 = *(const LAS f32x4*)(AB + 2860);
            asm volatile("" ::: "memory"); T[56] -= a2.x * T[42]; T[57] -= a2.y * T[42]; T[58] -= a2.z * T[42]; T[59] -= a2.w * T[42]; a2 = *(const LAS f32x4*)(AB + 2864);
            asm volatile("" ::: "memory"); T[60] -= a3.x * T[42]; T[61] -= a3.y * T[42]; T[62] -= a3.z * T[42]; T[63] -= a3.w * T[42]; a3 = *(const LAS f32x4*)(AB + 2868);
            asm volatile("" ::: "memory"); T[44] -= a4.x * T[43]; T[45] -= a4.y * T[43]; T[46] -= a4.z * T[43]; T[47] -= a4.w * T[43]; a4 = *(const LAS f32x4*)(AB + 2872);
            asm volatile("" ::: "memory"); T[48] -= a5.x * T[43]; T[49] -= a5.y * T[43]; T[50] -= a5.z * T[43]; T[51] -= a5.w * T[43]; a5 = *(const LAS f32x4*)(AB + 2876);
            asm volatile("" ::: "memory"); T[52] -= a6.x * T[43]; T[53] -= a6.y * T[43]; T[54] -= a6.z * T[43]; T[55] -= a6.w * T[43]; a6 = *(const LAS f32x4*)(AB + 2924);
            asm volatile("" ::: "memory"); T[56] -= a7.x * T[43]; T[57] -= a7.y * T[43]; T[58] -= a7.z * T[43]; T[59] -= a7.w * T[43]; a7 = *(const LAS f32x4*)(AB + 2928);
            asm volatile("" ::: "memory"); T[60] -= a0.x * T[43]; T[61] -= a0.y * T[43]; T[62] -= a0.z * T[43]; T[63] -= a0.w * T[43]; a0 = *(const LAS f32x4*)(AB + 2932);
            asm volatile("" ::: "memory"); T[45] -= a1.y * T[44]; T[46] -= a1.z * T[44]; T[47] -= a1.w * T[44]; a1 = *(const LAS f32x4*)(AB + 2936);
            asm volatile("" ::: "memory"); T[48] -= a2.x * T[44]; T[49] -= a2.y * T[44]; T[50] -= a2.z * T[44]; T[51] -= a2.w * T[44]; a2 = *(const LAS f32x4*)(AB + 2940);
            asm volatile("" ::: "memory"); T[52] -= a3.x * T[44]; T[53] -= a3.y * T[44]; T[54] -= a3.z * T[44]; T[55] -= a3.w * T[44]; a3 = *(const LAS f32x4*)(AB + 2988);
            asm volatile("" ::: "memory"); T[56] -= a4.x * T[44]; T[57] -= a4.y * T[44]; T[58] -= a4.z * T[44]; T[59] -= a4.w * T[44]; a4 = *(const LAS f32x4*)(AB + 2992);
            asm volatile("" ::: "memory"); T[60] -= a5.x * T[44]; T[61] -= a5.y * T[44]; T[62] -= a5.z * T[44]; T[63] -= a5.w * T[44]; a5 = *(const LAS f32x4*)(AB + 2996);
            asm volatile("" ::: "memory"); T[46] -= a6.z * T[45]; T[47] -= a6.w * T[45]; a6 = *(const LAS f32x4*)(AB + 3000);
            asm volatile("" ::: "memory"); T[48] -= a7.x * T[45]; T[49] -= a7.y * T[45]; T[50] -= a7.z * T[45]; T[51] -= a7.w * T[45]; a7 = *(const LAS f32x4*)(AB + 3004);
            asm volatile("" ::: "memory"); T[52] -= a0.x * T[45]; T[53] -= a0.y * T[45]; T[54] -= a0.z * T[45]; T[55] -= a0.w * T[45]; a0 = *(const LAS f32x4*)(AB + 3056);
            asm volatile("" ::: "memory"); T[56] -= a1.x * T[45]; T[57] -= a1.y * T[45]; T[58] -= a1.z * T[45]; T[59] -= a1.w * T[45]; a1 = *(const LAS f32x4*)(AB + 3060);
            asm volatile("" ::: "memory"); T[60] -= a2.x * T[45]; T[61] -= a2.y * T[45]; T[62] -= a2.z * T[45]; T[63] -= a2.w * T[45]; a2 = *(const LAS f32x4*)(AB + 3064);
            asm volatile("" ::: "memory"); T[47] -= a3.w * T[46]; a3 = *(const LAS f32x4*)(AB + 3068);
            asm volatile("" ::: "memory"); T[48] -= a4.x * T[46]; T[49] -= a4.y * T[46]; T[50] -= a4.z * T[46]; T[51] -= a4.w * T[46]; a4 = *(const LAS f32x4*)(AB + 3120);
            asm volatile("" ::: "memory"); T[52] -= a5.x * T[46]; T[53] -= a5.y * T[46]; T[54] -= a5.z * T[46]; T[55] -= a5.w * T[46]; a5 = *(const LAS f32x4*)(AB + 3124);
            asm volatile("" ::: "memory"); T[56] -= a6.x * T[46]; T[57] -= a6.y * T[46]; T[58] -= a6.z * T[46]; T[59] -= a6.w * T[46]; a6 = *(const LAS f32x4*)(AB + 3128);
            asm volatile("" ::: "memory"); T[60] -= a7.x * T[46]; T[61] -= a7.y * T[46]; T[62] -= a7.z * T[46]; T[63] -= a7.w * T[46]; a7 = *(const LAS f32x4*)(AB + 3132);
            asm volatile("" ::: "memory"); T[48] -= a0.x * T[47]; T[49] -= a0.y * T[47]; T[50] -= a0.z * T[47]; T[51] -= a0.w * T[47]; a0 = *(const LAS f32x4*)(AB + 3184);
            asm volatile("" ::: "memory"); T[52] -= a1.x * T[47]; T[53] -= a1.y * T[47]; T[54] -= a1.z * T[47]; T[55] -= a1.w * T[47]; a1 = *(const LAS f32x4*)(AB + 3188);
            asm volatile("" ::: "memory"); T[56] -= a2.x * T[47]; T[57] -= a2.y * T[47]; T[58] -= a2.z * T[47]; T[59] -= a2.w * T[47]; a2 = *(const LAS f32x4*)(AB + 3192);
            asm volatile("" ::: "memory"); T[60] -= a3.x * T[47]; T[61] -= a3.y * T[47]; T[62] -= a3.z * T[47]; T[63] -= a3.w * T[47]; a3 = *(const LAS f32x4*)(AB + 3196);
            asm volatile("" ::: "memory"); T[49] -= a4.y * T[48]; T[50] -= a4.z * T[48]; T[51] -= a4.w * T[48]; a4 = *(const LAS f32x4*)(AB + 3248);
            asm volatile("" ::: "memory"); T[52] -= a5.x * T[48]; T[53] -= a5.y * T[48]; T[54] -= a5.z * T[48]; T[55] -= a5.w * T[48]; a5 = *(const LAS f32x4*)(AB + 3252);
            asm volatile("" ::: "memory"); T[56] -= a6.x * T[48]; T[57] -= a6.y * T[48]; T[58] -= a6.z * T[48]; T[59] -= a6.w * T[48]; a6 = *(const LAS f32x4*)(AB + 3256);
            asm volatile("" ::: "memory"); T[60] -= a7.x * T[48]; T[61] -= a7.y * T[48]; T[62] -= a7.z * T[48]; T[63] -= a7.w * T[48]; a7 = *(const LAS f32x4*)(AB + 3260);
            asm volatile("" ::: "memory"); T[50] -= a0.z * T[49]; T[51] -= a0.w * T[49]; a0 = *(const LAS f32x4*)(AB + 3316);
            asm volatile("" ::: "memory"); T[52] -= a1.x * T[49]; T[53] -= a1.y * T[49]; T[54] -= a1.z * T[49]; T[55] -= a1.w * T[49]; a1 = *(const LAS f32x4*)(AB + 3320);
            asm volatile("" ::: "memory"); T[56] -= a2.x * T[49]; T[57] -= a2.y * T[49]; T[58] -= a2.z * T[49]; T[59] -= a2.w * T[49]; a2 = *(const LAS f32x4*)(AB + 3324);
            asm volatile("" ::: "memory"); T[60] -= a3.x * T[49]; T[61] -= a3.y * T[49]; T[62] -= a3.z * T[49]; T[63] -= a3.w * T[49]; a3 = *(const LAS f32x4*)(AB + 3380);
            asm volatile("" ::: "memory"); T[51] -= a4.w * T[50]; a4 = *(const LAS f32x4*)(AB + 3384);
            asm volatile("" ::: "memory"); T[52] -= a5.x * T[50]; T[53] -= a5.y * T[50]; T[54] -= a5.z * T[50]; T[55] -= a5.w * T[50]; a5 = *(const LAS f32x4*)(AB + 3388);
            asm volatile("" ::: "memory"); T[56] -= a6.x * T[50]; T[57] -= a6.y * T[50]; T[58] -= a6.z * T[50]; T[59] -= a6.w * T[50]; a6 = *(const LAS f32x4*)(AB + 3444);
            asm volatile("" ::: "memory"); T[60] -= a7.x * T[50]; T[61] -= a7.y * T[50]; T[62] -= a7.z * T[50]; T[63] -= a7.w * T[50]; a7 = *(const LAS f32x4*)(AB + 3448);
            asm volatile("" ::: "memory"); T[52] -= a0.x * T[51]; T[53] -= a0.y * T[51]; T[54] -= a0.z * T[51]; T[55] -= a0.w * T[51]; a0 = *(const LAS f32x4*)(AB + 3452);
            asm volatile("" ::: "memory"); T[56] -= a1.x * T[51]; T[57] -= a1.y * T[51]; T[58] -= a1.z * T[51]; T[59] -= a1.w * T[51]; a1 = *(const LAS f32x4*)(AB + 3508);
            asm volatile("" ::: "memory"); T[60] -= a2.x * T[51]; T[61] -= a2.y * T[51]; T[62] -= a2.z * T[51]; T[63] -= a2.w * T[51]; a2 = *(const LAS f32x4*)(AB + 3512);
            asm volatile("" ::: "memory"); T[53] -= a3.y * T[52]; T[54] -= a3.z * T[52]; T[55] -= a3.w * T[52]; a3 = *(const LAS f32x4*)(AB + 3516);
            asm volatile("" ::: "memory"); T[56] -= a4.x * T[52]; T[57] -= a4.y * T[52]; T[58] -= a4.z * T[52]; T[59] -= a4.w * T[52]; a4 = *(const LAS f32x4*)(AB + 3576);
            asm volatile("" ::: "memory"); T[60] -= a5.x * T[52]; T[61] -= a5.y * T[52]; T[62] -= a5.z * T[52]; T[63] -= a5.w * T[52]; a5 = *(const LAS f32x4*)(AB + 3580);
            asm volatile("" ::: "memory"); T[54] -= a6.z * T[53]; T[55] -= a6.w * T[53]; a6 = *(const LAS f32x4*)(AB + 3640);
            asm volatile("" ::: "memory"); T[56] -= a7.x * T[53]; T[57] -= a7.y * T[53]; T[58] -= a7.z * T[53]; T[59] -= a7.w * T[53]; a7 = *(const LAS f32x4*)(AB + 3644);
            asm volatile("" ::: "memory"); T[60] -= a0.x * T[53]; T[61] -= a0.y * T[53]; T[62] -= a0.z * T[53]; T[63] -= a0.w * T[53]; a0 = *(const LAS f32x4*)(AB + 3704);
            asm volatile("" ::: "memory"); T[55] -= a1.w * T[54]; a1 = *(const LAS f32x4*)(AB + 3708);
            asm volatile("" ::: "memory"); T[56] -= a2.x * T[54]; T[57] -= a2.y * T[54]; T[58] -= a2.z * T[54]; T[59] -= a2.w * T[54]; a2 = *(const LAS f32x4*)(AB + 3768);
            asm volatile("" ::: "memory"); T[60] -= a3.x * T[54]; T[61] -= a3.y * T[54]; T[62] -= a3.z * T[54]; T[63] -= a3.w * T[54]; a3 = *(const LAS f32x4*)(AB + 3772);
            asm volatile("" ::: "memory"); T[56] -= a4.x * T[55]; T[57] -= a4.y * T[55]; T[58] -= a4.z * T[55]; T[59] -= a4.w * T[55]; a4 = *(const LAS f32x4*)(AB + 3836);
            asm volatile("" ::: "memory"); T[60] -= a5.x * T[55]; T[61] -= a5.y * T[55]; T[62] -= a5.z * T[55]; T[63] -= a5.w * T[55]; a5 = *(const LAS f32x4*)(AB + 3900);
            asm volatile("" ::: "memory"); T[57] -= a6.y * T[56]; T[58] -= a6.z * T[56]; T[59] -= a6.w * T[56]; a6 = *(const LAS f32x4*)(AB + 3964);
            asm volatile("" ::: "memory"); T[60] -= a7.x * T[56]; T[61] -= a7.y * T[56]; T[62] -= a7.z * T[56]; T[63] -= a7.w * T[56]; a7 = *(const LAS f32x4*)(AB + 4028);
            asm volatile("" ::: "memory"); T[58] -= a0.z * T[57]; T[59] -= a0.w * T[57];
            asm volatile("" ::: "memory"); T[60] -= a1.x * T[57]; T[61] -= a1.y * T[57]; T[62] -= a1.z * T[57]; T[63] -= a1.w * T[57];
            asm volatile("" ::: "memory"); T[59] -= a2.w * T[58];
            asm volatile("" ::: "memory"); T[60] -= a3.x * T[58]; T[61] -= a3.y * T[58]; T[62] -= a3.z * T[58]; T[63] -= a3.w * T[58];
            asm volatile("" ::: "memory"); T[60] -= a4.x * T[59]; T[61] -= a4.y * T[59]; T[62] -= a4.z * T[59]; T[63] -= a4.w * T[59];
            asm volatile("" ::: "memory"); T[61] -= a5.y * T[60]; T[62] -= a5.z * T[60]; T[63] -= a5.w * T[60];
            asm volatile("" ::: "memory"); T[62] -= a6.z * T[61]; T[63] -= a6.w * T[61];
            asm volatile("" ::: "memory"); T[63] -= a7.w * T[62];
#pragma unroll
            for (int i = 0; i < 64; ++i) *(LAS unsigned short*)(L + PL_TB + i * TP + 2 * lane) = (unsigned short)f2bf(T[i]);
        }
        __syncthreads();
        { const int kt = w >> 1, ct = w & 1;
          f32x16 aw, au;
#pragma unroll
          for (int r = 0; r < 16; ++r) { aw[r] = 0.f; au[r] = 0.f; }
          const LAS unsigned char* kp = L + PL_KBGT + (32 * kt + l31) * TP + hh * 16; const LAS unsigned char* tp = L + PL_TB + (32 * ct + l31) * TP + hh * 16;
          const LAS unsigned char* vp = L + PL_VBT + (32 * kt + l31) * TP + hh * 16;
#pragma unroll
          for (int s = 0; s < 4; ++s) { const bf16x8 tf = *(const LAS bf16x8*)(tp + 32 * s);
              aw = MFMA32(*(const LAS bf16x8*)(kp + 32 * s), tf, aw);
              au = MFMA32(tf, *(const LAS bf16x8*)(vp + 32 * s), au); }
          { const int c = 32 * ct + l31;
#pragma unroll
            for (int g = 0; g < 4; ++g) { const int chunk = 4 * kt + 2 * (g >> 1) + hh; u32x2 o; o.x = cvtpk(aw[4 * g], aw[4 * g + 1]); o.y = cvtpk(aw[4 * g + 2], aw[4 * g + 3]);
                *(u32x2*)(Wimg + c * 256 + ((chunk ^ (c & 15)) << 4) + 8 * (g & 1)) = o; } }
          { const int dv = 32 * kt + l31;
#pragma unroll
            for (int g = 0; g < 4; ++g) { u32x2 o; o.x = cvtpk(au[4 * g], au[4 * g + 1]); o.y = cvtpk(au[4 * g + 2], au[4 * g + 3]);
                *(u32x2*)(UT + dv * 128 + (32 * ct + 8 * g + 4 * hh) * 2) = o; } } }
        __syncthreads();
    }
}

constexpr int SC_BUF = 57344, SC_OBUF = 2 * SC_BUF, SC_OB = 16384;
__device__ __forceinline__ void gdn_scan_phase(Frame& F) {
    const bf16* P = (const bf16*)(F.ws + WS_P); bf16* MIX = (bf16*)(F.ws + WS_MIXIN); const float* nw = F.in[13]; const float* CD = (const float*)(F.ws + WS_CD);
    const int lane = F.lane, l31 = lane & 31, hh = lane >> 5;
    LAS unsigned char* L = F.lds + RING_OFF;
    for (int item = blockIdx.x; item < BATCH * NH; item += F.G) {
        const int b = item >> 2, h = item & 3; const size_t ci0 = (size_t)item * 32;
        const unsigned char* Wg = F.ws + WS_WIMG + ci0 * 16384; const unsigned char* Qg = F.ws + WS_QIMG + ci0 * 16384; const unsigned char* Kg = F.ws + WS_KTIMG + ci0 * 16384;
        const unsigned char* QKg = F.ws + WS_QKIMG + ci0 * 8192; const unsigned char* Ug = F.ws + WS_UT + ci0 * 16384;
        const bool comp = F.wave < 4; const int w = F.wave & 3;
#define SC_LOAD(chunk, bufi) do { _Pragma("unroll") for (int p_ = 0; p_ < 14; ++p_) { const int piece = w * 14 + p_; \
            const unsigned char* src = piece < 16 ? Wg + (size_t)(chunk) * 16384 + piece * 1024 : piece < 32 ? Qg + (size_t)(chunk) * 16384 + (piece - 16) * 1024 : \
                                       piece < 48 ? Kg + (size_t)(chunk) * 16384 + (piece - 32) * 1024 : QKg + (size_t)(chunk) * 8192 + (piece - 48) * 1024; \
            __builtin_amdgcn_global_load_lds((const unsigned*)(src + lane * 16), (LAS unsigned*)(L + (bufi) * SC_BUF + piece * 1024), 16, 0, 0); } } while (0)
#define SC_FINAL(chunk) do { const LAS unsigned char* ob_ = L + SC_OBUF + ((chunk) & 1) * SC_OB; const int mb_ = b * SEQ + (chunk) * CL; const f32x2 n2_ = *(const f32x2*)(nw + 2 * lane); \
            _Pragma("unroll 4") for (int r_ = 0; r_ < 16; ++r_) { const int tok_ = 16 * w + r_; const unsigned ov_ = *(const LAS unsigned*)(ob_ + tok_ * 256 + 4 * lane); const float o0_ = bf_lo(ov_), o1_ = bf_hi(ov_); \
                const float rr_ = 1.0f / sqrtf(wave_sum(o0_ * o0_ + o1_ * o1_) * (1.f / HD) + EPS); const unsigned z2_ = *(const unsigned*)(P + (size_t)(mb_ + tok_) * NIN_G + PC_Z + h * HD + 2 * lane); \
                *(unsigned*)(MIX + (size_t)(mb_ + tok_) * D + GW + h * HD + 2 * lane) = cvtpk(o0_ * rr_ * n2_.x * siluf_(bf_lo(z2_)), o1_ * rr_ * n2_.y * siluf_(bf_hi(z2_))); } } while (0)
        f32x16 S[4];
#pragma unroll
        for (int kt = 0; kt < 4; ++kt)
#pragma unroll
            for (int r = 0; r < 16; ++r) S[kt][r] = 0.f;
        u32x2 ucur[8];
        const unsigned char* up = Ug + (32 * w + l31) * 128 + 8 * hh;
        if (comp) {
#pragma unroll
            for (int q = 0; q < 8; ++q) ucur[q] = *(const u32x2*)(up + (32 * (q >> 2) + 8 * (q & 3)) * 2);
        } else { SC_LOAD(0, 0); }
        asm volatile("s_waitcnt vmcnt(0)" ::: "memory");
        __syncthreads();
        for (int i = 0; i < SEQ / CL; ++i) {
            if (comp) {
                const LAS unsigned char* B = L + (i & 1) * SC_BUF;
                u32x2 unx[8];
                { const unsigned char* upn = up + (size_t)((i + 1 < SEQ / CL) ? i + 1 : i) * 16384;
#pragma unroll
                  for (int q = 0; q < 8; ++q) unx[q] = *(const u32x2*)(upn + (32 * (q >> 2) + 8 * (q & 3)) * 2); }
                const float cd = CD[ci0 + i];
                bf16x8 Sb[4][2];
#pragma unroll
                for (int kt = 0; kt < 4; ++kt)
#pragma unroll
                    for (int s = 0; s < 2; ++s) Sb[kt][s] = pack8(S[kt][8 * s], S[kt][8 * s + 1], S[kt][8 * s + 2], S[kt][8 * s + 3], S[kt][8 * s + 4], S[kt][8 * s + 5], S[kt][8 * s + 6], S[kt][8 * s + 7]);
                f32x16 VN[2], O[2];
#pragma unroll
                for (int tt = 0; tt < 2; ++tt)
#pragma unroll
                    for (int g = 0; g < 4; ++g) { const u32x2 u = ucur[tt * 4 + g]; VN[tt][4 * g] = bf_lo(u.x); VN[tt][4 * g + 1] = bf_hi(u.x); VN[tt][4 * g + 2] = bf_lo(u.y); VN[tt][4 * g + 3] = bf_hi(u.y);
                        O[tt][4 * g] = 0.f; O[tt][4 * g + 1] = 0.f; O[tt][4 * g + 2] = 0.f; O[tt][4 * g + 3] = 0.f; }
#pragma unroll
                for (int tt = 0; tt < 2; ++tt) { const int row = 32 * tt + l31; const LAS unsigned char* wp = B + row * 256; const LAS unsigned char* qp = B + 16384 + row * 256;
#pragma unroll
                    for (int kt = 0; kt < 4; ++kt)
#pragma unroll
                        for (int s = 0; s < 2; ++s) { const int co = ((4 * kt + 2 * s + hh) ^ (row & 15)) << 4;
                            VN[tt] = MFMA32(*(const LAS bf16x8*)(wp + co), Sb[kt][s], VN[tt]); O[tt] = MFMA32(*(const LAS bf16x8*)(qp + co), Sb[kt][s], O[tt]); } }
                bf16x8 Vb[2][2];
#pragma unroll
                for (int tt = 0; tt < 2; ++tt)
#pragma unroll
                    for (int s = 0; s < 2; ++s) Vb[tt][s] = pack8(VN[tt][8 * s], VN[tt][8 * s + 1], VN[tt][8 * s + 2], VN[tt][8 * s + 3], VN[tt][8 * s + 4], VN[tt][8 * s + 5], VN[tt][8 * s + 6], VN[tt][8 * s + 7]);
#pragma unroll
                for (int ct = 0; ct < 2; ++ct) { const int c = 32 * ct + l31; const LAS unsigned char* qkp = B + 49152 + c * 128; const int sw = (c >> 1) & 7;
#pragma unroll
                    for (int tt = 0; tt < 2; ++tt)
#pragma unroll
                        for (int s = 0; s < 2; ++s) O[ct] = MFMA32(*(const LAS bf16x8*)(qkp + (((4 * tt + 2 * s + hh) ^ sw) << 4)), Vb[tt][s], O[ct]); }
#pragma unroll
                for (int kt = 0; kt < 4; ++kt) { const int dk = 32 * kt + l31; const LAS unsigned char* kp = B + 32768 + dk * 128; const int sw = (dk >> 1) & 7;
#pragma unroll
                    for (int r = 0; r < 16; ++r) S[kt][r] *= cd;
#pragma unroll
                    for (int tt = 0; tt < 2; ++tt)
#pragma unroll
                        for (int s = 0; s < 2; ++s) S[kt] = MFMA32(*(const LAS bf16x8*)(kp + (((4 * tt + 2 * s + hh) ^ sw) << 4)), Vb[tt][s], S[kt]); }
                { LAS unsigned char* ob = L + SC_OBUF + (i & 1) * SC_OB + (32 * w + l31) * 2;
#pragma unroll
                  for (int tt = 0; tt < 2; ++tt)
#pragma unroll
                      for (int r = 0; r < 16; ++r) { const int tok = 32 * tt + (r & 3) + 8 * (r >> 2) + 4 * hh; *(LAS unsigned short*)(ob + tok * 256) = (unsigned short)(cvtpk(O[tt][r], 0.f) & 0xffffu); } }
#pragma unroll
                for (int q = 0; q < 8; ++q) ucur[q] = unx[q];
            } else {
                if (i + 1 < SEQ / CL) SC_LOAD(i + 1, (i + 1) & 1);
                if (i >= 1) SC_FINAL(i - 1);
            }
            asm volatile("s_waitcnt vmcnt(0)" ::: "memory");
            __syncthreads();
        }
        if (!comp) SC_FINAL(SEQ / CL - 1);
        asm volatile("s_waitcnt vmcnt(0)" ::: "memory");
        __syncthreads();
#undef SC_LOAD
#undef SC_FINAL
    }
}
struct Args { const float* in[19]; float* out; unsigned char* ws; int ph_lo, ph_hi; };
__global__ void __launch_bounds__(NWAVES * 64, 2) fwd_kernel(Args args) {
    extern __shared__ __attribute__((aligned(16))) unsigned char lds[];
    Frame F;
    F.lds = (LAS unsigned char*)lds;
    F.MISC = (volatile LAS unsigned*)(F.lds + MISC_OFF);
    F.tid = threadIdx.x; F.lane = F.tid & 63; F.wave = __builtin_amdgcn_readfirstlane(F.tid >> 6);
    F.G = gridDim.x; { const int bx = blockIdx.x; F.vcu = (F.G % 8 == 0) ? (bx % 8) * (F.G / 8) + bx / 8 : bx; }
#pragma unroll
    for (int i = 0; i < 19; ++i) F.in[i] = args.in[i];
    F.out = args.out; F.ws = args.ws;
    F.ctl = (gu32*)(F.ws + WS_CTL);
    for (int u = F.tid; u < (LDS_BYTES - LDSCTL_OFF) / 4; u += NWAVES * 64) ((LAS unsigned*)(F.lds + LDSCTL_OFF))[u] = 0u;
    __syncthreads();
    XcdBarrier bar; bar.bar = (unsigned*)(F.ctl + CW_BAR); bar.x = 0; bar.st = nullptr;
    if (MK_ONE_LAUNCH) bar = xcd_barrier_post((unsigned*)(F.ctl + CW_BAR), F.MISC + 8);
#define GRID_BAR() do { if (MK_ONE_LAUNCH) xcd_barrier(bar); } while (0)
    const int lo = args.ph_lo, hi = args.ph_hi;
#define IN(k) (lo <= (k) && (k) < hi)
#define BOTH(k) (IN(k) && IN((k) + 1))
    float* MOD = (float*)(F.ws + WS_MOD);
    bf16* XN = (bf16*)(F.ws + WS_XN); bf16* Pb = (bf16*)(F.ws + WS_P); bf16* MIX = (bf16*)(F.ws + WS_MIXIN); bf16* HID = (bf16*)(F.ws + WS_HID);

    if (IN(0)) { p0_prologue(F); if (BOTH(0)) GRID_BAR(); }
    if (IN(1)) { norm_mod_phase<true>(F, F.in[0], F.in[4], MOD + 0 * D, MOD + 1 * D, XN); if (BOTH(1)) GRID_BAR(); }
    if (IN(2)) {
        pg8::Gemm g{XN, (const bf16*)(F.ws + WS_WIN), M, NIN_G, D}; pg8::StaticOrder S; S.init(M, NIN_G, F.G, (int)blockIdx.x);
        pg8::EpiBf16<0> E{Pb, NIN_G, nullptr, 0, 0, 1.f};
        pg8::gemm_phase<pg8::EpiBf16<0>, pg8::StaticOrder, PG8_ALIGN, PG8_SP2>(F.lds + RING_OFF, g, S, E);
        if (BOTH(2)) GRID_BAR();
    }
    #if GDN_SIMPLE
    if (IN(3)) { conformer_phase(F); gdn_prep_simple(F); if (BOTH(3)) GRID_BAR(); }
#else
    if (IN(3)) { conformer_phase(F); gdn_prep_phase(F); if (BOTH(3)) GRID_BAR(); }
#endif
    #if GDN_SIMPLE
    if (IN(4)) { gdn_recurrent_simple(F); if (BOTH(4)) GRID_BAR(); }
#else
    if (IN(4)) { gdn_scan_phase(F); if (BOTH(4)) GRID_BAR(); }
#endif
    if (IN(5)) {
        pg8::Gemm g{MIX, (const bf16*)(F.ws + WS_WOUT), M, D, D}; pg8::StaticOrder S; S.init(M, D, F.G, (int)blockIdx.x);
        pg8::EpiResGate E{F.in[0], F.out, D, MOD + 2 * D, NMOD * D, SEQ / 256};
        pg8::gemm_phase<pg8::EpiResGate, pg8::StaticOrder, PG8_ALIGN, PG8_SP2>(F.lds + RING_OFF, g, S, E);
        if (BOTH(5)) GRID_BAR();
    }
    if (IN(6)) { norm_mod_phase<false>(F, F.out, F.in[15], MOD + 3 * D, MOD + 4 * D, XN); if (BOTH(6)) GRID_BAR(); }
    if (IN(7)) {
        pg8::Gemm g{XN, (const bf16*)(F.ws + WS_WFI), M, 2 * FF, D}; pg8::StaticOrder S; S.init(M, 2 * FF, F.G, (int)blockIdx.x);
        pg8::EpiSwiGLU E{HID, FF};
        pg8::gemm_phase<pg8::EpiSwiGLU, pg8::StaticOrder, PG8_ALIGN, PG8_SP2>(F.lds + RING_OFF, g, S, E);
        if (BOTH(7)) GRID_BAR();
    }
    if (IN(8)) {
        pg8::Gemm g{HID, (const bf16*)(F.ws + WS_WFO), M, D, FF}; pg8::StaticOrder S; S.init(M, D, F.G, (int)blockIdx.x);
        pg8::EpiResGate E{F.out, F.out, D, MOD + 5 * D, NMOD * D, SEQ / 256};
        pg8::gemm_phase<pg8::EpiResGate, pg8::StaticOrder, PG8_ALIGN, PG8_SP2>(F.lds + RING_OFF, g, S, E);
        if (BOTH(8)) GRID_BAR();
    }
    if (IN(9)) { final_norm_phase(F, F.out, F.in[18]); }
#undef IN
#undef BOTH
}

extern "C" void kernel_launch(void* const* d_in, const int* in_sizes, int n_in, void* d_out, int out_size, void* d_ws, size_t ws_size, hipStream_t stream) {
    static int grid = 0;
    if (grid == 0) {
        if (n_in != 19 || in_sizes[0] != M * D || out_size != M * D || ws_size < WS_END) { fprintf(stderr, "kernel_launch: unexpected shapes (n_in %d, in0 %d, out %d, ws %zu); nothing launched\n", n_in, n_in > 0 ? in_sizes[0] : -1, out_size, ws_size); grid = -1; return; }
        int dev = 0, cus = 0, per_cu = 0;
        if (hipGetDevice(&dev) != hipSuccess || hipDeviceGetAttribute(&cus, hipDeviceAttributeMultiprocessorCount, dev) != hipSuccess) { grid = -1; return; }
        if (hipFuncSetAttribute((const void*)fwd_kernel, hipFuncAttributeMaxDynamicSharedMemorySize, LDS_BYTES) != hipSuccess) { fprintf(stderr, "kernel_launch: hipFuncSetAttribute failed\n"); grid = -1; return; }
        if (hipOccupancyMaxActiveBlocksPerMultiprocessor(&per_cu, (const void*)fwd_kernel, NWAVES * 64, LDS_BYTES) != hipSuccess || per_cu < 1) { fprintf(stderr, "kernel_launch: occupancy query says %d blocks per CU\n", per_cu); per_cu = 1; }
        (void)hipGetLastError();
        grid = cus;
    }
    if (grid < 0) return;
    (void)hipMemsetAsync((char*)d_ws + WS_CTL, 0, CTL_ZERO_BYTES, stream);
    Args a{};
    for (int i = 0; i < 19; ++i) a.in[i] = (const float*)d_in[i];
    a.out = (float*)d_out; a.ws = (unsigned char*)d_ws;
#if MK_ONE_LAUNCH
    a.ph_lo = 0; a.ph_hi = N_PHASES;
    hipLaunchKernelGGL(fwd_kernel, dim3(grid), dim3(NWAVES * 64), LDS_BYTES, stream, a);
#else
    for (int p = 0; p < N_PHASES; ++p) { a.ph_lo = p; a.ph_hi = p + 1; hipLaunchKernelGGL(fwd_kernel, dim3(grid), dim3(NWAVES * 64), LDS_BYTES, stream, a); }
#endif
}
```

```cpp
#include <hip/hip_runtime.h>
#include <cstdio>
#include <cstdint>
namespace pg8 {
#define PG8_LAS __attribute__((address_space(3)))
typedef unsigned short bf16_t;
typedef short bf16x8 __attribute__((ext_vector_type(8)));
typedef float f32x4 __attribute__((ext_vector_type(4)));
typedef unsigned u32x4 __attribute__((ext_vector_type(4)));
constexpr int BM = 256, BK = 64, HALF = 128, HTB = HALF * BK * 2  , STAGE_BYTES = 8 * HTB, NXCD = 8, WGM = 8;

__host__ __device__ __forceinline__ int lds_byte(int r, int c) { const int st = (r >> 4) * 2 + (c >> 5), rr = r & 15, cc = c & 31, ob = rr * 64 + cc * 2; return st * 1024 + (ob ^ (((ob >> 9) & 1) << 5)); }
__host__ __device__ __forceinline__ void stage_rc(int b, int& R, int& C) { const int st = b / 1024, sb = b % 1024, swz = sb ^ (((sb >> 9) & 1) << 5); R = (st >> 1) * 16 + swz / 64; C = (st & 1) * 32 + (swz % 64) / 2; }
__host__ __device__ __forceinline__ int perm32(int rho) { const int n = rho >> 4, i = rho & 15; return 8 * (i >> 2) + 4 * n + (i & 3); }

struct Unit { int pm, pn; };
struct Gemm { const bf16_t* A; const bf16_t* Bt; int M, N, K; };

struct StaticOrder {
    int nM, nN, nwg, G, c;
    __host__ __device__ void init(int M, int N, int G_, int c_) { nM = M / BM; nN = N / BM; nwg = nM * nN; G = G_; c = c_; }
    __host__ __device__ bool next(int i, Unit& u) const {
        const long L = (long)i * G + c; if (L >= nwg) return false;
        int wgid = (int)L; { const int q = nwg / NXCD, r = nwg % NXCD, xcd = wgid % NXCD, off = wgid / NXCD; wgid = (xcd < r ? xcd * (q + 1) : r * (q + 1) + (xcd - r) * q) + off; }
        const int nig = WGM * nN, gid = wgid / nig, fm = gid * WGM, gsz = (nM - fm) < WGM ? (nM - fm) : WGM;
        u.pm = fm + ((wgid % nig) % gsz); u.pn = (wgid % nig) / gsz; return true;
    }
    __device__ __forceinline__ void a_ready(const Unit&) const {}
    __device__ __forceinline__ void done(const Unit&) const {}
};

__device__ __forceinline__ unsigned cvt_pk_bf16(float lo, float hi) { unsigned r; asm volatile("v_cvt_pk_bf16_f32 %0, %1, %2" : "=v"(r) : "v"(lo), "v"(hi)); return r; }
typedef float f32x2 __attribute__((ext_vector_type(2)));
__device__ __forceinline__ f32x2 gelu_pk(f32x2 v) {
    const f32x2 av = __builtin_elementwise_abs(v), d = av * 0.2316418882f + 1.0f;
    f32x2 t; t.x = __builtin_amdgcn_rcpf(d.x); t.y = __builtin_amdgcn_rcpf(d.y);
    f32x2 q = t * 0.5307027145f + (-0.7265760135f); q = q * t + 0.7107068705f; q = q * t + (-0.142248368f); q = q * t + 0.127414796f; q = q * t;
    const f32x2 s = (v * v) * (-0.72134752044f);
    f32x2 e; e.x = __builtin_amdgcn_exp2f(s.x); e.y = __builtin_amdgcn_exp2f(s.y);
    const f32x2 m = v * (q * e), r = v - m;
    f32x2 o; o.x = v.x < 0.f ? m.x : r.x; o.y = v.y < 0.f ? m.y : r.y; return o;
}

template <int ACT  > struct EpiBf16 {
    static constexpr bool PERM = true, AFTER_DRAIN = false; static_assert(ACT == 0 || ACT == 1, "EpiBf16: ACT is 0 (none) or 1 (gelu_pk)");
    bf16_t* O; int ldc; const float* bias; int split_cols; size_t split_stride; float scale0;
    __device__ __forceinline__ void operator()(const f32x4 (&acc)[2][2][4][2], const Unit& u, int wr, int wc, int fr, int fq) const {
        const int row0 = u.pm * BM + wr * 64 + fr; int colt = u.pn * BM; bf16_t* base = O;
        float sc = 1.f; if (split_cols) { const int t = colt / split_cols; base += (size_t)t * split_stride; colt -= t * split_cols; if (t == 0) sc = scale0; }
        const int col0 = colt + wc * 32 + 8 * fq, bcol0 = u.pn * BM + wc * 32 + 8 * fq;
        f32x4 bv[2][2];
#pragma unroll
        for (int bj = 0; bj < 2; ++bj)
#pragma unroll
            for (int n = 0; n < 2; ++n) bv[bj][n] = bias ? *(const f32x4*)(bias + bcol0 + bj * HALF + 4 * n) : (f32x4){0.f, 0.f, 0.f, 0.f};
#pragma unroll
        for (int ai = 0; ai < 2; ++ai)
#pragma unroll
            for (int m = 0; m < 4; ++m) { bf16_t* rowp = base + (size_t)(row0 + ai * HALF + m * 16) * ldc + col0;
#pragma unroll
                for (int bj = 0; bj < 2; ++bj) { f32x4 v0 = acc[ai][bj][m][0] + bv[bj][0], v1 = acc[ai][bj][m][1] + bv[bj][1];
                    if (ACT == 1) { f32x2 a = gelu_pk((f32x2){v0[0], v0[1]}), b = gelu_pk((f32x2){v0[2], v0[3]}), c = gelu_pk((f32x2){v1[0], v1[1]}), d = gelu_pk((f32x2){v1[2], v1[3]});
                        v0 = (f32x4){a.x, a.y, b.x, b.y}; v1 = (f32x4){c.x, c.y, d.x, d.y}; }
                    v0 = v0 * sc; v1 = v1 * sc; u32x4 w; w.x = cvt_pk_bf16(v0[0], v0[1]); w.y = cvt_pk_bf16(v0[2], v0[3]); w.z = cvt_pk_bf16(v1[0], v1[1]); w.w = cvt_pk_bf16(v1[2], v1[3]);
                    *(u32x4*)(rowp + bj * HALF) = w; } }
    }
};

struct PanelStats {
    unsigned* xbuf;
    unsigned* cnt;
    unsigned* tmo;
    int ntn; float eps;
    unsigned code;
    __device__ __forceinline__ bool run(const f32x4 (&v)[2][2][4][2], const Unit& u, int wr, int wc, int fr, int fq, PG8_LAS unsigned char* lds, int wid, int lane) const {
        typedef float f32x2v __attribute__((ext_vector_type(2)));
        PG8_LAS f32x2v* P = (PG8_LAS f32x2v*)lds;
        PG8_LAS f32x2v* S = (PG8_LAS f32x2v*)(lds + 8192);
        PG8_LAS unsigned* flag = (PG8_LAS unsigned*)(lds + 8192 + 2048);
#pragma unroll
        for (int ai = 0; ai < 2; ++ai)
#pragma unroll
            for (int m = 0; m < 4; ++m) {
                float s = 0.f;
#pragma unroll
                for (int bj = 0; bj < 2; ++bj)
#pragma unroll
                    for (int n = 0; n < 2; ++n) { const f32x4 x = v[ai][bj][m][n]; s += (x[0] + x[1]) + (x[2] + x[3]); }
                s += __shfl_xor(s, 16); s += __shfl_xor(s, 32);
                const float mw = s * (1.0f / 64.0f); float q = 0.f;
#pragma unroll
                for (int bj = 0; bj < 2; ++bj)
#pragma unroll
                    for (int n = 0; n < 2; ++n) { const f32x4 d = v[ai][bj][m][n] - mw; q += (d[0] * d[0] + d[1] * d[1]) + (d[2] * d[2] + d[3] * d[3]); }
                q += __shfl_xor(q, 16); q += __shfl_xor(q, 32);
                if (fq == 0) P[(ai * HALF + wr * 64 + m * 16 + fr) * 4 + wc] = (f32x2v){mw, q};
            }
        asm volatile("s_waitcnt lgkmcnt(0)" ::: "memory"); __builtin_amdgcn_s_barrier(); asm volatile("" ::: "memory");
#if defined(BROKEN_EXCHANGE_NO_WAIT)
#warning BROKEN CONTROL BUILD: the row-statistics exchange does not wait; results are wrong by design
        if (blockIdx.x >= 64) { const long long t0_ = clock64(); while (clock64() - t0_ < 60000) __builtin_amdgcn_s_sleep(8); }
#endif
        const int row = wid * 32 + (lane & 31);
        if (lane < 32) {
            const f32x2v a = P[row * 4 + 0], b = P[row * 4 + 1], c = P[row * 4 + 2], d = P[row * 4 + 3];
            const float mt = (a.x + b.x + c.x + d.x) * 0.25f;
            const float da = a.x - mt, db = b.x - mt, dc = c.x - mt, dd = d.x - mt;
            const float m2 = (a.y + b.y) + (c.y + d.y) + 64.0f * ((da * da + db * db) + (dc * dc + dd * dd));
            unsigned long long* slot = (unsigned long long*)xbuf + ((size_t)(u.pm * BM + row) * 4 + u.pn);
            __hip_atomic_store(slot, ((unsigned long long)__float_as_uint(m2) << 32) | __float_as_uint(mt), __ATOMIC_RELAXED, __HIP_MEMORY_SCOPE_AGENT);
        }
        asm volatile("s_waitcnt vmcnt(0)" ::: "memory");
        if (lane == 0) __hip_atomic_fetch_add(cnt + 64 * u.pm, 1u, __ATOMIC_RELAXED, __HIP_MEMORY_SCOPE_AGENT);
        if (wid == 0) {
            bool dead = false; const unsigned long long t0 = __builtin_amdgcn_s_memrealtime(); const unsigned want = 8u * (unsigned)ntn;
            for (;;) {
#if defined(BROKEN_EXCHANGE_NO_WAIT)
                break;
#endif
                if ((unsigned)__builtin_amdgcn_readfirstlane(__hip_atomic_load(cnt + 64 * u.pm, __ATOMIC_RELAXED, __HIP_MEMORY_SCOPE_AGENT)) >= want) break;
                if (__builtin_amdgcn_s_memrealtime() - t0 > 2000000ull) {
                    if (lane == 0) { unsigned expect = 0u; __hip_atomic_compare_exchange_strong(tmo + 1, &expect, code | (unsigned)(u.pm & 0xff), __ATOMIC_RELAXED, __ATOMIC_RELAXED, __HIP_MEMORY_SCOPE_AGENT);
                                     __hip_atomic_store(tmo, 1u, __ATOMIC_RELAXED, __HIP_MEMORY_SCOPE_AGENT); }
                    dead = true; break; }
                __builtin_amdgcn_s_sleep(2);
            }
            __builtin_amdgcn_fence(__ATOMIC_ACQUIRE, "agent");
            if (lane == 0) flag[0] = dead ? 1u : 0u;
        }
        asm volatile("s_waitcnt vmcnt(0) lgkmcnt(0)" ::: "memory"); __builtin_amdgcn_s_barrier(); asm volatile("" ::: "memory");
        const bool bad = flag[0] != 0u;
        if (lane < 32) {
            const unsigned long long* slot = (const unsigned long long*)xbuf + (size_t)(u.pm * BM + row) * 4; float mt[4], m2[4]; float ms = 0.f;
#pragma unroll
            for (int t = 0; t < 4; ++t) { if (t < ntn) { const unsigned long long w = __hip_atomic_load(slot + t, __ATOMIC_RELAXED, __HIP_MEMORY_SCOPE_AGENT); mt[t] = __uint_as_float((unsigned)w); m2[t] = __uint_as_float((unsigned)(w >> 32)); } else { mt[t] = 0.f; m2[t] = 0.f; } ms += mt[t]; }
            const float mean = ms / (float)ntn; float q = 0.f;
#pragma unroll
            for (int t = 0; t < 4; ++t) if (t < ntn) { const float dm = mt[t] - mean; q += m2[t] + 256.0f * dm * dm; }
            S[row] = (f32x2v){mean, 1.0f / sqrtf(q / (256.0f * (float)ntn) + eps)};
        }
        asm volatile("s_waitcnt lgkmcnt(0)" ::: "memory"); __builtin_amdgcn_s_barrier(); asm volatile("" ::: "memory");
        return bad;
    }
};
struct EpiLnRes {
    static constexpr bool PERM = false, AFTER_DRAIN = true;
    const float* base; float* out; int ldc; const float* bias; PanelStats st; unsigned poison;
    __device__ __forceinline__ void fused(f32x4 (&acc)[2][2][4][2], const Unit& u, int wr, int wc, int fr, int fq, PG8_LAS unsigned char* lds, int wid, int lane) const {
        typedef float f32x2v __attribute__((ext_vector_type(2)));
        const PG8_LAS f32x2v* S = (const PG8_LAS f32x2v*)(lds + 8192);
        const int col0 = u.pn * BM + wc * 32 + 4 * fq;
#pragma unroll
        for (int bj = 0; bj < 2; ++bj)
#pragma unroll
            for (int n = 0; n < 2; ++n) { const f32x4 bv = bias ? *(const f32x4*)(bias + col0 + bj * HALF + n * 16) : (f32x4){0.f, 0.f, 0.f, 0.f};
#pragma unroll
                for (int ai = 0; ai < 2; ++ai)
#pragma unroll
                    for (int m = 0; m < 4; ++m) acc[ai][bj][m][n] += bv; }
        f32x4 pre[4][2][2];
#pragma unroll
        for (int m = 0; m < 4; ++m) { const size_t off = (size_t)(u.pm * BM + wr * 64 + m * 16 + fr) * ldc + col0;
#pragma unroll
            for (int bj = 0; bj < 2; ++bj)
#pragma unroll
                for (int n = 0; n < 2; ++n) pre[m][bj][n] = *(const f32x4*)(base + off + bj * HALF + n * 16); }
        const bool bad = st.run(acc, u, wr, wc, fr, fq, lds, wid, lane) || poison != 0u;
        const float qnan = __builtin_nanf("");
#pragma unroll
        for (int ai = 0; ai < 2; ++ai)
#pragma unroll
            for (int m = 0; m < 4; ++m) { const int r = ai * HALF + wr * 64 + m * 16 + fr; const f32x2v sr = S[r]; const size_t off = (size_t)(u.pm * BM + r) * ldc + col0;
#pragma unroll
                for (int bj = 0; bj < 2; ++bj)
#pragma unroll
                    for (int n = 0; n < 2; ++n) { const f32x4 bs = ai == 0 ? pre[m][bj][n] : *(const f32x4*)(base + off + bj * HALF + n * 16); f32x4 o = bs + (acc[ai][bj][m][n] - sr.x) * sr.y;
                        if (bad) o = (f32x4){qnan, qnan, qnan, qnan}; *(f32x4*)(out + off + bj * HALF + n * 16) = o; }
                if (m & 1) asm volatile("" ::: "memory"); }
    }
};
struct EpiLnResLn {
    static constexpr bool PERM = false, AFTER_DRAIN = true;
    const float* base; float* out; bf16_t* xn; int ldc; const float* bias; PanelStats st1, st2; unsigned poison;
    __device__ __forceinline__ void fused(f32x4 (&acc)[2][2][4][2], const Unit& u, int wr, int wc, int fr, int fq, PG8_LAS unsigned char* lds, int wid, int lane) const {
        typedef float f32x2v __attribute__((ext_vector_type(2))); typedef unsigned u32x2v __attribute__((ext_vector_type(2)));
        const PG8_LAS f32x2v* S = (const PG8_LAS f32x2v*)(lds + 8192);
        const int col0 = u.pn * BM + wc * 32 + 4 * fq;
#pragma unroll
        for (int bj = 0; bj < 2; ++bj)
#pragma unroll
            for (int n = 0; n < 2; ++n) { const f32x4 bv = bias ? *(const f32x4*)(bias + col0 + bj * HALF + n * 16) : (f32x4){0.f, 0.f, 0.f, 0.f};
#pragma unroll
                for (int ai = 0; ai < 2; ++ai)
#pragma unroll
                    for (int m = 0; m < 4; ++m) acc[ai][bj][m][n] += bv; }
        bool bad = st1.run(acc, u, wr, wc, fr, fq, lds, wid, lane) || poison != 0u;
        const float qnan = __builtin_nanf("");
#pragma unroll
        for (int ai = 0; ai < 2; ++ai)
#pragma unroll
            for (int m = 0; m < 4; ++m) { const int r = ai * HALF + wr * 64 + m * 16 + fr; const f32x2v sr = S[r]; const size_t off = (size_t)(u.pm * BM + r) * ldc + col0;
#pragma unroll
                for (int bj = 0; bj < 2; ++bj)
#pragma unroll
                    for (int n = 0; n < 2; ++n) { const f32x4 bs = *(const f32x4*)(base + off + bj * HALF + n * 16); acc[ai][bj][m][n] = bs + (acc[ai][bj][m][n] - sr.x) * sr.y; }
                asm volatile("" : "+v"(acc[ai][0][m][0]), "+v"(acc[ai][0][m][1]), "+v"(acc[ai][1][m][0]), "+v"(acc[ai][1][m][1]));
                if (m & 1) asm volatile("" ::: "memory"); }
        const bool bad1 = bad;
        bad = st2.run(acc, u, wr, wc, fr, fq, lds, wid, lane) || bad;
#pragma unroll
        for (int ai = 0; ai < 2; ++ai)
#pragma unroll
            for (int m = 0; m < 4; ++m) { const int r = ai * HALF + wr * 64 + m * 16 + fr; const f32x2v sr = S[r]; const size_t off = (size_t)(u.pm * BM + r) * ldc + col0;
#pragma unroll
                for (int bj = 0; bj < 2; ++bj)
#pragma unroll
                    for (int n = 0; n < 2; ++n) { const f32x4 x1 = acc[ai][bj][m][n]; *(f32x4*)(out + off + bj * HALF + n * 16) = bad1 ? (f32x4){qnan, qnan, qnan, qnan} : x1;
                        const f32x4 o = (x1 - sr.x) * sr.y; u32x2v w; w.x = cvt_pk_bf16(o[0], o[1]); w.y = cvt_pk_bf16(o[2], o[3]);
                        if (bad) { w.x = 0x7fc07fc0u; w.y = 0x7fc07fc0u; } *(u32x2v*)(xn + off + bj * HALF + n * 16) = w; }
                asm volatile("" ::: "memory"); }
    }
};

template <class Epi, class Sched, bool ALIGN_EPI = false, bool SP2 = false>
__device__ __forceinline__ void gemm_phase(PG8_LAS unsigned char* lds, const Gemm g, const Sched& S, const Epi& E) {
    const int tid = threadIdx.x, wid = __builtin_amdgcn_readfirstlane(tid >> 6), lane = tid & 63, wr = wid >> 2, wc = wid & 3, fr = lane & 15, fq = lane >> 4;
    const int K = g.K, nt = K / BK;
    unsigned voffA[2], voffB[2];
#pragma unroll
    for (int i = 0; i < 2; ++i) { int R, C; stage_rc(tid * 16 + i * 8192, R, C); const int Rb = Epi::PERM ? ((R & ~31) + perm32(R & 31)) : R;
        voffA[i] = (unsigned)(R * K + C) * 2u; voffB[i] = (unsigned)(Rb * K + C) * 2u; }
    const size_t kstep = (size_t)(BK * 2);
    const size_t hstep = (size_t)HALF * K * 2;
    const size_t tstep = 2 * hstep;
    const unsigned ldsw = (unsigned)wid * 1024u;
    const int aoff = lds_byte(wr * 64 + fr, fq * 8), boff = lds_byte(wc * 32 + fr, fq * 8);
#define PG8_SA(b, h) (((b) * 2 + (h)) * HTB)
#define PG8_SB(b, h) ((4 + (b) * 2 + (h)) * HTB)
#define PG8_STAGE(bufoff, gbase, voff) do { _Pragma("unroll") for (int _i = 0; _i < 2; ++_i) \
        __builtin_amdgcn_global_load_lds((const unsigned*)((const char*)(gbase) + (voff)[_i]), (PG8_LAS unsigned*)(lds + (bufoff) + ldsw + _i * 8192), 16, 0, 0); } while (0)
#define PG8_LDA(dst, b, h) do { _Pragma("unroll") for (int m = 0; m < 4; ++m) _Pragma("unroll") for (int k = 0; k < 2; ++k) dst[m][k] = *(const PG8_LAS bf16x8*)(lds + PG8_SA(b, h) + aoff + m * 2048 + k * 1024); } while (0)
#define PG8_LDB(dst, b, h) do { _Pragma("unroll") for (int n = 0; n < 2; ++n) _Pragma("unroll") for (int k = 0; k < 2; ++k) dst[n][k] = *(const PG8_LAS bf16x8*)(lds + PG8_SB(b, h) + boff + n * 2048 + k * 1024); } while (0)
#define PG8_MMA(ai, bj, At, Bt) do { __builtin_amdgcn_s_setprio(1); _Pragma("unroll") for (int m = 0; m < 4; ++m) _Pragma("unroll") for (int n = 0; n < 2; ++n) _Pragma("unroll") for (int k = 0; k < 2; ++k) \
        acc[ai][bj][m][n] = __builtin_amdgcn_mfma_f32_16x16x32_bf16(Bt[n][k], At[m][k], acc[ai][bj][m][n], 0, 0, 0); __builtin_amdgcn_s_setprio(0); } while (0)
#define PG8_WAIT_V(n) asm volatile("s_waitcnt vmcnt(" #n ")" ::: "memory")
#define PG8_WAIT_L(n) asm volatile("s_waitcnt lgkmcnt(" #n ")" ::: "memory")
#define PG8_BAR __builtin_amdgcn_s_barrier()
#define PG8_SCHED __builtin_amdgcn_sched_barrier(0)
    Unit cur, nxt; int ui = 0;
    if (!S.next(0, cur)) return;
    f32x4 acc[2][2][4][2];
#pragma unroll
    for (int a = 0; a < 2; ++a)
#pragma unroll
        for (int b = 0; b < 2; ++b)
#pragma unroll
            for (int m = 0; m < 4; ++m)
#pragma unroll
                for (int n = 0; n < 2; ++n) acc[a][b][m][n] = (f32x4){0.f, 0.f, 0.f, 0.f};
    bf16x8 At[4][2], B0[2][2], B1[2][2];
    const char* cA = (const char*)g.A + (size_t)cur.pm * tstep; const char* cB = (const char*)g.Bt + (size_t)cur.pn * tstep;
    S.a_ready(cur);
    if constexpr (SP2) {
        PG8_STAGE(PG8_SB(0, 0), cB, voffB); PG8_STAGE(PG8_SB(0, 1), cB + hstep, voffB); PG8_STAGE(PG8_SA(0, 0), cA, voffA); PG8_STAGE(PG8_SA(0, 1), cA + hstep, voffA);
        if (wr == 1) PG8_BAR;
        PG8_WAIT_V(2); PG8_BAR;
        PG8_STAGE(PG8_SB(1, 0), cB + kstep, voffB); PG8_STAGE(PG8_SA(1, 0), cA + kstep, voffA); PG8_STAGE(PG8_SB(1, 1), cB + hstep + kstep, voffB);
        PG8_WAIT_V(6); PG8_BAR;
    } else {
        PG8_STAGE(PG8_SB(0, 0), cB, voffB); PG8_STAGE(PG8_SA(0, 0), cA, voffA); PG8_STAGE(PG8_SB(0, 1), cB + hstep, voffB); PG8_STAGE(PG8_SA(0, 1), cA + hstep, voffA);
        if (wr == 1) PG8_BAR;
        PG8_WAIT_V(4); PG8_BAR;
        PG8_STAGE(PG8_SB(1, 0), cB + kstep, voffB); PG8_STAGE(PG8_SA(1, 0), cA + kstep, voffA); PG8_STAGE(PG8_SB(1, 1), cB + hstep + kstep, voffB);
        PG8_WAIT_V(6); PG8_BAR;
    }
    for (;;) {
        const bool has_next = S.next(ui + 1, nxt);
        const char* nA = has_next ? (const char*)g.A + (size_t)nxt.pm * tstep : cA; const char* nB = has_next ? (const char*)g.Bt + (size_t)nxt.pn * tstep : cB;
        for (int t = 0; t < nt; t += 2) {
            const bool last = (t == nt - 2);
            const char* a1 = cA + (size_t)(t + 1) * kstep;
            const char* a2 = last ? nA : cA + (size_t)(t + 2) * kstep; const char* b2 = last ? nB : cB + (size_t)(t + 2) * kstep;
            const char* a3 = a2 + kstep; const char* b3 = b2 + kstep;
            if (last && has_next) S.a_ready(nxt);
            if constexpr (SP2) {
            PG8_LDB(B0, 0, 0); PG8_LDB(B1, 0, 1); PG8_SCHED; PG8_LDA(At, 0, 0); PG8_STAGE(PG8_SA(1, 1), a1 + hstep, voffA);
            PG8_WAIT_V(8); PG8_WAIT_L(0); PG8_BAR; PG8_MMA(0, 0, At, B0); PG8_MMA(0, 1, At, B1); PG8_BAR; PG8_SCHED;
            PG8_LDA(At, 0, 1); PG8_STAGE(PG8_SB(0, 0), b2, voffB); PG8_STAGE(PG8_SB(0, 1), b2 + hstep, voffB); PG8_STAGE(PG8_SA(0, 0), a2, voffA);
            PG8_WAIT_V(8); PG8_WAIT_L(0); PG8_BAR; PG8_MMA(1, 0, At, B0); PG8_MMA(1, 1, At, B1); PG8_BAR; PG8_SCHED;
            PG8_LDB(B0, 1, 0); PG8_LDB(B1, 1, 1); PG8_SCHED; PG8_LDA(At, 1, 0); PG8_STAGE(PG8_SA(0, 1), a2 + hstep, voffA);
            PG8_WAIT_V(8); PG8_WAIT_L(0); PG8_BAR; PG8_MMA(0, 0, At, B0); PG8_MMA(0, 1, At, B1); PG8_BAR; PG8_SCHED;
            PG8_LDA(At, 1, 1); PG8_STAGE(PG8_SB(1, 0), b3, voffB); PG8_STAGE(PG8_SB(1, 1), b3 + hstep, voffB); PG8_STAGE(PG8_SA(1, 0), a3, voffA);
            PG8_WAIT_V(8); PG8_WAIT_L(0); PG8_BAR; PG8_MMA(1, 0, At, B0); PG8_MMA(1, 1, At, B1); PG8_BAR; PG8_SCHED;
            } else {
            PG8_LDB(B0, 0, 0); PG8_SCHED; PG8_LDA(At, 0, 0); PG8_STAGE(PG8_SA(1, 1), a1 + hstep, voffA);
            PG8_WAIT_L(8); PG8_BAR; PG8_WAIT_L(0); PG8_MMA(0, 0, At, B0); PG8_BAR; PG8_SCHED;
            PG8_LDB(B1, 0, 1); PG8_STAGE(PG8_SB(0, 0), b2, voffB);
            PG8_BAR; PG8_WAIT_L(0); PG8_MMA(0, 1, At, B1); PG8_BAR;
            PG8_LDA(At, 0, 1); PG8_STAGE(PG8_SA(0, 0), a2, voffA);
            PG8_BAR; PG8_WAIT_L(0); PG8_MMA(1, 0, At, B0); PG8_BAR; PG8_SCHED;
            PG8_STAGE(PG8_SB(0, 1), b2 + hstep, voffB);
            PG8_WAIT_V(6); PG8_BAR; PG8_MMA(1, 1, At, B1); PG8_BAR;
            PG8_LDB(B0, 1, 0); PG8_SCHED; PG8_LDA(At, 1, 0); PG8_STAGE(PG8_SA(0, 1), a2 + hstep, voffA);
            PG8_WAIT_L(8); PG8_BAR; PG8_WAIT_L(0); PG8_MMA(0, 0, At, B0); PG8_BAR; PG8_SCHED;
            PG8_LDB(B1, 1, 1); PG8_STAGE(PG8_SB(1, 0), b3, voffB);
            PG8_BAR; PG8_WAIT_L(0); PG8_MMA(0, 1, At, B1); PG8_BAR;
            PG8_LDA(At, 1, 1); PG8_STAGE(PG8_SA(1, 0), a3, voffA);
            PG8_BAR; PG8_WAIT_L(0); PG8_MMA(1, 0, At, B0); PG8_BAR; PG8_SCHED;
            PG8_STAGE(PG8_SB(1, 1), b3 + hstep, voffB);
            PG8_WAIT_V(6); PG8_BAR; PG8_MMA(1, 1, At, B1); PG8_BAR;
            }
        }
        if constexpr (ALIGN_EPI) { if (wr == 0) PG8_BAR; }
        if constexpr (!Epi::AFTER_DRAIN) { E(acc, cur, wr, wc, fr, fq); S.done(cur); }
        if (!has_next) break;
#pragma unroll
        for (int a = 0; a < 2; ++a)
#pragma unroll
            for (int b = 0; b < 2; ++b)
#pragma unroll
                for (int m = 0; m < 4; ++m)
#pragma unroll
                    for (int n = 0; n < 2; ++n) acc[a][b][m][n] = (f32x4){0.f, 0.f, 0.f, 0.f};
        cur = nxt; cA = nA; cB = nB; ++ui;
        if constexpr (ALIGN_EPI) { if (wr == 1) PG8_BAR; }
    }
    PG8_WAIT_V(0);
    if constexpr (!ALIGN_EPI) { if (wr == 0) PG8_BAR; }
    PG8_BAR;
    if constexpr (Epi::AFTER_DRAIN) { E.fused(acc, cur, wr, wc, fr, fq, lds, wid, lane); S.done(cur); }
#undef PG8_SA
#undef PG8_SB
#undef PG8_STAGE
#undef PG8_LDA
#undef PG8_LDB
#undef PG8_MMA
#undef PG8_WAIT_V
#undef PG8_WAIT_L
#undef PG8_BAR
#undef PG8_SCHED
}
}
namespace pg8 {
__device__ __forceinline__ float fast_silu(float x) { return x * __builtin_amdgcn_rcpf(1.0f + __builtin_amdgcn_exp2f(-1.44269504089f * x)); }
struct EpiResGate {
    static constexpr bool PERM = false, AFTER_DRAIN = false;
    const float* base; float* out; int ldc; const float* gate; int gate_ld; int tiles_per_batch;
    __device__ __forceinline__ void operator()(const f32x4 (&acc)[2][2][4][2], const Unit& u, int wr, int wc, int fr, int fq) const {
        const int row0 = u.pm * BM + wr * 64 + fr, col0 = u.pn * BM + wc * 32 + 4 * fq;
        const float* gp = gate + (size_t)(u.pm / tiles_per_batch) * gate_ld + col0;
        f32x4 gv[2][2];
#pragma unroll
        for (int bj = 0; bj < 2; ++bj)
#pragma unroll
            for (int n = 0; n < 2; ++n) gv[bj][n] = *(const f32x4*)(gp + bj * HALF + n * 16);
#pragma unroll
        for (int ai = 0; ai < 2; ++ai)
#pragma unroll
            for (int m = 0; m < 4; ++m) { const size_t off = (size_t)(row0 + ai * HALF + m * 16) * ldc + col0;
#pragma unroll
                for (int bj = 0; bj < 2; ++bj)
#pragma unroll
                    for (int n = 0; n < 2; ++n) { const f32x4 b = *(const f32x4*)(base + off + bj * HALF + n * 16); *(f32x4*)(out + off + bj * HALF + n * 16) = b + gv[bj][n] * acc[ai][bj][m][n]; } }
    }
};
struct EpiSwiGLU {
    static constexpr bool PERM = true, AFTER_DRAIN = false;
    bf16_t* O; int ldc;
    __device__ __forceinline__ void operator()(const f32x4 (&acc)[2][2][4][2], const Unit& u, int wr, int wc, int fr, int fq) const {
        const int row0 = u.pm * BM + wr * 64 + fr, col0 = u.pn * HALF + wc * 32 + 8 * fq;
#pragma unroll
        for (int ai = 0; ai < 2; ++ai)
#pragma unroll
            for (int m = 0; m < 4; ++m) { bf16_t* rowp = O + (size_t)(row0 + ai * HALF + m * 16) * ldc + col0;
                const f32x4 g0 = acc[ai][0][m][0], g1 = acc[ai][0][m][1], u0 = acc[ai][1][m][0], u1 = acc[ai][1][m][1];
                u32x4 w; w.x = cvt_pk_bf16(fast_silu(g0[0]) * u0[0], fast_silu(g0[1]) * u0[1]); w.y = cvt_pk_bf16(fast_silu(g0[2]) * u0[2], fast_silu(g0[3]) * u0[3]);
                w.z = cvt_pk_bf16(fast_silu(g1[0]) * u1[0], fast_silu(g1[1]) * u1[1]); w.w = cvt_pk_bf16(fast_silu(g1[2]) * u1[2], fast_silu(g1[3]) * u1[3]);
                *(u32x4*)rowp = w; }
    }
};
}
#ifndef PG8_SP2
#define PG8_SP2 true
#endif
#ifndef PG8_ALIGN
#define PG8_ALIGN true
#endif
constexpr int NWAVES = 8;
#ifndef MK_ONE_LAUNCH
#define MK_ONE_LAUNCH 1
#endif
#ifndef GDN_SIMPLE
#define GDN_SIMPLE 0
#endif
#ifndef PROBE_REP
#define PROBE_REP -1
#endif
constexpr int N_PHASES = 10;

constexpr int BATCH = 8, SEQ = 2048, D = 1024, M = BATCH * SEQ;
constexpr int CW = 512, GW = 512, NH = 4, HD = 128, NIN = 3080, NIN_G = 3072, FF = 2816, NMOD = 6;
constexpr int CONVK = 31, CL = 64;
constexpr float EPS = 1e-6f;
constexpr int PC_A = 0, PC_GATE = 512, PC_Q = 1024, PC_K = 1536, PC_V = 2048, PC_Z = 2560;

constexpr size_t MiB = 1u << 20;
constexpr size_t WS_CTL = 0, CTL_ZERO_BYTES = 1 * MiB;
constexpr size_t WS_MOD = 1 * MiB;
constexpr size_t WS_BG = 1 * MiB + 512 * 1024;
constexpr size_t WS_WIN = 2 * MiB, WS_WOUT = 8 * MiB, WS_WFI = 10 * MiB, WS_WFO = 21 * MiB;
constexpr size_t WS_XN = 28 * MiB;
constexpr size_t WS_P = 60 * MiB;
constexpr size_t WS_HID = 60 * MiB;
constexpr size_t WS_MIXIN = 156 * MiB;
constexpr size_t WS_QN = 188 * MiB, WS_KN = 220 * MiB, WS_VN = 28 * MiB;
constexpr size_t WS_END = 256 * MiB;
constexpr int CW_BAR = 4096;

constexpr int RING_OFF = 0, RING_BYTES = 131072;
constexpr int EXTRA_OFF = RING_BYTES, EXTRA_BYTES = 16384;
constexpr int LDSCTL_OFF = EXTRA_OFF + EXTRA_BYTES, MISC_OFF = LDSCTL_OFF + 320;
constexpr int LDS_BYTES = 163840;
static_assert(MISC_OFF + 128 <= LDS_BYTES, "LDS map");
#define GAS __attribute__((address_space(1)))
#define LAS __attribute__((address_space(3)))
typedef unsigned short bf16;
typedef unsigned v4u __attribute__((ext_vector_type(4)));
typedef float f32x4 __attribute__((ext_vector_type(4)));
typedef short bf16x8 __attribute__((ext_vector_type(8)));
typedef GAS unsigned gu32;
typedef GAS unsigned long long gu64;
#define RLX_AGENT __ATOMIC_RELAXED, __HIP_MEMORY_SCOPE_AGENT
#define LDS_WAIT() asm volatile("s_waitcnt lgkmcnt(0)" ::: "memory")
#define VM_WAIT() asm volatile("s_waitcnt vmcnt(0)" ::: "memory")
__device__ __forceinline__ unsigned long long rt() { return __builtin_amdgcn_s_memrealtime(); }
__device__ __forceinline__ unsigned f2bf(float f) { unsigned u = __builtin_bit_cast(unsigned, f); return (u + 0x7fffu + ((u >> 16) & 1u)) >> 16; }
__device__ __forceinline__ unsigned pk2(float lo, float hi) { return f2bf(lo) | (f2bf(hi) << 16); }

#define XB_TMO      128
#define XB_XCNT(j)  (256  + 64 * (j))
#define XB_XSUB(j)  (1280 + 64 * (j))
#define XB_XGEN(j)  (2304 + 64 * (j))
#define XB_TOP      3328
#define XB_TOPGEN   3392
#define XCD_BAR_WORDS 3456
#define XB_SPIN_CAP (1u << 18)

__device__ __forceinline__ unsigned xb_ld(unsigned* p)              { return __hip_atomic_load(p, __ATOMIC_RELAXED, __HIP_MEMORY_SCOPE_AGENT); }
__device__ __forceinline__ unsigned xb_add(unsigned* p, unsigned v) { return __hip_atomic_fetch_add(p, v, __ATOMIC_RELAXED, __HIP_MEMORY_SCOPE_AGENT); }
__device__ __forceinline__ unsigned xb_xcc_id() { return (unsigned)__builtin_amdgcn_s_getreg((3 << 11) | 20) & 0xFu; }
#define XB_SPIN(cond, bar) do { unsigned _sp = 0; while (cond) { __builtin_amdgcn_s_sleep(1); \
    if ((++_sp & 255u) == 0u) { if (xb_ld(&(bar)[XB_TMO])) break; if (_sp > XB_SPIN_CAP) { atomicAdd(&(bar)[XB_TMO], 1u); break; } } } } while (0)

struct XcdBarrier {
    unsigned* bar; unsigned x;
    volatile LAS unsigned* st;
};

__device__ __forceinline__ XcdBarrier xcd_barrier_post(unsigned* bar, volatile LAS unsigned* st) {
    XcdBarrier b; b.bar = bar; b.x = xb_xcc_id(); b.st = st;
    if (threadIdx.x == 0) (void)xb_add(&bar[XB_XCNT(b.x)], 1u);
    return b;
}
__device__ __forceinline__ void xcd_barrier_complete(unsigned* bar, unsigned x, unsigned& nloc, unsigned& nx) {
    const unsigned G = gridDim.x * gridDim.y * gridDim.z;
    unsigned sum, cnt, mine, sp = 0u;
    for (;;) {
        sum = 0u; cnt = 0u; mine = 0u;
#pragma unroll
        for (unsigned j = 0; j < 16; ++j) { const unsigned c = xb_ld(&bar[XB_XCNT(j)]); sum += c; cnt += (c > 0u) ? 1u : 0u; mine = (j == x) ? c : mine; }
        if (sum == G) break;
        __builtin_amdgcn_s_sleep(1);
        if ((++sp & 255u) == 0u) { if (xb_ld(&bar[XB_TMO])) break; if (sp > XB_SPIN_CAP) { atomicAdd(&bar[XB_TMO], 1u); break; } }
    }
    nloc = mine > 0u ? mine : 1u; nx = cnt > 0u ? cnt : 1u;
}

__device__ __forceinline__ void xcd_barrier(const XcdBarrier& b) {
    asm volatile("s_waitcnt vmcnt(0)" ::: "memory");
    __syncthreads();
    if (threadIdx.x == 0) {
        unsigned* bar = b.bar;
        __builtin_amdgcn_s_waitcnt(0);
        unsigned nloc = b.st[0], nx = b.st[1];
        if (nloc == 0u) { xcd_barrier_complete(bar, b.x, nloc, nx); b.st[0] = nloc; b.st[1] = nx; }
        const unsigned old = xb_add(&bar[XB_XSUB(b.x)], 1u);
        const unsigned gen = old / nloc;
        if (old + 1u == (gen + 1u) * nloc) {
            __builtin_amdgcn_fence(__ATOMIC_RELEASE, "agent");
            asm volatile("s_waitcnt vmcnt(0)" ::: "memory");
            const unsigned og = xb_add(&bar[XB_TOP], 1u);
            const unsigned tg = og / nx;
            if (og + 1u == (tg + 1u) * nx) xb_add(&bar[XB_TOPGEN], 1u);
            else XB_SPIN(xb_ld(&bar[XB_TOPGEN]) == tg, bar);
            __builtin_amdgcn_fence(__ATOMIC_ACQUIRE, "agent");
            xb_add(&bar[XB_XGEN(b.x)], 1u);
            asm volatile("s_waitcnt vmcnt(0)" ::: "memory");
        } else {
            XB_SPIN(xb_ld(&bar[XB_XGEN(b.x)]) == gen, bar);
            __builtin_amdgcn_fence(__ATOMIC_ACQUIRE, "agent");
            asm volatile("s_waitcnt vmcnt(0)" ::: "memory");
        }
    }
    __syncthreads();
}
struct Frame {
    LAS unsigned char* lds;
    volatile LAS unsigned* MISC;
    gu32* ctl;
    int tid, lane, wave;
    int vcu, G;
    const float* in[19]; float* out; unsigned char* ws;
};
typedef float f32x2 __attribute__((ext_vector_type(2)));
template <int CTRL> __device__ __forceinline__ float dppf(float v) { return __builtin_bit_cast(float, __builtin_amdgcn_update_dpp(0, __builtin_bit_cast(int, v), CTRL, 0xf, 0xf, true)); }
__device__ __forceinline__ float wave_sum(float v) {
    v += dppf<0xB1>(v);
    v += dppf<0x4E>(v);
    v += dppf<0x141>(v);
    v += dppf<0x140>(v);
    const int iv = __builtin_bit_cast(int, v);
    const float s0 = __builtin_bit_cast(float, __builtin_amdgcn_readlane(iv, 0)), s1 = __builtin_bit_cast(float, __builtin_amdgcn_readlane(iv, 16));
    const float s2 = __builtin_bit_cast(float, __builtin_amdgcn_readlane(iv, 32)), s3 = __builtin_bit_cast(float, __builtin_amdgcn_readlane(iv, 48));
    return (s0 + s1) + (s2 + s3);
}
__device__ __forceinline__ float bf_lo(unsigned u) { return __builtin_bit_cast(float, u << 16); }
__device__ __forceinline__ float bf_hi(unsigned u) { return __builtin_bit_cast(float, u & 0xffff0000u); }
__device__ __forceinline__ float sigmoidf_(float x) { return 1.0f / (1.0f + __expf(-x)); }
__device__ __forceinline__ float siluf_(float x) { return x / (1.0f + __expf(-x)); }

__device__ __forceinline__ void transpose_item(const float* W, int ldw, int k0, int n_src, bf16* WT, int K, int n_dst, LAS float* scr, int lane) {
#pragma unroll 8
    for (int i = 0; i < 32; ++i) { const int kk = 2 * i + (lane >> 5); scr[kk * 33 + (lane & 31)] = W[(size_t)(k0 + kk) * ldw + n_src + (lane & 31)]; }
    LDS_WAIT(); asm volatile("" ::: "memory");
    const int c = lane & 7;
#pragma unroll
    for (int j = 0; j < 4; ++j) { const int n = (lane >> 3) + 8 * j; const LAS float* s = scr + (8 * c) * 33 + n;
        v4u o; o.x = pk2(s[0 * 33], s[1 * 33]); o.y = pk2(s[2 * 33], s[3 * 33]); o.z = pk2(s[4 * 33], s[5 * 33]); o.w = pk2(s[6 * 33], s[7 * 33]);
        *(GAS v4u*)(WT + (size_t)(n_dst + n) * K + k0 + 8 * c) = o; }
    LDS_WAIT(); asm volatile("" ::: "memory");
}
__device__ __forceinline__ void p0_prologue(Frame& F) {
    const float* c = F.in[1]; const float* w_ada = F.in[2]; const float* b_ada = F.in[3];
    float* MOD = (float*)(F.ws + WS_MOD);
    for (int item = blockIdx.x; item < (NMOD * D) / 32; item += F.G) {
        LAS float* cs = (LAS float*)(F.lds + RING_OFF);
        LAS float* red = (LAS float*)(F.lds + RING_OFF + 32768);
        for (int i = F.tid; i < BATCH * D; i += NWAVES * 64) cs[i] = siluf_(c[i]);
        __syncthreads();
        const int n0 = 32 * item, col = F.lane & 31, kp = F.lane >> 5;
        float acc[8];
#pragma unroll
        for (int b = 0; b < 8; ++b) acc[b] = 0.f;
#pragma unroll 8
        for (int i = 0; i < 64; ++i) { const int k = 128 * F.wave + 2 * i + kp; const float wv = w_ada[(size_t)k * (NMOD * D) + n0 + col];
#pragma unroll
            for (int b = 0; b < 8; ++b) acc[b] += cs[b * D + k] * wv; }
#pragma unroll
        for (int b = 0; b < 8; ++b) { acc[b] += __shfl_xor(acc[b], 32); if (F.lane < 32) red[(F.wave * 8 + b) * 32 + col] = acc[b]; }
        __syncthreads();
        if (F.tid < 256) { const int b = F.tid >> 5, cc = F.tid & 31; float s = b_ada[n0 + cc];
#pragma unroll
            for (int w = 0; w < 8; ++w) s += red[(w * 8 + b) * 32 + cc];
            MOD[b * (NMOD * D) + n0 + cc] = s; }
        __syncthreads();
    }
    LAS float* scr = (LAS float*)(F.lds + RING_OFF + F.wave * 16384);
    const int gw = F.vcu * NWAVES + F.wave, NGW = F.G * NWAVES;
    constexpr int I_IN = (D / 64) * (NIN_G / 32), I_OUT = (D / 64) * (D / 32), I_FI = (D / 64) * (2 * FF / 32), I_FO = (FF / 64) * (D / 32);
    constexpr int NITEMS = I_IN + I_OUT + I_FI + I_FO;
    bf16* WIN = (bf16*)(F.ws + WS_WIN); bf16* WOUT = (bf16*)(F.ws + WS_WOUT); bf16* WFI = (bf16*)(F.ws + WS_WFI); bf16* WFO = (bf16*)(F.ws + WS_WFO);
    for (int it = gw; it < NITEMS; it += NGW) {
        int r = it;
        if (r < I_IN) { const int nblk = NIN_G / 32, kb = r / nblk, nb = r % nblk; transpose_item(F.in[5], NIN, 64 * kb, 32 * nb, WIN, D, 32 * nb, scr, F.lane); continue; } r -= I_IN;
        if (r < I_OUT) { const int nblk = D / 32, kb = r / nblk, nb = r % nblk; transpose_item(F.in[14], D, 64 * kb, 32 * nb, WOUT, D, 32 * nb, scr, F.lane); continue; } r -= I_OUT;
        if (r < I_FI) { const int nblk = 2 * FF / 32, kb = r / nblk, nb = r % nblk; const int nd = 32 * nb, t = nd >> 8, rr = nd & 255;
            const int ns = rr < 128 ? t * 128 + rr : FF + t * 128 + (rr - 128);
            transpose_item(F.in[16], 2 * FF, 64 * kb, ns, WFI, D, nd, scr, F.lane); continue; } r -= I_FI;
        { const int nblk = D / 32, kb = r / nblk, nb = r % nblk; transpose_item(F.in[17], D, 64 * kb, 32 * nb, WFO, FF, 32 * nb, scr, F.lane); }
    }
}

template <bool WITH_BA>
__device__ __forceinline__ void norm_mod_phase(Frame& F, const float* src, const float* nw, const float* shift, const float* scale, bf16* dst) {
    const int gw = F.vcu * NWAVES + F.wave, NGW = F.G * NWAVES;
    constexpr int RPW = 8;
    f32x4 w8a[WITH_BA ? 16 : 1], w8b[WITH_BA ? 16 : 1];
    if (WITH_BA) {
        const float* w_in = F.in[5];
#pragma unroll
        for (int j = 0; j < 4; ++j)
#pragma unroll
            for (int e = 0; e < 4; ++e) { const int k = 4 * F.lane + 256 * j + e; w8a[j * 4 + e] = *(const f32x4*)(w_in + (size_t)k * NIN + NIN_G); w8b[j * 4 + e] = *(const f32x4*)(w_in + (size_t)k * NIN + NIN_G + 4); }
    }
    for (int it = gw; it < M / RPW; it += NGW) {
        const int m0 = it * RPW, b = m0 / SEQ;
        f32x4 wv[4], sv[4];
#pragma unroll
        for (int j = 0; j < 4; ++j) { const int cidx = 4 * F.lane + 256 * j; const f32x4 n4 = *(const f32x4*)(nw + cidx), sc = *(const f32x4*)(scale + (size_t)b * (NMOD * D) + cidx);
            wv[j] = n4 * (sc + 1.0f); sv[j] = *(const f32x4*)(shift + (size_t)b * (NMOD * D) + cidx); }
        f32x4 nx[4];
        { const GAS f32x4* xr = (const GAS f32x4*)(src + (size_t)m0 * D) + F.lane;
#pragma unroll
          for (int j = 0; j < 4; ++j) nx[j] = xr[64 * j]; }
        for (int r = 0; r < RPW; ++r) {
            const int m = m0 + r;
            f32x4 v[4]; float s = 0.f;
#pragma unroll
            for (int j = 0; j < 4; ++j) { v[j] = nx[j]; s += (v[j].x * v[j].x + v[j].y * v[j].y) + (v[j].z * v[j].z + v[j].w * v[j].w); }
            { const GAS f32x4* xr = (const GAS f32x4*)(src + (size_t)(m0 + (r + 1 < RPW ? r + 1 : r)) * D) + F.lane;
#pragma unroll
              for (int j = 0; j < 4; ++j) nx[j] = xr[64 * j]; }
            const float rstd = 1.0f / sqrtf(wave_sum(s) * (1.f / D) + EPS);
            GAS unsigned long long* o8 = (GAS unsigned long long*)(dst + (size_t)m * D) + F.lane;
#pragma unroll
            for (int j = 0; j < 4; ++j) { v[j] = v[j] * rstd * wv[j] + sv[j];
                o8[64 * j] = (unsigned long long)pk2(v[j].x, v[j].y) | ((unsigned long long)pk2(v[j].z, v[j].w) << 32); }
            if (WITH_BA) {
                f32x4 pa = {0.f, 0.f, 0.f, 0.f}, pb = {0.f, 0.f, 0.f, 0.f};
#pragma unroll
                for (int j = 0; j < 4; ++j) { pa += w8a[j * 4 + 0] * v[j].x + w8a[j * 4 + 1] * v[j].y + w8a[j * 4 + 2] * v[j].z + w8a[j * 4 + 3] * v[j].w;
                    pb += w8b[j * 4 + 0] * v[j].x + w8b[j * 4 + 1] * v[j].y + w8b[j * 4 + 2] * v[j].z + w8b[j * 4 + 3] * v[j].w; }
                float p[8] = {pa.x, pa.y, pa.z, pa.w, pb.x, pb.y, pb.z, pb.w};
#pragma unroll
                for (int q = 0; q < 8; ++q) p[q] = wave_sum(p[q]);
                const int l = F.lane & 7, h = l & 3;
                float mine = p[0];
#pragma unroll
                for (int q = 1; q < 8; ++q) mine = (l == q) ? p[q] : mine;
                const float a_log = F.in[11][h], dtb = F.in[12][h];
                const float xx = mine + dtb; const float sp = xx > 20.f ? xx : log1pf(expf(xx));
                const float val = (l < 4) ? 1.0f / (1.0f + expf(-mine)) : -expf(a_log) * sp;
                if (F.lane < 8) ((float*)(F.ws + WS_BG))[(size_t)m * 8 + l] = val;
            }
        }
    }
}

__device__ __forceinline__ void final_norm_phase(Frame& F, float* io, const float* nw) {
    const int gw = F.vcu * NWAVES + F.wave, NGW = F.G * NWAVES;
    f32x4 wv[4];
#pragma unroll
    for (int j = 0; j < 4; ++j) wv[j] = *(const f32x4*)(nw + 4 * F.lane + 256 * j);
    for (int m = 2 * gw; m < M; m += 2 * NGW) {
        GAS f32x4* xr = (GAS f32x4*)(io + (size_t)m * D) + F.lane;
        f32x4 v[4], u[4]; float s = 0.f, t = 0.f;
#pragma unroll
        for (int j = 0; j < 4; ++j) { v[j] = xr[64 * j]; u[j] = xr[256 + 64 * j]; }
#pragma unroll
        for (int j = 0; j < 4; ++j) { s += (v[j].x * v[j].x + v[j].y * v[j].y) + (v[j].z * v[j].z + v[j].w * v[j].w); t += (u[j].x * u[j].x + u[j].y * u[j].y) + (u[j].z * u[j].z + u[j].w * u[j].w); }
        const float rs = 1.0f / sqrtf(wave_sum(s) * (1.f / D) + EPS), rt_ = 1.0f / sqrtf(wave_sum(t) * (1.f / D) + EPS);
#pragma unroll
        for (int j = 0; j < 4; ++j) { xr[64 * j] = v[j] * rs * wv[j]; xr[256 + 64 * j] = u[j] * rt_ * wv[j]; }
    }
}

__device__ __forceinline__ void conformer_phase(Frame& F) {
    const bf16* P = (const bf16*)(F.ws + WS_P); bf16* MIX = (bf16*)(F.ws + WS_MIXIN);
    const float* conv_w = F.in[6]; const float* conv_b = F.in[7]; const float* gn_w = F.in[8]; const float* gn_b = F.in[9];
    LAS float* ub = (LAS float*)(F.lds + RING_OFF);
    constexpr int NR = CL + CONVK - 1;
    const int nsc = (MK_ONE_LAUNCH || 1) ? BATCH * NH : 0;
    for (int item = (int)blockIdx.x - nsc; item < (M / CL) * 8; item += F.G - nsc) {
        const int tt = item >> 3, g = item & 7, m0 = tt * CL, t0 = m0 % SEQ;
        for (int idx = F.tid; idx < NR * 32; idx += NWAVES * 64) { const int r = idx >> 5, cp = idx & 31; const int t = t0 - (CONVK - 1) + r;
            float u0 = 0.f, u1 = 0.f;
            if (t >= 0) { const size_t off = (size_t)(m0 - (CONVK - 1) + r) * NIN_G + g * 64 + 2 * cp;
                const unsigned a2 = *(const unsigned*)(P + off + PC_A), g2 = *(const unsigned*)(P + off + PC_GATE);
                u0 = bf_lo(a2) * sigmoidf_(bf_lo(g2)); u1 = bf_hi(a2) * sigmoidf_(bf_hi(g2)); }
            *(LAS f32x2*)(ub + r * 64 + 2 * cp) = (f32x2){u0, u1}; }
        const int c = F.tid & 63, tb = F.tid >> 6, ch = g * 64 + c;
        float w[CONVK];
#pragma unroll
        for (int k = 0; k < CONVK; ++k) w[k] = conv_w[k * CW + ch];
        const float bias = conv_b[ch], gw_ = gn_w[ch], gb_ = gn_b[ch];
        __syncthreads();
        float acc[8];
#pragma unroll
        for (int i = 0; i < 8; ++i) acc[i] = bias;
#pragma unroll
        for (int k = 0; k < 8 + CONVK - 1; ++k) { const float uv = ub[(8 * tb + k) * 64 + c];
#pragma unroll
            for (int i = 0; i < 8; ++i) { const int tap = k - i; if (tap >= 0 && tap < CONVK) acc[i] += w[tap] * uv; } }
#pragma unroll
        for (int i = 0; i < 8; ++i) { const float mu = wave_sum(acc[i]) * (1.f / 64.f), d = acc[i] - mu, var = wave_sum(d * d) * (1.f / 64.f);
            const float y = d * (1.0f / sqrtf(var + EPS)) * gw_ + gb_;
            MIX[(size_t)(m0 + 8 * tb + i) * D + ch] = (bf16)f2bf(siluf_(y)); }
        __syncthreads();
    }
}

__device__ __forceinline__ void gdn_prep_simple(Frame& F) {
    const bf16* P = (const bf16*)(F.ws + WS_P); const float* cw = F.in[10];
    float* QN = (float*)(F.ws + WS_QN); float* KN = (float*)(F.ws + WS_KN); float* VN = (float*)(F.ws + WS_VN);
    const int gw = F.vcu * NWAVES + F.wave, NGW = F.G * NWAVES;
    for (int m = gw; m < M; m += NGW) {
        const int t = m % SEQ;
#pragma unroll
        for (int i = 0; i < 12; ++i) {
            const int ch = 128 * i + 2 * F.lane;
            float y0 = 0.f, y1 = 0.f;
#pragma unroll
            for (int j = 0; j < 4; ++j) { const int tj = t - 3 + j; if (tj >= 0) { const unsigned pv = *(const unsigned*)(P + (size_t)(m - 3 + j) * NIN_G + PC_Q + ch);
                    const f32x2 wj = *(const f32x2*)(cw + j * (3 * GW) + ch); y0 += wj.x * bf_lo(pv); y1 += wj.y * bf_hi(pv); } }
            y0 = siluf_(y0); y1 = siluf_(y1);
            if (i < 8) { const float ss = wave_sum(y0 * y0 + y1 * y1); float r = 1.0f / sqrtf(ss + EPS); if (i < 4) r *= 0.08838834764831845f; y0 *= r; y1 *= r; }
            float* dstp = (i < 4) ? QN + (size_t)m * GW + ch : (i < 8) ? KN + (size_t)m * GW + (ch - 512) : VN + (size_t)m * GW + (ch - 1024);
            *(f32x2*)dstp = (f32x2){y0, y1};
        }
    }
}
__device__ __forceinline__ void gdn_recurrent_simple(Frame& F) {
    const bf16* P = (const bf16*)(F.ws + WS_P); bf16* MIX = (bf16*)(F.ws + WS_MIXIN);
    const float* QN = (const float*)(F.ws + WS_QN); const float* KN = (const float*)(F.ws + WS_KN); const float* VN = (const float*)(F.ws + WS_VN);
    const float* BG = (const float*)(F.ws + WS_BG); const float* nw = F.in[13];
    LAS float* QS = (LAS float*)(F.lds + RING_OFF); LAS float* KS = QS + CL * HD; LAS float* VS = KS + CL * HD; LAS float* OS = VS + CL * HD;
    LAS float* BS = (LAS float*)(F.lds + EXTRA_OFF);
    for (int item = blockIdx.x; item < BATCH * NH; item += F.G) {
        const int b = item / NH, h = item % NH;
        const int col = 16 * F.wave + (F.lane & 15), qd = F.lane >> 4;
        float S[32];
#pragma unroll
        for (int i = 0; i < 32; ++i) S[i] = 0.f;
        for (int ch = 0; ch < SEQ / CL; ++ch) {
            const int m0 = b * SEQ + ch * CL;
            for (int idx = F.tid; idx < CL * HD / 4; idx += NWAVES * 64) { const int r = idx >> 5, c4 = idx & 31; const size_t off = (size_t)(m0 + r) * GW + h * HD + 4 * c4;
                *(LAS f32x4*)(QS + r * HD + 4 * c4) = *(const f32x4*)(QN + off); *(LAS f32x4*)(KS + r * HD + 4 * c4) = *(const f32x4*)(KN + off); *(LAS f32x4*)(VS + r * HD + 4 * c4) = *(const f32x4*)(VN + off); }
            if (F.tid < 64) { BS[F.tid] = BG[(size_t)(m0 + F.tid) * 8 + h]; BS[64 + F.tid] = expf(BG[(size_t)(m0 + F.tid) * 8 + 4 + h]); }
            __syncthreads();
            for (int t = 0; t < CL; ++t) {
                float kv[32], qv[32];
#pragma unroll
                for (int i = 0; i < 8; ++i) { const f32x4 k4 = *(const LAS f32x4*)(KS + t * HD + 32 * qd + 4 * i), q4 = *(const LAS f32x4*)(QS + t * HD + 32 * qd + 4 * i);
                    kv[4 * i] = k4.x; kv[4 * i + 1] = k4.y; kv[4 * i + 2] = k4.z; kv[4 * i + 3] = k4.w; qv[4 * i] = q4.x; qv[4 * i + 1] = q4.y; qv[4 * i + 2] = q4.z; qv[4 * i + 3] = q4.w; }
                const float beta = BS[t], eg = BS[64 + t], vv = VS[t * HD + col];
                float ks = 0.f;
#pragma unroll
                for (int i = 0; i < 32; ++i) ks += kv[i] * S[i];
                ks += __shfl_xor(ks, 16); ks += __shfl_xor(ks, 32);
                const float dd = beta * (vv - eg * ks);
                float o = 0.f;
#pragma unroll
                for (int i = 0; i < 32; ++i) { S[i] = eg * S[i] + kv[i] * dd; o += qv[i] * S[i]; }
                o += __shfl_xor(o, 16); o += __shfl_xor(o, 32);
                if (qd == 0) OS[t * HD + col] = o;
            }
            __syncthreads();
#pragma unroll
            for (int r = 0; r < 8; ++r) { const int t = 8 * F.wave + r; const f32x2 o2 = *(const LAS f32x2*)(OS + t * HD + 2 * F.lane);
                const float ss = wave_sum(o2.x * o2.x + o2.y * o2.y); const float rr = 1.0f / sqrtf(ss * (1.f / HD) + EPS);
                const unsigned z2 = *(const unsigned*)(P + (size_t)(m0 + t) * NIN_G + PC_Z + h * HD + 2 * F.lane);
                const f32x2 n2 = *(const f32x2*)(nw + 2 * F.lane);
                const float y0 = o2.x * rr * n2.x * siluf_(bf_lo(z2)), y1 = o2.y * rr * n2.y * siluf_(bf_hi(z2));
                *(unsigned*)(MIX + (size_t)(m0 + t) * D + GW + h * HD + 2 * F.lane) = pk2(y0, y1); }
            __syncthreads();
        }
    }
}
typedef float f32x16 __attribute__((ext_vector_type(16)));
typedef unsigned u32x2 __attribute__((ext_vector_type(2)));
#define MFMA32(a, b, c) __builtin_amdgcn_mfma_f32_32x32x16_bf16((a), (b), (c), 0, 0, 0)
constexpr size_t WS_WIMG = 188 * MiB, WS_QIMG = 204 * MiB, WS_KTIMG = 220 * MiB, WS_UT = 236 * MiB, WS_QKIMG = 28 * MiB;
constexpr size_t WS_CD = 1 * MiB + 256 * 1024;
__device__ __forceinline__ int perm16(int x) { const int o = x & 15; return (x & ~15) | (8 * ((o >> 2) & 1) + 4 * (o >> 3) + (o & 3)); }
typedef __bf16 bf16x2_t __attribute__((ext_vector_type(2)));
__device__ __forceinline__ unsigned cvtpk(float lo, float hi) { const f32x2 v = {lo, hi}; return __builtin_bit_cast(unsigned, __builtin_convertvector(v, bf16x2_t)); }
__device__ __forceinline__ bf16x8 pack8(float a0, float a1, float a2, float a3, float a4, float a5, float a6, float a7) {
    v4u u; u.x = cvtpk(a0, a1); u.y = cvtpk(a2, a3); u.z = cvtpk(a4, a5); u.w = cvtpk(a6, a7); return __builtin_bit_cast(bf16x8, u); }

constexpr int PL_KR = 0, PL_KBR = 17408, PL_QR = 34816, PL_KBGT = 52224, PL_VBT = 70656, PL_AB = 89088, PL_TB = 105472, PL_GC = 114688;
constexpr int RP = 272, TP = 144;

__device__ __forceinline__ void gdn_prep_phase(Frame& F) {
    const bf16* P = (const bf16*)(F.ws + WS_P); const float* BG = (const float*)(F.ws + WS_BG); const float* cw = F.in[10];
    const int w = F.wave;
    LAS unsigned char* L = F.lds + RING_OFF;
    LAS float* GC = (LAS float*)(L + PL_GC); LAS float* AB = (LAS float*)(L + PL_AB);
    for (int item = F.vcu; item < BATCH * NH * (SEQ / CL); item += F.G) {
        int lane = F.lane; asm volatile("" : "+v"(lane));
        const int l31 = lane & 31, hh = lane >> 5;
        const int b = item >> 7, h = (item >> 5) & 3, n = item & 31, m0 = b * SEQ + n * CL, t0 = n * CL;
        unsigned char* Wimg = F.ws + WS_WIMG + (size_t)item * 16384; unsigned char* Qimg = F.ws + WS_QIMG + (size_t)item * 16384;
        unsigned char* KTimg = F.ws + WS_KTIMG + (size_t)item * 16384; unsigned char* QKimg = F.ws + WS_QKIMG + (size_t)item * 8192; unsigned char* UT = F.ws + WS_UT + (size_t)item * 16384;
        float gc = BG[(size_t)(m0 + lane) * 8 + 4 + h]; const float btl = BG[(size_t)(m0 + lane) * 8 + h];
#pragma unroll
        for (int o = 1; o < 64; o <<= 1) { const float t = __shfl_up(gc, o); if (lane >= o) gc += t; }
        const float glast = __shfl(gc, 63);
        if (w == 0) { GC[lane] = gc; if (lane == 0) ((float*)(F.ws + WS_CD))[item] = __expf(glast); }
        unsigned xq[11], xk[11], xv[11];
#pragma unroll
        for (int r = 0; r < 11; ++r) { const int tok = 8 * w - 3 + r; xq[r] = 0u; xk[r] = 0u; xv[r] = 0u;
            if (t0 + tok >= 0) { const bf16* base = P + (size_t)(m0 + tok) * NIN_G + h * HD + 2 * lane; xq[r] = *(const unsigned*)(base + PC_Q); xk[r] = *(const unsigned*)(base + PC_K); xv[r] = *(const unsigned*)(base + PC_V); } }
        f32x2 wq[4], wk[4], wvv[4];
#pragma unroll
        for (int j = 0; j < 4; ++j) { const float* cj = cw + j * (3 * GW) + h * HD + 2 * lane; wq[j] = *(const f32x2*)cj; wk[j] = *(const f32x2*)(cj + GW); wvv[j] = *(const f32x2*)(cj + 2 * GW); }
        float kbg0[8], kbg1[8], vb0[8], vb1[8], kd0[8], kd1[8];
#pragma unroll
        for (int i = 0; i < 8; ++i) {
            float q0 = 0.f, q1 = 0.f, k0 = 0.f, k1 = 0.f, v0 = 0.f, v1 = 0.f;
#pragma unroll
            for (int j = 0; j < 4; ++j) { q0 += wq[j].x * bf_lo(xq[i + j]); q1 += wq[j].y * bf_hi(xq[i + j]); k0 += wk[j].x * bf_lo(xk[i + j]); k1 += wk[j].y * bf_hi(xk[i + j]);
                v0 += wvv[j].x * bf_lo(xv[i + j]); v1 += wvv[j].y * bf_hi(xv[i + j]); }
            q0 = siluf_(q0); q1 = siluf_(q1); k0 = siluf_(k0); k1 = siluf_(k1); v0 = siluf_(v0); v1 = siluf_(v1);
            const float rq = 0.08838834764831845f / sqrtf(wave_sum(q0 * q0 + q1 * q1) + EPS), rk = 1.0f / sqrtf(wave_sum(k0 * k0 + k1 * k1) + EPS);
            q0 *= rq; q1 *= rq; k0 *= rk; k1 *= rk;
            const int tok = 8 * w + i;
            const float gci = __shfl(gc, tok), bti = __shfl(btl, tok), eg = __expf(gci), egl = __expf(glast - gci);
            *(LAS unsigned*)(L + PL_KR + tok * RP + 4 * lane) = cvtpk(k0, k1);
            *(LAS unsigned*)(L + PL_KBR + tok * RP + 4 * lane) = cvtpk(k0 * bti, k1 * bti);
            *(LAS unsigned*)(L + PL_QR + tok * RP + 4 * lane) = cvtpk(q0, q1);
            { const int pos = perm16(2 * lane), chunk = pos >> 3; *(unsigned*)(Qimg + tok * 256 + ((chunk ^ (tok & 15)) << 4) + (pos & 7) * 2) = cvtpk(q0 * eg, q1 * eg); }
            kbg0[i] = -k0 * bti * eg; kbg1[i] = -k1 * bti * eg; vb0[i] = v0 * bti; vb1[i] = v1 * bti; kd0[i] = k0 * egl; kd1[i] = k1 * egl;
        }
        { const int c0 = 2 * lane, c1 = 2 * lane + 1;
          *(LAS bf16x8*)(L + PL_KBGT + c0 * TP + 16 * w) = pack8(kbg0[0], kbg0[1], kbg0[2], kbg0[3], kbg0[4], kbg0[5], kbg0[6], kbg0[7]);
          *(LAS bf16x8*)(L + PL_KBGT + c1 * TP + 16 * w) = pack8(kbg1[0], kbg1[1], kbg1[2], kbg1[3], kbg1[4], kbg1[5], kbg1[6], kbg1[7]);
          *(LAS bf16x8*)(L + PL_VBT + c0 * TP + 16 * w) = pack8(vb0[0], vb0[1], vb0[2], vb0[3], vb0[4], vb0[5], vb0[6], vb0[7]);
          *(LAS bf16x8*)(L + PL_VBT + c1 * TP + 16 * w) = pack8(vb1[0], vb1[1], vb1[2], vb1[3], vb1[4], vb1[5], vb1[6], vb1[7]);
          const int chA = 2 * (w >> 1), ob = 8 * (w & 1);
          { const int sw = (c0 >> 1) & 7; u32x2 a, bq; a.x = cvtpk(kd0[0], kd0[1]); a.y = cvtpk(kd0[2], kd0[3]); bq.x = cvtpk(kd0[4], kd0[5]); bq.y = cvtpk(kd0[6], kd0[7]);
            *(u32x2*)(KTimg + c0 * 128 + ((chA ^ sw) << 4) + ob) = a; *(u32x2*)(KTimg + c0 * 128 + (((chA + 1) ^ sw) << 4) + ob) = bq; }
          { const int sw = (c1 >> 1) & 7; u32x2 a, bq; a.x = cvtpk(kd1[0], kd1[1]); a.y = cvtpk(kd1[2], kd1[3]); bq.x = cvtpk(kd1[4], kd1[5]); bq.y = cvtpk(kd1[6], kd1[7]);
            *(u32x2*)(KTimg + c1 * 128 + ((chA ^ sw) << 4) + ob) = a; *(u32x2*)(KTimg + c1 * 128 + (((chA + 1) ^ sw) << 4) + ob) = bq; } }
        __syncthreads();
        { const int tc = (w >> 1) & 1, te = w & 1; const bool isqk = w >= 4;
          f32x16 acc;
#pragma unroll
          for (int r = 0; r < 16; ++r) acc[r] = 0.f;
          if (!(tc == 0 && te == 1)) {
              const LAS unsigned char* ap = L + PL_KR + (32 * te + l31) * RP + hh * 16; const LAS unsigned char* bp = L + (isqk ? PL_QR : PL_KBR) + (32 * tc + l31) * RP + hh * 16;
#pragma unroll
              for (int s = 0; s < 8; ++s) acc = MFMA32(*(const LAS bf16x8*)(ap + 32 * s), *(const LAS bf16x8*)(bp + 32 * s), acc);
          }
          const int c = 32 * tc + l31; const float gcc = GC[c]; const int sw = (c >> 1) & 7;
#pragma unroll
          for (int g = 0; g < 4; ++g) { float v[4];
#pragma unroll
              for (int i = 0; i < 4; ++i) { const int e = 32 * te + 8 * g + 4 * hh + i; const bool keep = isqk ? (c >= e) : (c > e); const float dv_ = acc[4 * g + i] * __expf(fminf(gcc - GC[e], 0.f)); v[i] = keep ? dv_ : 0.f; }
              if (isqk) { const int chunk = 4 * te + 2 * (g >> 1) + hh; u32x2 o; o.x = cvtpk(v[0], v[1]); o.y = cvtpk(v[2], v[3]);
                  *(u32x2*)(QKimg + c * 128 + ((chunk ^ sw) << 4) + 8 * (g & 1)) = o; }
              else {
#pragma unroll
                  for (int i = 0; i < 4; ++i) AB[(32 * te + 8 * g + 4 * hh + i) * 64 + c] = v[i]; } } }
        __syncthreads();
        if (w == 0) {
            float T[64];
#pragma unroll
            for (int i = 0; i < 64; ++i) T[i] = (lane == i) ? 1.f : 0.f;
            f32x4 a0, a1, a2, a3, a4, a5, a6, a7;
            a0 = *(const LAS f32x4*)(AB + 0);
            a1 = *(const LAS f32x4*)(AB + 4);
            a2 = *(const LAS f32x4*)(AB + 8);
            a3 = *(const LAS f32x4*)(AB + 12);
            a4 = *(const LAS f32x4*)(AB + 16);
            a5 = *(const LAS f32x4*)(AB + 20);
            a6 = *(const LAS f32x4*)(AB + 24);
            a7 = *(const LAS f32x4*)(AB + 28);
            asm volatile("" ::: "memory"); T[1] -= a0.y * T[0]; T[2] -= a0.z * T[0]; T[3] -= a0.w * T[0]; a0 = *(const LAS f32x4*)(AB + 32);
            asm volatile("" ::: "memory"); T[4] -= a1.x * T[0]; T[5] -= a1.y * T[0]; T[6] -= a1.z * T[0]; T[7] -= a1.w * T[0]; a1 = *(const LAS f32x4*)(AB + 36);
            asm volatile("" ::: "memory"); T[8] -= a2.x * T[0]; T[9] -= a2.y * T[0]; T[10] -= a2.z * T[0]; T[11] -= a2.w * T[0]; a2 = *(const LAS f32x4*)(AB + 40);
            asm volatile("" ::: "memory"); T[12] -= a3.x * T[0]; T[13] -= a3.y * T[0]; T[14] -= a3.z * T[0]; T[15] -= a3.w * T[0]; a3 = *(const LAS f32x4*)(AB + 44);
            asm volatile("" ::: "memory"); T[16] -= a4.x * T[0]; T[17] -= a4.y * T[0]; T[18] -= a4.z * T[0]; T[19] -= a4.w * T[0]; a4 = *(const LAS f32x4*)(AB + 48);
            asm volatile("" ::: "memory"); T[20] -= a5.x * T[0]; T[21] -= a5.y * T[0]; T[22] -= a5.z * T[0]; T[23] -= a5.w * T[0]; a5 = *(const LAS f32x4*)(AB + 52);
            asm volatile("" ::: "memory"); T[24] -= a6.x * T[0]; T[25] -= a6.y * T[0]; T[26] -= a6.z * T[0]; T[27] -= a6.w * T[0]; a6 = *(const LAS f32x4*)(AB + 56);
            asm volatile("" ::: "memory"); T[28] -= a7.x * T[0]; T[29] -= a7.y * T[0]; T[30] -= a7.z * T[0]; T[31] -= a7.w * T[0]; a7 = *(const LAS f32x4*)(AB + 60);
            asm volatile("" ::: "memory"); T[32] -= a0.x * T[0]; T[33] -= a0.y * T[0]; T[34] -= a0.z * T[0]; T[35] -= a0.w * T[0]; a0 = *(const LAS f32x4*)(AB + 64);
            asm volatile("" ::: "memory"); T[36] -= a1.x * T[0]; T[37] -= a1.y * T[0]; T[38] -= a1.z * T[0]; T[39] -= a1.w * T[0]; a1 = *(const LAS f32x4*)(AB + 68);
            asm volatile("" ::: "memory"); T[40] -= a2.x * T[0]; T[41] -= a2.y * T[0]; T[42] -= a2.z * T[0]; T[43] -= a2.w * T[0]; a2 = *(const LAS f32x4*)(AB + 72);
            asm volatile("" ::: "memory"); T[44] -= a3.x * T[0]; T[45] -= a3.y * T[0]; T[46] -= a3.z * T[0]; T[47] -= a3.w * T[0]; a3 = *(const LAS f32x4*)(AB + 76);
            asm volatile("" ::: "memory"); T[48] -= a4.x * T[0]; T[49] -= a4.y * T[0]; T[50] -= a4.z * T[0]; T[51] -= a4.w * T[0]; a4 = *(const LAS f32x4*)(AB + 80);
            asm volatile("" ::: "memory"); T[52] -= a5.x * T[0]; T[53] -= a5.y * T[0]; T[54] -= a5.z * T[0]; T[55] -= a5.w * T[0]; a5 = *(const LAS f32x4*)(AB + 84);
            asm volatile("" ::: "memory"); T[56] -= a6.x * T[0]; T[57] -= a6.y * T[0]; T[58] -= a6.z * T[0]; T[59] -= a6.w * T[0]; a6 = *(const LAS f32x4*)(AB + 88);
            asm volatile("" ::: "memory"); T[60] -= a7.x * T[0]; T[61] -= a7.y * T[0]; T[62] -= a7.z * T[0]; T[63] -= a7.w * T[0]; a7 = *(const LAS f32x4*)(AB + 92);
            asm volatile("" ::: "memory"); T[2] -= a0.z * T[1]; T[3] -= a0.w * T[1]; a0 = *(const LAS f32x4*)(AB + 96);
            asm volatile("" ::: "memory"); T[4] -= a1.x * T[1]; T[5] -= a1.y * T[1]; T[6] -= a1.z * T[1]; T[7] -= a1.w * T[1]; a1 = *(const LAS f32x4*)(AB + 100);
            asm volatile("" ::: "memory"); T[8] -= a2.x * T[1]; T[9] -= a2.y * T[1]; T[10] -= a2.z * T[1]; T[11] -= a2.w * T[1]; a2 = *(const LAS f32x4*)(AB + 104);
            asm volatile("" ::: "memory"); T[12] -= a3.x * T[1]; T[13] -= a3.y * T[1]; T[14] -= a3.z * T[1]; T[15] -= a3.w * T[1]; a3 = *(const LAS f32x4*)(AB + 108);
            asm volatile("" ::: "memory"); T[16] -= a4.x * T[1]; T[17] -= a4.y * T[1]; T[18] -= a4.z * T[1]; T[19] -= a4.w * T[1]; a4 = *(const LAS f32x4*)(AB + 112);
            asm volatile("" ::: "memory"); T[20] -= a5.x * T[1]; T[21] -= a5.y * T[1]; T[22] -= a5.z * T[1]; T[23] -= a5.w * T[1]; a5 = *(const LAS f32x4*)(AB + 116);
            asm volatile("" ::: "memory"); T[24] -= a6.x * T[1]; T[25] -= a6.y * T[1]; T[26] -= a6.z * T[1]; T[27] -= a6.w * T[1]; a6 = *(const LAS f32x4*)(AB + 120);
            asm volatile("" ::: "memory"); T[28] -= a7.x * T[1]; T[29] -= a7.y * T[1]; T[30] -= a7.z * T[1]; T[31] -= a7.w * T[1]; a7 = *(const LAS f32x4*)(AB + 124);
            asm volatile("" ::: "memory"); T[32] -= a0.x * T[1]; T[33] -= a0.y * T[1]; T[34] -= a0.z * T[1]; T[35] -= a0.w * T[1]; a0 = *(const LAS f32x4*)(AB + 128);
            asm volatile("" ::: "memory"); T[36] -= a1.x * T[1]; T[37] -= a1.y * T[1]; T[38] -= a1.z * T[1]; T[39] -= a1.w * T[1]; a1 = *(const LAS f32x4*)(AB + 132);
            asm volatile("" ::: "memory"); T[40] -= a2.x * T[1]; T[41] -= a2.y * T[1]; T[42] -= a2.z * T[1]; T[43] -= a2.w * T[1]; a2 = *(const LAS f32x4*)(AB + 136);
            asm volatile("" ::: "memory"); T[44] -= a3.x * T[1]; T[45] -= a3.y * T[1]; T[46] -= a3.z * T[1]; T[47] -= a3.w * T[1]; a3 = *(const LAS f32x4*)(AB + 140);
            asm volatile("" ::: "memory"); T[48] -= a4.x * T[1]; T[49] -= a4.y * T[1]; T[50] -= a4.z * T[1]; T[51] -= a4.w * T[1]; a4 = *(const LAS f32x4*)(AB + 144);
            asm volatile("" ::: "memory"); T[52] -= a5.x * T[1]; T[53] -= a5.y * T[1]; T[54] -= a5.z * T[1]; T[55] -= a5.w * T[1]; a5 = *(const LAS f32x4*)(AB + 148);
            asm volatile("" ::: "memory"); T[56] -= a6.x * T[1]; T[57] -= a6.y * T[1]; T[58] -= a6.z * T[1]; T[59] -= a6.w * T[1]; a6 = *(const LAS f32x4*)(AB + 152);
            asm volatile("" ::: "memory"); T[60] -= a7.x * T[1]; T[61] -= a7.y * T[1]; T[62] -= a7.z * T[1]; T[63] -= a7.w * T[1]; a7 = *(const LAS f32x4*)(AB + 156);
            asm volatile("" ::: "memory"); T[3] -= a0.w * T[2]; a0 = *(const LAS f32x4*)(AB + 160);
            asm volatile("" ::: "memory"); T[4] -= a1.x * T[2]; T[5] -= a1.y * T[2]; T[6] -= a1.z * T[2]; T[7] -= a1.w * T[2]; a1 = *(const LAS f32x4*)(AB + 164);
            asm volatile("" ::: "memory"); T[8] -= a2.x * T[2]; T[9] -= a2.y * T[2]; T[10] -= a2.z * T[2]; T[11] -= a2.w * T[2]; a2 = *(const LAS f32x4*)(AB + 168);
            asm volatile("" ::: "memory"); T[12] -= a3.x * T[2]; T[13] -= a3.y * T[2]; T[14] -= a3.z * T[2]; T[15] -= a3.w * T[2]; a3 = *(const LAS f32x4*)(AB + 172);
            asm volatile("" ::: "memory"); T[16] -= a4.x * T[2]; T[17] -= a4.y * T[2]; T[18] -= a4.z * T[2]; T[19] -= a4.w * T[2]; a4 = *(const LAS f32x4*)(AB + 176);
            asm volatile("" ::: "memory"); T[20] -= a5.x * T[2]; T[21] -= a5.y * T[2]; T[22] -= a5.z * T[2]; T[23] -= a5.w * T[2]; a5 = *(const LAS f32x4*)(AB + 180);
            asm volatile("" ::: "memory"); T[24] -= a6.x * T[2]; T[25] -= a6.y * T[2]; T[26] -= a6.z * T[2]; T[27] -= a6.w * T[2]; a6 = *(const LAS f32x4*)(AB + 184);
            asm volatile("" ::: "memory"); T[28] -= a7.x * T[2]; T[29] -= a7.y * T[2]; T[30] -= a7.z * T[2]; T[31] -= a7.w * T[2]; a7 = *(const LAS f32x4*)(AB + 188);
            asm volatile("" ::: "memory"); T[32] -= a0.x * T[2]; T[33] -= a0.y * T[2]; T[34] -= a0.z * T[2]; T[35] -= a0.w * T[2]; a0 = *(const LAS f32x4*)(AB + 196);
            asm volatile("" ::: "memory"); T[36] -= a1.x * T[2]; T[37] -= a1.y * T[2]; T[38] -= a1.z * T[2]; T[39] -= a1.w * T[2]; a1 = *(const LAS f32x4*)(AB + 200);
            asm volatile("" ::: "memory"); T[40] -= a2.x * T[2]; T[41] -= a2.y * T[2]; T[42] -= a2.z * T[2]; T[43] -= a2.w * T[2]; a2 = *(const LAS f32x4*)(AB + 204);
            asm volatile("" ::: "memory"); T[44] -= a3.x * T[2]; T[45] -= a3.y * T[2]; T[46] -= a3.z * T[2]; T[47] -= a3.w * T[2]; a3 = *(const LAS f32x4*)(AB + 208);
            asm volatile("" ::: "memory"); T[48] -= a4.x * T[2]; T[49] -= a4.y * T[2]; T[50] -= a4.z * T[2]; T[51] -= a4.w * T[2]; a4 = *(const LAS f32x4*)(AB + 212);
            asm volatile("" ::: "memory"); T[52] -= a5.x * T[2]; T[53] -= a5.y * T[2]; T[54] -= a5.z * T[2]; T[55] -= a5.w * T[2]; a5 = *(const LAS f32x4*)(AB + 216);
            asm volatile("" ::: "memory"); T[56] -= a6.x * T[2]; T[57] -= a6.y * T[2]; T[58] -= a6.z * T[2]; T[59] -= a6.w * T[2]; a6 = *(const LAS f32x4*)(AB + 220);
            asm volatile("" ::: "memory"); T[60] -= a7.x * T[2]; T[61] -= a7.y * T[2]; T[62] -= a7.z * T[2]; T[63] -= a7.w * T[2]; a7 = *(const LAS f32x4*)(AB + 224);
            asm volatile("" ::: "memory"); T[4] -= a0.x * T[3]; T[5] -= a0.y * T[3]; T[6] -= a0.z * T[3]; T[7] -= a0.w * T[3]; a0 = *(const LAS f32x4*)(AB + 228);
            asm volatile("" ::: "memory"); T[8] -= a1.x * T[3]; T[9] -= a1.y * T[3]; T[10] -= a1.z * T[3]; T[11] -= a1.w * T[3]; a1 = *(const LAS f32x4*)(AB + 232);
            asm volatile("" ::: "memory"); T[12] -= a2.x * T[3]; T[13] -= a2.y * T[3]; T[14] -= a2.z * T[3]; T[15] -= a2.w * T[3]; a2 = *(const LAS f32x4*)(AB + 236);
            asm volatile("" ::: "memory"); T[16] -= a3.x * T[3]; T[17] -= a3.y * T[3]; T[18] -= a3.z * T[3]; T[19] -= a3.w * T[3]; a3 = *(const LAS f32x4*)(AB + 240);
            asm volatile("" ::: "memory"); T[20] -= a4.x * T[3]; T[21] -= a4.y * T[3]; T[22] -= a4.z * T[3]; T[23] -= a4.w * T[3]; a4 = *(const LAS f32x4*)(AB + 244);
            asm volatile("" ::: "memory"); T[24] -= a5.x * T[3]; T[25] -= a5.y * T[3]; T[26] -= a5.z * T[3]; T[27] -= a5.w * T[3]; a5 = *(const LAS f32x4*)(AB + 248);
            asm volatile("" ::: "memory"); T[28] -= a6.x * T[3]; T[29] -= a6.y * T[3]; T[30] -= a6.z * T[3]; T[31] -= a6.w * T[3]; a6 = *(const LAS f32x4*)(AB + 252);
            asm volatile("" ::: "memory"); T[32] -= a7.x * T[3]; T[33] -= a7.y * T[3]; T[34] -= a7.z * T[3]; T[35] -= a7.w * T[3]; a7 = *(const LAS f32x4*)(AB + 260);
            asm volatile("" ::: "memory"); T[36] -= a0.x * T[3]; T[37] -= a0.y * T[3]; T[38] -= a0.z * T[3]; T[39] -= a0.w * T[3]; a0 = *(const LAS f32x4*)(AB + 264);
            asm volatile("" ::: "memory"); T[40] -= a1.x * T[3]; T[41] -= a1.y * T[3]; T[42] -= a1.z * T[3]; T[43] -= a1.w * T[3]; a1 = *(const LAS f32x4*)(AB + 268);
            asm volatile("" ::: "memory"); T[44] -= a2.x * T[3]; T[45] -= a2.y * T[3]; T[46] -= a2.z * T[3]; T[47] -= a2.w * T[3]; a2 = *(const LAS f32x4*)(AB + 272);
            asm volatile("" ::: "memory"); T[48] -= a3.x * T[3]; T[49] -= a3.y * T[3]; T[50] -= a3.z * T[3]; T[51] -= a3.w * T[3]; a3 = *(const LAS f32x4*)(AB + 276);
            asm volatile("" ::: "memory"); T[52] -= a4.x * T[3]; T[53] -= a4.y * T[3]; T[54] -= a4.z * T[3]; T[55] -= a4.w * T[3]; a4 = *(const LAS f32x4*)(AB + 280);
            asm volatile("" ::: "memory"); T[56] -= a5.x * T[3]; T[57] -= a5.y * T[3]; T[58] -= a5.z * T[3]; T[59] -= a5.w * T[3]; a5 = *(const LAS f32x4*)(AB + 284);
            asm volatile("" ::: "memory"); T[60] -= a6.x * T[3]; T[61] -= a6.y * T[3]; T[62] -= a6.z * T[3]; T[63] -= a6.w * T[3]; a6 = *(const LAS f32x4*)(AB + 288);
            asm volatile("" ::: "memory"); T[5] -= a7.y * T[4]; T[6] -= a7.z * T[4]; T[7] -= a7.w * T[4]; a7 = *(const LAS f32x4*)(AB + 292);
            asm volatile("" ::: "memory"); T[8] -= a0.x * T[4]; T[9] -= a0.y * T[4]; T[10] -= a0.z * T[4]; T[11] -= a0.w * T[4]; a0 = *(const LAS f32x4*)(AB + 296);
            asm volatile("" ::: "memory"); T[12] -= a1.x * T[4]; T[13] -= a1.y * T[4]; T[14] -= a1.z * T[4]; T[15] -= a1.w * T[4]; a1 = *(const LAS f32x4*)(AB + 300);
            asm volatile("" ::: "memory"); T[16] -= a2.x * T[4]; T[17] -= a2.y * T[4]; T[18] -= a2.z * T[4]; T[19] -= a2.w * T[4]; a2 = *(const LAS f32x4*)(AB + 304);
            asm volatile("" ::: "memory"); T[20] -= a3.x * T[4]; T[21] -= a3.y * T[4]; T[22] -= a3.z * T[4]; T[23] -= a3.w * T[4]; a3 = *(const LAS f32x4*)(AB + 308);
            asm volatile("" ::: "memory"); T[24] -= a4.x * T[4]; T[25] -= a4.y * T[4]; T[26] -= a4.z * T[4]; T[27] -= a4.w * T[4]; a4 = *(const LAS f32x4*)(AB + 312);
            asm volatile("" ::: "memory"); T[28] -= a5.x * T[4]; T[29] -= a5.y * T[4]; T[30] -= a5.z * T[4]; T[31] -= a5.w * T[4]; a5 = *(const LAS f32x4*)(AB + 316);
            asm volatile("" ::: "memory"); T[32] -= a6.x * T[4]; T[33] -= a6.y * T[4]; T[34] -= a6.z * T[4]; T[35] -= a6.w * T[4]; a6 = *(const LAS f32x4*)(AB + 324);
            asm volatile("" ::: "memory"); T[36] -= a7.x * T[4]; T[37] -= a7.y * T[4]; T[38] -= a7.z * T[4]; T[39] -= a7.w * T[4]; a7 = *(const LAS f32x4*)(AB + 328);
            asm volatile("" ::: "memory"); T[40] -= a0.x * T[4]; T[41] -= a0.y * T[4]; T[42] -= a0.z * T[4]; T[43] -= a0.w * T[4]; a0 = *(const LAS f32x4*)(AB + 332);
            asm volatile("" ::: "memory"); T[44] -= a1.x * T[4]; T[45] -= a1.y * T[4]; T[46] -= a1.z * T[4]; T[47] -= a1.w * T[4]; a1 = *(const LAS f32x4*)(AB + 336);
            asm volatile("" ::: "memory"); T[48] -= a2.x * T[4]; T[49] -= a2.y * T[4]; T[50] -= a2.z * T[4]; T[51] -= a2.w * T[4]; a2 = *(const LAS f32x4*)(AB + 340);
            asm volatile("" ::: "memory"); T[52] -= a3.x * T[4]; T[53] -= a3.y * T[4]; T[54] -= a3.z * T[4]; T[55] -= a3.w * T[4]; a3 = *(const LAS f32x4*)(AB + 344);
            asm volatile("" ::: "memory"); T[56] -= a4.x * T[4]; T[57] -= a4.y * T[4]; T[58] -= a4.z * T[4]; T[59] -= a4.w * T[4]; a4 = *(const LAS f32x4*)(AB + 348);
            asm volatile("" ::: "memory"); T[60] -= a5.x * T[4]; T[61] -= a5.y * T[4]; T[62] -= a5.z * T[4]; T[63] -= a5.w * T[4]; a5 = *(const LAS f32x4*)(AB + 352);
            asm volatile("" ::: "memory"); T[6] -= a6.z * T[5]; T[7] -= a6.w * T[5]; a6 = *(const LAS f32x4*)(AB + 356);
            asm volatile("" ::: "memory"); T[8] -= a7.x * T[5]; T[9] -= a7.y * T[5]; T[10] -= a7.z * T[5]; T[11] -= a7.w * T[5]; a7 = *(const LAS f32x4*)(AB + 360);
            asm volatile("" ::: "memory"); T[12] -= a0.x * T[5]; T[13] -= a0.y * T[5]; T[14] -= a0.z * T[5]; T[15] -= a0.w * T[5]; a0 = *(const LAS f32x4*)(AB + 364);
            asm volatile("" ::: "memory"); T[16] -= a1.x * T[5]; T[17] -= a1.y * T[5]; T[18] -= a1.z * T[5]; T[19] -= a1.w * T[5]; a1 = *(const LAS f32x4*)(AB + 368);
            asm volatile("" ::: "memory"); T[20] -= a2.x * T[5]; T[21] -= a2.y * T[5]; T[22] -= a2.z * T[5]; T[23] -= a2.w * T[5]; a2 = *(const LAS f32x4*)(AB + 372);
            asm volatile("" ::: "memory"); T[24] -= a3.x * T[5]; T[25] -= a3.y * T[5]; T[26] -= a3.z * T[5]; T[27] -= a3.w * T[5]; a3 = *(const LAS f32x4*)(AB + 376);
            asm volatile("" ::: "memory"); T[28] -= a4.x * T[5]; T[29] -= a4.y * T[5]; T[30] -= a4.z * T[5]; T[31] -= a4.w * T[5]; a4 = *(const LAS f32x4*)(AB + 380);
            asm volatile("" ::: "memory"); T[32] -= a5.x * T[5]; T[33] -= a5.y * T[5]; T[34] -= a5.z * T[5]; T[35] -= a5.w * T[5]; a5 = *(const LAS f32x4*)(AB + 388);
            asm volatile("" ::: "memory"); T[36] -= a6.x * T[5]; T[37] -= a6.y * T[5]; T[38] -= a6.z * T[5]; T[39] -= a6.w * T[5]; a6 = *(const LAS f32x4*)(AB + 392);
            asm volatile("" ::: "memory"); T[40] -= a7.x * T[5]; T[41] -= a7.y * T[5]; T[42] -= a7.z * T[5]; T[43] -= a7.w * T[5]; a7 = *(const LAS f32x4*)(AB + 396);
            asm volatile("" ::: "memory"); T[44] -= a0.x * T[5]; T[45] -= a0.y * T[5]; T[46] -= a0.z * T[5]; T[47] -= a0.w * T[5]; a0 = *(const LAS f32x4*)(AB + 400);
            asm volatile("" ::: "memory"); T[48] -= a1.x * T[5]; T[49] -= a1.y * T[5]; T[50] -= a1.z * T[5]; T[51] -= a1.w * T[5]; a1 = *(const LAS f32x4*)(AB + 404);
            asm volatile("" ::: "memory"); T[52] -= a2.x * T[5]; T[53] -= a2.y * T[5]; T[54] -= a2.z * T[5]; T[55] -= a2.w * T[5]; a2 = *(const LAS f32x4*)(AB + 408);
            asm volatile("" ::: "memory"); T[56] -= a3.x * T[5]; T[57] -= a3.y * T[5]; T[58] -= a3.z * T[5]; T[59] -= a3.w * T[5]; a3 = *(const LAS f32x4*)(AB + 412);
            asm volatile("" ::: "memory"); T[60] -= a4.x * T[5]; T[61] -= a4.y * T[5]; T[62] -= a4.z * T[5]; T[63] -= a4.w * T[5]; a4 = *(const LAS f32x4*)(AB + 416);
            asm volatile("" ::: "memory"); T[7] -= a5.w * T[6]; a5 = *(const LAS f32x4*)(AB + 420);
            asm volatile("" ::: "memory"); T[8] -= a6.x * T[6]; T[9] -= a6.y * T[6]; T[10] -= a6.z * T[6]; T[11] -= a6.w * T[6]; a6 = *(const LAS f32x4*)(AB + 424);
            asm volatile("" ::: "memory"); T[12] -= a7.x * T[6]; T[13] -= a7.y * T[6]; T[14] -= a7.z * T[6]; T[15] -= a7.w * T[6]; a7 = *(const LAS f32x4*)(AB + 428);
            asm volatile("" ::: "memory"); T[16] -= a0.x * T[6]; T[17] -= a0.y * T[6]; T[18] -= a0.z * T[6]; T[19] -= a0.w * T[6]; a0 = *(const LAS f32x4*)(AB + 432);
            asm volatile("" ::: "memory"); T[20] -= a1.x * T[6]; T[21] -= a1.y * T[6]; T[22] -= a1.z * T[6]; T[23] -= a1.w * T[6]; a1 = *(const LAS f32x4*)(AB + 436);
            asm volatile("" ::: "memory"); T[24] -= a2.x * T[6]; T[25] -= a2.y * T[6]; T[26] -= a2.z * T[6]; T[27] -= a2.w * T[6]; a2 = *(const LAS f32x4*)(AB + 440);
            asm volatile("" ::: "memory"); T[28] -= a3.x * T[6]; T[29] -= a3.y * T[6]; T[30] -= a3.z * T[6]; T[31] -= a3.w * T[6]; a3 = *(const LAS f32x4*)(AB + 444);
            asm volatile("" ::: "memory"); T[32] -= a4.x * T[6]; T[33] -= a4.y * T[6]; T[34] -= a4.z * T[6]; T[35] -= a4.w * T[6]; a4 = *(const LAS f32x4*)(AB + 456);
            asm volatile("" ::: "memory"); T[36] -= a5.x * T[6]; T[37] -= a5.y * T[6]; T[38] -= a5.z * T[6]; T[39] -= a5.w * T[6]; a5 = *(const LAS f32x4*)(AB + 460);
            asm volatile("" ::: "memory"); T[40] -= a6.x * T[6]; T[41] -= a6.y * T[6]; T[42] -= a6.z * T[6]; T[43] -= a6.w * T[6]; a6 = *(const LAS f32x4*)(AB + 464);
            asm volatile("" ::: "memory"); T[44] -= a7.x * T[6]; T[45] -= a7.y * T[6]; T[46] -= a7.z * T[6]; T[47] -= a7.w * T[6]; a7 = *(const LAS f32x4*)(AB + 468);
            asm volatile("" ::: "memory"); T[48] -= a0.x * T[6]; T[49] -= a0.y * T[6]; T[50] -= a0.z * T[6]; T[51] -= a0.w * T[6]; a0 = *(const LAS f32x4*)(AB + 472);
            asm volatile("" ::: "memory"); T[52] -= a1.x * T[6]; T[53] -= a1.y * T[6]; T[54] -= a1.z * T[6]; T[55] -= a1.w * T[6]; a1 = *(const LAS f32x4*)(AB + 476);
            asm volatile("" ::: "memory"); T[56] -= a2.x * T[6]; T[57] -= a2.y * T[6]; T[58] -= a2.z * T[6]; T[59] -= a2.w * T[6]; a2 = *(const LAS f32x4*)(AB + 480);
            asm volatile("" ::: "memory"); T[60] -= a3.x * T[6]; T[61] -= a3.y * T[6]; T[62] -= a3.z * T[6]; T[63] -= a3.w * T[6]; a3 = *(const LAS f32x4*)(AB + 484);
            asm volatile("" ::: "memory"); T[8] -= a4.x * T[7]; T[9] -= a4.y * T[7]; T[10] -= a4.z * T[7]; T[11] -= a4.w * T[7]; a4 = *(const LAS f32x4*)(AB + 488);
            asm volatile("" ::: "memory"); T[12] -= a5.x * T[7]; T[13] -= a5.y * T[7]; T[14] -= a5.z * T[7]; T[15] -= a5.w * T[7]; a5 = *(const LAS f32x4*)(AB + 492);
            asm volatile("" ::: "memory"); T[16] -= a6.x * T[7]; T[17] -= a6.y * T[7]; T[18] -= a6.z * T[7]; T[19] -= a6.w * T[7]; a6 = *(const LAS f32x4*)(AB + 496);
            asm volatile("" ::: "memory"); T[20] -= a7.x * T[7]; T[21] -= a7.y * T[7]; T[22] -= a7.z * T[7]; T[23] -= a7.w * T[7]; a7 = *(const LAS f32x4*)(AB + 500);
            asm volatile("" ::: "memory"); T[24] -= a0.x * T[7]; T[25] -= a0.y * T[7]; T[26] -= a0.z * T[7]; T[27] -= a0.w * T[7]; a0 = *(const LAS f32x4*)(AB + 504);
            asm volatile("" ::: "memory"); T[28] -= a1.x * T[7]; T[29] -= a1.y * T[7]; T[30] -= a1.z * T[7]; T[31] -= a1.w * T[7]; a1 = *(const LAS f32x4*)(AB + 508);
            asm volatile("" ::: "memory"); T[32] -= a2.x * T[7]; T[33] -= a2.y * T[7]; T[34] -= a2.z * T[7]; T[35] -= a2.w * T[7]; a2 = *(const LAS f32x4*)(AB + 520);
            asm volatile("" ::: "memory"); T[36] -= a3.x * T[7]; T[37] -= a3.y * T[7]; T[38] -= a3.z * T[7]; T[39] -= a3.w * T[7]; a3 = *(const LAS f32x4*)(AB + 524);
            asm volatile("" ::: "memory"); T[40] -= a4.x * T[7]; T[41] -= a4.y * T[7]; T[42] -= a4.z * T[7]; T[43] -= a4.w * T[7]; a4 = *(const LAS f32x4*)(AB + 528);
            asm volatile("" ::: "memory"); T[44] -= a5.x * T[7]; T[45] -= a5.y * T[7]; T[46] -= a5.z * T[7]; T[47] -= a5.w * T[7]; a5 = *(const LAS f32x4*)(AB + 532);
            asm volatile("" ::: "memory"); T[48] -= a6.x * T[7]; T[49] -= a6.y * T[7]; T[50] -= a6.z * T[7]; T[51] -= a6.w * T[7]; a6 = *(const LAS f32x4*)(AB + 536);
            asm volatile("" ::: "memory"); T[52] -= a7.x * T[7]; T[53] -= a7.y * T[7]; T[54] -= a7.z * T[7]; T[55] -= a7.w * T[7]; a7 = *(const LAS f32x4*)(AB + 540);
            asm volatile("" ::: "memory"); T[56] -= a0.x * T[7]; T[57] -= a0.y * T[7]; T[58] -= a0.z * T[7]; T[59] -= a0.w * T[7]; a0 = *(const LAS f32x4*)(AB + 544);
            asm volatile("" ::: "memory"); T[60] -= a1.x * T[7]; T[61] -= a1.y * T[7]; T[62] -= a1.z * T[7]; T[63] -= a1.w * T[7]; a1 = *(const LAS f32x4*)(AB + 548);
            asm volatile("" ::: "memory"); T[9] -= a2.y * T[8]; T[10] -= a2.z * T[8]; T[11] -= a2.w * T[8]; a2 = *(const LAS f32x4*)(AB + 552);
            asm volatile("" ::: "memory"); T[12] -= a3.x * T[8]; T[13] -= a3.y * T[8]; T[14] -= a3.z * T[8]; T[15] -= a3.w * T[8]; a3 = *(const LAS f32x4*)(AB + 556);
            asm volatile("" ::: "memory"); T[16] -= a4.x * T[8]; T[17] -= a4.y * T[8]; T[18] -= a4.z * T[8]; T[19] -= a4.w * T[8]; a4 = *(const LAS f32x4*)(AB + 560);
            asm volatile("" ::: "memory"); T[20] -= a5.x * T[8]; T[21] -= a5.y * T[8]; T[22] -= a5.z * T[8]; T[23] -= a5.w * T[8]; a5 = *(const LAS f32x4*)(AB + 564);
            asm volatile("" ::: "memory"); T[24] -= a6.x * T[8]; T[25] -= a6.y * T[8]; T[26] -= a6.z * T[8]; T[27] -= a6.w * T[8]; a6 = *(const LAS f32x4*)(AB + 568);
            asm volatile("" ::: "memory"); T[28] -= a7.x * T[8]; T[29] -= a7.y * T[8]; T[30] -= a7.z * T[8]; T[31] -= a7.w * T[8]; a7 = *(const LAS f32x4*)(AB + 572);
            asm volatile("" ::: "memory"); T[32] -= a0.x * T[8]; T[33] -= a0.y * T[8]; T[34] -= a0.z * T[8]; T[35] -= a0.w * T[8]; a0 = *(const LAS f32x4*)(AB + 584);
            asm volatile("" ::: "memory"); T[36] -= a1.x * T[8]; T[37] -= a1.y * T[8]; T[38] -= a1.z * T[8]; T[39] -= a1.w * T[8]; a1 = *(const LAS f32x4*)(AB + 588);
            asm volatile("" ::: "memory"); T[40] -= a2.x * T[8]; T[41] -= a2.y * T[8]; T[42] -= a2.z * T[8]; T[43] -= a2.w * T[8]; a2 = *(const LAS f32x4*)(AB + 592);
            asm volatile("" ::: "memory"); T[44] -= a3.x * T[8]; T[45] -= a3.y * T[8]; T[46] -= a3.z * T[8]; T[47] -= a3.w * T[8]; a3 = *(const LAS f32x4*)(AB + 596);
            asm volatile("" ::: "memory"); T[48] -= a4.x * T[8]; T[49] -= a4.y * T[8]; T[50] -= a4.z * T[8]; T[51] -= a4.w * T[8]; a4 = *(const LAS f32x4*)(AB + 600);
            asm volatile("" ::: "memory"); T[52] -= a5.x * T[8]; T[53] -= a5.y * T[8]; T[54] -= a5.z * T[8]; T[55] -= a5.w * T[8]; a5 = *(const LAS f32x4*)(AB + 604);
            asm volatile("" ::: "memory"); T[56] -= a6.x * T[8]; T[57] -= a6.y * T[8]; T[58] -= a6.z * T[8]; T[59] -= a6.w * T[8]; a6 = *(const LAS f32x4*)(AB + 608);
            asm volatile("" ::: "memory"); T[60] -= a7.x * T[8]; T[61] -= a7.y * T[8]; T[62] -= a7.z * T[8]; T[63] -= a7.w * T[8]; a7 = *(const LAS f32x4*)(AB + 612);
            asm volatile("" ::: "memory"); T[10] -= a0.z * T[9]; T[11] -= a0.w * T[9]; a0 = *(const LAS f32x4*)(AB + 616);
            asm volatile("" ::: "memory"); T[12] -= a1.x * T[9]; T[13] -= a1.y * T[9]; T[14] -= a1.z * T[9]; T[15] -= a1.w * T[9]; a1 = *(const LAS f32x4*)(AB + 620);
            asm volatile("" ::: "memory"); T[16] -= a2.x * T[9]; T[17] -= a2.y * T[9]; T[18] -= a2.z * T[9]; T[19] -= a2.w * T[9]; a2 = *(const LAS f32x4*)(AB + 624);
            asm volatile("" ::: "memory"); T[20] -= a3.x * T[9]; T[21] -= a3.y * T[9]; T[22] -= a3.z * T[9]; T[23] -= a3.w * T[9]; a3 = *(const LAS f32x4*)(AB + 628);
            asm volatile("" ::: "memory"); T[24] -= a4.x * T[9]; T[25] -= a4.y * T[9]; T[26] -= a4.z * T[9]; T[27] -= a4.w * T[9]; a4 = *(const LAS f32x4*)(AB + 632);
            asm volatile("" ::: "memory"); T[28] -= a5.x * T[9]; T[29] -= a5.y * T[9]; T[30] -= a5.z * T[9]; T[31] -= a5.w * T[9]; a5 = *(const LAS f32x4*)(AB + 636);
            asm volatile("" ::: "memory"); T[32] -= a6.x * T[9]; T[33] -= a6.y * T[9]; T[34] -= a6.z * T[9]; T[35] -= a6.w * T[9]; a6 = *(const LAS f32x4*)(AB + 648);
            asm volatile("" ::: "memory"); T[36] -= a7.x * T[9]; T[37] -= a7.y * T[9]; T[38] -= a7.z * T[9]; T[39] -= a7.w * T[9]; a7 = *(const LAS f32x4*)(AB + 652);
            asm volatile("" ::: "memory"); T[40] -= a0.x * T[9]; T[41] -= a0.y * T[9]; T[42] -= a0.z * T[9]; T[43] -= a0.w * T[9]; a0 = *(const LAS f32x4*)(AB + 656);
            asm volatile("" ::: "memory"); T[44] -= a1.x * T[9]; T[45] -= a1.y * T[9]; T[46] -= a1.z * T[9]; T[47] -= a1.w * T[9]; a1 = *(const LAS f32x4*)(AB + 660);
            asm volatile("" ::: "memory"); T[48] -= a2.x * T[9]; T[49] -= a2.y * T[9]; T[50] -= a2.z * T[9]; T[51] -= a2.w * T[9]; a2 = *(const LAS f32x4*)(AB + 664);
            asm volatile("" ::: "memory"); T[52] -= a3.x * T[9]; T[53] -= a3.y * T[9]; T[54] -= a3.z * T[9]; T[55] -= a3.w * T[9]; a3 = *(const LAS f32x4*)(AB + 668);
            asm volatile("" ::: "memory"); T[56] -= a4.x * T[9]; T[57] -= a4.y * T[9]; T[58] -= a4.z * T[9]; T[59] -= a4.w * T[9]; a4 = *(const LAS f32x4*)(AB + 672);
            asm volatile("" ::: "memory"); T[60] -= a5.x * T[9]; T[61] -= a5.y * T[9]; T[62] -= a5.z * T[9]; T[63] -= a5.w * T[9]; a5 = *(const LAS f32x4*)(AB + 676);
            asm volatile("" ::: "memory"); T[11] -= a6.w * T[10]; a6 = *(const LAS f32x4*)(AB + 680);
            asm volatile("" ::: "memory"); T[12] -= a7.x * T[10]; T[13] -= a7.y * T[10]; T[14] -= a7.z * T[10]; T[15] -= a7.w * T[10]; a7 = *(const LAS f32x4*)(AB + 684);
            asm volatile("" ::: "memory"); T[16] -= a0.x * T[10]; T[17] -= a0.y * T[10]; T[18] -= a0.z * T[10]; T[19] -= a0.w * T[10]; a0 = *(const LAS f32x4*)(AB + 688);
            asm volatile("" ::: "memory"); T[20] -= a1.x * T[10]; T[21] -= a1.y * T[10]; T[22] -= a1.z * T[10]; T[23] -= a1.w * T[10]; a1 = *(const LAS f32x4*)(AB + 692);
            asm volatile("" ::: "memory"); T[24] -= a2.x * T[10]; T[25] -= a2.y * T[10]; T[26] -= a2.z * T[10]; T[27] -= a2.w * T[10]; a2 = *(const LAS f32x4*)(AB + 696);
            asm volatile("" ::: "memory"); T[28] -= a3.x * T[10]; T[29] -= a3.y * T[10]; T[30] -= a3.z * T[10]; T[31] -= a3.w * T[10]; a3 = *(const LAS f32x4*)(AB + 700);
            asm volatile("" ::: "memory"); T[32] -= a4.x * T[10]; T[33] -= a4.y * T[10]; T[34] -= a4.z * T[10]; T[35] -= a4.w * T[10]; a4 = *(const LAS f32x4*)(AB + 716);
            asm volatile("" ::: "memory"); T[36] -= a5.x * T[10]; T[37] -= a5.y * T[10]; T[38] -= a5.z * T[10]; T[39] -= a5.w * T[10]; a5 = *(const LAS f32x4*)(AB + 720);
            asm volatile("" ::: "memory"); T[40] -= a6.x * T[10]; T[41] -= a6.y * T[10]; T[42] -= a6.z * T[10]; T[43] -= a6.w * T[10]; a6 = *(const LAS f32x4*)(AB + 724);
            asm volatile("" ::: "memory"); T[44] -= a7.x * T[10]; T[45] -= a7.y * T[10]; T[46] -= a7.z * T[10]; T[47] -= a7.w * T[10]; a7 = *(const LAS f32x4*)(AB + 728);
            asm volatile("" ::: "memory"); T[48] -= a0.x * T[10]; T[49] -= a0.y * T[10]; T[50] -= a0.z * T[10]; T[51] -= a0.w * T[10]; a0 = *(const LAS f32x4*)(AB + 732);
            asm volatile("" ::: "memory"); T[52] -= a1.x * T[10]; T[53] -= a1.y * T[10]; T[54] -= a1.z * T[10]; T[55] -= a1.w * T[10]; a1 = *(const LAS f32x4*)(AB + 736);
            asm volatile("" ::: "memory"); T[56] -= a2.x * T[10]; T[57] -= a2.y * T[10]; T[58] -= a2.z * T[10]; T[59] -= a2.w * T[10]; a2 = *(const LAS f32x4*)(AB + 740);
            asm volatile("" ::: "memory"); T[60] -= a3.x * T[10]; T[61] -= a3.y * T[10]; T[62] -= a3.z * T[10]; T[63] -= a3.w * T[10]; a3 = *(const LAS f32x4*)(AB + 744);
            asm volatile("" ::: "memory"); T[12] -= a4.x * T[11]; T[13] -= a4.y * T[11]; T[14] -= a4.z * T[11]; T[15] -= a4.w * T[11]; a4 = *(const LAS f32x4*)(AB + 748);
            asm volatile("" ::: "memory"); T[16] -= a5.x * T[11]; T[17] -= a5.y * T[11]; T[18] -= a5.z * T[11]; T[19] -= a5.w * T[11]; a5 = *(const LAS f32x4*)(AB + 752);
            asm volatile("" ::: "memory"); T[20] -= a6.x * T[11]; T[21] -= a6.y * T[11]; T[22] -= a6.z * T[11]; T[23] -= a6.w * T[11]; a6 = *(const LAS f32x4*)(AB + 756);
            asm volatile("" ::: "memory"); T[24] -= a7.x * T[11]; T[25] -= a7.y * T[11]; T[26] -= a7.z * T[11]; T[27] -= a7.w * T[11]; a7 = *(const LAS f32x4*)(AB + 760);
            asm volatile("" ::: "memory"); T[28] -= a0.x * T[11]; T[29] -= a0.y * T[11]; T[30] -= a0.z * T[11]; T[31] -= a0.w * T[11]; a0 = *(const LAS f32x4*)(AB + 764);
            asm volatile("" ::: "memory"); T[32] -= a1.x * T[11]; T[33] -= a1.y * T[11]; T[34] -= a1.z * T[11]; T[35] -= a1.w * T[11]; a1 = *(const LAS f32x4*)(AB + 780);
            asm volatile("" ::: "memory"); T[36] -= a2.x * T[11]; T[37] -= a2.y * T[11]; T[38] -= a2.z * T[11]; T[39] -= a2.w * T[11]; a2 = *(const LAS f32x4*)(AB + 784);
            asm volatile("" ::: "memory"); T[40] -= a3.x * T[11]; T[41] -= a3.y * T[11]; T[42] -= a3.z * T[11]; T[43] -= a3.w * T[11]; a3 = *(const LAS f32x4*)(AB + 788);
            asm volatile("" ::: "memory"); T[44] -= a4.x * T[11]; T[45] -= a4.y * T[11]; T[46] -= a4.z * T[11]; T[47] -= a4.w * T[11]; a4 = *(const LAS f32x4*)(AB + 792);
            asm volatile("" ::: "memory"); T[48] -= a5.x * T[11]; T[49] -= a5.y * T[11]; T[50] -= a5.z * T[11]; T[51] -= a5.w * T[11]; a5 = *(const LAS f32x4*)(AB + 796);
            asm volatile("" ::: "memory"); T[52] -= a6.x * T[11]; T[53] -= a6.y * T[11]; T[54] -= a6.z * T[11]; T[55] -= a6.w * T[11]; a6 = *(const LAS f32x4*)(AB + 800);
            asm volatile("" ::: "memory"); T[56] -= a7.x * T[11]; T[57] -= a7.y * T[11]; T[58] -= a7.z * T[11]; T[59] -= a7.w * T[11]; a7 = *(const LAS f32x4*)(AB + 804);
            asm volatile("" ::: "memory"); T[60] -= a0.x * T[11]; T[61] -= a0.y * T[11]; T[62] -= a0.z * T[11]; T[63] -= a0.w * T[11]; a0 = *(const LAS f32x4*)(AB + 808);
            asm volatile("" ::: "memory"); T[13] -= a1.y * T[12]; T[14] -= a1.z * T[12]; T[15] -= a1.w * T[12]; a1 = *(const LAS f32x4*)(AB + 812);
            asm volatile("" ::: "memory"); T[16] -= a2.x * T[12]; T[17] -= a2.y * T[12]; T[18] -= a2.z * T[12]; T[19] -= a2.w * T[12]; a2 = *(const LAS f32x4*)(AB + 816);
            asm volatile("" ::: "memory"); T[20] -= a3.x * T[12]; T[21] -= a3.y * T[12]; T[22] -= a3.z * T[12]; T[23] -= a3.w * T[12]; a3 = *(const LAS f32x4*)(AB + 820);
            asm volatile("" ::: "memory"); T[24] -= a4.x * T[12]; T[25] -= a4.y * T[12]; T[26] -= a4.z * T[12]; T[27] -= a4.w * T[12]; a4 = *(const LAS f32x4*)(AB + 824);
            asm volatile("" ::: "memory"); T[28] -= a5.x * T[12]; T[29] -= a5.y * T[12]; T[30] -= a5.z * T[12]; T[31] -= a5.w * T[12]; a5 = *(const LAS f32x4*)(AB + 828);
            asm volatile("" ::: "memory"); T[32] -= a6.x * T[12]; T[33] -= a6.y * T[12]; T[34] -= a6.z * T[12]; T[35] -= a6.w * T[12]; a6 = *(const LAS f32x4*)(AB + 844);
            asm volatile("" ::: "memory"); T[36] -= a7.x * T[12]; T[37] -= a7.y * T[12]; T[38] -= a7.z * T[12]; T[39] -= a7.w * T[12]; a7 = *(const LAS f32x4*)(AB + 848);
            asm volatile("" ::: "memory"); T[40] -= a0.x * T[12]; T[41] -= a0.y * T[12]; T[42] -= a0.z * T[12]; T[43] -= a0.w * T[12]; a0 = *(const LAS f32x4*)(AB + 852);
            asm volatile("" ::: "memory"); T[44] -= a1.x * T[12]; T[45] -= a1.y * T[12]; T[46] -= a1.z * T[12]; T[47] -= a1.w * T[12]; a1 = *(const LAS f32x4*)(AB + 856);
            asm volatile("" ::: "memory"); T[48] -= a2.x * T[12]; T[49] -= a2.y * T[12]; T[50] -= a2.z * T[12]; T[51] -= a2.w * T[12]; a2 = *(const LAS f32x4*)(AB + 860);
            asm volatile("" ::: "memory"); T[52] -= a3.x * T[12]; T[53] -= a3.y * T[12]; T[54] -= a3.z * T[12]; T[55] -= a3.w * T[12]; a3 = *(const LAS f32x4*)(AB + 864);
            asm volatile("" ::: "memory"); T[56] -= a4.x * T[12]; T[57] -= a4.y * T[12]; T[58] -= a4.z * T[12]; T[59] -= a4.w * T[12]; a4 = *(const LAS f32x4*)(AB + 868);
            asm volatile("" ::: "memory"); T[60] -= a5.x * T[12]; T[61] -= a5.y * T[12]; T[62] -= a5.z * T[12]; T[63] -= a5.w * T[12]; a5 = *(const LAS f32x4*)(AB + 872);
            asm volatile("" ::: "memory"); T[14] -= a6.z * T[13]; T[15] -= a6.w * T[13]; a6 = *(const LAS f32x4*)(AB + 876);
            asm volatile("" ::: "memory"); T[16] -= a7.x * T[13]; T[17] -= a7.y * T[13]; T[18] -= a7.z * T[13]; T[19] -= a7.w * T[13]; a7 = *(const LAS f32x4*)(AB + 880);
            asm volatile("" ::: "memory"); T[20] -= a0.x * T[13]; T[21] -= a0.y * T[13]; T[22] -= a0.z * T[13]; T[23] -= a0.w * T[13]; a0 = *(const LAS f32x4*)(AB + 884);
            asm volatile("" ::: "memory"); T[24] -= a1.x * T[13]; T[25] -= a1.y * T[13]; T[26] -= a1.z * T[13]; T[27] -= a1.w * T[13]; a1 = *(const LAS f32x4*)(AB + 888);
            asm volatile("" ::: "memory"); T[28] -= a2.x * T[13]; T[29] -= a2.y * T[13]; T[30] -= a2.z * T[13]; T[31] -= a2.w * T[13]; a2 = *(const LAS f32x4*)(AB + 892);
            asm volatile("" ::: "memory"); T[32] -= a3.x * T[13]; T[33] -= a3.y * T[13]; T[34] -= a3.z * T[13]; T[35] -= a3.w * T[13]; a3 = *(const LAS f32x4*)(AB + 908);
            asm volatile("" ::: "memory"); T[36] -= a4.x * T[13]; T[37] -= a4.y * T[13]; T[38] -= a4.z * T[13]; T[39] -= a4.w * T[13]; a4 = *(const LAS f32x4*)(AB + 912);
            asm volatile("" ::: "memory"); T[40] -= a5.x * T[13]; T[41] -= a5.y * T[13]; T[42] -= a5.z * T[13]; T[43] -= a5.w * T[13]; a5 = *(const LAS f32x4*)(AB + 916);
            asm volatile("" ::: "memory"); T[44] -= a6.x * T[13]; T[45] -= a6.y * T[13]; T[46] -= a6.z * T[13]; T[47] -= a6.w * T[13]; a6 = *(const LAS f32x4*)(AB + 920);
            asm volatile("" ::: "memory"); T[48] -= a7.x * T[13]; T[49] -= a7.y * T[13]; T[50] -= a7.z * T[13]; T[51] -= a7.w * T[13]; a7 = *(const LAS f32x4*)(AB + 924);
            asm volatile("" ::: "memory"); T[52] -= a0.x * T[13]; T[53] -= a0.y * T[13]; T[54] -= a0.z * T[13]; T[55] -= a0.w * T[13]; a0 = *(const LAS f32x4*)(AB + 928);
            asm volatile("" ::: "memory"); T[56] -= a1.x * T[13]; T[57] -= a1.y * T[13]; T[58] -= a1.z * T[13]; T[59] -= a1.w * T[13]; a1 = *(const LAS f32x4*)(AB + 932);
            asm volatile("" ::: "memory"); T[60] -= a2.x * T[13]; T[61] -= a2.y * T[13]; T[62] -= a2.z * T[13]; T[63] -= a2.w * T[13]; a2 = *(const LAS f32x4*)(AB + 936);
            asm volatile("" ::: "memory"); T[15] -= a3.w * T[14]; a3 = *(const LAS f32x4*)(AB + 940);
            asm volatile("" ::: "memory"); T[16] -= a4.x * T[14]; T[17] -= a4.y * T[14]; T[18] -= a4.z * T[14]; T[19] -= a4.w * T[14]; a4 = *(const LAS f32x4*)(AB + 944);
            asm volatile("" ::: "memory"); T[20] -= a5.x * T[14]; T[21] -= a5.y * T[14]; T[22] -= a5.z * T[14]; T[23] -= a5.w * T[14]; a5 = *(const LAS f32x4*)(AB + 948);
            asm volatile("" ::: "memory"); T[24] -= a6.x * T[14]; T[25] -= a6.y * T[14]; T[26] -= a6.z * T[14]; T[27] -= a6.w * T[14]; a6 = *(const LAS f32x4*)(AB + 952);
            asm volatile("" ::: "memory"); T[28] -= a7.x * T[14]; T[29] -= a7.y * T[14]; T[30] -= a7.z * T[14]; T[31] -= a7.w * T[14]; a7 = *(const LAS f32x4*)(AB + 956);
            asm volatile("" ::: "memory"); T[32] -= a0.x * T[14]; T[33] -= a0.y * T[14]; T[34] -= a0.z * T[14]; T[35] -= a0.w * T[14]; a0 = *(const LAS f32x4*)(AB + 976);
            asm volatile("" ::: "memory"); T[36] -= a1.x * T[14]; T[37] -= a1.y * T[14]; T[38] -= a1.z * T[14]; T[39] -= a1.w * T[14]; a1 = *(const LAS f32x4*)(AB + 980);
            asm volatile("" ::: "memory"); T[40] -= a2.x * T[14]; T[41] -= a2.y * T[14]; T[42] -= a2.z * T[14]; T[43] -= a2.w * T[14]; a2 = *(const LAS f32x4*)(AB + 984);
            asm volatile("" ::: "memory"); T[44] -= a3.x * T[14]; T[45] -= a3.y * T[14]; T[46] -= a3.z * T[14]; T[47] -= a3.w * T[14]; a3 = *(const LAS f32x4*)(AB + 988);
            asm volatile("" ::: "memory"); T[48] -= a4.x * T[14]; T[49] -= a4.y * T[14]; T[50] -= a4.z * T[14]; T[51] -= a4.w * T[14]; a4 = *(const LAS f32x4*)(AB + 992);
            asm volatile("" ::: "memory"); T[52] -= a5.x * T[14]; T[53] -= a5.y * T[14]; T[54] -= a5.z * T[14]; T[55] -= a5.w * T[14]; a5 = *(const LAS f32x4*)(AB + 996);
            asm volatile("" ::: "memory"); T[56] -= a6.x * T[14]; T[57] -= a6.y * T[14]; T[58] -= a6.z * T[14]; T[59] -= a6.w * T[14]; a6 = *(const LAS f32x4*)(AB + 1000);
            asm volatile("" ::: "memory"); T[60] -= a7.x * T[14]; T[61] -= a7.y * T[14]; T[62] -= a7.z * T[14]; T[63] -= a7.w * T[14]; a7 = *(const LAS f32x4*)(AB + 1004);
            asm volatile("" ::: "memory"); T[16] -= a0.x * T[15]; T[17] -= a0.y * T[15]; T[18] -= a0.z * T[15]; T[19] -= a0.w * T[15]; a0 = *(const LAS f32x4*)(AB + 1008);
            asm volatile("" ::: "memory"); T[20] -= a1.x * T[15]; T[21] -= a1.y * T[15]; T[22] -= a1.z * T[15]; T[23] -= a1.w * T[15]; a1 = *(const LAS f32x4*)(AB + 1012);
            asm volatile("" ::: "memory"); T[24] -= a2.x * T[15]; T[25] -= a2.y * T[15]; T[26] -= a2.z * T[15]; T[27] -= a2.w * T[15]; a2 = *(const LAS f32x4*)(AB + 1016);
            asm volatile("" ::: "memory"); T[28] -= a3.x * T[15]; T[29] -= a3.y * T[15]; T[30] -= a3.z * T[15]; T[31] -= a3.w * T[15]; a3 = *(const LAS f32x4*)(AB + 1020);
            asm volatile("" ::: "memory"); T[32] -= a4.x * T[15]; T[33] -= a4.y * T[15]; T[34] -= a4.z * T[15]; T[35] -= a4.w * T[15]; a4 = *(const LAS f32x4*)(AB + 1040);
            asm volatile("" ::: "memory"); T[36] -= a5.x * T[15]; T[37] -= a5.y * T[15]; T[38] -= a5.z * T[15]; T[39] -= a5.w * T[15]; a5 = *(const LAS f32x4*)(AB + 1044);
            asm volatile("" ::: "memory"); T[40] -= a6.x * T[15]; T[41] -= a6.y * T[15]; T[42] -= a6.z * T[15]; T[43] -= a6.w * T[15]; a6 = *(const LAS f32x4*)(AB + 1048);
            asm volatile("" ::: "memory"); T[44] -= a7.x * T[15]; T[45] -= a7.y * T[15]; T[46] -= a7.z * T[15]; T[47] -= a7.w * T[15]; a7 = *(const LAS f32x4*)(AB + 1052);
            asm volatile("" ::: "memory"); T[48] -= a0.x * T[15]; T[49] -= a0.y * T[15]; T[50] -= a0.z * T[15]; T[51] -= a0.w * T[15]; a0 = *(const LAS f32x4*)(AB + 1056);
            asm volatile("" ::: "memory"); T[52] -= a1.x * T[15]; T[53] -= a1.y * T[15]; T[54] -= a1.z * T[15]; T[55] -= a1.w * T[15]; a1 = *(const LAS f32x4*)(AB + 1060);
            asm volatile("" ::: "memory"); T[56] -= a2.x * T[15]; T[57] -= a2.y * T[15]; T[58] -= a2.z * T[15]; T[59] -= a2.w * T[15]; a2 = *(const LAS f32x4*)(AB + 1064);
            asm volatile("" ::: "memory"); T[60] -= a3.x * T[15]; T[61] -= a3.y * T[15]; T[62] -= a3.z * T[15]; T[63] -= a3.w * T[15]; a3 = *(const LAS f32x4*)(AB + 1068);
            asm volatile("" ::: "memory"); T[17] -= a4.y * T[16]; T[18] -= a4.z * T[16]; T[19] -= a4.w * T[16]; a4 = *(const LAS f32x4*)(AB + 1072);
            asm volatile("" ::: "memory"); T[20] -= a5.x * T[16]; T[21] -= a5.y * T[16]; T[22] -= a5.z * T[16]; T[23] -= a5.w * T[16]; a5 = *(const LAS f32x4*)(AB + 1076);
            asm volatile("" ::: "memory"); T[24] -= a6.x * T[16]; T[25] -= a6.y * T[16]; T[26] -= a6.z * T[16]; T[27] -= a6.w * T[16]; a6 = *(const LAS f32x4*)(AB + 1080);
            asm volatile("" ::: "memory"); T[28] -= a7.x * T[16]; T[29] -= a7.y * T[16]; T[30] -= a7.z * T[16]; T[31] -= a7.w * T[16]; a7 = *(const LAS f32x4*)(AB + 1084);
            asm volatile("" ::: "memory"); T[32] -= a0.x * T[16]; T[33] -= a0.y * T[16]; T[34] -= a0.z * T[16]; T[35] -= a0.w * T[16]; a0 = *(const LAS f32x4*)(AB + 1104);
            asm volatile("" ::: "memory"); T[36] -= a1.x * T[16]; T[37] -= a1.y * T[16]; T[38] -= a1.z * T[16]; T[39] -= a1.w * T[16]; a1 = *(const LAS f32x4*)(AB + 1108);
            asm volatile("" ::: "memory"); T[40] -= a2.x * T[16]; T[41] -= a2.y * T[16]; T[42] -= a2.z * T[16]; T[43] -= a2.w * T[16]; a2 = *(const LAS f32x4*)(AB + 1112);
            asm volatile("" ::: "memory"); T[44] -= a3.x * T[16]; T[45] -= a3.y * T[16]; T[46] -= a3.z * T[16]; T[47] -= a3.w * T[16]; a3 = *(const LAS f32x4*)(AB + 1116);
            asm volatile("" ::: "memory"); T[48] -= a4.x * T[16]; T[49] -= a4.y * T[16]; T[50] -= a4.z * T[16]; T[51] -= a4.w * T[16]; a4 = *(const LAS f32x4*)(AB + 1120);
            asm volatile("" ::: "memory"); T[52] -= a5.x * T[16]; T[53] -= a5.y * T[16]; T[54] -= a5.z * T[16]; T[55] -= a5.w * T[16]; a5 = *(const LAS f32x4*)(AB + 1124);
            asm volatile("" ::: "memory"); T[56] -= a6.x * T[16]; T[57] -= a6.y * T[16]; T[58] -= a6.z * T[16]; T[59] -= a6.w * T[16]; a6 = *(const LAS f32x4*)(AB + 1128);
            asm volatile("" ::: "memory"); T[60] -= a7.x * T[16]; T[61] -= a7.y * T[16]; T[62] -= a7.z * T[16]; T[63] -= a7.w * T[16]; a7 = *(const LAS f32x4*)(AB + 1132);
            asm volatile("" ::: "memory"); T[18] -= a0.z * T[17]; T[19] -= a0.w * T[17]; a0 = *(const LAS f32x4*)(AB + 1136);
            asm volatile("" ::: "memory"); T[20] -= a1.x * T[17]; T[21] -= a1.y * T[17]; T[22] -= a1.z * T[17]; T[23] -= a1.w * T[17]; a1 = *(const LAS f32x4*)(AB + 1140);
            asm volatile("" ::: "memory"); T[24] -= a2.x * T[17]; T[25] -= a2.y * T[17]; T[26] -= a2.z * T[17]; T[27] -= a2.w * T[17]; a2 = *(const LAS f32x4*)(AB + 1144);
            asm volatile("" ::: "memory"); T[28] -= a3.x * T[17]; T[29] -= a3.y * T[17]; T[30] -= a3.z * T[17]; T[31] -= a3.w * T[17]; a3 = *(const LAS f32x4*)(AB + 1148);
            asm volatile("" ::: "memory"); T[32] -= a4.x * T[17]; T[33] -= a4.y * T[17]; T[34] -= a4.z * T[17]; T[35] -= a4.w * T[17]; a4 = *(const LAS f32x4*)(AB + 1168);
            asm volatile("" ::: "memory"); T[36] -= a5.x * T[17]; T[37] -= a5.y * T[17]; T[38] -= a5.z * T[17]; T[39] -= a5.w * T[17]; a5 = *(const LAS f32x4*)(AB + 1172);
            asm volatile("" ::: "memory"); T[40] -= a6.x * T[17]; T[41] -= a6.y * T[17]; T[42] -= a6.z * T[17]; T[43] -= a6.w * T[17]; a6 = *(const LAS f32x4*)(AB + 1176);
            asm volatile("" ::: "memory"); T[44] -= a7.x * T[17]; T[45] -= a7.y * T[17]; T[46] -= a7.z * T[17]; T[47] -= a7.w * T[17]; a7 = *(const LAS f32x4*)(AB + 1180);
            asm volatile("" ::: "memory"); T[48] -= a0.x * T[17]; T[49] -= a0.y * T[17]; T[50] -= a0.z * T[17]; T[51] -= a0.w * T[17]; a0 = *(const LAS f32x4*)(AB + 1184);
            asm volatile("" ::: "memory"); T[52] -= a1.x * T[17]; T[53] -= a1.y * T[17]; T[54] -= a1.z * T[17]; T[55] -= a1.w * T[17]; a1 = *(const LAS f32x4*)(AB + 1188);
            asm volatile("" ::: "memory"); T[56] -= a2.x * T[17]; T[57] -= a2.y * T[17]; T[58] -= a2.z * T[17]; T[59] -= a2.w * T[17]; a2 = *(const LAS f32x4*)(AB + 1192);
            asm volatile("" ::: "memory"); T[60] -= a3.x * T[17]; T[61] -= a3.y * T[17]; T[62] -= a3.z * T[17]; T[63] -= a3.w * T[17]; a3 = *(const LAS f32x4*)(AB + 1196);
            asm volatile("" ::: "memory"); T[19] -= a4.w * T[18]; a4 = *(const LAS f32x4*)(AB + 1200);
            asm volatile("" ::: "memory"); T[20] -= a5.x * T[18]; T[21] -= a5.y * T[18]; T[22] -= a5.z * T[18]; T[23] -= a5.w * T[18]; a5 = *(const LAS f32x4*)(AB + 1204);
            asm volatile("" ::: "memory"); T[24] -= a6.x * T[18]; T[25] -= a6.y * T[18]; T[26] -= a6.z * T[18]; T[27] -= a6.w * T[18]; a6 = *(const LAS f32x4*)(AB + 1208);
            asm volatile("" ::: "memory"); T[28] -= a7.x * T[18]; T[29] -= a7.y * T[18]; T[30] -= a7.z * T[18]; T[31] -= a7.w * T[18]; a7 = *(const LAS f32x4*)(AB + 1212);
            asm volatile("" ::: "memory"); T[32] -= a0.x * T[18]; T[33] -= a0.y * T[18]; T[34] -= a0.z * T[18]; T[35] -= a0.w * T[18]; a0 = *(const LAS f32x4*)(AB + 1236);
            asm volatile("" ::: "memory"); T[36] -= a1.x * T[18]; T[37] -= a1.y * T[18]; T[38] -= a1.z * T[18]; T[39] -= a1.w * T[18]; a1 = *(const LAS f32x4*)(AB + 1240);
            asm volatile("" ::: "memory"); T[40] -= a2.x * T[18]; T[41] -= a2.y * T[18]; T[42] -= a2.z * T[18]; T[43] -= a2.w * T[18]; a2 = *(const LAS f32x4*)(AB + 1244);
            asm volatile("" ::: "memory"); T[44] -= a3.x * T[18]; T[45] -= a3.y * T[18]; T[46] -= a3.z * T[18]; T[47] -= a3.w * T[18]; a3 = *(const LAS f32x4*)(AB + 1248);
            asm volatile("" ::: "memory"); T[48] -= a4.x * T[18]; T[49] -= a4.y * T[18]; T[50] -= a4.z * T[18]; T[51] -= a4.w * T[18]; a4 = *(const LAS f32x4*)(AB + 1252);
            asm volatile("" ::: "memory"); T[52] -= a5.x * T[18]; T[53] -= a5.y * T[18]; T[54] -= a5.z * T[18]; T[55] -= a5.w * T[18]; a5 = *(const LAS f32x4*)(AB + 1256);
            asm volatile("" ::: "memory"); T[56] -= a6.x * T[18]; T[57] -= a6.y * T[18]; T[58] -= a6.z * T[18]; T[59] -= a6.w * T[18]; a6 = *(const LAS f32x4*)(AB + 1260);
            asm volatile("" ::: "memory"); T[60] -= a7.x * T[18]; T[61] -= a7.y * T[18]; T[62] -= a7.z * T[18]; T[63] -= a7.w * T[18]; a7 = *(const LAS f32x4*)(AB + 1264);
            asm volatile("" ::: "memory"); T[20] -= a0.x * T[19]; T[21] -= a0.y * T[19]; T[22] -= a0.z * T[19]; T[23] -= a0.w * T[19]; a0 = *(const LAS f32x4*)(AB + 1268);
            asm volatile("" ::: "memory"); T[24] -= a1.x * T[19]; T[25] -= a1.y * T[19]; T[26] -= a1.z * T[19]; T[27] -= a1.w * T[19]; a1 = *(const LAS f32x4*)(AB + 1272);
            asm volatile("" ::: "memory"); T[28] -= a2.x * T[19]; T[29] -= a2.y * T[19]; T[30] -= a2.z * T[19]; T[31] -= a2.w * T[19]; a2 = *(const LAS f32x4*)(AB + 1276);
            asm volatile("" ::: "memory"); T[32] -= a3.x * T[19]; T[33] -= a3.y * T[19]; T[34] -= a3.z * T[19]; T[35] -= a3.w * T[19]; a3 = *(const LAS f32x4*)(AB + 1300);
            asm volatile("" ::: "memory"); T[36] -= a4.x * T[19]; T[37] -= a4.y * T[19]; T[38] -= a4.z * T[19]; T[39] -= a4.w * T[19]; a4 = *(const LAS f32x4*)(AB + 1304);
            asm volatile("" ::: "memory"); T[40] -= a5.x * T[19]; T[41] -= a5.y * T[19]; T[42] -= a5.z * T[19]; T[43] -= a5.w * T[19]; a5 = *(const LAS f32x4*)(AB + 1308);
            asm volatile("" ::: "memory"); T[44] -= a6.x * T[19]; T[45] -= a6.y * T[19]; T[46] -= a6.z * T[19]; T[47] -= a6.w * T[19]; a6 = *(const LAS f32x4*)(AB + 1312);
            asm volatile("" ::: "memory"); T[48] -= a7.x * T[19]; T[49] -= a7.y * T[19]; T[50] -= a7.z * T[19]; T[51] -= a7.w * T[19]; a7 = *(const LAS f32x4*)(AB + 1316);
            asm volatile("" ::: "memory"); T[52] -= a0.x * T[19]; T[53] -= a0.y * T[19]; T[54] -= a0.z * T[19]; T[55] -= a0.w * T[19]; a0 = *(const LAS f32x4*)(AB + 1320);
            asm volatile("" ::: "memory"); T[56] -= a1.x * T[19]; T[57] -= a1.y * T[19]; T[58] -= a1.z * T[19]; T[59] -= a1.w * T[19]; a1 = *(const LAS f32x4*)(AB + 1324);
            asm volatile("" ::: "memory"); T[60] -= a2.x * T[19]; T[61] -= a2.y * T[19]; T[62] -= a2.z * T[19]; T[63] -= a2.w * T[19]; a2 = *(const LAS f32x4*)(AB + 1328);
            asm volatile("" ::: "memory"); T[21] -= a3.y * T[20]; T[22] -= a3.z * T[20]; T[23] -= a3.w * T[20]; a3 = *(const LAS f32x4*)(AB + 1332);
            asm volatile("" ::: "memory"); T[24] -= a4.x * T[20]; T[25] -= a4.y * T[20]; T[26] -= a4.z * T[20]; T[27] -= a4.w * T[20]; a4 = *(const LAS f32x4*)(AB + 1336);
            asm volatile("" ::: "memory"); T[28] -= a5.x * T[20]; T[29] -= a5.y * T[20]; T[30] -= a5.z * T[20]; T[31] -= a5.w * T[20]; a5 = *(const LAS f32x4*)(AB + 1340);
            asm volatile("" ::: "memory"); T[32] -= a6.x * T[20]; T[33] -= a6.y * T[20]; T[34] -= a6.z * T[20]; T[35] -= a6.w * T[20]; a6 = *(const LAS f32x4*)(AB + 1364);
            asm volatile("" ::: "memory"); T[36] -= a7.x * T[20]; T[37] -= a7.y * T[20]; T[38] -= a7.z * T[20]; T[39] -= a7.w * T[20]; a7 = *(const LAS f32x4*)(AB + 1368);
            asm volatile("" ::: "memory"); T[40] -= a0.x * T[20]; T[41] -= a0.y * T[20]; T[42] -= a0.z * T[20]; T[43] -= a0.w * T[20]; a0 = *(const LAS f32x4*)(AB + 1372);
            asm volatile("" ::: "memory"); T[44] -= a1.x * T[20]; T[45] -= a1.y * T[20]; T[46] -= a1.z * T[20]; T[47] -= a1.w * T[20]; a1 = *(const LAS f32x4*)(AB + 1376);
            asm volatile("" ::: "memory"); T[48] -= a2.x * T[20]; T[49] -= a2.y * T[20]; T[50] -= a2.z * T[20]; T[51] -= a2.w * T[20]; a2 = *(const LAS f32x4*)(AB + 1380);
            asm volatile("" ::: "memory"); T[52] -= a3.x * T[20]; T[53] -= a3.y * T[20]; T[54] -= a3.z * T[20]; T[55] -= a3.w * T[20]; a3 = *(const LAS f32x4*)(AB + 1384);
            asm volatile("" ::: "memory"); T[56] -= a4.x * T[20]; T[57] -= a4.y * T[20]; T[58] -= a4.z * T[20]; T[59] -= a4.w * T[20]; a4 = *(const LAS f32x4*)(AB + 1388);
            asm volatile("" ::: "memory"); T[60] -= a5.x * T[20]; T[61] -= a5.y * T[20]; T[62] -= a5.z * T[20]; T[63] -= a5.w * T[20]; a5 = *(const LAS f32x4*)(AB + 1392);
            asm volatile("" ::: "memory"); T[22] -= a6.z * T[21]; T[23] -= a6.w * T[21]; a6 = *(const LAS f32x4*)(AB + 1396);
            asm volatile("" ::: "memory"); T[24] -= a7.x * T[21]; T[25] -= a7.y * T[21]; T[26] -= a7.z * T[21]; T[27] -= a7.w * T[21]; a7 = *(const LAS f32x4*)(AB + 1400);
            asm volatile("" ::: "memory"); T[28] -= a0.x * T[21]; T[29] -= a0.y * T[21]; T[30] -= a0.z * T[21]; T[31] -= a0.w * T[21]; a0 = *(const LAS f32x4*)(AB + 1404);
            asm volatile("" ::: "memory"); T[32] -= a1.x * T[21]; T[33] -= a1.y * T[21]; T[34] -= a1.z * T[21]; T[35] -= a1.w * T[21]; a1 = *(const LAS f32x4*)(AB + 1428);
            asm volatile("" ::: "memory"); T[36] -= a2.x * T[21]; T[37] -= a2.y * T[21]; T[38] -= a2.z * T[21]; T[39] -= a2.w * T[21]; a2 = *(const LAS f32x4*)(AB + 1432);
            asm volatile("" ::: "memory"); T[40] -= a3.x * T[21]; T[41] -= a3.y * T[21]; T[42] -= a3.z * T[21]; T[43] -= a3.w * T[21]; a3 = *(const LAS f32x4*)(AB + 1436);
            asm volatile("" ::: "memory"); T[44] -= a4.x * T[21]; T[45] -= a4.y * T[21]; T[46] -= a4.z * T[21]; T[47] -= a4.w * T[21]; a4 = *(const LAS f32x4*)(AB + 1440);
            asm volatile("" ::: "memory"); T[48] -= a5.x * T[21]; T[49] -= a5.y * T[21]; T[50] -= a5.z * T[21]; T[51] -= a5.w * T[21]; a5 = *(const LAS f32x4*)(AB + 1444);
            asm volatile("" ::: "memory"); T[52] -= a6.x * T[21]; T[53] -= a6.y * T[21]; T[54] -= a6.z * T[21]; T[55] -= a6.w * T[21]; a6 = *(const LAS f32x4*)(AB + 1448);
            asm volatile("" ::: "memory"); T[56] -= a7.x * T[21]; T[57] -= a7.y * T[21]; T[58] -= a7.z * T[21]; T[59] -= a7.w * T[21]; a7 = *(const LAS f32x4*)(AB + 1452);
            asm volatile("" ::: "memory"); T[60] -= a0.x * T[21]; T[61] -= a0.y * T[21]; T[62] -= a0.z * T[21]; T[63] -= a0.w * T[21]; a0 = *(const LAS f32x4*)(AB + 1456);
            asm volatile("" ::: "memory"); T[23] -= a1.w * T[22]; a1 = *(const LAS f32x4*)(AB + 1460);
            asm volatile("" ::: "memory"); T[24] -= a2.x * T[22]; T[25] -= a2.y * T[22]; T[26] -= a2.z * T[22]; T[27] -= a2.w * T[22]; a2 = *(const LAS f32x4*)(AB + 1464);
            asm volatile("" ::: "memory"); T[28] -= a3.x * T[22]; T[29] -= a3.y * T[22]; T[30] -= a3.z * T[22]; T[31] -= a3.w * T[22]; a3 = *(const LAS f32x4*)(AB + 1468);
            asm volatile("" ::: "memory"); T[32] -= a4.x * T[22]; T[33] -= a4.y * T[22]; T[34] -= a4.z * T[22]; T[35] -= a4.w * T[22]; a4 = *(const LAS f32x4*)(AB + 1496);
            asm volatile("" ::: "memory"); T[36] -= a5.x * T[22]; T[37] -= a5.y * T[22]; T[38] -= a5.z * T[22]; T[39] -= a5.w * T[22]; a5 = *(const LAS f32x4*)(AB + 1500);
            asm volatile("" ::: "memory"); T[40] -= a6.x * T[22]; T[41] -= a6.y * T[22]; T[42] -= a6.z * T[22]; T[43] -= a6.w * T[22]; a6 = *(const LAS f32x4*)(AB + 1504);
            asm volatile("" ::: "memory"); T[44] -= a7.x * T[22]; T[45] -= a7.y * T[22]; T[46] -= a7.z * T[22]; T[47] -= a7.w * T[22]; a7 = *(const LAS f32x4*)(AB + 1508);
            asm volatile("" ::: "memory"); T[48] -= a0.x * T[22]; T[49] -= a0.y * T[22]; T[50] -= a0.z * T[22]; T[51] -= a0.w * T[22]; a0 = *(const LAS f32x4*)(AB + 1512);
            asm volatile("" ::: "memory"); T[52] -= a1.x * T[22]; T[53] -= a1.y * T[22]; T[54] -= a1.z * T[22]; T[55] -= a1.w * T[22]; a1 = *(const LAS f32x4*)(AB + 1516);
            asm volatile("" ::: "memory"); T[56] -= a2.x * T[22]; T[57] -= a2.y * T[22]; T[58] -= a2.z * T[22]; T[59] -= a2.w * T[22]; a2 = *(const LAS f32x4*)(AB + 1520);
            asm volatile("" ::: "memory"); T[60] -= a3.x * T[22]; T[61] -= a3.y * T[22]; T[62] -= a3.z * T[22]; T[63] -= a3.w * T[22]; a3 = *(const LAS f32x4*)(AB + 1524);
            asm volatile("" ::: "memory"); T[24] -= a4.x * T[23]; T[25] -= a4.y * T[23]; T[26] -= a4.z * T[23]; T[27] -= a4.w * T[23]; a4 = *(const LAS f32x4*)(AB + 1528);
            asm volatile("" ::: "memory"); T[28] -= a5.x * T[23]; T[29] -= a5.y * T[23]; T[30] -= a5.z * T[23]; T[31] -= a5.w * T[23]; a5 = *(const LAS f32x4*)(AB + 1532);
            asm volatile("" ::: "memory"); T[32] -= a6.x * T[23]; T[33] -= a6.y * T[23]; T[34] -= a6.z * T[23]; T[35] -= a6.w * T[23]; a6 = *(const LAS f32x4*)(AB + 1560);
            asm volatile("" ::: "memory"); T[36] -= a7.x * T[23]; T[37] -= a7.y * T[23]; T[38] -= a7.z * T[23]; T[39] -= a7.w * T[23]; a7 = *(const LAS f32x4*)(AB + 1564);
            asm volatile("" ::: "memory"); T[40] -= a0.x * T[23]; T[41] -= a0.y * T[23]; T[42] -= a0.z * T[23]; T[43] -= a0.w * T[23]; a0 = *(const LAS f32x4*)(AB + 1568);
            asm volatile("" ::: "memory"); T[44] -= a1.x * T[23]; T[45] -= a1.y * T[23]; T[46] -= a1.z * T[23]; T[47] -= a1.w * T[23]; a1 = *(const LAS f32x4*)(AB + 1572);
            asm volatile("" ::: "memory"); T[48] -= a2.x * T[23]; T[49] -= a2.y * T[23]; T[50] -= a2.z * T[23]; T[51] -= a2.w * T[23]; a2 = *(const LAS f32x4*)(AB + 1576);
            asm volatile("" ::: "memory"); T[52] -= a3.x * T[23]; T[53] -= a3.y * T[23]; T[54] -= a3.z * T[23]; T[55] -= a3.w * T[23]; a3 = *(const LAS f32x4*)(AB + 1580);
            asm volatile("" ::: "memory"); T[56] -= a4.x * T[23]; T[57] -= a4.y * T[23]; T[58] -= a4.z * T[23]; T[59] -= a4.w * T[23]; a4 = *(const LAS f32x4*)(AB + 1584);
            asm volatile("" ::: "memory"); T[60] -= a5.x * T[23]; T[61] -= a5.y * T[23]; T[62] -= a5.z * T[23]; T[63] -= a5.w * T[23]; a5 = *(const LAS f32x4*)(AB + 1588);
            asm volatile("" ::: "memory"); T[25] -= a6.y * T[24]; T[26] -= a6.z * T[24]; T[27] -= a6.w * T[24]; a6 = *(const LAS f32x4*)(AB + 1592);
            asm volatile("" ::: "memory"); T[28] -= a7.x * T[24]; T[29] -= a7.y * T[24]; T[30] -= a7.z * T[24]; T[31] -= a7.w * T[24]; a7 = *(const LAS f32x4*)(AB + 1596);
            asm volatile("" ::: "memory"); T[32] -= a0.x * T[24]; T[33] -= a0.y * T[24]; T[34] -= a0.z * T[24]; T[35] -= a0.w * T[24]; a0 = *(const LAS f32x4*)(AB + 1624);
            asm volatile("" ::: "memory"); T[36] -= a1.x * T[24]; T[37] -= a1.y * T[24]; T[38] -= a1.z * T[24]; T[39] -= a1.w * T[24]; a1 = *(const LAS f32x4*)(AB + 1628);
            asm volatile("" ::: "memory"); T[40] -= a2.x * T[24]; T[41] -= a2.y * T[24]; T[42] -= a2.z * T[24]; T[43] -= a2.w * T[24]; a2 = *(const LAS f32x4*)(AB + 1632);
            asm volatile("" ::: "memory"); T[44] -= a3.x * T[24]; T[45] -= a3.y * T[24]; T[46] -= a3.z * T[24]; T[47] -= a3.w * T[24]; a3 = *(const LAS f32x4*)(AB + 1636);
            asm volatile("" ::: "memory"); T[48] -= a4.x * T[24]; T[49] -= a4.y * T[24]; T[50] -= a4.z * T[24]; T[51] -= a4.w * T[24]; a4 = *(const LAS f32x4*)(AB + 1640);
            asm volatile("" ::: "memory"); T[52] -= a5.x * T[24]; T[53] -= a5.y * T[24]; T[54] -= a5.z * T[24]; T[55] -= a5.w * T[24]; a5 = *(const LAS f32x4*)(AB + 1644);
            asm volatile("" ::: "memory"); T[56] -= a6.x * T[24]; T[57] -= a6.y * T[24]; T[58] -= a6.z * T[24]; T[59] -= a6.w * T[24]; a6 = *(const LAS f32x4*)(AB + 1648);
            asm volatile("" ::: "memory"); T[60] -= a7.x * T[24]; T[61] -= a7.y * T[24]; T[62] -= a7.z * T[24]; T[63] -= a7.w * T[24]; a7 = *(const LAS f32x4*)(AB + 1652);
            asm volatile("" ::: "memory"); T[26] -= a0.z * T[25]; T[27] -= a0.w * T[25]; a0 = *(const LAS f32x4*)(AB + 1656);
            asm volatile("" ::: "memory"); T[28] -= a1.x * T[25]; T[29] -= a1.y * T[25]; T[30] -= a1.z * T[25]; T[31] -= a1.w * T[25]; a1 = *(const LAS f32x4*)(AB + 1660);
            asm volatile("" ::: "memory"); T[32] -= a2.x * T[25]; T[33] -= a2.y * T[25]; T[34] -= a2.z * T[25]; T[35] -= a2.w * T[25]; a2 = *(const LAS f32x4*)(AB + 1688);
            asm volatile("" ::: "memory"); T[36] -= a3.x * T[25]; T[37] -= a3.y * T[25]; T[38] -= a3.z * T[25]; T[39] -= a3.w * T[25]; a3 = *(const LAS f32x4*)(AB + 1692);
            asm volatile("" ::: "memory"); T[40] -= a4.x * T[25]; T[41] -= a4.y * T[25]; T[42] -= a4.z * T[25]; T[43] -= a4.w * T[25]; a4 = *(const LAS f32x4*)(AB + 1696);
            asm volatile("" ::: "memory"); T[44] -= a5.x * T[25]; T[45] -= a5.y * T[25]; T[46] -= a5.z * T[25]; T[47] -= a5.w * T[25]; a5 = *(const LAS f32x4*)(AB + 1700);
            asm volatile("" ::: "memory"); T[48] -= a6.x * T[25]; T[49] -= a6.y * T[25]; T[50] -= a6.z * T[25]; T[51] -= a6.w * T[25]; a6 = *(const LAS f32x4*)(AB + 1704);
            asm volatile("" ::: "memory"); T[52] -= a7.x * T[25]; T[53] -= a7.y * T[25]; T[54] -= a7.z * T[25]; T[55] -= a7.w * T[25]; a7 = *(const LAS f32x4*)(AB + 1708);
            asm volatile("" ::: "memory"); T[56] -= a0.x * T[25]; T[57] -= a0.y * T[25]; T[58] -= a0.z * T[25]; T[59] -= a0.w * T[25]; a0 = *(const LAS f32x4*)(AB + 1712);
            asm volatile("" ::: "memory"); T[60] -= a1.x * T[25]; T[61] -= a1.y * T[25]; T[62] -= a1.z * T[25]; T[63] -= a1.w * T[25]; a1 = *(const LAS f32x4*)(AB + 1716);
            asm volatile("" ::: "memory"); T[27] -= a2.w * T[26]; a2 = *(const LAS f32x4*)(AB + 1720);
            asm volatile("" ::: "memory"); T[28] -= a3.x * T[26]; T[29] -= a3.y * T[26]; T[30] -= a3.z * T[26]; T[31] -= a3.w * T[26]; a3 = *(const LAS f32x4*)(AB + 1724);
            asm volatile("" ::: "memory"); T[32] -= a4.x * T[26]; T[33] -= a4.y * T[26]; T[34] -= a4.z * T[26]; T[35] -= a4.w * T[26]; a4 = *(const LAS f32x4*)(AB + 1756);
            asm volatile("" ::: "memory"); T[36] -= a5.x * T[26]; T[37] -= a5.y * T[26]; T[38] -= a5.z * T[26]; T[39] -= a5.w * T[26]; a5 = *(const LAS f32x4*)(AB + 1760);
            asm volatile("" ::: "memory"); T[40] -= a6.x * T[26]; T[41] -= a6.y * T[26]; T[42] -= a6.z * T[26]; T[43] -= a6.w * T[26]; a6 = *(const LAS f32x4*)(AB + 1764);
            asm volatile("" ::: "memory"); T[44] -= a7.x * T[26]; T[45] -= a7.y * T[26]; T[46] -= a7.z * T[26]; T[47] -= a7.w * T[26]; a7 = *(const LAS f32x4*)(AB + 1768);
            asm volatile("" ::: "memory"); T[48] -= a0.x * T[26]; T[49] -= a0.y * T[26]; T[50] -= a0.z * T[26]; T[51] -= a0.w * T[26]; a0 = *(const LAS f32x4*)(AB + 1772);
            asm volatile("" ::: "memory"); T[52] -= a1.x * T[26]; T[53] -= a1.y * T[26]; T[54] -= a1.z * T[26]; T[55] -= a1.w * T[26]; a1 = *(const LAS f32x4*)(AB + 1776);
            asm volatile("" ::: "memory"); T[56] -= a2.x * T[26]; T[57] -= a2.y * T[26]; T[58] -= a2.z * T[26]; T[59] -= a2.w * T[26]; a2 = *(const LAS f32x4*)(AB + 1780);
            asm volatile("" ::: "memory"); T[60] -= a3.x * T[26]; T[61] -= a3.y * T[26]; T[62] -= a3.z * T[26]; T[63] -= a3.w * T[26]; a3 = *(const LAS f32x4*)(AB + 1784);
            asm volatile("" ::: "memory"); T[28] -= a4.x * T[27]; T[29] -= a4.y * T[27]; T[30] -= a4.z * T[27]; T[31] -= a4.w * T[27]; a4 = *(const LAS f32x4*)(AB + 1788);
            asm volatile("" ::: "memory"); T[32] -= a5.x * T[27]; T[33] -= a5.y * T[27]; T[34] -= a5.z * T[27]; T[35] -= a5.w * T[27]; a5 = *(const LAS f32x4*)(AB + 1820);
            asm volatile("" ::: "memory"); T[36] -= a6.x * T[27]; T[37] -= a6.y * T[27]; T[38] -= a6.z * T[27]; T[39] -= a6.w * T[27]; a6 = *(const LAS f32x4*)(AB + 1824);
            asm volatile("" ::: "memory"); T[40] -= a7.x * T[27]; T[41] -= a7.y * T[27]; T[42] -= a7.z * T[27]; T[43] -= a7.w * T[27]; a7 = *(const LAS f32x4*)(AB + 1828);
            asm volatile("" ::: "memory"); T[44] -= a0.x * T[27]; T[45] -= a0.y * T[27]; T[46] -= a0.z * T[27]; T[47] -= a0.w * T[27]; a0 = *(const LAS f32x4*)(AB + 1832);
            asm volatile("" ::: "memory"); T[48] -= a1.x * T[27]; T[49] -= a1.y * T[27]; T[50] -= a1.z * T[27]; T[51] -= a1.w * T[27]; a1 = *(const LAS f32x4*)(AB + 1836);
            asm volatile("" ::: "memory"); T[52] -= a2.x * T[27]; T[53] -= a2.y * T[27]; T[54] -= a2.z * T[27]; T[55] -= a2.w * T[27]; a2 = *(const LAS f32x4*)(AB + 1840);
            asm volatile("" ::: "memory"); T[56] -= a3.x * T[27]; T[57] -= a3.y * T[27]; T[58] -= a3.z * T[27]; T[59] -= a3.w * T[27]; a3 = *(const LAS f32x4*)(AB + 1844);
            asm volatile("" ::: "memory"); T[60] -= a4.x * T[27]; T[61] -= a4.y * T[27]; T[62] -= a4.z * T[27]; T[63] -= a4.w * T[27]; a4 = *(const LAS f32x4*)(AB + 1848);
            asm volatile("" ::: "memory"); T[29] -= a5.y * T[28]; T[30] -= a5.z * T[28]; T[31] -= a5.w * T[28]; a5 = *(const LAS f32x4*)(AB + 1852);
            asm volatile("" ::: "memory"); T[32] -= a6.x * T[28]; T[33] -= a6.y * T[28]; T[34] -= a6.z * T[28]; T[35] -= a6.w * T[28]; a6 = *(const LAS f32x4*)(AB + 1884);
            asm volatile("" ::: "memory"); T[36] -= a7.x * T[28]; T[37] -= a7.y * T[28]; T[38] -= a7.z * T[28]; T[39] -= a7.w * T[28]; a7 = *(const LAS f32x4*)(AB + 1888);
            asm volatile("" ::: "memory"); T[40] -= a0.x * T[28]; T[41] -= a0.y * T[28]; T[42] -= a0.z * T[28]; T[43] -= a0.w * T[28]; a0 = *(const LAS f32x4*)(AB + 1892);
            asm volatile("" ::: "memory"); T[44] -= a1.x * T[28]; T[45] -= a1.y * T[28]; T[46] -= a1.z * T[28]; T[47] -= a1.w * T[28]; a1 = *(const LAS f32x4*)(AB + 1896);
            asm volatile("" ::: "memory"); T[48] -= a2.x * T[28]; T[49] -= a2.y * T[28]; T[50] -= a2.z * T[28]; T[51] -= a2.w * T[28]; a2 = *(const LAS f32x4*)(AB + 1900);
            asm volatile("" ::: "memory"); T[52] -= a3.x * T[28]; T[53] -= a3.y * T[28]; T[54] -= a3.z * T[28]; T[55] -= a3.w * T[28]; a3 = *(const LAS f32x4*)(AB + 1904);
            asm volatile("" ::: "memory"); T[56] -= a4.x * T[28]; T[57] -= a4.y * T[28]; T[58] -= a4.z * T[28]; T[59] -= a4.w * T[28]; a4 = *(const LAS f32x4*)(AB + 1908);
            asm volatile("" ::: "memory"); T[60] -= a5.x * T[28]; T[61] -= a5.y * T[28]; T[62] -= a5.z * T[28]; T[63] -= a5.w * T[28]; a5 = *(const LAS f32x4*)(AB + 1912);
            asm volatile("" ::: "memory"); T[30] -= a6.z * T[29]; T[31] -= a6.w * T[29]; a6 = *(const LAS f32x4*)(AB + 1916);
            asm volatile("" ::: "memory"); T[32] -= a7.x * T[29]; T[33] -= a7.y * T[29]; T[34] -= a7.z * T[29]; T[35] -= a7.w * T[29]; a7 = *(const LAS f32x4*)(AB + 1948);
            asm volatile("" ::: "memory"); T[36] -= a0.x * T[29]; T[37] -= a0.y * T[29]; T[38] -= a0.z * T[29]; T[39] -= a0.w * T[29]; a0 = *(const LAS f32x4*)(AB + 1952);
            asm volatile("" ::: "memory"); T[40] -= a1.x * T[29]; T[41] -= a1.y * T[29]; T[42] -= a1.z * T[29]; T[43] -= a1.w * T[29]; a1 = *(const LAS f32x4*)(AB + 1956);
            asm volatile("" ::: "memory"); T[44] -= a2.x * T[29]; T[45] -= a2.y * T[29]; T[46] -= a2.z * T[29]; T[47] -= a2.w * T[29]; a2 = *(const LAS f32x4*)(AB + 1960);
            asm volatile("" ::: "memory"); T[48] -= a3.x * T[29]; T[49] -= a3.y * T[29]; T[50] -= a3.z * T[29]; T[51] -= a3.w * T[29]; a3 = *(const LAS f32x4*)(AB + 1964);
            asm volatile("" ::: "memory"); T[52] -= a4.x * T[29]; T[53] -= a4.y * T[29]; T[54] -= a4.z * T[29]; T[55] -= a4.w * T[29]; a4 = *(const LAS f32x4*)(AB + 1968);
            asm volatile("" ::: "memory"); T[56] -= a5.x * T[29]; T[57] -= a5.y * T[29]; T[58] -= a5.z * T[29]; T[59] -= a5.w * T[29]; a5 = *(const LAS f32x4*)(AB + 1972);
            asm volatile("" ::: "memory"); T[60] -= a6.x * T[29]; T[61] -= a6.y * T[29]; T[62] -= a6.z * T[29]; T[63] -= a6.w * T[29]; a6 = *(const LAS f32x4*)(AB + 1976);
            asm volatile("" ::: "memory"); T[31] -= a7.w * T[30]; a7 = *(const LAS f32x4*)(AB + 1980);
            asm volatile("" ::: "memory"); T[32] -= a0.x * T[30]; T[33] -= a0.y * T[30]; T[34] -= a0.z * T[30]; T[35] -= a0.w * T[30]; a0 = *(const LAS f32x4*)(AB + 2016);
            asm volatile("" ::: "memory"); T[36] -= a1.x * T[30]; T[37] -= a1.y * T[30]; T[38] -= a1.z * T[30]; T[39] -= a1.w * T[30]; a1 = *(const LAS f32x4*)(AB + 2020);
            asm volatile("" ::: "memory"); T[40] -= a2.x * T[30]; T[41] -= a2.y * T[30]; T[42] -= a2.z * T[30]; T[43] -= a2.w * T[30]; a2 = *(const LAS f32x4*)(AB + 2024);
            asm volatile("" ::: "memory"); T[44] -= a3.x * T[30]; T[45] -= a3.y * T[30]; T[46] -= a3.z * T[30]; T[47] -= a3.w * T[30]; a3 = *(const LAS f32x4*)(AB + 2028);
            asm volatile("" ::: "memory"); T[48] -= a4.x * T[30]; T[49] -= a4.y * T[30]; T[50] -= a4.z * T[30]; T[51] -= a4.w * T[30]; a4 = *(const LAS f32x4*)(AB + 2032);
            asm volatile("" ::: "memory"); T[52] -= a5.x * T[30]; T[53] -= a5.y * T[30]; T[54] -= a5.z * T[30]; T[55] -= a5.w * T[30]; a5 = *(const LAS f32x4*)(AB + 2036);
            asm volatile("" ::: "memory"); T[56] -= a6.x * T[30]; T[57] -= a6.y * T[30]; T[58] -= a6.z * T[30]; T[59] -= a6.w * T[30]; a6 = *(const LAS f32x4*)(AB + 2040);
            asm volatile("" ::: "memory"); T[60] -= a7.x * T[30]; T[61] -= a7.y * T[30]; T[62] -= a7.z * T[30]; T[63] -= a7.w * T[30]; a7 = *(const LAS f32x4*)(AB + 2044);
            asm volatile("" ::: "memory"); T[32] -= a0.x * T[31]; T[33] -= a0.y * T[31]; T[34] -= a0.z * T[31]; T[35] -= a0.w * T[31]; a0 = *(const LAS f32x4*)(AB + 2080);
            asm volatile("" ::: "memory"); T[36] -= a1.x * T[31]; T[37] -= a1.y * T[31]; T[38] -= a1.z * T[31]; T[39] -= a1.w * T[31]; a1 = *(const LAS f32x4*)(AB + 2084);
            asm volatile("" ::: "memory"); T[40] -= a2.x * T[31]; T[41] -= a2.y * T[31]; T[42] -= a2.z * T[31]; T[43] -= a2.w * T[31]; a2 = *(const LAS f32x4*)(AB + 2088);
            asm volatile("" ::: "memory"); T[44] -= a3.x * T[31]; T[45] -= a3.y * T[31]; T[46] -= a3.z * T[31]; T[47] -= a3.w * T[31]; a3 = *(const LAS f32x4*)(AB + 2092);
            asm volatile("" ::: "memory"); T[48] -= a4.x * T[31]; T[49] -= a4.y * T[31]; T[50] -= a4.z * T[31]; T[51] -= a4.w * T[31]; a4 = *(const LAS f32x4*)(AB + 2096);
            asm volatile("" ::: "memory"); T[52] -= a5.x * T[31]; T[53] -= a5.y * T[31]; T[54] -= a5.z * T[31]; T[55] -= a5.w * T[31]; a5 = *(const LAS f32x4*)(AB + 2100);
            asm volatile("" ::: "memory"); T[56] -= a6.x * T[31]; T[57] -= a6.y * T[31]; T[58] -= a6.z * T[31]; T[59] -= a6.w * T[31]; a6 = *(const LAS f32x4*)(AB + 2104);
            asm volatile("" ::: "memory"); T[60] -= a7.x * T[31]; T[61] -= a7.y * T[31]; T[62] -= a7.z * T[31]; T[63] -= a7.w * T[31]; a7 = *(const LAS f32x4*)(AB + 2108);
            asm volatile("" ::: "memory"); T[33] -= a0.y * T[32]; T[34] -= a0.z * T[32]; T[35] -= a0.w * T[32]; a0 = *(const LAS f32x4*)(AB + 2144);
            asm volatile("" ::: "memory"); T[36] -= a1.x * T[32]; T[37] -= a1.y * T[32]; T[38] -= a1.z * T[32]; T[39] -= a1.w * T[32]; a1 = *(const LAS f32x4*)(AB + 2148);
            asm volatile("" ::: "memory"); T[40] -= a2.x * T[32]; T[41] -= a2.y * T[32]; T[42] -= a2.z * T[32]; T[43] -= a2.w * T[32]; a2 = *(const LAS f32x4*)(AB + 2152);
            asm volatile("" ::: "memory"); T[44] -= a3.x * T[32]; T[45] -= a3.y * T[32]; T[46] -= a3.z * T[32]; T[47] -= a3.w * T[32]; a3 = *(const LAS f32x4*)(AB + 2156);
            asm volatile("" ::: "memory"); T[48] -= a4.x * T[32]; T[49] -= a4.y * T[32]; T[50] -= a4.z * T[32]; T[51] -= a4.w * T[32]; a4 = *(const LAS f32x4*)(AB + 2160);
            asm volatile("" ::: "memory"); T[52] -= a5.x * T[32]; T[53] -= a5.y * T[32]; T[54] -= a5.z * T[32]; T[55] -= a5.w * T[32]; a5 = *(const LAS f32x4*)(AB + 2164);
            asm volatile("" ::: "memory"); T[56] -= a6.x * T[32]; T[57] -= a6.y * T[32]; T[58] -= a6.z * T[32]; T[59] -= a6.w * T[32]; a6 = *(const LAS f32x4*)(AB + 2168);
            asm volatile("" ::: "memory"); T[60] -= a7.x * T[32]; T[61] -= a7.y * T[32]; T[62] -= a7.z * T[32]; T[63] -= a7.w * T[32]; a7 = *(const LAS f32x4*)(AB + 2172);
            asm volatile("" ::: "memory"); T[34] -= a0.z * T[33]; T[35] -= a0.w * T[33]; a0 = *(const LAS f32x4*)(AB + 2208);
            asm volatile("" ::: "memory"); T[36] -= a1.x * T[33]; T[37] -= a1.y * T[33]; T[38] -= a1.z * T[33]; T[39] -= a1.w * T[33]; a1 = *(const LAS f32x4*)(AB + 2212);
            asm volatile("" ::: "memory"); T[40] -= a2.x * T[33]; T[41] -= a2.y * T[33]; T[42] -= a2.z * T[33]; T[43] -= a2.w * T[33]; a2 = *(const LAS f32x4*)(AB + 2216);
            asm volatile("" ::: "memory"); T[44] -= a3.x * T[33]; T[45] -= a3.y * T[33]; T[46] -= a3.z * T[33]; T[47] -= a3.w * T[33]; a3 = *(const LAS f32x4*)(AB + 2220);
            asm volatile("" ::: "memory"); T[48] -= a4.x * T[33]; T[49] -= a4.y * T[33]; T[50] -= a4.z * T[33]; T[51] -= a4.w * T[33]; a4 = *(const LAS f32x4*)(AB + 2224);
            asm volatile("" ::: "memory"); T[52] -= a5.x * T[33]; T[53] -= a5.y * T[33]; T[54] -= a5.z * T[33]; T[55] -= a5.w * T[33]; a5 = *(const LAS f32x4*)(AB + 2228);
            asm volatile("" ::: "memory"); T[56] -= a6.x * T[33]; T[57] -= a6.y * T[33]; T[58] -= a6.z * T[33]; T[59] -= a6.w * T[33]; a6 = *(const LAS f32x4*)(AB + 2232);
            asm volatile("" ::: "memory"); T[60] -= a7.x * T[33]; T[61] -= a7.y * T[33]; T[62] -= a7.z * T[33]; T[63] -= a7.w * T[33]; a7 = *(const LAS f32x4*)(AB + 2236);
            asm volatile("" ::: "memory"); T[35] -= a0.w * T[34]; a0 = *(const LAS f32x4*)(AB + 2276);
            asm volatile("" ::: "memory"); T[36] -= a1.x * T[34]; T[37] -= a1.y * T[34]; T[38] -= a1.z * T[34]; T[39] -= a1.w * T[34]; a1 = *(const LAS f32x4*)(AB + 2280);
            asm volatile("" ::: "memory"); T[40] -= a2.x * T[34]; T[41] -= a2.y * T[34]; T[42] -= a2.z * T[34]; T[43] -= a2.w * T[34]; a2 = *(const LAS f32x4*)(AB + 2284);
            asm volatile("" ::: "memory"); T[44] -= a3.x * T[34]; T[45] -= a3.y * T[34]; T[46] -= a3.z * T[34]; T[47] -= a3.w * T[34]; a3 = *(const LAS f32x4*)(AB + 2288);
            asm volatile("" ::: "memory"); T[48] -= a4.x * T[34]; T[49] -= a4.y * T[34]; T[50] -= a4.z * T[34]; T[51] -= a4.w * T[34]; a4 = *(const LAS f32x4*)(AB + 2292);
            asm volatile("" ::: "memory"); T[52] -= a5.x * T[34]; T[53] -= a5.y * T[34]; T[54] -= a5.z * T[34]; T[55] -= a5.w * T[34]; a5 = *(const LAS f32x4*)(AB + 2296);
            asm volatile("" ::: "memory"); T[56] -= a6.x * T[34]; T[57] -= a6.y * T[34]; T[58] -= a6.z * T[34]; T[59] -= a6.w * T[34]; a6 = *(const LAS f32x4*)(AB + 2300);
            asm volatile("" ::: "memory"); T[60] -= a7.x * T[34]; T[61] -= a7.y * T[34]; T[62] -= a7.z * T[34]; T[63] -= a7.w * T[34]; a7 = *(const LAS f32x4*)(AB + 2340);
            asm volatile("" ::: "memory"); T[36] -= a0.x * T[35]; T[37] -= a0.y * T[35]; T[38] -= a0.z * T[35]; T[39] -= a0.w * T[35]; a0 = *(const LAS f32x4*)(AB + 2344);
            asm volatile("" ::: "memory"); T[40] -= a1.x * T[35]; T[41] -= a1.y * T[35]; T[42] -= a1.z * T[35]; T[43] -= a1.w * T[35]; a1 = *(const LAS f32x4*)(AB + 2348);
            asm volatile("" ::: "memory"); T[44] -= a2.x * T[35]; T[45] -= a2.y * T[35]; T[46] -= a2.z * T[35]; T[47] -= a2.w * T[35]; a2 = *(const LAS f32x4*)(AB + 2352);
            asm volatile("" ::: "memory"); T[48] -= a3.x * T[35]; T[49] -= a3.y * T[35]; T[50] -= a3.z * T[35]; T[51] -= a3.w * T[35]; a3 = *(const LAS f32x4*)(AB + 2356);
            asm volatile("" ::: "memory"); T[52] -= a4.x * T[35]; T[53] -= a4.y * T[35]; T[54] -= a4.z * T[35]; T[55] -= a4.w * T[35]; a4 = *(const LAS f32x4*)(AB + 2360);
            asm volatile("" ::: "memory"); T[56] -= a5.x * T[35]; T[57] -= a5.y * T[35]; T[58] -= a5.z * T[35]; T[59] -= a5.w * T[35]; a5 = *(const LAS f32x4*)(AB + 2364);
            asm volatile("" ::: "memory"); T[60] -= a6.x * T[35]; T[61] -= a6.y * T[35]; T[62] -= a6.z * T[35]; T[63] -= a6.w * T[35]; a6 = *(const LAS f32x4*)(AB + 2404);
            asm volatile("" ::: "memory"); T[37] -= a7.y * T[36]; T[38] -= a7.z * T[36]; T[39] -= a7.w * T[36]; a7 = *(const LAS f32x4*)(AB + 2408);
            asm volatile("" ::: "memory"); T[40] -= a0.x * T[36]; T[41] -= a0.y * T[36]; T[42] -= a0.z * T[36]; T[43] -= a0.w * T[36]; a0 = *(const LAS f32x4*)(AB + 2412);
            asm volatile("" ::: "memory"); T[44] -= a1.x * T[36]; T[45] -= a1.y * T[36]; T[46] -= a1.z * T[36]; T[47] -= a1.w * T[36]; a1 = *(const LAS f32x4*)(AB + 2416);
            asm volatile("" ::: "memory"); T[48] -= a2.x * T[36]; T[49] -= a2.y * T[36]; T[50] -= a2.z * T[36]; T[51] -= a2.w * T[36]; a2 = *(const LAS f32x4*)(AB + 2420);
            asm volatile("" ::: "memory"); T[52] -= a3.x * T[36]; T[53] -= a3.y * T[36]; T[54] -= a3.z * T[36]; T[55] -= a3.w * T[36]; a3 = *(const LAS f32x4*)(AB + 2424);
            asm volatile("" ::: "memory"); T[56] -= a4.x * T[36]; T[57] -= a4.y * T[36]; T[58] -= a4.z * T[36]; T[59] -= a4.w * T[36]; a4 = *(const LAS f32x4*)(AB + 2428);
            asm volatile("" ::: "memory"); T[60] -= a5.x * T[36]; T[61] -= a5.y * T[36]; T[62] -= a5.z * T[36]; T[63] -= a5.w * T[36]; a5 = *(const LAS f32x4*)(AB + 2468);
            asm volatile("" ::: "memory"); T[38] -= a6.z * T[37]; T[39] -= a6.w * T[37]; a6 = *(const LAS f32x4*)(AB + 2472);
            asm volatile("" ::: "memory"); T[40] -= a7.x * T[37]; T[41] -= a7.y * T[37]; T[42] -= a7.z * T[37]; T[43] -= a7.w * T[37]; a7 = *(const LAS f32x4*)(AB + 2476);
            asm volatile("" ::: "memory"); T[44] -= a0.x * T[37]; T[45] -= a0.y * T[37]; T[46] -= a0.z * T[37]; T[47] -= a0.w * T[37]; a0 = *(const LAS f32x4*)(AB + 2480);
            asm volatile("" ::: "memory"); T[48] -= a1.x * T[37]; T[49] -= a1.y * T[37]; T[50] -= a1.z * T[37]; T[51] -= a1.w * T[37]; a1 = *(const LAS f32x4*)(AB + 2484);
            asm volatile("" ::: "memory"); T[52] -= a2.x * T[37]; T[53] -= a2.y * T[37]; T[54] -= a2.z * T[37]; T[55] -= a2.w * T[37]; a2 = *(const LAS f32x4*)(AB + 2488);
            asm volatile("" ::: "memory"); T[56] -= a3.x * T[37]; T[57] -= a3.y * T[37]; T[58] -= a3.z * T[37]; T[59] -= a3.w * T[37]; a3 = *(const LAS f32x4*)(AB + 2492);
            asm volatile("" ::: "memory"); T[60] -= a4.x * T[37]; T[61] -= a4.y * T[37]; T[62] -= a4.z * T[37]; T[63] -= a4.w * T[37]; a4 = *(const LAS f32x4*)(AB + 2536);
            asm volatile("" ::: "memory"); T[39] -= a5.w * T[38]; a5 = *(const LAS f32x4*)(AB + 2540);
            asm volatile("" ::: "memory"); T[40] -= a6.x * T[38]; T[41] -= a6.y * T[38]; T[42] -= a6.z * T[38]; T[43] -= a6.w * T[38]; a6 = *(const LAS f32x4*)(AB + 2544);
            asm volatile("" ::: "memory"); T[44] -= a7.x * T[38]; T[45] -= a7.y * T[38]; T[46] -= a7.z * T[38]; T[47] -= a7.w * T[38]; a7 = *(const LAS f32x4*)(AB + 2548);
            asm volatile("" ::: "memory"); T[48] -= a0.x * T[38]; T[49] -= a0.y * T[38]; T[50] -= a0.z * T[38]; T[51] -= a0.w * T[38]; a0 = *(const LAS f32x4*)(AB + 2552);
            asm volatile("" ::: "memory"); T[52] -= a1.x * T[38]; T[53] -= a1.y * T[38]; T[54] -= a1.z * T[38]; T[55] -= a1.w * T[38]; a1 = *(const LAS f32x4*)(AB + 2556);
            asm volatile("" ::: "memory"); T[56] -= a2.x * T[38]; T[57] -= a2.y * T[38]; T[58] -= a2.z * T[38]; T[59] -= a2.w * T[38]; a2 = *(const LAS f32x4*)(AB + 2600);
            asm volatile("" ::: "memory"); T[60] -= a3.x * T[38]; T[61] -= a3.y * T[38]; T[62] -= a3.z * T[38]; T[63] -= a3.w * T[38]; a3 = *(const LAS f32x4*)(AB + 2604);
            asm volatile("" ::: "memory"); T[40] -= a4.x * T[39]; T[41] -= a4.y * T[39]; T[42] -= a4.z * T[39]; T[43] -= a4.w * T[39]; a4 = *(const LAS f32x4*)(AB + 2608);
            asm volatile("" ::: "memory"); T[44] -= a5.x * T[39]; T[45] -= a5.y * T[39]; T[46] -= a5.z * T[39]; T[47] -= a5.w * T[39]; a5 = *(const LAS f32x4*)(AB + 2612);
            asm volatile("" ::: "memory"); T[48] -= a6.x * T[39]; T[49] -= a6.y * T[39]; T[50] -= a6.z * T[39]; T[51] -= a6.w * T[39]; a6 = *(const LAS f32x4*)(AB + 2616);
            asm volatile("" ::: "memory"); T[52] -= a7.x * T[39]; T[53] -= a7.y * T[39]; T[54] -= a7.z * T[39]; T[55] -= a7.w * T[39]; a7 = *(const LAS f32x4*)(AB + 2620);
            asm volatile("" ::: "memory"); T[56] -= a0.x * T[39]; T[57] -= a0.y * T[39]; T[58] -= a0.z * T[39]; T[59] -= a0.w * T[39]; a0 = *(const LAS f32x4*)(AB + 2664);
            asm volatile("" ::: "memory"); T[60] -= a1.x * T[39]; T[61] -= a1.y * T[39]; T[62] -= a1.z * T[39]; T[63] -= a1.w * T[39]; a1 = *(const LAS f32x4*)(AB + 2668);
            asm volatile("" ::: "memory"); T[41] -= a2.y * T[40]; T[42] -= a2.z * T[40]; T[43] -= a2.w * T[40]; a2 = *(const LAS f32x4*)(AB + 2672);
            asm volatile("" ::: "memory"); T[44] -= a3.x * T[40]; T[45] -= a3.y * T[40]; T[46] -= a3.z * T[40]; T[47] -= a3.w * T[40]; a3 = *(const LAS f32x4*)(AB + 2676);
            asm volatile("" ::: "memory"); T[48] -= a4.x * T[40]; T[49] -= a4.y * T[40]; T[50] -= a4.z * T[40]; T[51] -= a4.w * T[40]; a4 = *(const LAS f32x4*)(AB + 2680);
            asm volatile("" ::: "memory"); T[52] -= a5.x * T[40]; T[53] -= a5.y * T[40]; T[54] -= a5.z * T[40]; T[55] -= a5.w * T[40]; a5 = *(const LAS f32x4*)(AB + 2684);
            asm volatile("" ::: "memory"); T[56] -= a6.x * T[40]; T[57] -= a6.y * T[40]; T[58] -= a6.z * T[40]; T[59] -= a6.w * T[40]; a6 = *(const LAS f32x4*)(AB + 2728);
            asm volatile("" ::: "memory"); T[60] -= a7.x * T[40]; T[61] -= a7.y * T[40]; T[62] -= a7.z * T[40]; T[63] -= a7.w * T[40]; a7 = *(const LAS f32x4*)(AB + 2732);
            asm volatile("" ::: "memory"); T[42] -= a0.z * T[41]; T[43] -= a0.w * T[41]; a0 = *(const LAS f32x4*)(AB + 2736);
            asm volatile("" ::: "memory"); T[44] -= a1.x * T[41]; T[45] -= a1.y * T[41]; T[46] -= a1.z * T[41]; T[47] -= a1.w * T[41]; a1 = *(const LAS f32x4*)(AB + 2740);
            asm volatile("" ::: "memory"); T[48] -= a2.x * T[41]; T[49] -= a2.y * T[41]; T[50] -= a2.z * T[41]; T[51] -= a2.w * T[41]; a2 = *(const LAS f32x4*)(AB + 2744);
            asm volatile("" ::: "memory"); T[52] -= a3.x * T[41]; T[53] -= a3.y * T[41]; T[54] -= a3.z * T[41]; T[55] -= a3.w * T[41]; a3 = *(const LAS f32x4*)(AB + 2748);
            asm volatile("" ::: "memory"); T[56] -= a4.x * T[41]; T[57] -= a4.y * T[41]; T[58] -= a4.z * T[41]; T[59] -= a4.w * T[41]; a4 = *(const LAS f32x4*)(AB + 2796);
            asm volatile("" ::: "memory"); T[60] -= a5.x * T[41]; T[61] -= a5.y * T[41]; T[62] -= a5.z * T[41]; T[63] -= a5.w * T[41]; a5 = *(const LAS f32x4*)(AB + 2800);
            asm volatile("" ::: "memory"); T[43] -= a6.w * T[42]; a6 = *(const LAS f32x4*)(AB + 2804);
            asm volatile("" ::: "memory"); T[44] -= a7.x * T[42]; T[45] -= a7.y * T[42]; T[46] -= a7.z * T[42]; T[47] -= a7.w * T[42]; a7 = *(const LAS f32x4*)(AB + 2808);
            asm volatile("" ::: "memory"); T[48] -= a0.x * T[42]; T[49] -= a0.y * T[42]; T[50] -= a0.z * T[42]; T[51] -= a0.w * T[42]; a0 = *(const LAS f32x4*)(AB + 2812);
            asm volatile("" ::: "memory"); T[52] -= a1.x * T[42]; T[53] -= a1.y * T[42]; T[54] -= a1.z * T[42]; T[55] -= a1.w * T[42]; a1 = *(const LAS f32x4*)(AB + 2860);
            asm volatile("" ::: "memory"); T[56] -= a2.x * T[42]; T[57] -= a2.y * T[42]; T[58] -= a2.z * T[42]; T[59] -= a2.w * T[42]; a2 = *(const LAS f32x4*)(AB + 2864);
            asm volatile("" ::: "memory"); T[60] -= a3.x * T[42]; T[61] -= a3.y * T[42]; T[62] -= a3.z * T[42]; T[63] -= a3.w * T[42]; a3 = *(const LAS f32x4*)(AB + 2868);
            asm volatile("" ::: "memory"); T[44] -= a4.x * T[43]; T[45] -= a4.y * T[43]; T[46] -= a4.z * T[43]; T[47] -= a4.w * T[43]; a4 = *(const LAS f32x4*)(AB + 2872);
            asm volatile("" ::: "memory"); T[48] -= a5.x * T[43]; T[49] -= a5.y * T[43]; T[50] -= a5.z * T[43]; T[51] -= a5.w * T[43]; a5 = *(const LAS f32x4*)(AB + 2876);
            asm volatile("" ::: "memory"); T[52] -= a6.x * T[43]; T[53] -= a6.y * T[43]; T[54] -= a6.z * T[43]; T[55] -= a6.w * T[43]; a6 = *(const LAS f32x4*)(AB + 2924);
            asm volatile("" ::: "memory"); T[56] -= a7.x * T[43]; T[57] -= a7.y * T[43]; T[58] -= a7.z * T[43]; T[59] -= a7.w * T[43]; a7 = *(const LAS f32x4*)(AB + 2928);
            asm volatile("" ::: "memory"); T[60] -= a0.x * T[43]; T[61] -= a0.y * T[43]; T[62] -= a0.z * T[43]; T[63] -= a0.w * T[43]; a0 = *(const LAS f32x4*)(AB + 2932);
            asm volatile("" ::: "memory"); T[45] -= a1.y * T[44]; T[46] -= a1.z * T[44]; T[47] -= a1.w * T[44]; a1 = *(const LAS f32x4*)(AB + 2936);
            asm volatile("" ::: "memory"); T[48] -= a2.x * T[44]; T[49] -= a2.y * T[44]; T[50] -= a2.z * T[44]; T[51] -= a2.w * T[44]; a2 = *(const LAS f32x4*)(AB + 2940);
            asm volatile("" ::: "memory"); T[52] -= a3.x * T[44]; T[53] -= a3.y * T[44]; T[54] -= a3.z * T[44]; T[55] -= a3.w * T[44]; a3 = *(const LAS f32x4*)(AB + 2988);
            asm volatile("" ::: "memory"); T[56] -= a4.x * T[44]; T[57] -= a4.y * T[44]; T[58] -= a4.z * T[44]; T[59] -= a4.w * T[44]; a4 = *(const LAS f32x4*)(AB + 2992);
            asm volatile("" ::: "memory"); T[60] -= a5.x * T[44]; T[61] -= a5.y * T[44]; T[62] -= a5.z * T[44]; T[63] -= a5.w * T[44]; a5 = *(const LAS f32x4*)(AB + 2996);
            asm volatile("" ::: "memory"); T[46] -= a6.z * T[45]; T[47] -= a6.w * T[45]; a6 = *(const LAS f32x4*)(AB + 3000);
            asm volatile("" ::: "memory"); T[48] -= a7.x * T[45]; T[49] -= a7.y * T[45]; T[50] -= a7.z * T[45]; T[51] -= a7.w * T[45]; a7 = *(const LAS f32x4*)(AB + 3004);
            asm volatile("" ::: "memory"); T[52] -= a0.x * T[45]; T[53] -= a0.y * T[45]; T[54] -= a0.z * T[45]; T[55] -= a0.w * T[45]; a0 = *(const LAS f32x4*)(AB + 3056);
            asm volatile("" ::: "memory"); T[56] -= a1.x * T[45]; T[57] -= a1.y * T[45]; T[58] -= a1.z * T[45]; T[59] -= a1.w * T[45]; a1 = *(const LAS f32x4*)(AB + 3060);
            asm volatile("" ::: "memory"); T[60] -= a2.x * T[45]; T[61] -= a2.y * T[45]; T[62] -= a2.z * T[45]; T[63] -= a2.w * T[45]; a2 = *(const LAS f32x4*)(AB + 3064);
            asm volatile("" ::: "memory"); T[47] -= a3.w * T[46]; a3 = *(const LAS f32x4*)(AB + 3068);
            asm volatile("" ::: "memory"); T[48] -= a4.x * T[46]; T[49] -= a4.y * T[46]; T[50] -= a4.z * T[46]; T[51] -= a4.w * T[46]; a4 = *(const LAS f32x4*)(AB + 3120);
            asm volatile("" ::: "memory"); T[52] -= a5.x * T[46]; T[53] -= a5.y * T[46]; T[54] -= a5.z * T[46]; T[55] -= a5.w * T[46]; a5 = *(const LAS f32x4*)(AB + 3124);
            asm volatile("" ::: "memory"); T[56] -= a6.x * T[46]; T[57] -= a6.y * T[46]; T[58] -= a6.z * T[46]; T[59] -= a6.w * T[46]; a6 = *(const LAS f32x4*)(AB + 3128);
            asm volatile("" ::: "memory"); T[60] -= a7.x * T[46]; T[61] -= a7.y * T[46]; T[62] -= a7.z * T[46]; T[63] -= a7.w * T[46]; a7 = *(const LAS f32x4*)(AB + 3132);
            asm volatile("" ::: "memory"); T[48] -= a0.x * T[47]; T[49] -= a0.y * T[47]; T[50] -= a0.z * T[47]; T[51] -= a0.w * T[47]; a0 = *(const LAS f32x4*)(AB + 3184);
            asm volatile("" ::: "memory"); T[52] -= a1.x * T[47]; T[53] -= a1.y * T[47]; T[54] -= a1.z * T[47]; T[55] -= a1.w * T[47]; a1 = *(const LAS f32x4*)(AB + 3188);
            asm volatile("" ::: "memory"); T[56] -= a2.x * T[47]; T[57] -= a2.y * T[47]; T[58] -= a2.z * T[47]; T[59] -= a2.w * T[47]; a2 = *(const LAS f32x4*)(AB + 3192);
            asm volatile("" ::: "memory"); T[60] -= a3.x * T[47]; T[61] -= a3.y * T[47]; T[62] -= a3.z * T[47]; T[63] -= a3.w * T[47]; a3 = *(const LAS f32x4*)(AB + 3196);
            asm volatile("" ::: "memory"); T[49] -= a4.y * T[48]; T[50] -= a4.z * T[48]; T[51] -= a4.w * T[48]; a4 = *(const LAS f32x4*)(AB + 3248);
            asm volatile("" ::: "memory"); T[52] -= a5.x * T[48]; T[53] -= a5.y * T[48]; T[54] -= a5.z * T[48]; T[55] -= a5.w * T[48]; a5 = *(const LAS f32x4*)(AB + 3252);
            asm volatile("" ::: "memory"); T[56] -= a6.x * T[48]; T[57] -= a6.y * T[48]; T[58] -= a6.z * T[48]; T[59] -= a6.w * T[48]; a6 = *(const LAS f32x4*)(AB + 3256);
            asm volatile("" ::: "memory"); T[60] -= a7.x * T[48]; T[61] -= a7.y * T[48]; T[62] -= a7.z * T[48]; T[63] -= a7.w * T[48]; a7 = *(const LAS f32x4*)(AB + 3260);
            asm volatile("" ::: "memory"); T[50] -= a0.z * T[49]; T[51] -= a0.w * T[49]; a0 = *(const LAS f32x4*)(AB + 3316);
            asm volatile("" ::: "memory"); T[52] -= a1.x * T[49]; T[53] -= a1.y * T[49]; T[54] -= a1.z * T[49]; T[55] -= a1.w * T[49]; a1 = *(const LAS f32x4*)(AB + 3320);
            asm volatile("" ::: "memory"); T[56] -= a2.x * T[49]; T[57] -= a2.y * T[49]; T[58] -= a2.z * T[49]; T[59] -= a2.w * T[49]; a2 = *(const LAS f32x4*)(AB + 3324);
            asm volatile("" ::: "memory"); T[60] -= a3.x * T[49]; T[61] -= a3.y * T[49]; T[62] -= a3.z * T[49]; T[63] -= a3.w * T[49]; a3 = *(const LAS f32x4*)(AB + 3380);
            asm volatile("" ::: "memory"); T[51] -= a4.w * T[50]; a4 = *(const LAS f32x4*)(AB + 3384);
            asm volatile("" ::: "memory"); T[52] -= a5.x * T[50]; T[53] -= a5.y * T[50]; T[54] -= a5.z * T[50]; T[55] -= a5.w * T[50]; a5 = *(const LAS f32x4*)(AB + 3388);
            asm volatile("" ::: "memory"); T[56] -= a6.x * T[50]; T[57] -= a6.y * T[50]; T[58] -= a6.z * T[50]; T[59] -= a6.w * T[50]; a6 = *(const LAS f32x4*)(AB + 3444);
            asm volatile("" ::: "memory"); T[60] -= a7.x * T[50]; T[61] -= a7.y * T[50]; T[62] -= a7.z * T[50]; T[63] -= a7.w * T[50]; a7 = *(const LAS f32x4*)(AB + 3448);
            asm volatile("" ::: "memory"); T[52] -= a0.x * T[51]; T[53] -= a0.y * T[51]; T[54] -= a0.z * T[51]; T[55] -= a0.w * T[51]; a0 = *(const LAS f32x4*)(AB + 3452);
            asm volatile("" ::: "memory"); T[56] -= a1.x * T[51]; T[57] -= a1.y * T[51]; T[58] -= a1.z * T[51]; T[59] -= a1.w * T[51]; a1 = *(const LAS f32x4*)(AB + 3508);
            asm volatile("" ::: "memory"); T[60] -= a2.x * T[51]; T[61] -= a2.y * T[51]; T[62] -= a2.z * T[51]; T[63] -= a2.w * T[51]; a2 = *(const LAS f32x4*)(AB + 3512);
            asm volatile("" ::: "memory"); T[53] -= a3.y * T[52]; T[54] -= a3.z * T[52]; T[55] -= a3.w * T[52]; a3 = *(const LAS f32x4*)(AB + 3516);
            asm volatile("" ::: "memory"); T[56] -= a4.x * T[52]; T[57] -= a4.y * T[52]; T[58] -= a4.z * T[52]; T[59] -= a4.w * T[52]; a4 = *(const LAS f32x4*)(AB + 3576);
            asm volatile("" ::: "memory"); T[60] -= a5.x * T[52]; T[61] -= a5.y * T[52]; T[62] -= a5.z * T[52]; T[63] -= a5.w * T[52]; a5 = *(const LAS f32x4*)(AB + 3580);
            asm volatile("" ::: "memory"); T[54] -= a6.z * T[53]; T[55] -= a6.w * T[53]; a6 = *(const LAS f32x4*)(AB + 3640);
            asm volatile("" ::: "memory"); T[56] -= a7.x * T[53]; T[57] -= a7.y * T[53]; T[58] -= a7.z * T[53]; T[59] -= a7.w * T[53]; a7 = *(const LAS f32x4*)(AB + 3644);
            asm volatile("" ::: "memory"); T[60] -= a0.x * T[53]; T[61] -= a0.y * T[53]; T[62] -= a0.z * T[53]; T[63] -= a0.w * T[53]; a0 = *(const LAS f32x4*)(AB + 3704);
            asm volatile("" ::: "memory"); T[55] -= a1.w * T[54]; a1 = *(const LAS f32x4*)(AB + 3708);
            asm volatile("" ::: "memory"); T[56] -= a2.x * T[54]; T[57] -= a2.y * T[54]; T[58] -= a2.z * T[54]; T[59] -= a2.w * T[54]; a2 = *(const LAS f32x4*)(AB + 3768);
            asm volatile("" ::: "memory"); T[60] -= a3.x * T[54]; T[61] -= a3.y * T[54]; T[62] -= a3.z * T[54]; T[63] -= a3.w * T[54]; a3 = *(const LAS f32x4*)(AB + 3772);
            asm volatile("" ::: "memory"); T[56] -= a4.x * T[55]; T[57] -= a4.y * T[55]; T[58] -= a4.z * T[55]; T[59] -= a4.w * T[55]; a4 = *(const LAS f32x4*)(AB + 3836);
            asm volatile("" ::: "memory"); T[60] -= a5.x * T[55]; T[61] -= a5.y * T[55]; T[62] -= a5.z * T[55]; T[63] -= a5.w * T[55]; a5 = *(const LAS f32x4*)(AB + 3900);
            asm volatile("" ::: "memory"); T[57] -= a6.y * T[56]; T[58] -= a6.z * T[56]; T[59] -= a6.w * T[56]; a6 = *(const LAS f32x4*)(AB + 3964);
            asm volatile("" ::: "memory"); T[60] -= a7.x * T[56]; T[61] -= a7.y * T[56]; T[62] -= a7.z * T[56]; T[63] -= a7.w * T[56]; a7 = *(const LAS f32x4*)(AB + 4028);
            asm volatile("" ::: "memory"); T[58] -= a0.z * T[57]; T[59] -= a0.w * T[57];
            asm volatile("" ::: "memory"); T[60] -= a1.x * T[57]; T[61] -= a1.y * T[57]; T[62] -= a1.z * T[57]; T[63] -= a1.w * T[57];
            asm volatile("" ::: "memory"); T[59] -= a2.w * T[58];
            asm volatile("" ::: "memory"); T[60] -= a3.x * T[58]; T[61] -= a3.y * T[58]; T[62] -= a3.z * T[58]; T[63] -= a3.w * T[58];
            asm volatile("" ::: "memory"); T[60] -= a4.x * T[59]; T[61] -= a4.y * T[59]; T[62] -= a4.z * T[59]; T[63] -= a4.w * T[59];
            asm volatile("" ::: "memory"); T[61] -= a5.y * T[60]; T[62] -= a5.z * T[60]; T[63] -= a5.w * T[60];
            asm volatile("" ::: "memory"); T[62] -= a6.z * T[61]; T[63] -= a6.w * T[61];
            asm volatile("" ::: "memory"); T[63] -= a7.w * T[62];
#pragma unroll
            for (int i = 0; i < 64; ++i) *(LAS unsigned short*)(L + PL_TB + i * TP + 2 * lane) = (unsigned short)f2bf(T[i]);
        }
        __syncthreads();
        { const int kt = w >> 1, ct = w & 1;
          f32x16 aw, au;
#pragma unroll
          for (int r = 0; r < 16; ++r) { aw[r] = 0.f; au[r] = 0.f; }
          const LAS unsigned char* kp = L + PL_KBGT + (32 * kt + l31) * TP + hh * 16; const LAS unsigned char* tp = L + PL_TB + (32 * ct + l31) * TP + hh * 16;
          const LAS unsigned char* vp = L + PL_VBT + (32 * kt + l31) * TP + hh * 16;
#pragma unroll
          for (int s = 0; s < 4; ++s) { const bf16x8 tf = *(const LAS bf16x8*)(tp + 32 * s);
              aw = MFMA32(*(const LAS bf16x8*)(kp + 32 * s), tf, aw);
              au = MFMA32(tf, *(const LAS bf16x8*)(vp + 32 * s), au); }
          { const int c = 32 * ct + l31;
#pragma unroll
            for (int g = 0; g < 4; ++g) { const int chunk = 4 * kt + 2 * (g >> 1) + hh; u32x2 o; o.x = cvtpk(aw[4 * g], aw[4 * g + 1]); o.y = cvtpk(aw[4 * g + 2], aw[4 * g + 3]);
                *(u32x2*)(Wimg + c * 256 + ((chunk ^ (c & 15)) << 4) + 8 * (g & 1)) = o; } }
          { const int dv = 32 * kt + l31;
#pragma unroll
            for (int g = 0; g < 4; ++g) { u32x2 o; o.x = cvtpk(au[4 * g], au[4 * g + 1]); o.y = cvtpk(au[4 * g + 2], au[4 * g + 3]);
                *(u32x2*)(UT + dv * 128 + (32 * ct + 8 * g + 4 * hh) * 2) = o; } } }
        __syncthreads();
    }
}

constexpr int SC_BUF = 57344, SC_OBUF = 2 * SC_BUF, SC_OB = 16384;
__device__ __forceinline__ void gdn_scan_phase(Frame& F) {
    const bf16* P = (const bf16*)(F.ws + WS_P); bf16* MIX = (bf16*)(F.ws + WS_MIXIN); const float* nw = F.in[13]; const float* CD = (const float*)(F.ws + WS_CD);
    const int lane = F.lane, l31 = lane & 31, hh = lane >> 5;
    LAS unsigned char* L = F.lds + RING_OFF;
    for (int item = blockIdx.x; item < BATCH * NH; item += F.G) {
        const int b = item >> 2, h = item & 3; const size_t ci0 = (size_t)item * 32;
        const unsigned char* Wg = F.ws + WS_WIMG + ci0 * 16384; const unsigned char* Qg = F.ws + WS_QIMG + ci0 * 16384; const unsigned char* Kg = F.ws + WS_KTIMG + ci0 * 16384;
        const unsigned char* QKg = F.ws + WS_QKIMG + ci0 * 8192; const unsigned char* Ug = F.ws + WS_UT + ci0 * 16384;
        const bool comp = F.wave < 4; const int w = F.wave & 3;
#define SC_LOAD(chunk, bufi) do { _Pragma("unroll") for (int p_ = 0; p_ < 14; ++p_) { const int piece = w * 14 + p_; \
            const unsigned char* src = piece < 16 ? Wg + (size_t)(chunk) * 16384 + piece * 1024 : piece < 32 ? Qg + (size_t)(chunk) * 16384 + (piece - 16) * 1024 : \
                                       piece < 48 ? Kg + (size_t)(chunk) * 16384 + (piece - 32) * 1024 : QKg + (size_t)(chunk) * 8192 + (piece - 48) * 1024; \
            __builtin_amdgcn_global_load_lds((const unsigned*)(src + lane * 16), (LAS unsigned*)(L + (bufi) * SC_BUF + piece * 1024), 16, 0, 0); } } while (0)
#define SC_ZLOAD(chunk) do { const int mb_ = b * SEQ + (chunk) * CL; _Pragma("unroll") for (int r_ = 0; r_ < 16; ++r_) zz[r_] = *(const unsigned*)(P + (size_t)(mb_ + 16 * w + r_) * NIN_G + PC_Z + h * HD + 2 * lane); } while (0)
#define SC_FINAL(chunk) do { const LAS unsigned char* ob_ = L + SC_OBUF + ((chunk) & 1) * SC_OB; const int mb_ = b * SEQ + (chunk) * CL; const f32x2 n2_ = *(const f32x2*)(nw + 2 * lane); \
            _Pragma("unroll") for (int r_ = 0; r_ < 16; ++r_) { const int tok_ = 16 * w + r_; const unsigned ov_ = *(const LAS unsigned*)(ob_ + tok_ * 256 + 4 * lane); const float o0_ = bf_lo(ov_), o1_ = bf_hi(ov_); \
                const float rr_ = 1.0f / sqrtf(wave_sum(o0_ * o0_ + o1_ * o1_) * (1.f / HD) + EPS); const unsigned z2_ = zz[r_]; \
                *(unsigned*)(MIX + (size_t)(mb_ + tok_) * D + GW + h * HD + 2 * lane) = cvtpk(o0_ * rr_ * n2_.x * siluf_(bf_lo(z2_)), o1_ * rr_ * n2_.y * siluf_(bf_hi(z2_))); } } while (0)
        unsigned zz[16];
        f32x16 S[4];
#pragma unroll
        for (int kt = 0; kt < 4; ++kt)
#pragma unroll
            for (int r = 0; r < 16; ++r) S[kt][r] = 0.f;
        u32x2 ucur[8];
        const unsigned char* up = Ug + (32 * w + l31) * 128 + 8 * hh;
        if (comp) {
#pragma unroll
            for (int q = 0; q < 8; ++q) ucur[q] = *(const u32x2*)(up + (32 * (q >> 2) + 8 * (q & 3)) * 2);
        } else { SC_LOAD(0, 0); }
        asm volatile("s_waitcnt vmcnt(0)" ::: "memory");
        __syncthreads();
        for (int i = 0; i < SEQ / CL; ++i) {
            if (comp) {
                const LAS unsigned char* B = L + (i & 1) * SC_BUF;
                u32x2 unx[8];
                { const unsigned char* upn = up + (size_t)((i + 1 < SEQ / CL) ? i + 1 : i) * 16384;
#pragma unroll
                  for (int q = 0; q < 8; ++q) unx[q] = *(const u32x2*)(upn + (32 * (q >> 2) + 8 * (q & 3)) * 2); }
                const float cd = CD[ci0 + i];
                bf16x8 Sb[4][2];
#pragma unroll
                for (int kt = 0; kt < 4; ++kt)
#pragma unroll
                    for (int s = 0; s < 2; ++s) Sb[kt][s] = pack8(S[kt][8 * s], S[kt][8 * s + 1], S[kt][8 * s + 2], S[kt][8 * s + 3], S[kt][8 * s + 4], S[kt][8 * s + 5], S[kt][8 * s + 6], S[kt][8 * s + 7]);
                f32x16 VN[2], O[2];
#pragma unroll
                for (int tt = 0; tt < 2; ++tt)
#pragma unroll
                    for (int g = 0; g < 4; ++g) { const u32x2 u = ucur[tt * 4 + g]; VN[tt][4 * g] = bf_lo(u.x); VN[tt][4 * g + 1] = bf_hi(u.x); VN[tt][4 * g + 2] = bf_lo(u.y); VN[tt][4 * g + 3] = bf_hi(u.y);
                        O[tt][4 * g] = 0.f; O[tt][4 * g + 1] = 0.f; O[tt][4 * g + 2] = 0.f; O[tt][4 * g + 3] = 0.f; }
#pragma unroll
                for (int tt = 0; tt < 2; ++tt) { const int row = 32 * tt + l31; const LAS unsigned char* wp = B + row * 256; const LAS unsigned char* qp = B + 16384 + row * 256;
#pragma unroll
                    for (int kt = 0; kt < 4; ++kt)
#pragma unroll
                        for (int s = 0; s < 2; ++s) { const int co = ((4 * kt + 2 * s + hh) ^ (row & 15)) << 4;
                            VN[tt] = MFMA32(*(const LAS bf16x8*)(wp + co), Sb[kt][s], VN[tt]); O[tt] = MFMA32(*(const LAS bf16x8*)(qp + co), Sb[kt][s], O[tt]); } }
                bf16x8 Vb[2][2];
#pragma unroll
                for (int tt = 0; tt < 2; ++tt)
#pragma unroll
                    for (int s = 0; s < 2; ++s) Vb[tt][s] = pack8(VN[tt][8 * s], VN[tt][8 * s + 1], VN[tt][8 * s + 2], VN[tt][8 * s + 3], VN[tt][8 * s + 4], VN[tt][8 * s + 5], VN[tt][8 * s + 6], VN[tt][8 * s + 7]);
#pragma unroll
                for (int ct = 0; ct < 2; ++ct) { const int c = 32 * ct + l31; const LAS unsigned char* qkp = B + 49152 + c * 128; const int sw = (c >> 1) & 7;
#pragma unroll
                    for (int tt = 0; tt < 2; ++tt)
#pragma unroll
                        for (int s = 0; s < 2; ++s) O[ct] = MFMA32(*(const LAS bf16x8*)(qkp + (((4 * tt + 2 * s + hh) ^ sw) << 4)), Vb[tt][s], O[ct]); }
#pragma unroll
                for (int kt = 0; kt < 4; ++kt) { const int dk = 32 * kt + l31; const LAS unsigned char* kp = B + 32768 + dk * 128; const int sw = (dk >> 1) & 7;
#pragma unroll
                    for (int r = 0; r < 16; ++r) S[kt][r] *= cd;
#pragma unroll
                    for (int tt = 0; tt < 2; ++tt)
#pragma unroll
                        for (int s = 0; s < 2; ++s) S[kt] = MFMA32(*(const LAS bf16x8*)(kp + (((4 * tt + 2 * s + hh) ^ sw) << 4)), Vb[tt][s], S[kt]); }
                { LAS unsigned char* ob = L + SC_OBUF + (i & 1) * SC_OB + (32 * w + l31) * 2;
#pragma unroll
                  for (int tt = 0; tt < 2; ++tt)
#pragma unroll
                      for (int r = 0; r < 16; ++r) { const int tok = 32 * tt + (r & 3) + 8 * (r >> 2) + 4 * hh; *(LAS unsigned short*)(ob + tok * 256) = (unsigned short)(cvtpk(O[tt][r], 0.f) & 0xffffu); } }
#pragma unroll
                for (int q = 0; q < 8; ++q) ucur[q] = unx[q];
            } else {
                if (i >= 1) SC_ZLOAD(i - 1);
                if (i + 1 < SEQ / CL) SC_LOAD(i + 1, (i + 1) & 1);
                if (i >= 1) SC_FINAL(i - 1);
            }
            asm volatile("s_waitcnt vmcnt(0)" ::: "memory");
            __syncthreads();
        }
        if (!comp) { SC_ZLOAD(SEQ / CL - 1); SC_FINAL(SEQ / CL - 1); }
        asm volatile("s_waitcnt vmcnt(0)" ::: "memory");
        __syncthreads();
#undef SC_LOAD
#undef SC_FINAL
#undef SC_ZLOAD
    }
}
struct Args { const float* in[19]; float* out; unsigned char* ws; int ph_lo, ph_hi, li, pad; };
__global__ void __launch_bounds__(NWAVES * 64, 2) fwd_kernel(Args args) {
    extern __shared__ __attribute__((aligned(16))) unsigned char lds[];
    Frame F;
    F.lds = (LAS unsigned char*)lds;
    F.MISC = (volatile LAS unsigned*)(F.lds + MISC_OFF);
    F.tid = threadIdx.x; F.lane = F.tid & 63; F.wave = __builtin_amdgcn_readfirstlane(F.tid >> 6);
    F.G = gridDim.x; { const int bx = blockIdx.x; F.vcu = (F.G % 8 == 0) ? (bx % 8) * (F.G / 8) + bx / 8 : bx; }
#pragma unroll
    for (int i = 0; i < 19; ++i) F.in[i] = args.in[i];
    F.out = args.out; F.ws = args.ws;
    F.ctl = (gu32*)(F.ws + WS_CTL);
    for (int u = F.tid; u < (LDS_BYTES - LDSCTL_OFF) / 4; u += NWAVES * 64) ((LAS unsigned*)(F.lds + LDSCTL_OFF))[u] = 0u;
    __syncthreads();
    XcdBarrier bar; bar.bar = (unsigned*)(F.ctl + CW_BAR) + args.li * XCD_BAR_WORDS; bar.x = 0; bar.st = nullptr;
    if (MK_ONE_LAUNCH) bar = xcd_barrier_post((unsigned*)(F.ctl + CW_BAR) + args.li * XCD_BAR_WORDS, F.MISC + 8);
#define GRID_BAR() do { if (MK_ONE_LAUNCH) xcd_barrier(bar); } while (0)
    const int lo = args.ph_lo, hi = args.ph_hi;
#define IN(k) (lo <= (k) && (k) < hi)
#define BOTH(k) (IN(k) && IN((k) + 1))
    float* MOD = (float*)(F.ws + WS_MOD);
    bf16* XN = (bf16*)(F.ws + WS_XN); bf16* Pb = (bf16*)(F.ws + WS_P); bf16* MIX = (bf16*)(F.ws + WS_MIXIN); bf16* HID = (bf16*)(F.ws + WS_HID);

    if (IN(0)) { p0_prologue(F); if (BOTH(0)) GRID_BAR(); }
    if (IN(1)) { norm_mod_phase<true>(F, F.in[0], F.in[4], MOD + 0 * D, MOD + 1 * D, XN); if (BOTH(1)) GRID_BAR(); }
    if (IN(2)) {
        pg8::Gemm g{XN, (const bf16*)(F.ws + WS_WIN), M, NIN_G, D}; pg8::StaticOrder S; S.init(M, NIN_G, F.G, (int)blockIdx.x);
        pg8::EpiBf16<0> E{Pb, NIN_G, nullptr, 0, 0, 1.f};
        pg8::gemm_phase<pg8::EpiBf16<0>, pg8::StaticOrder, PG8_ALIGN, PG8_SP2>(F.lds + RING_OFF, g, S, E);
        if (BOTH(2)) GRID_BAR();
    }
#if GDN_SIMPLE
    if (IN(3)) { conformer_phase(F); gdn_prep_simple(F); if (BOTH(3)) GRID_BAR(); }
#else
    if (IN(3)) { gdn_prep_phase(F); if (BOTH(3)) GRID_BAR(); }
#endif
#if GDN_SIMPLE
    if (IN(4)) { gdn_recurrent_simple(F); if (BOTH(4)) GRID_BAR(); }
#else
    if (IN(4)) { if (blockIdx.x < BATCH * NH) gdn_scan_phase(F); else conformer_phase(F); if (BOTH(4)) GRID_BAR(); }
#endif
    if (IN(5)) {
        pg8::Gemm g{MIX, (const bf16*)(F.ws + WS_WOUT), M, D, D}; pg8::StaticOrder S; S.init(M, D, F.G, (int)blockIdx.x);
        pg8::EpiResGate E{F.in[0], F.out, D, MOD + 2 * D, NMOD * D, SEQ / 256};
        pg8::gemm_phase<pg8::EpiResGate, pg8::StaticOrder, PG8_ALIGN, PG8_SP2>(F.lds + RING_OFF, g, S, E);
        if (BOTH(5)) GRID_BAR();
    }
    if (IN(6)) { norm_mod_phase<false>(F, F.out, F.in[15], MOD + 3 * D, MOD + 4 * D, XN); if (BOTH(6)) GRID_BAR(); }
    if (IN(7)) {
        pg8::Gemm g{XN, (const bf16*)(F.ws + WS_WFI), M, 2 * FF, D}; pg8::StaticOrder S; S.init(M, 2 * FF, F.G, (int)blockIdx.x);
        pg8::EpiSwiGLU E{HID, FF};
        pg8::gemm_phase<pg8::EpiSwiGLU, pg8::StaticOrder, PG8_ALIGN, PG8_SP2>(F.lds + RING_OFF, g, S, E);
        if (BOTH(7)) GRID_BAR();
    }
    if (IN(8)) {
        pg8::Gemm g{HID, (const bf16*)(F.ws + WS_WFO), M, D, FF}; pg8::StaticOrder S; S.init(M, D, F.G, (int)blockIdx.x);
        pg8::EpiResGate E{F.out, F.out, D, MOD + 5 * D, NMOD * D, SEQ / 256};
        pg8::gemm_phase<pg8::EpiResGate, pg8::StaticOrder, PG8_ALIGN, PG8_SP2>(F.lds + RING_OFF, g, S, E);
        if (BOTH(8)) GRID_BAR();
    }
    if (IN(9)) { final_norm_phase(F, F.out, F.in[18]); }
#undef IN
#undef BOTH
}

extern "C" void kernel_launch(void* const* d_in, const int* in_sizes, int n_in, void* d_out, int out_size, void* d_ws, size_t ws_size, hipStream_t stream) {
    static int grid = 0;
    if (grid == 0) {
        if (n_in != 19 || in_sizes[0] != M * D || out_size != M * D || ws_size < WS_END) { fprintf(stderr, "kernel_launch: unexpected shapes (n_in %d, in0 %d, out %d, ws %zu); nothing launched\n", n_in, n_in > 0 ? in_sizes[0] : -1, out_size, ws_size); grid = -1; return; }
        int dev = 0, cus = 0, per_cu = 0;
        if (hipGetDevice(&dev) != hipSuccess || hipDeviceGetAttribute(&cus, hipDeviceAttributeMultiprocessorCount, dev) != hipSuccess) { grid = -1; return; }
        if (hipFuncSetAttribute((const void*)fwd_kernel, hipFuncAttributeMaxDynamicSharedMemorySize, LDS_BYTES) != hipSuccess) { fprintf(stderr, "kernel_launch: hipFuncSetAttribute failed\n"); grid = -1; return; }
        if (hipOccupancyMaxActiveBlocksPerMultiprocessor(&per_cu, (const void*)fwd_kernel, NWAVES * 64, LDS_BYTES) != hipSuccess || per_cu < 1) { fprintf(stderr, "kernel_launch: occupancy query says %d blocks per CU\n", per_cu); per_cu = 1; }
        (void)hipGetLastError();
        grid = cus;
    }
    if (grid < 0) return;
    (void)hipMemsetAsync((char*)d_ws + WS_CTL, 0, CTL_ZERO_BYTES, stream);
    Args a{};
    for (int i = 0; i < 19; ++i) a.in[i] = (const float*)d_in[i];
    a.out = (float*)d_out; a.ws = (unsigned char*)d_ws;
#if MK_ONE_LAUNCH
#if PROBE_REP >= 0
    a.ph_lo = 0; a.ph_hi = PROBE_REP + 1; a.li = 0;
    hipLaunchKernelGGL(fwd_kernel, dim3(grid), dim3(NWAVES * 64), LDS_BYTES, stream, a);
    a.ph_lo = PROBE_REP; a.ph_hi = N_PHASES; a.li = 1;
    hipLaunchKernelGGL(fwd_kernel, dim3(grid), dim3(NWAVES * 64), LDS_BYTES, stream, a);
#else
    a.ph_lo = 0; a.ph_hi = N_PHASES; a.li = 0;
    hipLaunchKernelGGL(fwd_kernel, dim3(grid), dim3(NWAVES * 64), LDS_BYTES, stream, a);
#endif
#else
    for (int p = 0; p < N_PHASES; ++p) { a.ph_lo = p; a.ph_hi = p + 1; a.li = 0; hipLaunchKernelGGL(fwd_kernel, dim3(grid), dim3(NWAVES * 64), LDS_BYTES, stream, a); }
#endif
}
```

```cpp
#include <hip/hip_runtime.h>
#include <cstdio>
#include <cstdint>
namespace pg8 {
#define PG8_LAS __attribute__((address_space(3)))
typedef unsigned short bf16_t;
typedef short bf16x8 __attribute__((ext_vector_type(8)));
typedef float f32x4 __attribute__((ext_vector_type(4)));
typedef unsigned u32x4 __attribute__((ext_vector_type(4)));
constexpr int BM = 256, BK = 64, HALF = 128, HTB = HALF * BK * 2  , STAGE_BYTES = 8 * HTB, NXCD = 8, WGM = 8;

__host__ __device__ __forceinline__ int lds_byte(int r, int c) { const int st = (r >> 4) * 2 + (c >> 5), rr = r & 15, cc = c & 31, ob = rr * 64 + cc * 2; return st * 1024 + (ob ^ (((ob >> 9) & 1) << 5)); }
__host__ __device__ __forceinline__ void stage_rc(int b, int& R, int& C) { const int st = b / 1024, sb = b % 1024, swz = sb ^ (((sb >> 9) & 1) << 5); R = (st >> 1) * 16 + swz / 64; C = (st & 1) * 32 + (swz % 64) / 2; }
__host__ __device__ __forceinline__ int perm32(int rho) { const int n = rho >> 4, i = rho & 15; return 8 * (i >> 2) + 4 * n + (i & 3); }

struct Unit { int pm, pn; };
struct Gemm { const bf16_t* A; const bf16_t* Bt; int M, N, K; };

struct StaticOrder {
    int nM, nN, nwg, G, c;
    __host__ __device__ void init(int M, int N, int G_, int c_) { nM = M / BM; nN = N / BM; nwg = nM * nN; G = G_; c = c_; }
    __host__ __device__ bool next(int i, Unit& u) const {
        const long L = (long)i * G + c; if (L >= nwg) return false;
        int wgid = (int)L; { const int q = nwg / NXCD, r = nwg % NXCD, xcd = wgid % NXCD, off = wgid / NXCD; wgid = (xcd < r ? xcd * (q + 1) : r * (q + 1) + (xcd - r) * q) + off; }
        const int nig = WGM * nN, gid = wgid / nig, fm = gid * WGM, gsz = (nM - fm) < WGM ? (nM - fm) : WGM;
        u.pm = fm + ((wgid % nig) % gsz); u.pn = (wgid % nig) / gsz; return true;
    }
    __device__ __forceinline__ void a_ready(const Unit&) const {}
    __device__ __forceinline__ void done(const Unit&) const {}
};

__device__ __forceinline__ unsigned cvt_pk_bf16(float lo, float hi) { unsigned r; asm volatile("v_cvt_pk_bf16_f32 %0, %1, %2" : "=v"(r) : "v"(lo), "v"(hi)); return r; }
typedef float f32x2 __attribute__((ext_vector_type(2)));
__device__ __forceinline__ f32x2 gelu_pk(f32x2 v) {
    const f32x2 av = __builtin_elementwise_abs(v), d = av * 0.2316418882f + 1.0f;
    f32x2 t; t.x = __builtin_amdgcn_rcpf(d.x); t.y = __builtin_amdgcn_rcpf(d.y);
    f32x2 q = t * 0.5307027145f + (-0.7265760135f); q = q * t + 0.7107068705f; q = q * t + (-0.142248368f); q = q * t + 0.127414796f; q = q * t;
    const f32x2 s = (v * v) * (-0.72134752044f);
    f32x2 e; e.x = __builtin_amdgcn_exp2f(s.x); e.y = __builtin_amdgcn_exp2f(s.y);
    const f32x2 m = v * (q * e), r = v - m;
    f32x2 o; o.x = v.x < 0.f ? m.x : r.x; o.y = v.y < 0.f ? m.y : r.y; return o;
}

template <int ACT  > struct EpiBf16 {
    static constexpr bool PERM = true, AFTER_DRAIN = false; static_assert(ACT == 0 || ACT == 1, "EpiBf16: ACT is 0 (none) or 1 (gelu_pk)");
    bf16_t* O; int ldc; const float* bias; int split_cols; size_t split_stride; float scale0;
    __device__ __forceinline__ void operator()(const f32x4 (&acc)[2][2][4][2], const Unit& u, int wr, int wc, int fr, int fq) const {
        const int row0 = u.pm * BM + wr * 64 + fr; int colt = u.pn * BM; bf16_t* base = O;
        float sc = 1.f; if (split_cols) { const int t = colt / split_cols; base += (size_t)t * split_stride; colt -= t * split_cols; if (t == 0) sc = scale0; }
        const int col0 = colt + wc * 32 + 8 * fq, bcol0 = u.pn * BM + wc * 32 + 8 * fq;
        f32x4 bv[2][2];
#pragma unroll
        for (int bj = 0; bj < 2; ++bj)
#pragma unroll
            for (int n = 0; n < 2; ++n) bv[bj][n] = bias ? *(const f32x4*)(bias + bcol0 + bj * HALF + 4 * n) : (f32x4){0.f, 0.f, 0.f, 0.f};
#pragma unroll
        for (int ai = 0; ai < 2; ++ai)
#pragma unroll
            for (int m = 0; m < 4; ++m) { bf16_t* rowp = base + (size_t)(row0 + ai * HALF + m * 16) * ldc + col0;
#pragma unroll
                for (int bj = 0; bj < 2; ++bj) { f32x4 v0 = acc[ai][bj][m][0] + bv[bj][0], v1 = acc[ai][bj][m][1] + bv[bj][1];
                    if (ACT == 1) { f32x2 a = gelu_pk((f32x2){v0[0], v0[1]}), b = gelu_pk((f32x2){v0[2], v0[3]}), c = gelu_pk((f32x2){v1[0], v1[1]}), d = gelu_pk((f32x2){v1[2], v1[3]});
                        v0 = (f32x4){a.x, a.y, b.x, b.y}; v1 = (f32x4){c.x, c.y, d.x, d.y}; }
                    v0 = v0 * sc; v1 = v1 * sc; u32x4 w; w.x = cvt_pk_bf16(v0[0], v0[1]); w.y = cvt_pk_bf16(v0[2], v0[3]); w.z = cvt_pk_bf16(v1[0], v1[1]); w.w = cvt_pk_bf16(v1[2], v1[3]);
                    *(u32x4*)(rowp + bj * HALF) = w; } }
    }
};

struct PanelStats {
    unsigned* xbuf;
    unsigned* cnt;
    unsigned* tmo;
    int ntn; float eps;
    unsigned code;
    __device__ __forceinline__ bool run(const f32x4 (&v)[2][2][4][2], const Unit& u, int wr, int wc, int fr, int fq, PG8_LAS unsigned char* lds, int wid, int lane) const {
        typedef float f32x2v __attribute__((ext_vector_type(2)));
        PG8_LAS f32x2v* P = (PG8_LAS f32x2v*)lds;
        PG8_LAS f32x2v* S = (PG8_LAS f32x2v*)(lds + 8192);
        PG8_LAS unsigned* flag = (PG8_LAS unsigned*)(lds + 8192 + 2048);
#pragma unroll
        for (int ai = 0; ai < 2; ++ai)
#pragma unroll
            for (int m = 0; m < 4; ++m) {
                float s = 0.f;
#pragma unroll
                for (int bj = 0; bj < 2; ++bj)
#pragma unroll
                    for (int n = 0; n < 2; ++n) { const f32x4 x = v[ai][bj][m][n]; s += (x[0] + x[1]) + (x[2] + x[3]); }
                s += __shfl_xor(s, 16); s += __shfl_xor(s, 32);
                const float mw = s * (1.0f / 64.0f); float q = 0.f;
#pragma unroll
                for (int bj = 0; bj < 2; ++bj)
#pragma unroll
                    for (int n = 0; n < 2; ++n) { const f32x4 d = v[ai][bj][m][n] - mw; q += (d[0] * d[0] + d[1] * d[1]) + (d[2] * d[2] + d[3] * d[3]); }
                q += __shfl_xor(q, 16); q += __shfl_xor(q, 32);
                if (fq == 0) P[(ai * HALF + wr * 64 + m * 16 + fr) * 4 + wc] = (f32x2v){mw, q};
            }
        asm volatile("s_waitcnt lgkmcnt(0)" ::: "memory"); __builtin_amdgcn_s_barrier(); asm volatile("" ::: "memory");
#if defined(BROKEN_EXCHANGE_NO_WAIT)
#warning BROKEN CONTROL BUILD: the row-statistics exchange does not wait; results are wrong by design
        if (blockIdx.x >= 64) { const long long t0_ = clock64(); while (clock64() - t0_ < 60000) __builtin_amdgcn_s_sleep(8); }
#endif
        const int row = wid * 32 + (lane & 31);
        if (lane < 32) {
            const f32x2v a = P[row * 4 + 0], b = P[row * 4 + 1], c = P[row * 4 + 2], d = P[row * 4 + 3];
            const float mt = (a.x + b.x + c.x + d.x) * 0.25f;
            const float da = a.x - mt, db = b.x - mt, dc = c.x - mt, dd = d.x - mt;
            const float m2 = (a.y + b.y) + (c.y + d.y) + 64.0f * ((da * da + db * db) + (dc * dc + dd * dd));
            unsigned long long* slot = (unsigned long long*)xbuf + ((size_t)(u.pm * BM + row) * 4 + u.pn);
            __hip_atomic_store(slot, ((unsigned long long)__float_as_uint(m2) << 32) | __float_as_uint(mt), __ATOMIC_RELAXED, __HIP_MEMORY_SCOPE_AGENT);
        }
        asm volatile("s_waitcnt vmcnt(0)" ::: "memory");
        if (lane == 0) __hip_atomic_fetch_add(cnt + 64 * u.pm, 1u, __ATOMIC_RELAXED, __HIP_MEMORY_SCOPE_AGENT);
        if (wid == 0) {
            bool dead = false; const unsigned long long t0 = __builtin_amdgcn_s_memrealtime(); const unsigned want = 8u * (unsigned)ntn;
            for (;;) {
#if defined(BROKEN_EXCHANGE_NO_WAIT)
                break;
#endif
                if ((unsigned)__builtin_amdgcn_readfirstlane(__hip_atomic_load(cnt + 64 * u.pm, __ATOMIC_RELAXED, __HIP_MEMORY_SCOPE_AGENT)) >= want) break;
                if (__builtin_amdgcn_s_memrealtime() - t0 > 2000000ull) {
                    if (lane == 0) { unsigned expect = 0u; __hip_atomic_compare_exchange_strong(tmo + 1, &expect, code | (unsigned)(u.pm & 0xff), __ATOMIC_RELAXED, __ATOMIC_RELAXED, __HIP_MEMORY_SCOPE_AGENT);
                                     __hip_atomic_store(tmo, 1u, __ATOMIC_RELAXED, __HIP_MEMORY_SCOPE_AGENT); }
                    dead = true; break; }
                __builtin_amdgcn_s_sleep(2);
            }
            __builtin_amdgcn_fence(__ATOMIC_ACQUIRE, "agent");
            if (lane == 0) flag[0] = dead ? 1u : 0u;
        }
        asm volatile("s_waitcnt vmcnt(0) lgkmcnt(0)" ::: "memory"); __builtin_amdgcn_s_barrier(); asm volatile("" ::: "memory");
        const bool bad = flag[0] != 0u;
        if (lane < 32) {
            const unsigned long long* slot = (const unsigned long long*)xbuf + (size_t)(u.pm * BM + row) * 4; float mt[4], m2[4]; float ms = 0.f;
#pragma unroll
            for (int t = 0; t < 4; ++t) { if (t < ntn) { const unsigned long long w = __hip_atomic_load(slot + t, __ATOMIC_RELAXED, __HIP_MEMORY_SCOPE_AGENT); mt[t] = __uint_as_float((unsigned)w); m2[t] = __uint_as_float((unsigned)(w >> 32)); } else { mt[t] = 0.f; m2[t] = 0.f; } ms += mt[t]; }
            const float mean = ms / (float)ntn; float q = 0.f;
#pragma unroll
            for (int t = 0; t < 4; ++t) if (t < ntn) { const float dm = mt[t] - mean; q += m2[t] + 256.0f * dm * dm; }
            S[row] = (f32x2v){mean, 1.0f / sqrtf(q / (256.0f * (float)ntn) + eps)};
        }
        asm volatile("s_waitcnt lgkmcnt(0)" ::: "memory"); __builtin_amdgcn_s_barrier(); asm volatile("" ::: "memory");
        return bad;
    }
};
struct EpiLnRes {
    static constexpr bool PERM = false, AFTER_DRAIN = true;
    const float* base; float* out; int ldc; const float* bias; PanelStats st; unsigned poison;
    __device__ __forceinline__ void fused(f32x4 (&acc)[2][2][4][2], const Unit& u, int wr, int wc, int fr, int fq, PG8_LAS unsigned char* lds, int wid, int lane) const {
        typedef float f32x2v __attribute__((ext_vector_type(2)));
        const PG8_LAS f32x2v* S = (const PG8_LAS f32x2v*)(lds + 8192);
        const int col0 = u.pn * BM + wc * 32 + 4 * fq;
#pragma unroll
        for (int bj = 0; bj < 2; ++bj)
#pragma unroll
            for (int n = 0; n < 2; ++n) { const f32x4 bv = bias ? *(const f32x4*)(bias + col0 + bj * HALF + n * 16) : (f32x4){0.f, 0.f, 0.f, 0.f};
#pragma unroll
                for (int ai = 0; ai < 2; ++ai)
#pragma unroll
                    for (int m = 0; m < 4; ++m) acc[ai][bj][m][n] += bv; }
        f32x4 pre[4][2][2];
#pragma unroll
        for (int m = 0; m < 4; ++m) { const size_t off = (size_t)(u.pm * BM + wr * 64 + m * 16 + fr) * ldc + col0;
#pragma unroll
            for (int bj = 0; bj < 2; ++bj)
#pragma unroll
                for (int n = 0; n < 2; ++n) pre[m][bj][n] = *(const f32x4*)(base + off + bj * HALF + n * 16); }
        const bool bad = st.run(acc, u, wr, wc, fr, fq, lds, wid, lane) || poison != 0u;
        const float qnan = __builtin_nanf("");
#pragma unroll
        for (int ai = 0; ai < 2; ++ai)
#pragma unroll
            for (int m = 0; m < 4; ++m) { const int r = ai * HALF + wr * 64 + m * 16 + fr; const f32x2v sr = S[r]; const size_t off = (size_t)(u.pm * BM + r) * ldc + col0;
#pragma unroll
                for (int bj = 0; bj < 2; ++bj)
#pragma unroll
                    for (int n = 0; n < 2; ++n) { const f32x4 bs = ai == 0 ? pre[m][bj][n] : *(const f32x4*)(base + off + bj * HALF + n * 16); f32x4 o = bs + (acc[ai][bj][m][n] - sr.x) * sr.y;
                        if (bad) o = (f32x4){qnan, qnan, qnan, qnan}; *(f32x4*)(out + off + bj * HALF + n * 16) = o; }
                if (m & 1) asm volatile("" ::: "memory"); }
    }
};
struct EpiLnResLn {
    static constexpr bool PERM = false, AFTER_DRAIN = true;
    const float* base; float* out; bf16_t* xn; int ldc; const float* bias; PanelStats st1, st2; unsigned poison;
    __device__ __forceinline__ void fused(f32x4 (&acc)[2][2][4][2], const Unit& u, int wr, int wc, int fr, int fq, PG8_LAS unsigned char* lds, int wid, int lane) const {
        typedef float f32x2v __attribute__((ext_vector_type(2))); typedef unsigned u32x2v __attribute__((ext_vector_type(2)));
        const PG8_LAS f32x2v* S = (const PG8_LAS f32x2v*)(lds + 8192);
        const int col0 = u.pn * BM + wc * 32 + 4 * fq;
#pragma unroll
        for (int bj = 0; bj < 2; ++bj)
#pragma unroll
            for (int n = 0; n < 2; ++n) { const f32x4 bv = bias ? *(const f32x4*)(bias + col0 + bj * HALF + n * 16) : (f32x4){0.f, 0.f, 0.f, 0.f};
#pragma unroll
                for (int ai = 0; ai < 2; ++ai)
#pragma unroll
                    for (int m = 0; m < 4; ++m) acc[ai][bj][m][n] += bv; }
        bool bad = st1.run(acc, u, wr, wc, fr, fq, lds, wid, lane) || poison != 0u;
        const float qnan = __builtin_nanf("");
#pragma unroll
        for (int ai = 0; ai < 2; ++ai)
#pragma unroll
            for (int m = 0; m < 4; ++m) { const int r = ai * HALF + wr * 64 + m * 16 + fr; const f32x2v sr = S[r]; const size_t off = (size_t)(u.pm * BM + r) * ldc + col0;
#pragma unroll
                for (int bj = 0; bj < 2; ++bj)
#pragma unroll
                    for (int n = 0; n < 2; ++n) { const f32x4 bs = *(const f32x4*)(base + off + bj * HALF + n * 16); acc[ai][bj][m][n] = bs + (acc[ai][bj][m][n] - sr.x) * sr.y; }
                asm volatile("" : "+v"(acc[ai][0][m][0]), "+v"(acc[ai][0][m][1]), "+v"(acc[ai][1][m][0]), "+v"(acc[ai][1][m][1]));
                if (m & 1) asm volatile("" ::: "memory"); }
        const bool bad1 = bad;
        bad = st2.run(acc, u, wr, wc, fr, fq, lds, wid, lane) || bad;
#pragma unroll
        for (int ai = 0; ai < 2; ++ai)
#pragma unroll
            for (int m = 0; m < 4; ++m) { const int r = ai * HALF + wr * 64 + m * 16 + fr; const f32x2v sr = S[r]; const size_t off = (size_t)(u.pm * BM + r) * ldc + col0;
#pragma unroll
                for (int bj = 0; bj < 2; ++bj)
#pragma unroll
                    for (int n = 0; n < 2; ++n) { const f32x4 x1 = acc[ai][bj][m][n]; *(f32x4*)(out + off + bj * HALF + n * 16) = bad1 ? (f32x4){qnan, qnan, qnan, qnan} : x1;
                        const f32x4 o = (x1 - sr.x) * sr.y; u32x2v w; w.x = cvt_pk_bf16(o[0], o[1]); w.y = cvt_pk_bf16(o[2], o[3]);
                        if (bad) { w.x = 0x7fc07fc0u; w.y = 0x7fc07fc0u; } *(u32x2v*)(xn + off + bj * HALF + n * 16) = w; }
                asm volatile("" ::: "memory"); }
    }
};

template <class Epi, class Sched, bool ALIGN_EPI = false, bool SP2 = false>
__device__ __forceinline__ void gemm_phase(PG8_LAS unsigned char* lds, const Gemm g, const Sched& S, const Epi& E) {
    const int tid = threadIdx.x, wid = __builtin_amdgcn_readfirstlane(tid >> 6), lane = tid & 63, wr = wid >> 2, wc = wid & 3, fr = lane & 15, fq = lane >> 4;
    const int K = g.K, nt = K / BK;
    unsigned voffA[2], voffB[2];
#pragma unroll
    for (int i = 0; i < 2; ++i) { int R, C; stage_rc(tid * 16 + i * 8192, R, C); const int Rb = Epi::PERM ? ((R & ~31) + perm32(R & 31)) : R;
        voffA[i] = (unsigned)(R * K + C) * 2u; voffB[i] = (unsigned)(Rb * K + C) * 2u; }
    const size_t kstep = (size_t)(BK * 2);
    const size_t hstep = (size_t)HALF * K * 2;
    const size_t tstep = 2 * hstep;
    const unsigned ldsw = (unsigned)wid * 1024u;
    const int aoff = lds_byte(wr * 64 + fr, fq * 8), boff = lds_byte(wc * 32 + fr, fq * 8);
#define PG8_SA(b, h) (((b) * 2 + (h)) * HTB)
#define PG8_SB(b, h) ((4 + (b) * 2 + (h)) * HTB)
#define PG8_STAGE(bufoff, gbase, voff) do { _Pragma("unroll") for (int _i = 0; _i < 2; ++_i) \
        __builtin_amdgcn_global_load_lds((const unsigned*)((const char*)(gbase) + (voff)[_i]), (PG8_LAS unsigned*)(lds + (bufoff) + ldsw + _i * 8192), 16, 0, 0); } while (0)
#define PG8_LDA(dst, b, h) do { _Pragma("unroll") for (int m = 0; m < 4; ++m) _Pragma("unroll") for (int k = 0; k < 2; ++k) dst[m][k] = *(const PG8_LAS bf16x8*)(lds + PG8_SA(b, h) + aoff + m * 2048 + k * 1024); } while (0)
#define PG8_LDB(dst, b, h) do { _Pragma("unroll") for (int n = 0; n < 2; ++n) _Pragma("unroll") for (int k = 0; k < 2; ++k) dst[n][k] = *(const PG8_LAS bf16x8*)(lds + PG8_SB(b, h) + boff + n * 2048 + k * 1024); } while (0)
#define PG8_MMA(ai, bj, At, Bt) do { __builtin_amdgcn_s_setprio(1); _Pragma("unroll") for (int m = 0; m < 4; ++m) _Pragma("unroll") for (int n = 0; n < 2; ++n) _Pragma("unroll") for (int k = 0; k < 2; ++k) \
        acc[ai][bj][m][n] = __builtin_amdgcn_mfma_f32_16x16x32_bf16(Bt[n][k], At[m][k], acc[ai][bj][m][n], 0, 0, 0); __builtin_amdgcn_s_setprio(0); } while (0)
#define PG8_WAIT_V(n) asm volatile("s_waitcnt vmcnt(" #n ")" ::: "memory")
#define PG8_WAIT_L(n) asm volatile("s_waitcnt lgkmcnt(" #n ")" ::: "memory")
#define PG8_BAR __builtin_amdgcn_s_barrier()
#define PG8_SCHED __builtin_amdgcn_sched_barrier(0)
    Unit cur, nxt; int ui = 0;
    if (!S.next(0, cur)) return;
    f32x4 acc[2][2][4][2];
#pragma unroll
    for (int a = 0; a < 2; ++a)
#pragma unroll
        for (int b = 0; b < 2; ++b)
#pragma unroll
            for (int m = 0; m < 4; ++m)
#pragma unroll
                for (int n = 0; n < 2; ++n) acc[a][b][m][n] = (f32x4){0.f, 0.f, 0.f, 0.f};
    bf16x8 At[4][2], B0[2][2], B1[2][2];
    const char* cA = (const char*)g.A + (size_t)cur.pm * tstep; const char* cB = (const char*)g.Bt + (size_t)cur.pn * tstep;
    S.a_ready(cur);
    if constexpr (SP2) {
        PG8_STAGE(PG8_SB(0, 0), cB, voffB); PG8_STAGE(PG8_SB(0, 1), cB + hstep, voffB); PG8_STAGE(PG8_SA(0, 0), cA, voffA); PG8_STAGE(PG8_SA(0, 1), cA + hstep, voffA);
        if (wr == 1) PG8_BAR;
        PG8_WAIT_V(2); PG8_BAR;
        PG8_STAGE(PG8_SB(1, 0), cB + kstep, voffB); PG8_STAGE(PG8_SA(1, 0), cA + kstep, voffA); PG8_STAGE(PG8_SB(1, 1), cB + hstep + kstep, voffB);
        PG8_WAIT_V(6); PG8_BAR;
    } else {
        PG8_STAGE(PG8_SB(0, 0), cB, voffB); PG8_STAGE(PG8_SA(0, 0), cA, voffA); PG8_STAGE(PG8_SB(0, 1), cB + hstep, voffB); PG8_STAGE(PG8_SA(0, 1), cA + hstep, voffA);
        if (wr == 1) PG8_BAR;
        PG8_WAIT_V(4); PG8_BAR;
        PG8_STAGE(PG8_SB(1, 0), cB + kstep, voffB); PG8_STAGE(PG8_SA(1, 0), cA + kstep, voffA); PG8_STAGE(PG8_SB(1, 1), cB + hstep + kstep, voffB);
        PG8_WAIT_V(6); PG8_BAR;
    }
    for (;;) {
        const bool has_next = S.next(ui + 1, nxt);
        const char* nA = has_next ? (const char*)g.A + (size_t)nxt.pm * tstep : cA; const char* nB = has_next ? (const char*)g.Bt + (size_t)nxt.pn * tstep : cB;
        for (int t = 0; t < nt; t += 2) {
            const bool last = (t == nt - 2);
            const char* a1 = cA + (size_t)(t + 1) * kstep;
            const char* a2 = last ? nA : cA + (size_t)(t + 2) * kstep; const char* b2 = last ? nB : cB + (size_t)(t + 2) * kstep;
            const char* a3 = a2 + kstep; const char* b3 = b2 + kstep;
            if (last && has_next) S.a_ready(nxt);
            if constexpr (SP2) {
            PG8_LDB(B0, 0, 0); PG8_LDB(B1, 0, 1); PG8_SCHED; PG8_LDA(At, 0, 0); PG8_STAGE(PG8_SA(1, 1), a1 + hstep, voffA);
            PG8_WAIT_V(8); PG8_WAIT_L(0); PG8_BAR; PG8_MMA(0, 0, At, B0); PG8_MMA(0, 1, At, B1); PG8_BAR; PG8_SCHED;
            PG8_LDA(At, 0, 1); PG8_STAGE(PG8_SB(0, 0), b2, voffB); PG8_STAGE(PG8_SB(0, 1), b2 + hstep, voffB); PG8_STAGE(PG8_SA(0, 0), a2, voffA);
            PG8_WAIT_V(8); PG8_WAIT_L(0); PG8_BAR; PG8_MMA(1, 0, At, B0); PG8_MMA(1, 1, At, B1); PG8_BAR; PG8_SCHED;
            PG8_LDB(B0, 1, 0); PG8_LDB(B1, 1, 1); PG8_SCHED; PG8_LDA(At, 1, 0); PG8_STAGE(PG8_SA(0, 1), a2 + hstep, voffA);
            PG8_WAIT_V(8); PG8_WAIT_L(0); PG8_BAR; PG8_MMA(0, 0, At, B0); PG8_MMA(0, 1, At, B1); PG8_BAR; PG8_SCHED;
            PG8_LDA(At, 1, 1); PG8_STAGE(PG8_SB(1, 0), b3, voffB); PG8_STAGE(PG8_SB(1, 1), b3 + hstep, voffB); PG8_STAGE(PG8_SA(1, 0), a3, voffA);
            PG8_WAIT_V(8); PG8_WAIT_L(0); PG8_BAR; PG8_MMA(1, 0, At, B0); PG8_MMA(1, 1, At, B1); PG8_BAR; PG8_SCHED;
            } else {
            PG8_LDB(B0, 0, 0); PG8_SCHED; PG8_LDA(At, 0, 0); PG8_STAGE(PG8_SA(1, 1), a1 + hstep, voffA);
            PG8_WAIT_L(8); PG8_BAR; PG8_WAIT_L(0); PG8_MMA(0, 0, At, B0); PG8_BAR; PG8_SCHED;
            PG8_LDB(B1, 0, 1); PG8_STAGE(PG8_SB(0, 0), b2, voffB);
            PG8_BAR; PG8_WAIT_L(0); PG8_MMA(0, 1, At, B1); PG8_BAR;
            PG8_LDA(At, 0, 1); PG8_STAGE(PG8_SA(0, 0), a2, voffA);
            PG8_BAR; PG8_WAIT_L(0); PG8_MMA(1, 0, At, B0); PG8_BAR; PG8_SCHED;
            PG8_STAGE(PG8_SB(0, 1), b2 + hstep, voffB);
            PG8_WAIT_V(6); PG8_BAR; PG8_MMA(1, 1, At, B1); PG8_BAR;
            PG8_LDB(B0, 1, 0); PG8_SCHED; PG8_LDA(At, 1, 0); PG8_STAGE(PG8_SA(0, 1), a2 + hstep, voffA);
            PG8_WAIT_L(8); PG8_BAR; PG8_WAIT_L(0); PG8_MMA(0, 0, At, B0); PG8_BAR; PG8_SCHED;
            PG8_LDB(B1, 1, 1); PG8_STAGE(PG8_SB(1, 0), b3, voffB);
            PG8_BAR; PG8_WAIT_L(0); PG8_MMA(0, 1, At, B1); PG8_BAR;
            PG8_LDA(At, 1, 1); PG8_STAGE(PG8_SA(1, 0), a3, voffA);
            PG8_BAR; PG8_WAIT_L(0); PG8_MMA(1, 0, At, B0); PG8_BAR; PG8_SCHED;
            PG8_STAGE(PG8_SB(1, 1), b3 + hstep, voffB);
            PG8_WAIT_V(6); PG8_BAR; PG8_MMA(1, 1, At, B1); PG8_BAR;
            }
        }
        if constexpr (ALIGN_EPI) { if (wr == 0) PG8_BAR; }
        if constexpr (!Epi::AFTER_DRAIN) { E(acc, cur, wr, wc, fr, fq); S.done(cur); }
        if (!has_next) break;
#pragma unroll
        for (int a = 0; a < 2; ++a)
#pragma unroll
            for (int b = 0; b < 2; ++b)
#pragma unroll
                for (int m = 0; m < 4; ++m)
#pragma unroll
                    for (int n = 0; n < 2; ++n) acc[a][b][m][n] = (f32x4){0.f, 0.f, 0.f, 0.f};
        cur = nxt; cA = nA; cB = nB; ++ui;
        if constexpr (ALIGN_EPI) { if (wr == 1) PG8_BAR; }
    }
    PG8_WAIT_V(0);
    if constexpr (!ALIGN_EPI) { if (wr == 0) PG8_BAR; }
    PG8_BAR;
    if constexpr (Epi::AFTER_DRAIN) { E.fused(acc, cur, wr, wc, fr, fq, lds, wid, lane); S.done(cur); }
#undef PG8_SA
#undef PG8_SB
#undef PG8_STAGE
#undef PG8_LDA
#undef PG8_LDB
#undef PG8_MMA
#undef PG8_WAIT_V
#undef PG8_WAIT_L
#undef PG8_BAR
#undef PG8_SCHED
}
}
namespace pg8 {
__device__ __forceinline__ float fast_silu(float x) { return x * __builtin_amdgcn_rcpf(1.0f + __builtin_amdgcn_exp2f(-1.44269504089f * x)); }
struct EpiResGate {
    static constexpr bool PERM = false, AFTER_DRAIN = false;
    const float* base; float* out; int ldc; const float* gate; int gate_ld; int tiles_per_batch;
    __device__ __forceinline__ void operator()(const f32x4 (&acc)[2][2][4][2], const Unit& u, int wr, int wc, int fr, int fq) const {
        const int row0 = u.pm * BM + wr * 64 + fr, col0 = u.pn * BM + wc * 32 + 4 * fq;
        const float* gp = gate + (size_t)(u.pm / tiles_per_batch) * gate_ld + col0;
        f32x4 gv[2][2];
#pragma unroll
        for (int bj = 0; bj < 2; ++bj)
#pragma unroll
            for (int n = 0; n < 2; ++n) gv[bj][n] = *(const f32x4*)(gp + bj * HALF + n * 16);
#pragma unroll
        for (int ai = 0; ai < 2; ++ai)
#pragma unroll
            for (int m = 0; m < 4; ++m) { const size_t off = (size_t)(row0 + ai * HALF + m * 16) * ldc + col0;
#pragma unroll
                for (int bj = 0; bj < 2; ++bj)
#pragma unroll
                    for (int n = 0; n < 2; ++n) { const f32x4 b = *(const f32x4*)(base + off + bj * HALF + n * 16); *(f32x4*)(out + off + bj * HALF + n * 16) = b + gv[bj][n] * acc[ai][bj][m][n]; } }
    }
};
struct EpiSwiGLU {
    static constexpr bool PERM = true, AFTER_DRAIN = false;
    bf16_t* O; int ldc;
    __device__ __forceinline__ void operator()(const f32x4 (&acc)[2][2][4][2], const Unit& u, int wr, int wc, int fr, int fq) const {
        const int row0 = u.pm * BM + wr * 64 + fr, col0 = u.pn * HALF + wc * 32 + 8 * fq;
#pragma unroll
        for (int ai = 0; ai < 2; ++ai)
#pragma unroll
            for (int m = 0; m < 4; ++m) { bf16_t* rowp = O + (size_t)(row0 + ai * HALF + m * 16) * ldc + col0;
                const f32x4 g0 = acc[ai][0][m][0], g1 = acc[ai][0][m][1], u0 = acc[ai][1][m][0], u1 = acc[ai][1][m][1];
                u32x4 w; w.x = cvt_pk_bf16(fast_silu(g0[0]) * u0[0], fast_silu(g0[1]) * u0[1]); w.y = cvt_pk_bf16(fast_silu(g0[2]) * u0[2], fast_silu(g0[3]) * u0[3]);
                w.z = cvt_pk_bf16(fast_silu(g1[0]) * u1[0], fast_silu(g1[1]) * u1[1]); w.w = cvt_pk_bf16(fast_silu(g1[2]) * u1[2], fast_silu(g1[3]) * u1[3]);
                *(u32x4*)rowp = w; }
    }
};
struct EpiP {
    static constexpr bool PERM = true, AFTER_DRAIN = false;
    bf16_t* O; int ldc; int sig_lo, sig_hi, silu_lo, silu_hi;
    __device__ __forceinline__ void operator()(const f32x4 (&acc)[2][2][4][2], const Unit& u, int wr, int wc, int fr, int fq) const {
        const int row0 = u.pm * BM + wr * 64 + fr, col0 = u.pn * BM + wc * 32 + 8 * fq;
        const int act = (u.pn >= sig_lo && u.pn < sig_hi) ? 1 : (u.pn >= silu_lo && u.pn < silu_hi) ? 2 : 0;
#pragma unroll
        for (int ai = 0; ai < 2; ++ai)
#pragma unroll
            for (int m = 0; m < 4; ++m) { bf16_t* rowp = O + (size_t)(row0 + ai * HALF + m * 16) * ldc + col0;
#pragma unroll
                for (int bj = 0; bj < 2; ++bj) { f32x4 v0 = acc[ai][bj][m][0], v1 = acc[ai][bj][m][1];
                    if (act) {
#pragma unroll
                        for (int i = 0; i < 4; ++i) { const float s0 = __builtin_amdgcn_rcpf(1.0f + __builtin_amdgcn_exp2f(-1.44269504089f * v0[i])), s1 = __builtin_amdgcn_rcpf(1.0f + __builtin_amdgcn_exp2f(-1.44269504089f * v1[i]));
                            v0[i] = act == 1 ? s0 : v0[i] * s0; v1[i] = act == 1 ? s1 : v1[i] * s1; } }
                    u32x4 w; w.x = cvt_pk_bf16(v0[0], v0[1]); w.y = cvt_pk_bf16(v0[2], v0[3]); w.z = cvt_pk_bf16(v1[0], v1[1]); w.w = cvt_pk_bf16(v1[2], v1[3]);
                    *(u32x4*)(rowp + bj * HALF) = w; } }
    }
};
}
#ifndef PG8_SP2
#define PG8_SP2 true
#endif
#ifndef PG8_ALIGN
#define PG8_ALIGN true
#endif
constexpr int NWAVES = 8;
#ifndef MK_ONE_LAUNCH
#define MK_ONE_LAUNCH 1
#endif
#ifndef GDN_SIMPLE
#define GDN_SIMPLE 0
#endif
#ifndef PROBE_REP
#define PROBE_REP -1
#endif
constexpr int N_PHASES = 10;

constexpr int BATCH = 8, SEQ = 2048, D = 1024, M = BATCH * SEQ;
constexpr int CW = 512, GW = 512, NH = 4, HD = 128, NIN = 3080, NIN_G = 3072, FF = 2816, NMOD = 6;
constexpr int CONVK = 31, CL = 64;
constexpr float EPS = 1e-6f;
constexpr int PC_A = 0, PC_GATE = 512, PC_Q = 1024, PC_K = 1536, PC_V = 2048, PC_Z = 2560;

constexpr size_t MiB = 1u << 20;
constexpr size_t WS_CTL = 0, CTL_ZERO_BYTES = 1 * MiB;
constexpr size_t WS_MOD = 1 * MiB;
constexpr size_t WS_BG = 1 * MiB + 512 * 1024;
constexpr size_t WS_WIN = 2 * MiB, WS_WOUT = 8 * MiB, WS_WFI = 10 * MiB, WS_WFO = 21 * MiB;
constexpr size_t WS_XN = 28 * MiB;
constexpr size_t WS_P = 60 * MiB;
constexpr size_t WS_HID = 60 * MiB;
constexpr size_t WS_MIXIN = 156 * MiB;
constexpr size_t WS_QN = 188 * MiB, WS_KN = 220 * MiB, WS_VN = 28 * MiB;
constexpr size_t WS_END = 256 * MiB;
constexpr int CW_BAR = 4096;

constexpr int RING_OFF = 0, RING_BYTES = 131072;
constexpr int EXTRA_OFF = RING_BYTES, EXTRA_BYTES = 16384;
constexpr int LDSCTL_OFF = 162816, MISC_OFF = LDSCTL_OFF + 320;
constexpr int LDS_BYTES = 163840;
static_assert(MISC_OFF + 128 <= LDS_BYTES, "LDS map");
#define GAS __attribute__((address_space(1)))
#define LAS __attribute__((address_space(3)))
typedef unsigned short bf16;
typedef unsigned v4u __attribute__((ext_vector_type(4)));
typedef float f32x4 __attribute__((ext_vector_type(4)));
typedef short bf16x8 __attribute__((ext_vector_type(8)));
typedef GAS unsigned gu32;
typedef GAS unsigned long long gu64;
#define RLX_AGENT __ATOMIC_RELAXED, __HIP_MEMORY_SCOPE_AGENT
#define LDS_WAIT() asm volatile("s_waitcnt lgkmcnt(0)" ::: "memory")
#define VM_WAIT() asm volatile("s_waitcnt vmcnt(0)" ::: "memory")
__device__ __forceinline__ unsigned long long rt() { return __builtin_amdgcn_s_memrealtime(); }
__device__ __forceinline__ unsigned f2bf(float f) { unsigned u = __builtin_bit_cast(unsigned, f); return (u + 0x7fffu + ((u >> 16) & 1u)) >> 16; }
__device__ __forceinline__ unsigned pk2(float lo, float hi) { return f2bf(lo) | (f2bf(hi) << 16); }

#define XB_TMO      128
#define XB_XCNT(j)  (256  + 64 * (j))
#define XB_XSUB(j)  (1280 + 64 * (j))
#define XB_XGEN(j)  (2304 + 64 * (j))
#define XB_TOP      3328
#define XB_TOPGEN   3392
#define XCD_BAR_WORDS 3456
#define XB_SPIN_CAP (1u << 18)

__device__ __forceinline__ unsigned xb_ld(unsigned* p)              { return __hip_atomic_load(p, __ATOMIC_RELAXED, __HIP_MEMORY_SCOPE_AGENT); }
__device__ __forceinline__ unsigned xb_add(unsigned* p, unsigned v) { return __hip_atomic_fetch_add(p, v, __ATOMIC_RELAXED, __HIP_MEMORY_SCOPE_AGENT); }
__device__ __forceinline__ unsigned xb_xcc_id() { return (unsigned)__builtin_amdgcn_s_getreg((3 << 11) | 20) & 0xFu; }
#define XB_SPIN(cond, bar) do { unsigned _sp = 0; while (cond) { __builtin_amdgcn_s_sleep(1); \
    if ((++_sp & 255u) == 0u) { if (xb_ld(&(bar)[XB_TMO])) break; if (_sp > XB_SPIN_CAP) { atomicAdd(&(bar)[XB_TMO], 1u); break; } } } } while (0)

struct XcdBarrier {
    unsigned* bar; unsigned x;
    volatile LAS unsigned* st;
};

__device__ __forceinline__ XcdBarrier xcd_barrier_post(unsigned* bar, volatile LAS unsigned* st) {
    XcdBarrier b; b.bar = bar; b.x = xb_xcc_id(); b.st = st;
    if (threadIdx.x == 0) (void)xb_add(&bar[XB_XCNT(b.x)], 1u);
    return b;
}
__device__ __forceinline__ void xcd_barrier_complete(unsigned* bar, unsigned x, unsigned& nloc, unsigned& nx) {
    const unsigned G = gridDim.x * gridDim.y * gridDim.z;
    unsigned sum, cnt, mine, sp = 0u;
    for (;;) {
        sum = 0u; cnt = 0u; mine = 0u;
#pragma unroll
        for (unsigned j = 0; j < 16; ++j) { const unsigned c = xb_ld(&bar[XB_XCNT(j)]); sum += c; cnt += (c > 0u) ? 1u : 0u; mine = (j == x) ? c : mine; }
        if (sum == G) break;
        __builtin_amdgcn_s_sleep(1);
        if ((++sp & 255u) == 0u) { if (xb_ld(&bar[XB_TMO])) break; if (sp > XB_SPIN_CAP) { atomicAdd(&bar[XB_TMO], 1u); break; } }
    }
    nloc = mine > 0u ? mine : 1u; nx = cnt > 0u ? cnt : 1u;
}

__device__ __forceinline__ void xcd_barrier(const XcdBarrier& b) {
    asm volatile("s_waitcnt vmcnt(0)" ::: "memory");
    __syncthreads();
    if (threadIdx.x == 0) {
        unsigned* bar = b.bar;
        __builtin_amdgcn_s_waitcnt(0);
        unsigned nloc = b.st[0], nx = b.st[1];
        if (nloc == 0u) { xcd_barrier_complete(bar, b.x, nloc, nx); b.st[0] = nloc; b.st[1] = nx; }
        const unsigned old = xb_add(&bar[XB_XSUB(b.x)], 1u);
        const unsigned gen = old / nloc;
        if (old + 1u == (gen + 1u) * nloc) {
            __builtin_amdgcn_fence(__ATOMIC_RELEASE, "agent");
            asm volatile("s_waitcnt vmcnt(0)" ::: "memory");
            const unsigned og = xb_add(&bar[XB_TOP], 1u);
            const unsigned tg = og / nx;
            if (og + 1u == (tg + 1u) * nx) xb_add(&bar[XB_TOPGEN], 1u);
            else XB_SPIN(xb_ld(&bar[XB_TOPGEN]) == tg, bar);
            __builtin_amdgcn_fence(__ATOMIC_ACQUIRE, "agent");
            xb_add(&bar[XB_XGEN(b.x)], 1u);
            asm volatile("s_waitcnt vmcnt(0)" ::: "memory");
        } else {
            XB_SPIN(xb_ld(&bar[XB_XGEN(b.x)]) == gen, bar);
            __builtin_amdgcn_fence(__ATOMIC_ACQUIRE, "agent");
            asm volatile("s_waitcnt vmcnt(0)" ::: "memory");
        }
    }
    __syncthreads();
}
struct Frame {
    LAS unsigned char* lds;
    volatile LAS unsigned* MISC;
    gu32* ctl;
    int tid, lane, wave;
    int vcu, G;
    const float* in[19]; float* out; unsigned char* ws;
};
typedef float f32x2 __attribute__((ext_vector_type(2)));
template <int CTRL> __device__ __forceinline__ float dppf(float v) { return __builtin_bit_cast(float, __builtin_amdgcn_update_dpp(0, __builtin_bit_cast(int, v), CTRL, 0xf, 0xf, true)); }
__device__ __forceinline__ float wave_sum(float v) {
    v += dppf<0xB1>(v);
    v += dppf<0x4E>(v);
    v += dppf<0x141>(v);
    v += dppf<0x140>(v);
    const int iv = __builtin_bit_cast(int, v);
    const float s0 = __builtin_bit_cast(float, __builtin_amdgcn_readlane(iv, 0)), s1 = __builtin_bit_cast(float, __builtin_amdgcn_readlane(iv, 16));
    const float s2 = __builtin_bit_cast(float, __builtin_amdgcn_readlane(iv, 32)), s3 = __builtin_bit_cast(float, __builtin_amdgcn_readlane(iv, 48));
    return (s0 + s1) + (s2 + s3);
}
__device__ __forceinline__ float bf_lo(unsigned u) { return __builtin_bit_cast(float, u << 16); }
__device__ __forceinline__ float bf_hi(unsigned u) { return __builtin_bit_cast(float, u & 0xffff0000u); }
__device__ __forceinline__ float sigmoidf_(float x) { return __builtin_amdgcn_rcpf(1.0f + __builtin_amdgcn_exp2f(-1.44269504089f * x)); }
__device__ __forceinline__ float siluf_(float x) { return x * __builtin_amdgcn_rcpf(1.0f + __builtin_amdgcn_exp2f(-1.44269504089f * x)); }
__device__ __forceinline__ float rsqrtf_(float x) { return __builtin_amdgcn_rsqf(x); }

__device__ __forceinline__ void transpose_item(const float* W, int ldw, int k0, int n_src, bf16* WT, int K, int n_dst, LAS float* scr, int lane) {
#pragma unroll 8
    for (int i = 0; i < 32; ++i) { const int kk = 2 * i + (lane >> 5); scr[kk * 33 + (lane & 31)] = W[(size_t)(k0 + kk) * ldw + n_src + (lane & 31)]; }
    LDS_WAIT(); asm volatile("" ::: "memory");
    const int c = lane & 7;
#pragma unroll
    for (int j = 0; j < 4; ++j) { const int n = (lane >> 3) + 8 * j; const LAS float* s = scr + (8 * c) * 33 + n;
        v4u o; o.x = pk2(s[0 * 33], s[1 * 33]); o.y = pk2(s[2 * 33], s[3 * 33]); o.z = pk2(s[4 * 33], s[5 * 33]); o.w = pk2(s[6 * 33], s[7 * 33]);
        *(GAS v4u*)(WT + (size_t)(n_dst + n) * K + k0 + 8 * c) = o; }
    LDS_WAIT(); asm volatile("" ::: "memory");
}
__device__ __forceinline__ void p0_prologue(Frame& F) {
    const float* c = F.in[1]; const float* w_ada = F.in[2]; const float* b_ada = F.in[3];
    float* MOD = (float*)(F.ws + WS_MOD);
    for (int item = blockIdx.x; item < (NMOD * D) / 32; item += F.G) {
        LAS float* cs = (LAS float*)(F.lds + RING_OFF);
        LAS float* red = (LAS float*)(F.lds + RING_OFF + 32768);
        for (int i = F.tid; i < BATCH * D; i += NWAVES * 64) cs[i] = siluf_(c[i]);
        __syncthreads();
        const int n0 = 32 * item, col = F.lane & 31, kp = F.lane >> 5;
        float acc[8];
#pragma unroll
        for (int b = 0; b < 8; ++b) acc[b] = 0.f;
#pragma unroll 8
        for (int i = 0; i < 64; ++i) { const int k = 128 * F.wave + 2 * i + kp; const float wv = w_ada[(size_t)k * (NMOD * D) + n0 + col];
#pragma unroll
            for (int b = 0; b < 8; ++b) acc[b] += cs[b * D + k] * wv; }
#pragma unroll
        for (int b = 0; b < 8; ++b) { acc[b] += __shfl_xor(acc[b], 32); if (F.lane < 32) red[(F.wave * 8 + b) * 32 + col] = acc[b]; }
        __syncthreads();
        if (F.tid < 256) { const int b = F.tid >> 5, cc = F.tid & 31; float s = b_ada[n0 + cc];
#pragma unroll
            for (int w = 0; w < 8; ++w) s += red[(w * 8 + b) * 32 + cc];
            MOD[b * (NMOD * D) + n0 + cc] = s; }
        __syncthreads();
    }
    LAS float* scr = (LAS float*)(F.lds + RING_OFF + F.wave * 16384);
    const int gw = F.vcu * NWAVES + F.wave, NGW = F.G * NWAVES;
    constexpr int I_IN = (D / 64) * (NIN_G / 32), I_OUT = (D / 64) * (D / 32), I_FI = (D / 64) * (2 * FF / 32), I_FO = (FF / 64) * (D / 32);
    constexpr int NITEMS = I_IN + I_OUT + I_FI + I_FO;
    bf16* WIN = (bf16*)(F.ws + WS_WIN); bf16* WOUT = (bf16*)(F.ws + WS_WOUT); bf16* WFI = (bf16*)(F.ws + WS_WFI); bf16* WFO = (bf16*)(F.ws + WS_WFO);
    for (int it = gw; it < NITEMS; it += NGW) {
        int r = it;
        if (r < I_IN) { const int nblk = NIN_G / 32, kb = r / nblk, nb = r % nblk; transpose_item(F.in[5], NIN, 64 * kb, 32 * nb, WIN, D, 32 * nb, scr, F.lane); continue; } r -= I_IN;
        if (r < I_OUT) { const int nblk = D / 32, kb = r / nblk, nb = r % nblk; transpose_item(F.in[14], D, 64 * kb, 32 * nb, WOUT, D, 32 * nb, scr, F.lane); continue; } r -= I_OUT;
        if (r < I_FI) { const int nblk = 2 * FF / 32, kb = r / nblk, nb = r % nblk; const int nd = 32 * nb, t = nd >> 8, rr = nd & 255;
            const int ns = rr < 128 ? t * 128 + rr : FF + t * 128 + (rr - 128);
            transpose_item(F.in[16], 2 * FF, 64 * kb, ns, WFI, D, nd, scr, F.lane); continue; } r -= I_FI;
        { const int nblk = D / 32, kb = r / nblk, nb = r % nblk; transpose_item(F.in[17], D, 64 * kb, 32 * nb, WFO, FF, 32 * nb, scr, F.lane); }
    }
}

template <bool WITH_BA>
__device__ __forceinline__ void norm_mod_phase(Frame& F, const float* src, const float* nw, const float* shift, const float* scale, bf16* dst) {
    const int gw = F.vcu * NWAVES + F.wave, NGW = F.G * NWAVES;
    constexpr int RPW = 8;
    f32x4 w8a[WITH_BA ? 16 : 1], w8b[WITH_BA ? 16 : 1];
    if (WITH_BA) {
        const float* w_in = F.in[5];
#pragma unroll
        for (int j = 0; j < 4; ++j)
#pragma unroll
            for (int e = 0; e < 4; ++e) { const int k = 4 * F.lane + 256 * j + e; w8a[j * 4 + e] = *(const f32x4*)(w_in + (size_t)k * NIN + NIN_G); w8b[j * 4 + e] = *(const f32x4*)(w_in + (size_t)k * NIN + NIN_G + 4); }
    }
    for (int it = gw; it < M / RPW; it += NGW) {
        const int m0 = it * RPW, b = m0 / SEQ;
        f32x4 wv[4], sv[4];
#pragma unroll
        for (int j = 0; j < 4; ++j) { const int cidx = 4 * F.lane + 256 * j; const f32x4 n4 = *(const f32x4*)(nw + cidx), sc = *(const f32x4*)(scale + (size_t)b * (NMOD * D) + cidx);
            wv[j] = n4 * (sc + 1.0f); sv[j] = *(const f32x4*)(shift + (size_t)b * (NMOD * D) + cidx); }
        f32x4 nx[4];
        { const GAS f32x4* xr = (const GAS f32x4*)(src + (size_t)m0 * D) + F.lane;
#pragma unroll
          for (int j = 0; j < 4; ++j) nx[j] = xr[64 * j]; }
        for (int r = 0; r < RPW; ++r) {
            const int m = m0 + r;
            f32x4 v[4]; float s = 0.f;
#pragma unroll
            for (int j = 0; j < 4; ++j) { v[j] = nx[j]; s += (v[j].x * v[j].x + v[j].y * v[j].y) + (v[j].z * v[j].z + v[j].w * v[j].w); }
            { const GAS f32x4* xr = (const GAS f32x4*)(src + (size_t)(m0 + (r + 1 < RPW ? r + 1 : r)) * D) + F.lane;
#pragma unroll
              for (int j = 0; j < 4; ++j) nx[j] = xr[64 * j]; }
            const float rstd = rsqrtf_(wave_sum(s) * (1.f / D) + EPS);
            GAS unsigned long long* o8 = (GAS unsigned long long*)(dst + (size_t)m * D) + F.lane;
#pragma unroll
            for (int j = 0; j < 4; ++j) { v[j] = v[j] * rstd * wv[j] + sv[j];
                o8[64 * j] = (unsigned long long)pk2(v[j].x, v[j].y) | ((unsigned long long)pk2(v[j].z, v[j].w) << 32); }
            if (WITH_BA) {
                f32x4 pa = {0.f, 0.f, 0.f, 0.f}, pb = {0.f, 0.f, 0.f, 0.f};
#pragma unroll
                for (int j = 0; j < 4; ++j) { pa += w8a[j * 4 + 0] * v[j].x + w8a[j * 4 + 1] * v[j].y + w8a[j * 4 + 2] * v[j].z + w8a[j * 4 + 3] * v[j].w;
                    pb += w8b[j * 4 + 0] * v[j].x + w8b[j * 4 + 1] * v[j].y + w8b[j * 4 + 2] * v[j].z + w8b[j * 4 + 3] * v[j].w; }
                float p[8] = {pa.x, pa.y, pa.z, pa.w, pb.x, pb.y, pb.z, pb.w};
#pragma unroll
                for (int q = 0; q < 8; ++q) p[q] = wave_sum(p[q]);
                const int l = F.lane & 7, h = l & 3;
                float mine = p[0];
#pragma unroll
                for (int q = 1; q < 8; ++q) mine = (l == q) ? p[q] : mine;
                const float a_log = F.in[11][h], dtb = F.in[12][h];
                const float xx = mine + dtb, ex = __expf(fminf(xx, 20.f));
                const float sp = xx > 20.f ? xx : (ex < 0.01f ? ex * (1.0f - ex * (0.5f - ex * (1.0f / 3.0f))) : __logf(1.0f + ex));
                const float val = (l < 4) ? sigmoidf_(mine) : -__expf(a_log) * sp;
                if (F.lane < 8) ((float*)(F.ws + WS_BG))[(size_t)m * 8 + l] = val;
            }
        }
    }
}

__device__ __forceinline__ void final_norm_phase(Frame& F, float* io, const float* nw) {
    const int gw = F.vcu * NWAVES + F.wave, NGW = F.G * NWAVES;
    f32x4 wv[4];
#pragma unroll
    for (int j = 0; j < 4; ++j) wv[j] = *(const f32x4*)(nw + 4 * F.lane + 256 * j);
    for (int m = 2 * gw; m < M; m += 2 * NGW) {
        GAS f32x4* xr = (GAS f32x4*)(io + (size_t)m * D) + F.lane;
        f32x4 v[4], u[4]; float s = 0.f, t = 0.f;
#pragma unroll
        for (int j = 0; j < 4; ++j) { v[j] = xr[64 * j]; u[j] = xr[256 + 64 * j]; }
#pragma unroll
        for (int j = 0; j < 4; ++j) { s += (v[j].x * v[j].x + v[j].y * v[j].y) + (v[j].z * v[j].z + v[j].w * v[j].w); t += (u[j].x * u[j].x + u[j].y * u[j].y) + (u[j].z * u[j].z + u[j].w * u[j].w); }
        const float rs = rsqrtf_(wave_sum(s) * (1.f / D) + EPS), rt_ = rsqrtf_(wave_sum(t) * (1.f / D) + EPS);
#pragma unroll
        for (int j = 0; j < 4; ++j) { xr[64 * j] = v[j] * rs * wv[j]; xr[256 + 64 * j] = u[j] * rt_ * wv[j]; }
    }
}

__device__ __forceinline__ void conformer_phase(Frame& F) {
    const bf16* P = (const bf16*)(F.ws + WS_P); bf16* MIX = (bf16*)(F.ws + WS_MIXIN);
    const float* conv_w = F.in[6]; const float* conv_b = F.in[7]; const float* gn_w = F.in[8]; const float* gn_b = F.in[9];
    LAS float* ub = (LAS float*)(F.lds + RING_OFF);
    constexpr int NR = CL + CONVK - 1;
    const int nsc = (MK_ONE_LAUNCH || 1) ? BATCH * NH : 0;
    for (int item = (int)blockIdx.x - nsc; item < (M / CL) * 8; item += F.G - nsc) {
        const int tt = item >> 3, g = item & 7, m0 = tt * CL, t0 = m0 % SEQ;
        { unsigned a2[6], g2[6];
#pragma unroll
          for (int k = 0; k < 6; ++k) { const int idx = F.tid + 512 * k, r = idx >> 5, cp = idx & 31; const int t = t0 - (CONVK - 1) + r; a2[k] = 0u; g2[k] = 0u;
              if (idx < NR * 32 && t >= 0) { const size_t off = (size_t)(m0 - (CONVK - 1) + r) * NIN_G + g * 64 + 2 * cp; a2[k] = *(const unsigned*)(P + off + PC_A); g2[k] = *(const unsigned*)(P + off + PC_GATE); } }
#pragma unroll
          for (int k = 0; k < 6; ++k) { const int idx = F.tid + 512 * k, r = idx >> 5, cp = idx & 31;
              if (idx < NR * 32) *(LAS f32x2*)(ub + r * 64 + 2 * cp) = (f32x2){bf_lo(a2[k]) * bf_lo(g2[k]), bf_hi(a2[k]) * bf_hi(g2[k])}; } }
        const int c = F.tid & 63, tb = F.tid >> 6, ch = g * 64 + c;
        float w[CONVK];
#pragma unroll
        for (int k = 0; k < CONVK; ++k) w[k] = conv_w[k * CW + ch];
        const float bias = conv_b[ch], gw_ = gn_w[ch], gb_ = gn_b[ch];
        __syncthreads();
        float acc[8];
#pragma unroll
        for (int i = 0; i < 8; ++i) acc[i] = bias;
#pragma unroll
        for (int k = 0; k < 8 + CONVK - 1; ++k) { const float uv = ub[(8 * tb + k) * 64 + c];
#pragma unroll
            for (int i = 0; i < 8; ++i) { const int tap = k - i; if (tap >= 0 && tap < CONVK) acc[i] += w[tap] * uv; } }
#pragma unroll
        for (int i = 0; i < 8; ++i) { const float mu = wave_sum(acc[i]) * (1.f / 64.f), d = acc[i] - mu, var = wave_sum(d * d) * (1.f / 64.f);
            const float y = d * rsqrtf_(var + EPS) * gw_ + gb_;
            MIX[(size_t)(m0 + 8 * tb + i) * D + ch] = (bf16)f2bf(siluf_(y)); }
        __syncthreads();
    }
}

__device__ __forceinline__ void gdn_prep_simple(Frame& F) {
    const bf16* P = (const bf16*)(F.ws + WS_P); const float* cw = F.in[10];
    float* QN = (float*)(F.ws + WS_QN); float* KN = (float*)(F.ws + WS_KN); float* VN = (float*)(F.ws + WS_VN);
    const int gw = F.vcu * NWAVES + F.wave, NGW = F.G * NWAVES;
    for (int m = gw; m < M; m += NGW) {
        const int t = m % SEQ;
#pragma unroll
        for (int i = 0; i < 12; ++i) {
            const int ch = 128 * i + 2 * F.lane;
            float y0 = 0.f, y1 = 0.f;
#pragma unroll
            for (int j = 0; j < 4; ++j) { const int tj = t - 3 + j; if (tj >= 0) { const unsigned pv = *(const unsigned*)(P + (size_t)(m - 3 + j) * NIN_G + PC_Q + ch);
                    const f32x2 wj = *(const f32x2*)(cw + j * (3 * GW) + ch); y0 += wj.x * bf_lo(pv); y1 += wj.y * bf_hi(pv); } }
            y0 = siluf_(y0); y1 = siluf_(y1);
            if (i < 8) { const float ss = wave_sum(y0 * y0 + y1 * y1); float r = 1.0f / sqrtf(ss + EPS); if (i < 4) r *= 0.08838834764831845f; y0 *= r; y1 *= r; }
            float* dstp = (i < 4) ? QN + (size_t)m * GW + ch : (i < 8) ? KN + (size_t)m * GW + (ch - 512) : VN + (size_t)m * GW + (ch - 1024);
            *(f32x2*)dstp = (f32x2){y0, y1};
        }
    }
}
__device__ __forceinline__ void gdn_recurrent_simple(Frame& F) {
    const bf16* P = (const bf16*)(F.ws + WS_P); bf16* MIX = (bf16*)(F.ws + WS_MIXIN);
    const float* QN = (const float*)(F.ws + WS_QN); const float* KN = (const float*)(F.ws + WS_KN); const float* VN = (const float*)(F.ws + WS_VN);
    const float* BG = (const float*)(F.ws + WS_BG); const float* nw = F.in[13];
    LAS float* QS = (LAS float*)(F.lds + RING_OFF); LAS float* KS = QS + CL * HD; LAS float* VS = KS + CL * HD; LAS float* OS = VS + CL * HD;
    LAS float* BS = (LAS float*)(F.lds + EXTRA_OFF);
    for (int item = blockIdx.x; item < BATCH * NH; item += F.G) {
        const int b = item / NH, h = item % NH;
        const int col = 16 * F.wave + (F.lane & 15), qd = F.lane >> 4;
        float S[32];
#pragma unroll
        for (int i = 0; i < 32; ++i) S[i] = 0.f;
        for (int ch = 0; ch < SEQ / CL; ++ch) {
            const int m0 = b * SEQ + ch * CL;
            for (int idx = F.tid; idx < CL * HD / 4; idx += NWAVES * 64) { const int r = idx >> 5, c4 = idx & 31; const size_t off = (size_t)(m0 + r) * GW + h * HD + 4 * c4;
                *(LAS f32x4*)(QS + r * HD + 4 * c4) = *(const f32x4*)(QN + off); *(LAS f32x4*)(KS + r * HD + 4 * c4) = *(const f32x4*)(KN + off); *(LAS f32x4*)(VS + r * HD + 4 * c4) = *(const f32x4*)(VN + off); }
            if (F.tid < 64) { BS[F.tid] = BG[(size_t)(m0 + F.tid) * 8 + h]; BS[64 + F.tid] = expf(BG[(size_t)(m0 + F.tid) * 8 + 4 + h]); }
            __syncthreads();
            for (int t = 0; t < CL; ++t) {
                float kv[32], qv[32];
#pragma unroll
                for (int i = 0; i < 8; ++i) { const f32x4 k4 = *(const LAS f32x4*)(KS + t * HD + 32 * qd + 4 * i), q4 = *(const LAS f32x4*)(QS + t * HD + 32 * qd + 4 * i);
                    kv[4 * i] = k4.x; kv[4 * i + 1] = k4.y; kv[4 * i + 2] = k4.z; kv[4 * i + 3] = k4.w; qv[4 * i] = q4.x; qv[4 * i + 1] = q4.y; qv[4 * i + 2] = q4.z; qv[4 * i + 3] = q4.w; }
                const float beta = BS[t], eg = BS[64 + t], vv = VS[t * HD + col];
                float ks = 0.f;
#pragma unroll
                for (int i = 0; i < 32; ++i) ks += kv[i] * S[i];
                ks += __shfl_xor(ks, 16); ks += __shfl_xor(ks, 32);
                const float dd = beta * (vv - eg * ks);
                float o = 0.f;
#pragma unroll
                for (int i = 0; i < 32; ++i) { S[i] = eg * S[i] + kv[i] * dd; o += qv[i] * S[i]; }
                o += __shfl_xor(o, 16); o += __shfl_xor(o, 32);
                if (qd == 0) OS[t * HD + col] = o;
            }
            __syncthreads();
#pragma unroll
            for (int r = 0; r < 8; ++r) { const int t = 8 * F.wave + r; const f32x2 o2 = *(const LAS f32x2*)(OS + t * HD + 2 * F.lane);
                const float ss = wave_sum(o2.x * o2.x + o2.y * o2.y); const float rr = 1.0f / sqrtf(ss * (1.f / HD) + EPS);
                const unsigned z2 = *(const unsigned*)(P + (size_t)(m0 + t) * NIN_G + PC_Z + h * HD + 2 * F.lane);
                const f32x2 n2 = *(const f32x2*)(nw + 2 * F.lane);
                const float y0 = o2.x * rr * n2.x * siluf_(bf_lo(z2)), y1 = o2.y * rr * n2.y * siluf_(bf_hi(z2));
                *(unsigned*)(MIX + (size_t)(m0 + t) * D + GW + h * HD + 2 * F.lane) = pk2(y0, y1); }
            __syncthreads();
        }
    }
}
typedef float f32x16 __attribute__((ext_vector_type(16)));
typedef unsigned u32x2 __attribute__((ext_vector_type(2)));
#define MFMA32(a, b, c) __builtin_amdgcn_mfma_f32_32x32x16_bf16((a), (b), (c), 0, 0, 0)
constexpr int IMG_W = 0, IMG_Q = 17408, IMG_KT = 34816, IMG_QK = 53248, IMG_BYTES = 62464;
constexpr size_t WS_IMG = 188 * MiB, WS_UT = 28 * MiB;
constexpr size_t WS_CD = 1 * MiB + 256 * 1024;
__device__ __forceinline__ int perm16(int x) { const int o = x & 15; return (x & ~15) | (8 * ((o >> 2) & 1) + 4 * (o >> 3) + (o & 3)); }
typedef __bf16 bf16x2_t __attribute__((ext_vector_type(2)));
__device__ __forceinline__ unsigned cvtpk(float lo, float hi) { const f32x2 v = {lo, hi}; return __builtin_bit_cast(unsigned, __builtin_convertvector(v, bf16x2_t)); }
__device__ __forceinline__ bf16x8 pack8(float a0, float a1, float a2, float a3, float a4, float a5, float a6, float a7) {
    v4u u; u.x = cvtpk(a0, a1); u.y = cvtpk(a2, a3); u.z = cvtpk(a4, a5); u.w = cvtpk(a6, a7); return __builtin_bit_cast(bf16x8, u); }

constexpr int PL_KR = 0, PL_KBR = 17408, PL_QR = 34816, PL_KBGT = 52224, PL_VBT = 70656, PL_AB = 89088, PL_TB = 105472, PL_GC = 114688;
constexpr int RP = 272, TP = 144;

__device__ __forceinline__ void gdn_prep_phase(Frame& F) {
    const bf16* P = (const bf16*)(F.ws + WS_P); const float* BG = (const float*)(F.ws + WS_BG); const float* cw = F.in[10];
    const int w = F.wave;
    LAS unsigned char* L = F.lds + RING_OFF;
    LAS float* GC = (LAS float*)(L + PL_GC); LAS float* AB = (LAS float*)(L + PL_AB);
    for (int item = F.vcu; item < BATCH * NH * (SEQ / CL); item += F.G) {
        int lane = F.lane; asm volatile("" : "+v"(lane));
        const int l31 = lane & 31, hh = lane >> 5;
        const int b = item >> 7, h = (item >> 5) & 3, n = item & 31, m0 = b * SEQ + n * CL, t0 = n * CL;
        unsigned char* img = F.ws + WS_IMG + (size_t)item * IMG_BYTES; unsigned char* Wimg = img + IMG_W; unsigned char* Qimg = img + IMG_Q; unsigned char* KTimg = img + IMG_KT; unsigned char* QKimg = img + IMG_QK;
        unsigned char* UT = F.ws + WS_UT + (size_t)item * 16384;
        float gc = BG[(size_t)(m0 + lane) * 8 + 4 + h]; const float btl = BG[(size_t)(m0 + lane) * 8 + h];
#pragma unroll
        for (int o = 1; o < 64; o <<= 1) { const float t = __shfl_up(gc, o); if (lane >= o) gc += t; }
        const float glast = __shfl(gc, 63);
        if (w == 0) { GC[lane] = gc; if (lane == 0) ((float*)(F.ws + WS_CD))[item] = __expf(glast); }
        unsigned xq[11], xk[11], xv[11];
#pragma unroll
        for (int r = 0; r < 11; ++r) { const int tok = 8 * w - 3 + r; xq[r] = 0u; xk[r] = 0u; xv[r] = 0u;
            if (t0 + tok >= 0) { const bf16* base = P + (size_t)(m0 + tok) * NIN_G + h * HD + 2 * lane; xq[r] = *(const unsigned*)(base + PC_Q); xk[r] = *(const unsigned*)(base + PC_K); xv[r] = *(const unsigned*)(base + PC_V); } }
        f32x2 wq[4], wk[4], wvv[4];
#pragma unroll
        for (int j = 0; j < 4; ++j) { const float* cj = cw + j * (3 * GW) + h * HD + 2 * lane; wq[j] = *(const f32x2*)cj; wk[j] = *(const f32x2*)(cj + GW); wvv[j] = *(const f32x2*)(cj + 2 * GW); }
        float kbg0[8], kbg1[8], vb0[8], vb1[8], kd0[8], kd1[8];
#pragma unroll
        for (int i = 0; i < 8; ++i) {
            float q0 = 0.f, q1 = 0.f, k0 = 0.f, k1 = 0.f, v0 = 0.f, v1 = 0.f;
#pragma unroll
            for (int j = 0; j < 4; ++j) { q0 += wq[j].x * bf_lo(xq[i + j]); q1 += wq[j].y * bf_hi(xq[i + j]); k0 += wk[j].x * bf_lo(xk[i + j]); k1 += wk[j].y * bf_hi(xk[i + j]);
                v0 += wvv[j].x * bf_lo(xv[i + j]); v1 += wvv[j].y * bf_hi(xv[i + j]); }
            q0 = siluf_(q0); q1 = siluf_(q1); k0 = siluf_(k0); k1 = siluf_(k1); v0 = siluf_(v0); v1 = siluf_(v1);
            const float rq = 0.08838834764831845f * rsqrtf_(wave_sum(q0 * q0 + q1 * q1) + EPS), rk = rsqrtf_(wave_sum(k0 * k0 + k1 * k1) + EPS);
            q0 *= rq; q1 *= rq; k0 *= rk; k1 *= rk;
            const int tok = 8 * w + i;
            const float gci = __shfl(gc, tok), bti = __shfl(btl, tok), eg = __expf(gci), egl = __expf(glast - gci);
            *(LAS unsigned*)(L + PL_KR + tok * RP + 4 * lane) = cvtpk(k0, k1);
            *(LAS unsigned*)(L + PL_KBR + tok * RP + 4 * lane) = cvtpk(k0 * bti, k1 * bti);
            *(LAS unsigned*)(L + PL_QR + tok * RP + 4 * lane) = cvtpk(q0, q1);
            *(unsigned*)(Qimg + tok * RP + perm16(2 * lane) * 2) = cvtpk(q0 * eg, q1 * eg);
            kbg0[i] = -k0 * bti * eg; kbg1[i] = -k1 * bti * eg; vb0[i] = v0 * bti; vb1[i] = v1 * bti; kd0[i] = k0 * egl; kd1[i] = k1 * egl;
        }
        { const int c0 = 2 * lane, c1 = 2 * lane + 1;
          *(LAS bf16x8*)(L + PL_KBGT + c0 * TP + 16 * w) = pack8(kbg0[0], kbg0[1], kbg0[2], kbg0[3], kbg0[4], kbg0[5], kbg0[6], kbg0[7]);
          *(LAS bf16x8*)(L + PL_KBGT + c1 * TP + 16 * w) = pack8(kbg1[0], kbg1[1], kbg1[2], kbg1[3], kbg1[4], kbg1[5], kbg1[6], kbg1[7]);
          *(LAS bf16x8*)(L + PL_VBT + c0 * TP + 16 * w) = pack8(vb0[0], vb0[1], vb0[2], vb0[3], vb0[4], vb0[5], vb0[6], vb0[7]);
          *(LAS bf16x8*)(L + PL_VBT + c1 * TP + 16 * w) = pack8(vb1[0], vb1[1], vb1[2], vb1[3], vb1[4], vb1[5], vb1[6], vb1[7]);
          const int pb = 32 * (w >> 1) + 8 * (w & 1);
          { u32x2 a, bq; a.x = cvtpk(kd0[0], kd0[1]); a.y = cvtpk(kd0[2], kd0[3]); bq.x = cvtpk(kd0[4], kd0[5]); bq.y = cvtpk(kd0[6], kd0[7]);
            *(u32x2*)(KTimg + c0 * TP + pb) = a; *(u32x2*)(KTimg + c0 * TP + pb + 16) = bq; }
          { u32x2 a, bq; a.x = cvtpk(kd1[0], kd1[1]); a.y = cvtpk(kd1[2], kd1[3]); bq.x = cvtpk(kd1[4], kd1[5]); bq.y = cvtpk(kd1[6], kd1[7]);
            *(u32x2*)(KTimg + c1 * TP + pb) = a; *(u32x2*)(KTimg + c1 * TP + pb + 16) = bq; } }
        __syncthreads();
        { const int tc = (w >> 1) & 1, te = w & 1; const bool isqk = w >= 4;
          f32x16 acc;
#pragma unroll
          for (int r = 0; r < 16; ++r) acc[r] = 0.f;
          if (!(tc == 0 && te == 1)) {
              const LAS unsigned char* ap = L + PL_KR + (32 * te + l31) * RP + hh * 16; const LAS unsigned char* bp = L + (isqk ? PL_QR : PL_KBR) + (32 * tc + l31) * RP + hh * 16;
#pragma unroll
              for (int s = 0; s < 8; ++s) acc = MFMA32(*(const LAS bf16x8*)(ap + 32 * s), *(const LAS bf16x8*)(bp + 32 * s), acc);
          }
          const int c = 32 * tc + l31; const float gcc = GC[c];
#pragma unroll
          for (int g = 0; g < 4; ++g) { float v[4];
#pragma unroll
              for (int i = 0; i < 4; ++i) { const int e = 32 * te + 8 * g + 4 * hh + i; const bool keep = isqk ? (c >= e) : (c > e); const float dv_ = acc[4 * g + i] * __expf(fminf(gcc - GC[e], 0.f)); v[i] = keep ? dv_ : 0.f; }
              if (isqk) { u32x2 o; o.x = cvtpk(v[0], v[1]); o.y = cvtpk(v[2], v[3]);
                  *(u32x2*)(QKimg + c * TP + (32 * te + 16 * (g >> 1) + 8 * hh + 4 * (g & 1)) * 2) = o; }
              else {
#pragma unroll
                  for (int i = 0; i < 4; ++i) AB[(32 * te + 8 * g + 4 * hh + i) * 64 + c] = v[i]; } } }
        __syncthreads();
        if (w == 0) {
            float T[64];
#pragma unroll
            for (int i = 0; i < 64; ++i) T[i] = (lane == i) ? 1.f : 0.f;
            f32x4 a0, a1, a2, a3, a4, a5, a6, a7;
            a0 = *(const LAS f32x4*)(AB + 0);
            a1 = *(const LAS f32x4*)(AB + 4);
            a2 = *(const LAS f32x4*)(AB + 8);
            a3 = *(const LAS f32x4*)(AB + 12);
            a4 = *(const LAS f32x4*)(AB + 16);
            a5 = *(const LAS f32x4*)(AB + 20);
            a6 = *(const LAS f32x4*)(AB + 24);
            a7 = *(const LAS f32x4*)(AB + 28);
            asm volatile("" ::: "memory"); T[1] -= a0.y * T[0]; T[2] -= a0.z * T[0]; T[3] -= a0.w * T[0]; a0 = *(const LAS f32x4*)(AB + 32);
            asm volatile("" ::: "memory"); T[4] -= a1.x * T[0]; T[5] -= a1.y * T[0]; T[6] -= a1.z * T[0]; T[7] -= a1.w * T[0]; a1 = *(const LAS f32x4*)(AB + 36);
            asm volatile("" ::: "memory"); T[8] -= a2.x * T[0]; T[9] -= a2.y * T[0]; T[10] -= a2.z * T[0]; T[11] -= a2.w * T[0]; a2 = *(const LAS f32x4*)(AB + 40);
            asm volatile("" ::: "memory"); T[12] -= a3.x * T[0]; T[13] -= a3.y * T[0]; T[14] -= a3.z * T[0]; T[15] -= a3.w * T[0]; a3 = *(const LAS f32x4*)(AB + 44);
            asm volatile("" ::: "memory"); T[16] -= a4.x * T[0]; T[17] -= a4.y * T[0]; T[18] -= a4.z * T[0]; T[19] -= a4.w * T[0]; a4 = *(const LAS f32x4*)(AB + 48);
            asm volatile("" ::: "memory"); T[20] -= a5.x * T[0]; T[21] -= a5.y * T[0]; T[22] -= a5.z * T[0]; T[23] -= a5.w * T[0]; a5 = *(const LAS f32x4*)(AB + 52);
            asm volatile("" ::: "memory"); T[24] -= a6.x * T[0]; T[25] -= a6.y * T[0]; T[26] -= a6.z * T[0]; T[27] -= a6.w * T[0]; a6 = *(const LAS f32x4*)(AB + 56);
            asm volatile("" ::: "memory"); T[28] -= a7.x * T[0]; T[29] -= a7.y * T[0]; T[30] -= a7.z * T[0]; T[31] -= a7.w * T[0]; a7 = *(const LAS f32x4*)(AB + 60);
            asm volatile("" ::: "memory"); T[32] -= a0.x * T[0]; T[33] -= a0.y * T[0]; T[34] -= a0.z * T[0]; T[35] -= a0.w * T[0]; a0 = *(const LAS f32x4*)(AB + 64);
            asm volatile("" ::: "memory"); T[36] -= a1.x * T[0]; T[37] -= a1.y * T[0]; T[38] -= a1.z * T[0]; T[39] -= a1.w * T[0]; a1 = *(const LAS f32x4*)(AB + 68);
            asm volatile("" ::: "memory"); T[40] -= a2.x * T[0]; T[41] -= a2.y * T[0]; T[42] -= a2.z * T[0]; T[43] -= a2.w * T[0]; a2 = *(const LAS f32x4*)(AB + 72);
            asm volatile("" ::: "memory"); T[44] -= a3.x * T[0]; T[45] -= a3.y * T[0]; T[46] -= a3.z * T[0]; T[47] -= a3.w * T[0]; a3 = *(const LAS f32x4*)(AB + 76);
            asm volatile("" ::: "memory"); T[48] -= a4.x * T[0]; T[49] -= a4.y * T[0]; T[50] -= a4.z * T[0]; T[51] -= a4.w * T[0]; a4 = *(const LAS f32x4*)(AB + 80);
            asm volatile("" ::: "memory"); T[52] -= a5.x * T[0]; T[53] -= a5.y * T[0]; T[54] -= a5.z * T[0]; T[55] -= a5.w * T[0]; a5 = *(const LAS f32x4*)(AB + 84);
            asm volatile("" ::: "memory"); T[56] -= a6.x * T[0]; T[57] -= a6.y * T[0]; T[58] -= a6.z * T[0]; T[59] -= a6.w * T[0]; a6 = *(const LAS f32x4*)(AB + 88);
            asm volatile("" ::: "memory"); T[60] -= a7.x * T[0]; T[61] -= a7.y * T[0]; T[62] -= a7.z * T[0]; T[63] -= a7.w * T[0]; a7 = *(const LAS f32x4*)(AB + 92);
            asm volatile("" ::: "memory"); T[2] -= a0.z * T[1]; T[3] -= a0.w * T[1]; a0 = *(const LAS f32x4*)(AB + 96);
            asm volatile("" ::: "memory"); T[4] -= a1.x * T[1]; T[5] -= a1.y * T[1]; T[6] -= a1.z * T[1]; T[7] -= a1.w * T[1]; a1 = *(const LAS f32x4*)(AB + 100);
            asm volatile("" ::: "memory"); T[8] -= a2.x * T[1]; T[9] -= a2.y * T[1]; T[10] -= a2.z * T[1]; T[11] -= a2.w * T[1]; a2 = *(const LAS f32x4*)(AB + 104);
            asm volatile("" ::: "memory"); T[12] -= a3.x * T[1]; T[13] -= a3.y * T[1]; T[14] -= a3.z * T[1]; T[15] -= a3.w * T[1]; a3 = *(const LAS f32x4*)(AB + 108);
            asm volatile("" ::: "memory"); T[16] -= a4.x * T[1]; T[17] -= a4.y * T[1]; T[18] -= a4.z * T[1]; T[19] -= a4.w * T[1]; a4 = *(const LAS f32x4*)(AB + 112);
            asm volatile("" ::: "memory"); T[20] -= a5.x * T[1]; T[21] -= a5.y * T[1]; T[22] -= a5.z * T[1]; T[23] -= a5.w * T[1]; a5 = *(const LAS f32x4*)(AB + 116);
            asm volatile("" ::: "memory"); T[24] -= a6.x * T[1]; T[25] -= a6.y * T[1]; T[26] -= a6.z * T[1]; T[27] -= a6.w * T[1]; a6 = *(const LAS f32x4*)(AB + 120);
            asm volatile("" ::: "memory"); T[28] -= a7.x * T[1]; T[29] -= a7.y * T[1]; T[30] -= a7.z * T[1]; T[31] -= a7.w * T[1]; a7 = *(const LAS f32x4*)(AB + 124);
            asm volatile("" ::: "memory"); T[32] -= a0.x * T[1]; T[33] -= a0.y * T[1]; T[34] -= a0.z * T[1]; T[35] -= a0.w * T[1]; a0 = *(const LAS f32x4*)(AB + 128);
            asm volatile("" ::: "memory"); T[36] -= a1.x * T[1]; T[37] -= a1.y * T[1]; T[38] -= a1.z * T[1]; T[39] -= a1.w * T[1]; a1 = *(const LAS f32x4*)(AB + 132);
            asm volatile("" ::: "memory"); T[40] -= a2.x * T[1]; T[41] -= a2.y * T[1]; T[42] -= a2.z * T[1]; T[43] -= a2.w * T[1]; a2 = *(const LAS f32x4*)(AB + 136);
            asm volatile("" ::: "memory"); T[44] -= a3.x * T[1]; T[45] -= a3.y * T[1]; T[46] -= a3.z * T[1]; T[47] -= a3.w * T[1]; a3 = *(const LAS f32x4*)(AB + 140);
            asm volatile("" ::: "memory"); T[48] -= a4.x * T[1]; T[49] -= a4.y * T[1]; T[50] -= a4.z * T[1]; T[51] -= a4.w * T[1]; a4 = *(const LAS f32x4*)(AB + 144);
            asm volatile("" ::: "memory"); T[52] -= a5.x * T[1]; T[53] -= a5.y * T[1]; T[54] -= a5.z * T[1]; T[55] -= a5.w * T[1]; a5 = *(const LAS f32x4*)(AB + 148);
            asm volatile("" ::: "memory"); T[56] -= a6.x * T[1]; T[57] -= a6.y * T[1]; T[58] -= a6.z * T[1]; T[59] -= a6.w * T[1]; a6 = *(const LAS f32x4*)(AB + 152);
            asm volatile("" ::: "memory"); T[60] -= a7.x * T[1]; T[61] -= a7.y * T[1]; T[62] -= a7.z * T[1]; T[63] -= a7.w * T[1]; a7 = *(const LAS f32x4*)(AB + 156);
            asm volatile("" ::: "memory"); T[3] -= a0.w * T[2]; a0 = *(const LAS f32x4*)(AB + 160);
            asm volatile("" ::: "memory"); T[4] -= a1.x * T[2]; T[5] -= a1.y * T[2]; T[6] -= a1.z * T[2]; T[7] -= a1.w * T[2]; a1 = *(const LAS f32x4*)(AB + 164);
            asm volatile("" ::: "memory"); T[8] -= a2.x * T[2]; T[9] -= a2.y * T[2]; T[10] -= a2.z * T[2]; T[11] -= a2.w * T[2]; a2 = *(const LAS f32x4*)(AB + 168);
            asm volatile("" ::: "memory"); T[12] -= a3.x * T[2]; T[13] -= a3.y * T[2]; T[14] -= a3.z * T[2]; T[15] -= a3.w * T[2]; a3 = *(const LAS f32x4*)(AB + 172);
            asm volatile("" ::: "memory"); T[16] -= a4.x * T[2]; T[17] -= a4.y * T[2]; T[18] -= a4.z * T[2]; T[19] -= a4.w * T[2]; a4 = *(const LAS f32x4*)(AB + 176);
            asm volatile("" ::: "memory"); T[20] -= a5.x * T[2]; T[21] -= a5.y * T[2]; T[22] -= a5.z * T[2]; T[23] -= a5.w * T[2]; a5 = *(const LAS f32x4*)(AB + 180);
            asm volatile("" ::: "memory"); T[24] -= a6.x * T[2]; T[25] -= a6.y * T[2]; T[26] -= a6.z * T[2]; T[27] -= a6.w * T[2]; a6 = *(const LAS f32x4*)(AB + 184);
            asm volatile("" ::: "memory"); T[28] -= a7.x * T[2]; T[29] -= a7.y * T[2]; T[30] -= a7.z * T[2]; T[31] -= a7.w * T[2]; a7 = *(const LAS f32x4*)(AB + 188);
            asm volatile("" ::: "memory"); T[32] -= a0.x * T[2]; T[33] -= a0.y * T[2]; T[34] -= a0.z * T[2]; T[35] -= a0.w * T[2]; a0 = *(const LAS f32x4*)(AB + 196);
            asm volatile("" ::: "memory"); T[36] -= a1.x * T[2]; T[37] -= a1.y * T[2]; T[38] -= a1.z * T[2]; T[39] -= a1.w * T[2]; a1 = *(const LAS f32x4*)(AB + 200);
            asm volatile("" ::: "memory"); T[40] -= a2.x * T[2]; T[41] -= a2.y * T[2]; T[42] -= a2.z * T[2]; T[43] -= a2.w * T[2]; a2 = *(const LAS f32x4*)(AB + 204);
            asm volatile("" ::: "memory"); T[44] -= a3.x * T[2]; T[45] -= a3.y * T[2]; T[46] -= a3.z * T[2]; T[47] -= a3.w * T[2]; a3 = *(const LAS f32x4*)(AB + 208);
            asm volatile("" ::: "memory"); T[48] -= a4.x * T[2]; T[49] -= a4.y * T[2]; T[50] -= a4.z * T[2]; T[51] -= a4.w * T[2]; a4 = *(const LAS f32x4*)(AB + 212);
            asm volatile("" ::: "memory"); T[52] -= a5.x * T[2]; T[53] -= a5.y * T[2]; T[54] -= a5.z * T[2]; T[55] -= a5.w * T[2]; a5 = *(const LAS f32x4*)(AB + 216);
            asm volatile("" ::: "memory"); T[56] -= a6.x * T[2]; T[57] -= a6.y * T[2]; T[58] -= a6.z * T[2]; T[59] -= a6.w * T[2]; a6 = *(const LAS f32x4*)(AB + 220);
            asm volatile("" ::: "memory"); T[60] -= a7.x * T[2]; T[61] -= a7.y * T[2]; T[62] -= a7.z * T[2]; T[63] -= a7.w * T[2]; a7 = *(const LAS f32x4*)(AB + 224);
            asm volatile("" ::: "memory"); T[4] -= a0.x * T[3]; T[5] -= a0.y * T[3]; T[6] -= a0.z * T[3]; T[7] -= a0.w * T[3]; a0 = *(const LAS f32x4*)(AB + 228);
            asm volatile("" ::: "memory"); T[8] -= a1.x * T[3]; T[9] -= a1.y * T[3]; T[10] -= a1.z * T[3]; T[11] -= a1.w * T[3]; a1 = *(const LAS f32x4*)(AB + 232);
            asm volatile("" ::: "memory"); T[12] -= a2.x * T[3]; T[13] -= a2.y * T[3]; T[14] -= a2.z * T[3]; T[15] -= a2.w * T[3]; a2 = *(const LAS f32x4*)(AB + 236);
            asm volatile("" ::: "memory"); T[16] -= a3.x * T[3]; T[17] -= a3.y * T[3]; T[18] -= a3.z * T[3]; T[19] -= a3.w * T[3]; a3 = *(const LAS f32x4*)(AB + 240);
            asm volatile("" ::: "memory"); T[20] -= a4.x * T[3]; T[21] -= a4.y * T[3]; T[22] -= a4.z * T[3]; T[23] -= a4.w * T[3]; a4 = *(const LAS f32x4*)(AB + 244);
            asm volatile("" ::: "memory"); T[24] -= a5.x * T[3]; T[25] -= a5.y * T[3]; T[26] -= a5.z * T[3]; T[27] -= a5.w * T[3]; a5 = *(const LAS f32x4*)(AB + 248);
            asm volatile("" ::: "memory"); T[28] -= a6.x * T[3]; T[29] -= a6.y * T[3]; T[30] -= a6.z * T[3]; T[31] -= a6.w * T[3]; a6 = *(const LAS f32x4*)(AB + 252);
            asm volatile("" ::: "memory"); T[32] -= a7.x * T[3]; T[33] -= a7.y * T[3]; T[34] -= a7.z * T[3]; T[35] -= a7.w * T[3]; a7 = *(const LAS f32x4*)(AB + 260);
            asm volatile("" ::: "memory"); T[36] -= a0.x * T[3]; T[37] -= a0.y * T[3]; T[38] -= a0.z * T[3]; T[39] -= a0.w * T[3]; a0 = *(const LAS f32x4*)(AB + 264);
            asm volatile("" ::: "memory"); T[40] -= a1.x * T[3]; T[41] -= a1.y * T[3]; T[42] -= a1.z * T[3]; T[43] -= a1.w * T[3]; a1 = *(const LAS f32x4*)(AB + 268);
            asm volatile("" ::: "memory"); T[44] -= a2.x * T[3]; T[45] -= a2.y * T[3]; T[46] -= a2.z * T[3]; T[47] -= a2.w * T[3]; a2 = *(const LAS f32x4*)(AB + 272);
            asm volatile("" ::: "memory"); T[48] -= a3.x * T[3]; T[49] -= a3.y * T[3]; T[50] -= a3.z * T[3]; T[51] -= a3.w * T[3]; a3 = *(const LAS f32x4*)(AB + 276);
            asm volatile("" ::: "memory"); T[52] -= a4.x * T[3]; T[53] -= a4.y * T[3]; T[54] -= a4.z * T[3]; T[55] -= a4.w * T[3]; a4 = *(const LAS f32x4*)(AB + 280);
            asm volatile("" ::: "memory"); T[56] -= a5.x * T[3]; T[57] -= a5.y * T[3]; T[58] -= a5.z * T[3]; T[59] -= a5.w * T[3]; a5 = *(const LAS f32x4*)(AB + 284);
            asm volatile("" ::: "memory"); T[60] -= a6.x * T[3]; T[61] -= a6.y * T[3]; T[62] -= a6.z * T[3]; T[63] -= a6.w * T[3]; a6 = *(const LAS f32x4*)(AB + 288);
            asm volatile("" ::: "memory"); T[5] -= a7.y * T[4]; T[6] -= a7.z * T[4]; T[7] -= a7.w * T[4]; a7 = *(const LAS f32x4*)(AB + 292);
            asm volatile("" ::: "memory"); T[8] -= a0.x * T[4]; T[9] -= a0.y * T[4]; T[10] -= a0.z * T[4]; T[11] -= a0.w * T[4]; a0 = *(const LAS f32x4*)(AB + 296);
            asm volatile("" ::: "memory"); T[12] -= a1.x * T[4]; T[13] -= a1.y * T[4]; T[14] -= a1.z * T[4]; T[15] -= a1.w * T[4]; a1 = *(const LAS f32x4*)(AB + 300);
            asm volatile("" ::: "memory"); T[16] -= a2.x * T[4]; T[17] -= a2.y * T[4]; T[18] -= a2.z * T[4]; T[19] -= a2.w * T[4]; a2 = *(const LAS f32x4*)(AB + 304);
            asm volatile("" ::: "memory"); T[20] -= a3.x * T[4]; T[21] -= a3.y * T[4]; T[22] -= a3.z * T[4]; T[23] -= a3.w * T[4]; a3 = *(const LAS f32x4*)(AB + 308);
            asm volatile("" ::: "memory"); T[24] -= a4.x * T[4]; T[25] -= a4.y * T[4]; T[26] -= a4.z * T[4]; T[27] -= a4.w * T[4]; a4 = *(const LAS f32x4*)(AB + 312);
            asm volatile("" ::: "memory"); T[28] -= a5.x * T[4]; T[29] -= a5.y * T[4]; T[30] -= a5.z * T[4]; T[31] -= a5.w * T[4]; a5 = *(const LAS f32x4*)(AB + 316);
            asm volatile("" ::: "memory"); T[32] -= a6.x * T[4]; T[33] -= a6.y * T[4]; T[34] -= a6.z * T[4]; T[35] -= a6.w * T[4]; a6 = *(const LAS f32x4*)(AB + 324);
            asm volatile("" ::: "memory"); T[36] -= a7.x * T[4]; T[37] -= a7.y * T[4]; T[38] -= a7.z * T[4]; T[39] -= a7.w * T[4]; a7 = *(const LAS f32x4*)(AB + 328);
            asm volatile("" ::: "memory"); T[40] -= a0.x * T[4]; T[41] -= a0.y * T[4]; T[42] -= a0.z * T[4]; T[43] -= a0.w * T[4]; a0 = *(const LAS f32x4*)(AB + 332);
            asm volatile("" ::: "memory"); T[44] -= a1.x * T[4]; T[45] -= a1.y * T[4]; T[46] -= a1.z * T[4]; T[47] -= a1.w * T[4]; a1 = *(const LAS f32x4*)(AB + 336);
            asm volatile("" ::: "memory"); T[48] -= a2.x * T[4]; T[49] -= a2.y * T[4]; T[50] -= a2.z * T[4]; T[51] -= a2.w * T[4]; a2 = *(const LAS f32x4*)(AB + 340);
            asm volatile("" ::: "memory"); T[52] -= a3.x * T[4]; T[53] -= a3.y * T[4]; T[54] -= a3.z * T[4]; T[55] -= a3.w * T[4]; a3 = *(const LAS f32x4*)(AB + 344);
            asm volatile("" ::: "memory"); T[56] -= a4.x * T[4]; T[57] -= a4.y * T[4]; T[58] -= a4.z * T[4]; T[59] -= a4.w * T[4]; a4 = *(const LAS f32x4*)(AB + 348);
            asm volatile("" ::: "memory"); T[60] -= a5.x * T[4]; T[61] -= a5.y * T[4]; T[62] -= a5.z * T[4]; T[63] -= a5.w * T[4]; a5 = *(const LAS f32x4*)(AB + 352);
            asm volatile("" ::: "memory"); T[6] -= a6.z * T[5]; T[7] -= a6.w * T[5]; a6 = *(const LAS f32x4*)(AB + 356);
            asm volatile("" ::: "memory"); T[8] -= a7.x * T[5]; T[9] -= a7.y * T[5]; T[10] -= a7.z * T[5]; T[11] -= a7.w * T[5]; a7 = *(const LAS f32x4*)(AB + 360);
            asm volatile("" ::: "memory"); T[12] -= a0.x * T[5]; T[13] -= a0.y * T[5]; T[14] -= a0.z * T[5]; T[15] -= a0.w * T[5]; a0 = *(const LAS f32x4*)(AB + 364);
            asm volatile("" ::: "memory"); T[16] -= a1.x * T[5]; T[17] -= a1.y * T[5]; T[18] -= a1.z * T[5]; T[19] -= a1.w * T[5]; a1 = *(const LAS f32x4*)(AB + 368);
            asm volatile("" ::: "memory"); T[20] -= a2.x * T[5]; T[21] -= a2.y * T[5]; T[22] -= a2.z * T[5]; T[23] -= a2.w * T[5]; a2 = *(const LAS f32x4*)(AB + 372);
            asm volatile("" ::: "memory"); T[24] -= a3.x * T[5]; T[25] -= a3.y * T[5]; T[26] -= a3.z * T[5]; T[27] -= a3.w * T[5]; a3 = *(const LAS f32x4*)(AB + 376);
            asm volatile("" ::: "memory"); T[28] -= a4.x * T[5]; T[29] -= a4.y * T[5]; T[30] -= a4.z * T[5]; T[31] -= a4.w * T[5]; a4 = *(const LAS f32x4*)(AB + 380);
            asm volatile("" ::: "memory"); T[32] -= a5.x * T[5]; T[33] -= a5.y * T[5]; T[34] -= a5.z * T[5]; T[35] -= a5.w * T[5]; a5 = *(const LAS f32x4*)(AB + 388);
            asm volatile("" ::: "memory"); T[36] -= a6.x * T[5]; T[37] -= a6.y * T[5]; T[38] -= a6.z * T[5]; T[39] -= a6.w * T[5]; a6 = *(const LAS f32x4*)(AB + 392);
            asm volatile("" ::: "memory"); T[40] -= a7.x * T[5]; T[41] -= a7.y * T[5]; T[42] -= a7.z * T[5]; T[43] -= a7.w * T[5]; a7 = *(const LAS f32x4*)(AB + 396);
            asm volatile("" ::: "memory"); T[44] -= a0.x * T[5]; T[45] -= a0.y * T[5]; T[46] -= a0.z * T[5]; T[47] -= a0.w * T[5]; a0 = *(const LAS f32x4*)(AB + 400);
            asm volatile("" ::: "memory"); T[48] -= a1.x * T[5]; T[49] -= a1.y * T[5]; T[50] -= a1.z * T[5]; T[51] -= a1.w * T[5]; a1 = *(const LAS f32x4*)(AB + 404);
            asm volatile("" ::: "memory"); T[52] -= a2.x * T[5]; T[53] -= a2.y * T[5]; T[54] -= a2.z * T[5]; T[55] -= a2.w * T[5]; a2 = *(const LAS f32x4*)(AB + 408);
            asm volatile("" ::: "memory"); T[56] -= a3.x * T[5]; T[57] -= a3.y * T[5]; T[58] -= a3.z * T[5]; T[59] -= a3.w * T[5]; a3 = *(const LAS f32x4*)(AB + 412);
            asm volatile("" ::: "memory"); T[60] -= a4.x * T[5]; T[61] -= a4.y * T[5]; T[62] -= a4.z * T[5]; T[63] -= a4.w * T[5]; a4 = *(const LAS f32x4*)(AB + 416);
            asm volatile("" ::: "memory"); T[7] -= a5.w * T[6]; a5 = *(const LAS f32x4*)(AB + 420);
            asm volatile("" ::: "memory"); T[8] -= a6.x * T[6]; T[9] -= a6.y * T[6]; T[10] -= a6.z * T[6]; T[11] -= a6.w * T[6]; a6 = *(const LAS f32x4*)(AB + 424);
            asm volatile("" ::: "memory"); T[12] -= a7.x * T[6]; T[13] -= a7.y * T[6]; T[14] -= a7.z * T[6]; T[15] -= a7.w * T[6]; a7 = *(const LAS f32x4*)(AB + 428);
            asm volatile("" ::: "memory"); T[16] -= a0.x * T[6]; T[17] -= a0.y * T[6]; T[18] -= a0.z * T[6]; T[19] -= a0.w * T[6]; a0 = *(const LAS f32x4*)(AB + 432);
            asm volatile("" ::: "memory"); T[20] -= a1.x * T[6]; T[21] -= a1.y * T[6]; T[22] -= a1.z * T[6]; T[23] -= a1.w * T[6]; a1 = *(const LAS f32x4*)(AB + 436);
            asm volatile("" ::: "memory"); T[24] -= a2.x * T[6]; T[25] -= a2.y * T[6]; T[26] -= a2.z * T[6]; T[27] -= a2.w * T[6]; a2 = *(const LAS f32x4*)(AB + 440);
            asm volatile("" ::: "memory"); T[28] -= a3.x * T[6]; T[29] -= a3.y * T[6]; T[30] -= a3.z * T[6]; T[31] -= a3.w * T[6]; a3 = *(const LAS f32x4*)(AB + 444);
            asm volatile("" ::: "memory"); T[32] -= a4.x * T[6]; T[33] -= a4.y * T[6]; T[34] -= a4.z * T[6]; T[35] -= a4.w * T[6]; a4 = *(const LAS f32x4*)(AB + 456);
            asm volatile("" ::: "memory"); T[36] -= a5.x * T[6]; T[37] -= a5.y * T[6]; T[38] -= a5.z * T[6]; T[39] -= a5.w * T[6]; a5 = *(const LAS f32x4*)(AB + 460);
            asm volatile("" ::: "memory"); T[40] -= a6.x * T[6]; T[41] -= a6.y * T[6]; T[42] -= a6.z * T[6]; T[43] -= a6.w * T[6]; a6 = *(const LAS f32x4*)(AB + 464);
            asm volatile("" ::: "memory"); T[44] -= a7.x * T[6]; T[45] -= a7.y * T[6]; T[46] -= a7.z * T[6]; T[47] -= a7.w * T[6]; a7 = *(const LAS f32x4*)(AB + 468);
            asm volatile("" ::: "memory"); T[48] -= a0.x * T[6]; T[49] -= a0.y * T[6]; T[50] -= a0.z * T[6]; T[51] -= a0.w * T[6]; a0 = *(const LAS f32x4*)(AB + 472);
            asm volatile("" ::: "memory"); T[52] -= a1.x * T[6]; T[53] -= a1.y * T[6]; T[54] -= a1.z * T[6]; T[55] -= a1.w * T[6]; a1 = *(const LAS f32x4*)(AB + 476);
            asm volatile("" ::: "memory"); T[56] -= a2.x * T[6]; T[57] -= a2.y * T[6]; T[58] -= a2.z * T[6]; T[59] -= a2.w * T[6]; a2 = *(const LAS f32x4*)(AB + 480);
            asm volatile("" ::: "memory"); T[60] -= a3.x * T[6]; T[61] -= a3.y * T[6]; T[62] -= a3.z * T[6]; T[63] -= a3.w * T[6]; a3 = *(const LAS f32x4*)(AB + 484);
            asm volatile("" ::: "memory"); T[8] -= a4.x * T[7]; T[9] -= a4.y * T[7]; T[10] -= a4.z * T[7]; T[11] -= a4.w * T[7]; a4 = *(const LAS f32x4*)(AB + 488);
            asm volatile("" ::: "memory"); T[12] -= a5.x * T[7]; T[13] -= a5.y * T[7]; T[14] -= a5.z * T[7]; T[15] -= a5.w * T[7]; a5 = *(const LAS f32x4*)(AB + 492);
            asm volatile("" ::: "memory"); T[16] -= a6.x * T[7]; T[17] -= a6.y * T[7]; T[18] -= a6.z * T[7]; T[19] -= a6.w * T[7]; a6 = *(const LAS f32x4*)(AB + 496);
            asm volatile("" ::: "memory"); T[20] -= a7.x * T[7]; T[21] -= a7.y * T[7]; T[22] -= a7.z * T[7]; T[23] -= a7.w * T[7]; a7 = *(const LAS f32x4*)(AB + 500);
            asm volatile("" ::: "memory"); T[24] -= a0.x * T[7]; T[25] -= a0.y * T[7]; T[26] -= a0.z * T[7]; T[27] -= a0.w * T[7]; a0 = *(const LAS f32x4*)(AB + 504);
            asm volatile("" ::: "memory"); T[28] -= a1.x * T[7]; T[29] -= a1.y * T[7]; T[30] -= a1.z * T[7]; T[31] -= a1.w * T[7]; a1 = *(const LAS f32x4*)(AB + 508);
            asm volatile("" ::: "memory"); T[32] -= a2.x * T[7]; T[33] -= a2.y * T[7]; T[34] -= a2.z * T[7]; T[35] -= a2.w * T[7]; a2 = *(const LAS f32x4*)(AB + 520);
            asm volatile("" ::: "memory"); T[36] -= a3.x * T[7]; T[37] -= a3.y * T[7]; T[38] -= a3.z * T[7]; T[39] -= a3.w * T[7]; a3 = *(const LAS f32x4*)(AB + 524);
            asm volatile("" ::: "memory"); T[40] -= a4.x * T[7]; T[41] -= a4.y * T[7]; T[42] -= a4.z * T[7]; T[43] -= a4.w * T[7]; a4 = *(const LAS f32x4*)(AB + 528);
            asm volatile("" ::: "memory"); T[44] -= a5.x * T[7]; T[45] -= a5.y * T[7]; T[46] -= a5.z * T[7]; T[47] -= a5.w * T[7]; a5 = *(const LAS f32x4*)(AB + 532);
            asm volatile("" ::: "memory"); T[48] -= a6.x * T[7]; T[49] -= a6.y * T[7]; T[50] -= a6.z * T[7]; T[51] -= a6.w * T[7]; a6 = *(const LAS f32x4*)(AB + 536);
            asm volatile("" ::: "memory"); T[52] -= a7.x * T[7]; T[53] -= a7.y * T[7]; T[54] -= a7.z * T[7]; T[55] -= a7.w * T[7]; a7 = *(const LAS f32x4*)(AB + 540);
            asm volatile("" ::: "memory"); T[56] -= a0.x * T[7]; T[57] -= a0.y * T[7]; T[58] -= a0.z * T[7]; T[59] -= a0.w * T[7]; a0 = *(const LAS f32x4*)(AB + 544);
            asm volatile("" ::: "memory"); T[60] -= a1.x * T[7]; T[61] -= a1.y * T[7]; T[62] -= a1.z * T[7]; T[63] -= a1.w * T[7]; a1 = *(const LAS f32x4*)(AB + 548);
            asm volatile("" ::: "memory"); T[9] -= a2.y * T[8]; T[10] -= a2.z * T[8]; T[11] -= a2.w * T[8]; a2 = *(const LAS f32x4*)(AB + 552);
            asm volatile("" ::: "memory"); T[12] -= a3.x * T[8]; T[13] -= a3.y * T[8]; T[14] -= a3.z * T[8]; T[15] -= a3.w * T[8]; a3 = *(const LAS f32x4*)(AB + 556);
            asm volatile("" ::: "memory"); T[16] -= a4.x * T[8]; T[17] -= a4.y * T[8]; T[18] -= a4.z * T[8]; T[19] -= a4.w * T[8]; a4 = *(const LAS f32x4*)(AB + 560);
            asm volatile("" ::: "memory"); T[20] -= a5.x * T[8]; T[21] -= a5.y * T[8]; T[22] -= a5.z * T[8]; T[23] -= a5.w * T[8]; a5 = *(const LAS f32x4*)(AB + 564);
            asm volatile("" ::: "memory"); T[24] -= a6.x * T[8]; T[25] -= a6.y * T[8]; T[26] -= a6.z * T[8]; T[27] -= a6.w * T[8]; a6 = *(const LAS f32x4*)(AB + 568);
            asm volatile("" ::: "memory"); T[28] -= a7.x * T[8]; T[29] -= a7.y * T[8]; T[30] -= a7.z * T[8]; T[31] -= a7.w * T[8]; a7 = *(const LAS f32x4*)(AB + 572);
            asm volatile("" ::: "memory"); T[32] -= a0.x * T[8]; T[33] -= a0.y * T[8]; T[34] -= a0.z * T[8]; T[35] -= a0.w * T[8]; a0 = *(const LAS f32x4*)(AB + 584);
            asm volatile("" ::: "memory"); T[36] -= a1.x * T[8]; T[37] -= a1.y * T[8]; T[38] -= a1.z * T[8]; T[39] -= a1.w * T[8]; a1 = *(const LAS f32x4*)(AB + 588);
            asm volatile("" ::: "memory"); T[40] -= a2.x * T[8]; T[41] -= a2.y * T[8]; T[42] -= a2.z * T[8]; T[43] -= a2.w * T[8]; a2 = *(const LAS f32x4*)(AB + 592);
            asm volatile("" ::: "memory"); T[44] -= a3.x * T[8]; T[45] -= a3.y * T[8]; T[46] -= a3.z * T[8]; T[47] -= a3.w * T[8]; a3 = *(const LAS f32x4*)(AB + 596);
            asm volatile("" ::: "memory"); T[48] -= a4.x * T[8]; T[49] -= a4.y * T[8]; T[50] -= a4.z * T[8]; T[51] -= a4.w * T[8]; a4 = *(const LAS f32x4*)(AB + 600);
            asm volatile("" ::: "memory"); T[52] -= a5.x * T[8]; T[53] -= a5.y * T[8]; T[54] -= a5.z * T[8]; T[55] -= a5.w * T[8]; a5 = *(const LAS f32x4*)(AB + 604);
            asm volatile("" ::: "memory"); T[56] -= a6.x * T[8]; T[57] -= a6.y * T[8]; T[58] -= a6.z * T[8]; T[59] -= a6.w * T[8]; a6 = *(const LAS f32x4*)(AB + 608);
            asm volatile("" ::: "memory"); T[60] -= a7.x * T[8]; T[61] -= a7.y * T[8]; T[62] -= a7.z * T[8]; T[63] -= a7.w * T[8]; a7 = *(const LAS f32x4*)(AB + 612);
            asm volatile("" ::: "memory"); T[10] -= a0.z * T[9]; T[11] -= a0.w * T[9]; a0 = *(const LAS f32x4*)(AB + 616);
            asm volatile("" ::: "memory"); T[12] -= a1.x * T[9]; T[13] -= a1.y * T[9]; T[14] -= a1.z * T[9]; T[15] -= a1.w * T[9]; a1 = *(const LAS f32x4*)(AB + 620);
            asm volatile("" ::: "memory"); T[16] -= a2.x * T[9]; T[17] -= a2.y * T[9]; T[18] -= a2.z * T[9]; T[19] -= a2.w * T[9]; a2 = *(const LAS f32x4*)(AB + 624);
            asm volatile("" ::: "memory"); T[20] -= a3.x * T[9]; T[21] -= a3.y * T[9]; T[22] -= a3.z * T[9]; T[23] -= a3.w * T[9]; a3 = *(const LAS f32x4*)(AB + 628);
            asm volatile("" ::: "memory"); T[24] -= a4.x * T[9]; T[25] -= a4.y * T[9]; T[26] -= a4.z * T[9]; T[27] -= a4.w * T[9]; a4 = *(const LAS f32x4*)(AB + 632);
            asm volatile("" ::: "memory"); T[28] -= a5.x * T[9]; T[29] -= a5.y * T[9]; T[30] -= a5.z * T[9]; T[31] -= a5.w * T[9]; a5 = *(const LAS f32x4*)(AB + 636);
            asm volatile("" ::: "memory"); T[32] -= a6.x * T[9]; T[33] -= a6.y * T[9]; T[34] -= a6.z * T[9]; T[35] -= a6.w * T[9]; a6 = *(const LAS f32x4*)(AB + 648);
            asm volatile("" ::: "memory"); T[36] -= a7.x * T[9]; T[37] -= a7.y * T[9]; T[38] -= a7.z * T[9]; T[39] -= a7.w * T[9]; a7 = *(const LAS f32x4*)(AB + 652);
            asm volatile("" ::: "memory"); T[40] -= a0.x * T[9]; T[41] -= a0.y * T[9]; T[42] -= a0.z * T[9]; T[43] -= a0.w * T[9]; a0 = *(const LAS f32x4*)(AB + 656);
            asm volatile("" ::: "memory"); T[44] -= a1.x * T[9]; T[45] -= a1.y * T[9]; T[46] -= a1.z * T[9]; T[47] -= a1.w * T[9]; a1 = *(const LAS f32x4*)(AB + 660);
            asm volatile("" ::: "memory"); T[48] -= a2.x * T[9]; T[49] -= a2.y * T[9]; T[50] -= a2.z * T[9]; T[51] -= a2.w * T[9]; a2 = *(const LAS f32x4*)(AB + 664);
            asm volatile("" ::: "memory"); T[52] -= a3.x * T[9]; T[53] -= a3.y * T[9]; T[54] -= a3.z * T[9]; T[55] -= a3.w * T[9]; a3 = *(const LAS f32x4*)(AB + 668);
            asm volatile("" ::: "memory"); T[56] -= a4.x * T[9]; T[57] -= a4.y * T[9]; T[58] -= a4.z * T[9]; T[59] -= a4.w * T[9]; a4 = *(const LAS f32x4*)(AB + 672);
            asm volatile("" ::: "memory"); T[60] -= a5.x * T[9]; T[61] -= a5.y * T[9]; T[62] -= a5.z * T[9]; T[63] -= a5.w * T[9]; a5 = *(const LAS f32x4*)(AB + 676);
            asm volatile("" ::: "memory"); T[11] -= a6.w * T[10]; a6 = *(const LAS f32x4*)(AB + 680);
            asm volatile("" ::: "memory"); T[12] -= a7.x * T[10]; T[13] -= a7.y * T[10]; T[14] -= a7.z * T[10]; T[15] -= a7.w * T[10]; a7 = *(const LAS f32x4*)(AB + 684);
            asm volatile("" ::: "memory"); T[16] -= a0.x * T[10]; T[17] -= a0.y * T[10]; T[18] -= a0.z * T[10]; T[19] -= a0.w * T[10]; a0 = *(const LAS f32x4*)(AB + 688);
            asm volatile("" ::: "memory"); T[20] -= a1.x * T[10]; T[21] -= a1.y * T[10]; T[22] -= a1.z * T[10]; T[23] -= a1.w * T[10]; a1 = *(const LAS f32x4*)(AB + 692);
            asm volatile("" ::: "memory"); T[24] -= a2.x * T[10]; T[25] -= a2.y * T[10]; T[26] -= a2.z * T[10]; T[27] -= a2.w * T[10]; a2 = *(const LAS f32x4*)(AB + 696);
            asm volatile("" ::: "memory"); T[28] -= a3.x * T[10]; T[29] -= a3.y * T[10]; T[30] -= a3.z * T[10]; T[31] -= a3.w * T[10]; a3 = *(const LAS f32x4*)(AB + 700);
            asm volatile("" ::: "memory"); T[32] -= a4.x * T[10]; T[33] -= a4.y * T[10]; T[34] -= a4.z * T[10]; T[35] -= a4.w * T[10]; a4 = *(const LAS f32x4*)(AB + 716);
            asm volatile("" ::: "memory"); T[36] -= a5.x * T[10]; T[37] -= a5.y * T[10]; T[38] -= a5.z * T[10]; T[39] -= a5.w * T[10]; a5 = *(const LAS f32x4*)(AB + 720);
            asm volatile("" ::: "memory"); T[40] -= a6.x * T[10]; T[41] -= a6.y * T[10]; T[42] -= a6.z * T[10]; T[43] -= a6.w * T[10]; a6 = *(const LAS f32x4*)(AB + 724);
            asm volatile("" ::: "memory"); T[44] -= a7.x * T[10]; T[45] -= a7.y * T[10]; T[46] -= a7.z * T[10]; T[47] -= a7.w * T[10]; a7 = *(const LAS f32x4*)(AB + 728);
            asm volatile("" ::: "memory"); T[48] -= a0.x * T[10]; T[49] -= a0.y * T[10]; T[50] -= a0.z * T[10]; T[51] -= a0.w * T[10]; a0 = *(const LAS f32x4*)(AB + 732);
            asm volatile("" ::: "memory"); T[52] -= a1.x * T[10]; T[53] -= a1.y * T[10]; T[54] -= a1.z * T[10]; T[55] -= a1.w * T[10]; a1 = *(const LAS f32x4*)(AB + 736);
            asm volatile("" ::: "memory"); T[56] -= a2.x * T[10]; T[57] -= a2.y * T[10]; T[58] -= a2.z * T[10]; T[59] -= a2.w * T[10]; a2 = *(const LAS f32x4*)(AB + 740);
            asm volatile("" ::: "memory"); T[60] -= a3.x * T[10]; T[61] -= a3.y * T[10]; T[62] -= a3.z * T[10]; T[63] -= a3.w * T[10]; a3 = *(const LAS f32x4*)(AB + 744);
            asm volatile("" ::: "memory"); T[12] -= a4.x * T[11]; T[13] -= a4.y * T[11]; T[14] -= a4.z * T[11]; T[15] -= a4.w * T[11]; a4 = *(const LAS f32x4*)(AB + 748);
            asm volatile("" ::: "memory"); T[16] -= a5.x * T[11]; T[17] -= a5.y * T[11]; T[18] -= a5.z * T[11]; T[19] -= a5.w * T[11]; a5 = *(const LAS f32x4*)(AB + 752);
            asm volatile("" ::: "memory"); T[20] -= a6.x * T[11]; T[21] -= a6.y * T[11]; T[22] -= a6.z * T[11]; T[23] -= a6.w * T[11]; a6 = *(const LAS f32x4*)(AB + 756);
            asm volatile("" ::: "memory"); T[24] -= a7.x * T[11]; T[25] -= a7.y * T[11]; T[26] -= a7.z * T[11]; T[27] -= a7.w * T[11]; a7 = *(const LAS f32x4*)(AB + 760);
            asm volatile("" ::: "memory"); T[28] -= a0.x * T[11]; T[29] -= a0.y * T[11]; T[30] -= a0.z * T[11]; T[31] -= a0.w * T[11]; a0 = *(const LAS f32x4*)(AB + 764);
            asm volatile("" ::: "memory"); T[32] -= a1.x * T[11]; T[33] -= a1.y * T[11]; T[34] -= a1.z * T[11]; T[35] -= a1.w * T[11]; a1 = *(const LAS f32x4*)(AB + 780);
            asm volatile("" ::: "memory"); T[36] -= a2.x * T[11]; T[37] -= a2.y * T[11]; T[38] -= a2.z * T[11]; T[39] -= a2.w * T[11]; a2 = *(const LAS f32x4*)(AB + 784);
            asm volatile("" ::: "memory"); T[40] -= a3.x * T[11]; T[41] -= a3.y * T[11]; T[42] -= a3.z * T[11]; T[43] -= a3.w * T[11]; a3 = *(const LAS f32x4*)(AB + 788);
            asm volatile("" ::: "memory"); T[44] -= a4.x * T[11]; T[45] -= a4.y * T[11]; T[46] -= a4.z * T[11]; T[47] -= a4.w * T[11]; a4 = *(const LAS f32x4*)(AB + 792);
            asm volatile("" ::: "memory"); T[48] -= a5.x * T[11]; T[49] -= a5.y * T[11]; T[50] -= a5.z * T[11]; T[51] -= a5.w * T[11]; a5 = *(const LAS f32x4*)(AB + 796);
            asm volatile("" ::: "memory"); T[52] -= a6.x * T[11]; T[53] -= a6.y * T[11]; T[54] -= a6.z * T[11]; T[55] -= a6.w * T[11]; a6 = *(const LAS f32x4*)(AB + 800);
            asm volatile("" ::: "memory"); T[56] -= a7.x * T[11]; T[57] -= a7.y * T[11]; T[58] -= a7.z * T[11]; T[59] -= a7.w * T[11]; a7 = *(const LAS f32x4*)(AB + 804);
            asm volatile("" ::: "memory"); T[60] -= a0.x * T[11]; T[61] -= a0.y * T[11]; T[62] -= a0.z * T[11]; T[63] -= a0.w * T[11]; a0 = *(const LAS f32x4*)(AB + 808);
            asm volatile("" ::: "memory"); T[13] -= a1.y * T[12]; T[14] -= a1.z * T[12]; T[15] -= a1.w * T[12]; a1 = *(const LAS f32x4*)(AB + 812);
            asm volatile("" ::: "memory"); T[16] -= a2.x * T[12]; T[17] -= a2.y * T[12]; T[18] -= a2.z * T[12]; T[19] -= a2.w * T[12]; a2 = *(const LAS f32x4*)(AB + 816);
            asm volatile("" ::: "memory"); T[20] -= a3.x * T[12]; T[21] -= a3.y * T[12]; T[22] -= a3.z * T[12]; T[23] -= a3.w * T[12]; a3 = *(const LAS f32x4*)(AB + 820);
            asm volatile("" ::: "memory"); T[24] -= a4.x * T[12]; T[25] -= a4.y * T[12]; T[26] -= a4.z * T[12]; T[27] -= a4.w * T[12]; a4 = *(const LAS f32x4*)(AB + 824);
            asm volatile("" ::: "memory"); T[28] -= a5.x * T[12]; T[29] -= a5.y * T[12]; T[30] -= a5.z * T[12]; T[31] -= a5.w * T[12]; a5 = *(const LAS f32x4*)(AB + 828);
            asm volatile("" ::: "memory"); T[32] -= a6.x * T[12]; T[33] -= a6.y * T[12]; T[34] -= a6.z * T[12]; T[35] -= a6.w * T[12]; a6 = *(const LAS f32x4*)(AB + 844);
            asm volatile("" ::: "memory"); T[36] -= a7.x * T[12]; T[37] -= a7.y * T[12]; T[38] -= a7.z * T[12]; T[39] -= a7.w * T[12]; a7 = *(const LAS f32x4*)(AB + 848);
            asm volatile("" ::: "memory"); T[40] -= a0.x * T[12]; T[41] -= a0.y * T[12]; T[42] -= a0.z * T[12]; T[43] -= a0.w * T[12]; a0 = *(const LAS f32x4*)(AB + 852);
            asm volatile("" ::: "memory"); T[44] -= a1.x * T[12]; T[45] -= a1.y * T[12]; T[46] -= a1.z * T[12]; T[47] -= a1.w * T[12]; a1 = *(const LAS f32x4*)(AB + 856);
            asm volatile("" ::: "memory"); T[48] -= a2.x * T[12]; T[49] -= a2.y * T[12]; T[50] -= a2.z * T[12]; T[51] -= a2.w * T[12]; a2 = *(const LAS f32x4*)(AB + 860);
            asm volatile("" ::: "memory"); T[52] -= a3.x * T[12]; T[53] -= a3.y * T[12]; T[54] -= a3.z * T[12]; T[55] -= a3.w * T[12]; a3 = *(const LAS f32x4*)(AB + 864);
            asm volatile("" ::: "memory"); T[56] -= a4.x * T[12]; T[57] -= a4.y * T[12]; T[58] -= a4.z * T[12]; T[59] -= a4.w * T[12]; a4 = *(const LAS f32x4*)(AB + 868);
            asm volatile("" ::: "memory"); T[60] -= a5.x * T[12]; T[61] -= a5.y * T[12]; T[62] -= a5.z * T[12]; T[63] -= a5.w * T[12]; a5 = *(const LAS f32x4*)(AB + 872);
            asm volatile("" ::: "memory"); T[14] -= a6.z * T[13]; T[15] -= a6.w * T[13]; a6 = *(const LAS f32x4*)(AB + 876);
            asm volatile("" ::: "memory"); T[16] -= a7.x * T[13]; T[17] -= a7.y * T[13]; T[18] -= a7.z * T[13]; T[19] -= a7.w * T[13]; a7 = *(const LAS f32x4*)(AB + 880);
            asm volatile("" ::: "memory"); T[20] -= a0.x * T[13]; T[21] -= a0.y * T[13]; T[22] -= a0.z * T[13]; T[23] -= a0.w * T[13]; a0 = *(const LAS f32x4*)(AB + 884);
            asm volatile("" ::: "memory"); T[24] -= a1.x * T[13]; T[25] -= a1.y * T[13]; T[26] -= a1.z * T[13]; T[27] -= a1.w * T[13]; a1 = *(const LAS f32x4*)(AB + 888);
            asm volatile("" ::: "memory"); T[28] -= a2.x * T[13]; T[29] -= a2.y * T[13]; T[30] -= a2.z * T[13]; T[31] -= a2.w * T[13]; a2 = *(const LAS f32x4*)(AB + 892);
            asm volatile("" ::: "memory"); T[32] -= a3.x * T[13]; T[33] -= a3.y * T[13]; T[34] -= a3.z * T[13]; T[35] -= a3.w * T[13]; a3 = *(const LAS f32x4*)(AB + 908);
            asm volatile("" ::: "memory"); T[36] -= a4.x * T[13]; T[37] -= a4.y * T[13]; T[38] -= a4.z * T[13]; T[39] -= a4.w * T[13]; a4 = *(const LAS f32x4*)(AB + 912);
            asm volatile("" ::: "memory"); T[40] -= a5.x * T[13]; T[41] -= a5.y * T[13]; T[42] -= a5.z * T[13]; T[43] -= a5.w * T[13]; a5 = *(const LAS f32x4*)(AB + 916);
            asm volatile("" ::: "memory"); T[44] -= a6.x * T[13]; T[45] -= a6.y * T[13]; T[46] -= a6.z * T[13]; T[47] -= a6.w * T[13]; a6 = *(const LAS f32x4*)(AB + 920);
            asm volatile("" ::: "memory"); T[48] -= a7.x * T[13]; T[49] -= a7.y * T[13]; T[50] -= a7.z * T[13]; T[51] -= a7.w * T[13]; a7 = *(const LAS f32x4*)(AB + 924);
            asm volatile("" ::: "memory"); T[52] -= a0.x * T[13]; T[53] -= a0.y * T[13]; T[54] -= a0.z * T[13]; T[55] -= a0.w * T[13]; a0 = *(const LAS f32x4*)(AB + 928);
            asm volatile("" ::: "memory"); T[56] -= a1.x * T[13]; T[57] -= a1.y * T[13]; T[58] -= a1.z * T[13]; T[59] -= a1.w * T[13]; a1 = *(const LAS f32x4*)(AB + 932);
            asm volatile("" ::: "memory"); T[60] -= a2.x * T[13]; T[61] -= a2.y * T[13]; T[62] -= a2.z * T[13]; T[63] -= a2.w * T[13]; a2 = *(const LAS f32x4*)(AB + 936);
            asm volatile("" ::: "memory"); T[15] -= a3.w * T[14]; a3 = *(const LAS f32x4*)(AB + 940);
            asm volatile("" ::: "memory"); T[16] -= a4.x * T[14]; T[17] -= a4.y * T[14]; T[18] -= a4.z * T[14]; T[19] -= a4.w * T[14]; a4 = *(const LAS f32x4*)(AB + 944);
            asm volatile("" ::: "memory"); T[20] -= a5.x * T[14]; T[21] -= a5.y * T[14]; T[22] -= a5.z * T[14]; T[23] -= a5.w * T[14]; a5 = *(const LAS f32x4*)(AB + 948);
            asm volatile("" ::: "memory"); T[24] -= a6.x * T[14]; T[25] -= a6.y * T[14]; T[26] -= a6.z * T[14]; T[27] -= a6.w * T[14]; a6 = *(const LAS f32x4*)(AB + 952);
            asm volatile("" ::: "memory"); T[28] -= a7.x * T[14]; T[29] -= a7.y * T[14]; T[30] -= a7.z * T[14]; T[31] -= a7.w * T[14]; a7 = *(const LAS f32x4*)(AB + 956);
            asm volatile("" ::: "memory"); T[32] -= a0.x * T[14]; T[33] -= a0.y * T[14]; T[34] -= a0.z * T[14]; T[35] -= a0.w * T[14]; a0 = *(const LAS f32x4*)(AB + 976);
            asm volatile("" ::: "memory"); T[36] -= a1.x * T[14]; T[37] -= a1.y * T[14]; T[38] -= a1.z * T[14]; T[39] -= a1.w * T[14]; a1 = *(const LAS f32x4*)(AB + 980);
            asm volatile("" ::: "memory"); T[40] -= a2.x * T[14]; T[41] -= a2.y * T[14]; T[42] -= a2.z * T[14]; T[43] -= a2.w * T[14]; a2 = *(const LAS f32x4*)(AB + 984);
            asm volatile("" ::: "memory"); T[44] -= a3.x * T[14]; T[45] -= a3.y * T[14]; T[46] -= a3.z * T[14]; T[47] -= a3.w * T[14]; a3 = *(const LAS f32x4*)(AB + 988);
            asm volatile("" ::: "memory"); T[48] -= a4.x * T[14]; T[49] -= a4.y * T[14]; T[50] -= a4.z * T[14]; T[51] -= a4.w * T[14]; a4 = *(const LAS f32x4*)(AB + 992);
            asm volatile("" ::: "memory"); T[52] -= a5.x * T[14]; T[53] -= a5.y * T[14]; T[54] -= a5.z * T[14]; T[55] -= a5.w * T[14]; a5 = *(const LAS f32x4*)(AB + 996);
            asm volatile("" ::: "memory"); T[56] -= a6.x * T[14]; T[57] -= a6.y * T[14]; T[58] -= a6.z * T[14]; T[59] -= a6.w * T[14]; a6 = *(const LAS f32x4*)(AB + 1000);
            asm volatile("" ::: "memory"); T[60] -= a7.x * T[14]; T[61] -= a7.y * T[14]; T[62] -= a7.z * T[14]; T[63] -= a7.w * T[14]; a7 = *(const LAS f32x4*)(AB + 1004);
            asm volatile("" ::: "memory"); T[16] -= a0.x * T[15]; T[17] -= a0.y * T[15]; T[18] -= a0.z * T[15]; T[19] -= a0.w * T[15]; a0 = *(const LAS f32x4*)(AB + 1008);
            asm volatile("" ::: "memory"); T[20] -= a1.x * T[15]; T[21] -= a1.y * T[15]; T[22] -= a1.z * T[15]; T[23] -= a1.w * T[15]; a1 = *(const LAS f32x4*)(AB + 1012);
            asm volatile("" ::: "memory"); T[24] -= a2.x * T[15]; T[25] -= a2.y * T[15]; T[26] -= a2.z * T[15]; T[27] -= a2.w * T[15]; a2 = *(const LAS f32x4*)(AB + 1016);
            asm volatile("" ::: "memory"); T[28] -= a3.x * T[15]; T[29] -= a3.y * T[15]; T[30] -= a3.z * T[15]; T[31] -= a3.w * T[15]; a3 = *(const LAS f32x4*)(AB + 1020);
            asm volatile("" ::: "memory"); T[32] -= a4.x * T[15]; T[33] -= a4.y * T[15]; T[34] -= a4.z * T[15]; T[35] -= a4.w * T[15]; a4 = *(const LAS f32x4*)(AB + 1040);
            asm volatile("" ::: "memory"); T[36] -= a5.x * T[15]; T[37] -= a5.y * T[15]; T[38] -= a5.z * T[15]; T[39] -= a5.w * T[15]; a5 = *(const LAS f32x4*)(AB + 1044);
            asm volatile("" ::: "memory"); T[40] -= a6.x * T[15]; T[41] -= a6.y * T[15]; T[42] -= a6.z * T[15]; T[43] -= a6.w * T[15]; a6 = *(const LAS f32x4*)(AB + 1048);
            asm volatile("" ::: "memory"); T[44] -= a7.x * T[15]; T[45] -= a7.y * T[15]; T[46] -= a7.z * T[15]; T[47] -= a7.w * T[15]; a7 = *(const LAS f32x4*)(AB + 1052);
            asm volatile("" ::: "memory"); T[48] -= a0.x * T[15]; T[49] -= a0.y * T[15]; T[50] -= a0.z * T[15]; T[51] -= a0.w * T[15]; a0 = *(const LAS f32x4*)(AB + 1056);
            asm volatile("" ::: "memory"); T[52] -= a1.x * T[15]; T[53] -= a1.y * T[15]; T[54] -= a1.z * T[15]; T[55] -= a1.w * T[15]; a1 = *(const LAS f32x4*)(AB + 1060);
            asm volatile("" ::: "memory"); T[56] -= a2.x * T[15]; T[57] -= a2.y * T[15]; T[58] -= a2.z * T[15]; T[59] -= a2.w * T[15]; a2 = *(const LAS f32x4*)(AB + 1064);
            asm volatile("" ::: "memory"); T[60] -= a3.x * T[15]; T[61] -= a3.y * T[15]; T[62] -= a3.z * T[15]; T[63] -= a3.w * T[15]; a3 = *(const LAS f32x4*)(AB + 1068);
            asm volatile("" ::: "memory"); T[17] -= a4.y * T[16]; T[18] -= a4.z * T[16]; T[19] -= a4.w * T[16]; a4 = *(const LAS f32x4*)(AB + 1072);
            asm volatile("" ::: "memory"); T[20] -= a5.x * T[16]; T[21] -= a5.y * T[16]; T[22] -= a5.z * T[16]; T[23] -= a5.w * T[16]; a5 = *(const LAS f32x4*)(AB + 1076);
            asm volatile("" ::: "memory"); T[24] -= a6.x * T[16]; T[25] -= a6.y * T[16]; T[26] -= a6.z * T[16]; T[27] -= a6.w * T[16]; a6 = *(const LAS f32x4*)(AB + 1080);
            asm volatile("" ::: "memory"); T[28] -= a7.x * T[16]; T[29] -= a7.y * T[16]; T[30] -= a7.z * T[16]; T[31] -= a7.w * T[16]; a7 = *(const LAS f32x4*)(AB + 1084);
            asm volatile("" ::: "memory"); T[32] -= a0.x * T[16]; T[33] -= a0.y * T[16]; T[34] -= a0.z * T[16]; T[35] -= a0.w * T[16]; a0 = *(const LAS f32x4*)(AB + 1104);
            asm volatile("" ::: "memory"); T[36] -= a1.x * T[16]; T[37] -= a1.y * T[16]; T[38] -= a1.z * T[16]; T[39] -= a1.w * T[16]; a1 = *(const LAS f32x4*)(AB + 1108);
            asm volatile("" ::: "memory"); T[40] -= a2.x * T[16]; T[41] -= a2.y * T[16]; T[42] -= a2.z * T[16]; T[43] -= a2.w * T[16]; a2 = *(const LAS f32x4*)(AB + 1112);
            asm volatile("" ::: "memory"); T[44] -= a3.x * T[16]; T[45] -= a3.y * T[16]; T[46] -= a3.z * T[16]; T[47] -= a3.w * T[16]; a3 = *(const LAS f32x4*)(AB + 1116);
            asm volatile("" ::: "memory"); T[48] -= a4.x * T[16]; T[49] -= a4.y * T[16]; T[50] -= a4.z * T[16]; T[51] -= a4.w * T[16]; a4 = *(const LAS f32x4*)(AB + 1120);
            asm volatile("" ::: "memory"); T[52] -= a5.x * T[16]; T[53] -= a5.y * T[16]; T[54] -= a5.z * T[16]; T[55] -= a5.w * T[16]; a5 = *(const LAS f32x4*)(AB + 1124);
            asm volatile("" ::: "memory"); T[56] -= a6.x * T[16]; T[57] -= a6.y * T[16]; T[58] -= a6.z * T[16]; T[59] -= a6.w * T[16]; a6 = *(const LAS f32x4*)(AB + 1128);
            asm volatile("" ::: "memory"); T[60] -= a7.x * T[16]; T[61] -= a7.y * T[16]; T[62] -= a7.z * T[16]; T[63] -= a7.w * T[16]; a7 = *(const LAS f32x4*)(AB + 1132);
            asm volatile("" ::: "memory"); T[18] -= a0.z * T[17]; T[19] -= a0.w * T[17]; a0 = *(const LAS f32x4*)(AB + 1136);
            asm volatile("" ::: "memory"); T[20] -= a1.x * T[17]; T[21] -= a1.y * T[17]; T[22] -= a1.z * T[17]; T[23] -= a1.w * T[17]; a1 = *(const LAS f32x4*)(AB + 1140);
            asm volatile("" ::: "memory"); T[24] -= a2.x * T[17]; T[25] -= a2.y * T[17]; T[26] -= a2.z * T[17]; T[27] -= a2.w * T[17]; a2 = *(const LAS f32x4*)(AB + 1144);
            asm volatile("" ::: "memory"); T[28] -= a3.x * T[17]; T[29] -= a3.y * T[17]; T[30] -= a3.z * T[17]; T[31] -= a3.w * T[17]; a3 = *(const LAS f32x4*)(AB + 1148);
            asm volatile("" ::: "memory"); T[32] -= a4.x * T[17]; T[33] -= a4.y * T[17]; T[34] -= a4.z * T[17]; T[35] -= a4.w * T[17]; a4 = *(const LAS f32x4*)(AB + 1168);
            asm volatile("" ::: "memory"); T[36] -= a5.x * T[17]; T[37] -= a5.y * T[17]; T[38] -= a5.z * T[17]; T[39] -= a5.w * T[17]; a5 = *(const LAS f32x4*)(AB + 1172);
            asm volatile("" ::: "memory"); T[40] -= a6.x * T[17]; T[41] -= a6.y * T[17]; T[42] -= a6.z * T[17]; T[43] -= a6.w * T[17]; a6 = *(const LAS f32x4*)(AB + 1176);
            asm volatile("" ::: "memory"); T[44] -= a7.x * T[17]; T[45] -= a7.y * T[17]; T[46] -= a7.z * T[17]; T[47] -= a7.w * T[17]; a7 = *(const LAS f32x4*)(AB + 1180);
            asm volatile("" ::: "memory"); T[48] -= a0.x * T[17]; T[49] -= a0.y * T[17]; T[50] -= a0.z * T[17]; T[51] -= a0.w * T[17]; a0 = *(const LAS f32x4*)(AB + 1184);
            asm volatile("" ::: "memory"); T[52] -= a1.x * T[17]; T[53] -= a1.y * T[17]; T[54] -= a1.z * T[17]; T[55] -= a1.w * T[17]; a1 = *(const LAS f32x4*)(AB + 1188);
            asm volatile("" ::: "memory"); T[56] -= a2.x * T[17]; T[57] -= a2.y * T[17]; T[58] -= a2.z * T[17]; T[59] -= a2.w * T[17]; a2 = *(const LAS f32x4*)(AB + 1192);
            asm volatile("" ::: "memory"); T[60] -= a3.x * T[17]; T[61] -= a3.y * T[17]; T[62] -= a3.z * T[17]; T[63] -= a3.w * T[17]; a3 = *(const LAS f32x4*)(AB + 1196);
            asm volatile("" ::: "memory"); T[19] -= a4.w * T[18]; a4 = *(const LAS f32x4*)(AB + 1200);
            asm volatile("" ::: "memory"); T[20] -= a5.x * T[18]; T[21] -= a5.y * T[18]; T[22] -= a5.z * T[18]; T[23] -= a5.w * T[18]; a5 = *(const LAS f32x4*)(AB + 1204);
            asm volatile("" ::: "memory"); T[24] -= a6.x * T[18]; T[25] -= a6.y * T[18]; T[26] -= a6.z * T[18]; T[27] -= a6.w * T[18]; a6 = *(const LAS f32x4*)(AB + 1208);
            asm volatile("" ::: "memory"); T[28] -= a7.x * T[18]; T[29] -= a7.y * T[18]; T[30] -= a7.z * T[18]; T[31] -= a7.w * T[18]; a7 = *(const LAS f32x4*)(AB + 1212);
            asm volatile("" ::: "memory"); T[32] -= a0.x * T[18]; T[33] -= a0.y * T[18]; T[34] -= a0.z * T[18]; T[35] -= a0.w * T[18]; a0 = *(const LAS f32x4*)(AB + 1236);
            asm volatile("" ::: "memory"); T[36] -= a1.x * T[18]; T[37] -= a1.y * T[18]; T[38] -= a1.z * T[18]; T[39] -= a1.w * T[18]; a1 = *(const LAS f32x4*)(AB + 1240);
            asm volatile("" ::: "memory"); T[40] -= a2.x * T[18]; T[41] -= a2.y * T[18]; T[42] -= a2.z * T[18]; T[43] -= a2.w * T[18]; a2 = *(const LAS f32x4*)(AB + 1244);
            asm volatile("" ::: "memory"); T[44] -= a3.x * T[18]; T[45] -= a3.y * T[18]; T[46] -= a3.z * T[18]; T[47] -= a3.w * T[18]; a3 = *(const LAS f32x4*)(AB + 1248);
            asm volatile("" ::: "memory"); T[48] -= a4.x * T[18]; T[49] -= a4.y * T[18]; T[50] -= a4.z * T[18]; T[51] -= a4.w * T[18]; a4 = *(const LAS f32x4*)(AB + 1252);
            asm volatile("" ::: "memory"); T[52] -= a5.x * T[18]; T[53] -= a5.y * T[18]; T[54] -= a5.z * T[18]; T[55] -= a5.w * T[18]; a5 = *(const LAS f32x4*)(AB + 1256);
            asm volatile("" ::: "memory"); T[56] -= a6.x * T[18]; T[57] -= a6.y * T[18]; T[58] -= a6.z * T[18]; T[59] -= a6.w * T[18]; a6 = *(const LAS f32x4*)(AB + 1260);
            asm volatile("" ::: "memory"); T[60] -= a7.x * T[18]; T[61] -= a7.y * T[18]; T[62] -= a7.z * T[18]; T[63] -= a7.w * T[18]; a7 = *(const LAS f32x4*)(AB + 1264);
            asm volatile("" ::: "memory"); T[20] -= a0.x * T[19]; T[21] -= a0.y * T[19]; T[22] -= a0.z * T[19]; T[23] -= a0.w * T[19]; a0 = *(const LAS f32x4*)(AB + 1268);
            asm volatile("" ::: "memory"); T[24] -= a1.x * T[19]; T[25] -= a1.y * T[19]; T[26] -= a1.z * T[19]; T[27] -= a1.w * T[19]; a1 = *(const LAS f32x4*)(AB + 1272);
            asm volatile("" ::: "memory"); T[28] -= a2.x * T[19]; T[29] -= a2.y * T[19]; T[30] -= a2.z * T[19]; T[31] -= a2.w * T[19]; a2 = *(const LAS f32x4*)(AB + 1276);
            asm volatile("" ::: "memory"); T[32] -= a3.x * T[19]; T[33] -= a3.y * T[19]; T[34] -= a3.z * T[19]; T[35] -= a3.w * T[19]; a3 = *(const LAS f32x4*)(AB + 1300);
            asm volatile("" ::: "memory"); T[36] -= a4.x * T[19]; T[37] -= a4.y * T[19]; T[38] -= a4.z * T[19]; T[39] -= a4.w * T[19]; a4 = *(const LAS f32x4*)(AB + 1304);
            asm volatile("" ::: "memory"); T[40] -= a5.x * T[19]; T[41] -= a5.y * T[19]; T[42] -= a5.z * T[19]; T[43] -= a5.w * T[19]; a5 = *(const LAS f32x4*)(AB + 1308);
            asm volatile("" ::: "memory"); T[44] -= a6.x * T[19]; T[45] -= a6.y * T[19]; T[46] -= a6.z * T[19]; T[47] -= a6.w * T[19]; a6 = *(const LAS f32x4*)(AB + 1312);
            asm volatile("" ::: "memory"); T[48] -= a7.x * T[19]; T[49] -= a7.y * T[19]; T[50] -= a7.z * T[19]; T[51] -= a7.w * T[19]; a7 = *(const LAS f32x4*)(AB + 1316);
            asm volatile("" ::: "memory"); T[52] -= a0.x * T[19]; T[53] -= a0.y * T[19]; T[54] -= a0.z * T[19]; T[55] -= a0.w * T[19]; a0 = *(const LAS f32x4*)(AB + 1320);
            asm volatile("" ::: "memory"); T[56] -= a1.x * T[19]; T[57] -= a1.y * T[19]; T[58] -= a1.z * T[19]; T[59] -= a1.w * T[19]; a1 = *(const LAS f32x4*)(AB + 1324);
            asm volatile("" ::: "memory"); T[60] -= a2.x * T[19]; T[61] -= a2.y * T[19]; T[62] -= a2.z * T[19]; T[63] -= a2.w * T[19]; a2 = *(const LAS f32x4*)(AB + 1328);
            asm volatile("" ::: "memory"); T[21] -= a3.y * T[20]; T[22] -= a3.z * T[20]; T[23] -= a3.w * T[20]; a3 = *(const LAS f32x4*)(AB + 1332);
            asm volatile("" ::: "memory"); T[24] -= a4.x * T[20]; T[25] -= a4.y * T[20]; T[26] -= a4.z * T[20]; T[27] -= a4.w * T[20]; a4 = *(const LAS f32x4*)(AB + 1336);
            asm volatile("" ::: "memory"); T[28] -= a5.x * T[20]; T[29] -= a5.y * T[20]; T[30] -= a5.z * T[20]; T[31] -= a5.w * T[20]; a5 = *(const LAS f32x4*)(AB + 1340);
            asm volatile("" ::: "memory"); T[32] -= a6.x * T[20]; T[33] -= a6.y * T[20]; T[34] -= a6.z * T[20]; T[35] -= a6.w * T[20]; a6 = *(const LAS f32x4*)(AB + 1364);
            asm volatile("" ::: "memory"); T[36] -= a7.x * T[20]; T[37] -= a7.y * T[20]; T[38] -= a7.z * T[20]; T[39] -= a7.w * T[20]; a7 = *(const LAS f32x4*)(AB + 1368);
            asm volatile("" ::: "memory"); T[40] -= a0.x * T[20]; T[41] -= a0.y * T[20]; T[42] -= a0.z * T[20]; T[43] -= a0.w * T[20]; a0 = *(const LAS f32x4*)(AB + 1372);
            asm volatile("" ::: "memory"); T[44] -= a1.x * T[20]; T[45] -= a1.y * T[20]; T[46] -= a1.z * T[20]; T[47] -= a1.w * T[20]; a1 = *(const LAS f32x4*)(AB + 1376);
            asm volatile("" ::: "memory"); T[48] -= a2.x * T[20]; T[49] -= a2.y * T[20]; T[50] -= a2.z * T[20]; T[51] -= a2.w * T[20]; a2 = *(const LAS f32x4*)(AB + 1380);
            asm volatile("" ::: "memory"); T[52] -= a3.x * T[20]; T[53] -= a3.y * T[20]; T[54] -= a3.z * T[20]; T[55] -= a3.w * T[20]; a3 = *(const LAS f32x4*)(AB + 1384);
            asm volatile("" ::: "memory"); T[56] -= a4.x * T[20]; T[57] -= a4.y * T[20]; T[58] -= a4.z * T[20]; T[59] -= a4.w * T[20]; a4 = *(const LAS f32x4*)(AB + 1388);
            asm volatile("" ::: "memory"); T[60] -= a5.x * T[20]; T[61] -= a5.y * T[20]; T[62] -= a5.z * T[20]; T[63] -= a5.w * T[20]; a5 = *(const LAS f32x4*)(AB + 1392);
            asm volatile("" ::: "memory"); T[22] -= a6.z * T[21]; T[23] -= a6.w * T[21]; a6 = *(const LAS f32x4*)(AB + 1396);
            asm volatile("" ::: "memory"); T[24] -= a7.x * T[21]; T[25] -= a7.y * T[21]; T[26] -= a7.z * T[21]; T[27] -= a7.w * T[21]; a7 = *(const LAS f32x4*)(AB + 1400);
            asm volatile("" ::: "memory"); T[28] -= a0.x * T[21]; T[29] -= a0.y * T[21]; T[30] -= a0.z * T[21]; T[31] -= a0.w * T[21]; a0 = *(const LAS f32x4*)(AB + 1404);
            asm volatile("" ::: "memory"); T[32] -= a1.x * T[21]; T[33] -= a1.y * T[21]; T[34] -= a1.z * T[21]; T[35] -= a1.w * T[21]; a1 = *(const LAS f32x4*)(AB + 1428);
            asm volatile("" ::: "memory"); T[36] -= a2.x * T[21]; T[37] -= a2.y * T[21]; T[38] -= a2.z * T[21]; T[39] -= a2.w * T[21]; a2 = *(const LAS f32x4*)(AB + 1432);
            asm volatile("" ::: "memory"); T[40] -= a3.x * T[21]; T[41] -= a3.y * T[21]; T[42] -= a3.z * T[21]; T[43] -= a3.w * T[21]; a3 = *(const LAS f32x4*)(AB + 1436);
            asm volatile("" ::: "memory"); T[44] -= a4.x * T[21]; T[45] -= a4.y * T[21]; T[46] -= a4.z * T[21]; T[47] -= a4.w * T[21]; a4 = *(const LAS f32x4*)(AB + 1440);
            asm volatile("" ::: "memory"); T[48] -= a5.x * T[21]; T[49] -= a5.y * T[21]; T[50] -= a5.z * T[21]; T[51] -= a5.w * T[21]; a5 = *(const LAS f32x4*)(AB + 1444);
            asm volatile("" ::: "memory"); T[52] -= a6.x * T[21]; T[53] -= a6.y * T[21]; T[54] -= a6.z * T[21]; T[55] -= a6.w * T[21]; a6 = *(const LAS f32x4*)(AB + 1448);
            asm volatile("" ::: "memory"); T[56] -= a7.x * T[21]; T[57] -= a7.y * T[21]; T[58] -= a7.z * T[21]; T[59] -= a7.w * T[21]; a7 = *(const LAS f32x4*)(AB + 1452);
            asm volatile("" ::: "memory"); T[60] -= a0.x * T[21]; T[61] -= a0.y * T[21]; T[62] -= a0.z * T[21]; T[63] -= a0.w * T[21]; a0 = *(const LAS f32x4*)(AB + 1456);
            asm volatile("" ::: "memory"); T[23] -= a1.w * T[22]; a1 = *(const LAS f32x4*)(AB + 1460);
            asm volatile("" ::: "memory"); T[24] -= a2.x * T[22]; T[25] -= a2.y * T[22]; T[26] -= a2.z * T[22]; T[27] -= a2.w * T[22]; a2 = *(const LAS f32x4*)(AB + 1464);
            asm volatile("" ::: "memory"); T[28] -= a3.x * T[22]; T[29] -= a3.y * T[22]; T[30] -= a3.z * T[22]; T[31] -= a3.w * T[22]; a3 = *(const LAS f32x4*)(AB + 1468);
            asm volatile("" ::: "memory"); T[32] -= a4.x * T[22]; T[33] -= a4.y * T[22]; T[34] -= a4.z * T[22]; T[35] -= a4.w * T[22]; a4 = *(const LAS f32x4*)(AB + 1496);
            asm volatile("" ::: "memory"); T[36] -= a5.x * T[22]; T[37] -= a5.y * T[22]; T[38] -= a5.z * T[22]; T[39] -= a5.w * T[22]; a5 = *(const LAS f32x4*)(AB + 1500);
            asm volatile("" ::: "memory"); T[40] -= a6.x * T[22]; T[41] -= a6.y * T[22]; T[42] -= a6.z * T[22]; T[43] -= a6.w * T[22]; a6 = *(const LAS f32x4*)(AB + 1504);
            asm volatile("" ::: "memory"); T[44] -= a7.x * T[22]; T[45] -= a7.y * T[22]; T[46] -= a7.z * T[22]; T[47] -= a7.w * T[22]; a7 = *(const LAS f32x4*)(AB + 1508);
            asm volatile("" ::: "memory"); T[48] -= a0.x * T[22]; T[49] -= a0.y * T[22]; T[50] -= a0.z * T[22]; T[51] -= a0.w * T[22]; a0 = *(const LAS f32x4*)(AB + 1512);
            asm volatile("" ::: "memory"); T[52] -= a1.x * T[22]; T[53] -= a1.y * T[22]; T[54] -= a1.z * T[22]; T[55] -= a1.w * T[22]; a1 = *(const LAS f32x4*)(AB + 1516);
            asm volatile("" ::: "memory"); T[56] -= a2.x * T[22]; T[57] -= a2.y * T[22]; T[58] -= a2.z * T[22]; T[59] -= a2.w * T[22]; a2 = *(const LAS f32x4*)(AB + 1520);
            asm volatile("" ::: "memory"); T[60] -= a3.x * T[22]; T[61] -= a3.y * T[22]; T[62] -= a3.z * T[22]; T[63] -= a3.w * T[22]; a3 = *(const LAS f32x4*)(AB + 1524);
            asm volatile("" ::: "memory"); T[24] -= a4.x * T[23]; T[25] -= a4.y * T[23]; T[26] -= a4.z * T[23]; T[27] -= a4.w * T[23]; a4 = *(const LAS f32x4*)(AB + 1528);
            asm volatile("" ::: "memory"); T[28] -= a5.x * T[23]; T[29] -= a5.y * T[23]; T[30] -= a5.z * T[23]; T[31] -= a5.w * T[23]; a5 = *(const LAS f32x4*)(AB + 1532);
            asm volatile("" ::: "memory"); T[32] -= a6.x * T[23]; T[33] -= a6.y * T[23]; T[34] -= a6.z * T[23]; T[35] -= a6.w * T[23]; a6 = *(const LAS f32x4*)(AB + 1560);
            asm volatile("" ::: "memory"); T[36] -= a7.x * T[23]; T[37] -= a7.y * T[23]; T[38] -= a7.z * T[23]; T[39] -= a7.w * T[23]; a7 = *(const LAS f32x4*)(AB + 1564);
            asm volatile("" ::: "memory"); T[40] -= a0.x * T[23]; T[41] -= a0.y * T[23]; T[42] -= a0.z * T[23]; T[43] -= a0.w * T[23]; a0 = *(const LAS f32x4*)(AB + 1568);
            asm volatile("" ::: "memory"); T[44] -= a1.x * T[23]; T[45] -= a1.y * T[23]; T[46] -= a1.z * T[23]; T[47] -= a1.w * T[23]; a1 = *(const LAS f32x4*)(AB + 1572);
            asm volatile("" ::: "memory"); T[48] -= a2.x * T[23]; T[49] -= a2.y * T[23]; T[50] -= a2.z * T[23]; T[51] -= a2.w * T[23]; a2 = *(const LAS f32x4*)(AB + 1576);
            asm volatile("" ::: "memory"); T[52] -= a3.x * T[23]; T[53] -= a3.y * T[23]; T[54] -= a3.z * T[23]; T[55] -= a3.w * T[23]; a3 = *(const LAS f32x4*)(AB + 1580);
            asm volatile("" ::: "memory"); T[56] -= a4.x * T[23]; T[57] -= a4.y * T[23]; T[58] -= a4.z * T[23]; T[59] -= a4.w * T[23]; a4 = *(const LAS f32x4*)(AB + 1584);
            asm volatile("" ::: "memory"); T[60] -= a5.x * T[23]; T[61] -= a5.y * T[23]; T[62] -= a5.z * T[23]; T[63] -= a5.w * T[23]; a5 = *(const LAS f32x4*)(AB + 1588);
            asm volatile("" ::: "memory"); T[25] -= a6.y * T[24]; T[26] -= a6.z * T[24]; T[27] -= a6.w * T[24]; a6 = *(const LAS f32x4*)(AB + 1592);
            asm volatile("" ::: "memory"); T[28] -= a7.x * T[24]; T[29] -= a7.y * T[24]; T[30] -= a7.z * T[24]; T[31] -= a7.w * T[24]; a7 = *(const LAS f32x4*)(AB + 1596);
            asm volatile("" ::: "memory"); T[32] -= a0.x * T[24]; T[33] -= a0.y * T[24]; T[34] -= a0.z * T[24]; T[35] -= a0.w * T[24]; a0 = *(const LAS f32x4*)(AB + 1624);
            asm volatile("" ::: "memory"); T[36] -= a1.x * T[24]; T[37] -= a1.y * T[24]; T[38] -= a1.z * T[24]; T[39] -= a1.w * T[24]; a1 = *(const LAS f32x4*)(AB + 1628);
            asm volatile("" ::: "memory"); T[40] -= a2.x * T[24]; T[41] -= a2.y * T[24]; T[42] -= a2.z * T[24]; T[43] -= a2.w * T[24]; a2 = *(const LAS f32x4*)(AB + 1632);
            asm volatile("" ::: "memory"); T[44] -= a3.x * T[24]; T[45] -= a3.y * T[24]; T[46] -= a3.z * T[24]; T[47] -= a3.w * T[24]; a3 = *(const LAS f32x4*)(AB + 1636);
            asm volatile("" ::: "memory"); T[48] -= a4.x * T[24]; T[49] -= a4.y * T[24]; T[50] -= a4.z * T[24]; T[51] -= a4.w * T[24]; a4 = *(const LAS f32x4*)(AB + 1640);
            asm volatile("" ::: "memory"); T[52] -= a5.x * T[24]; T[53] -= a5.y * T[24]; T[54] -= a5.z * T[24]; T[55] -= a5.w * T[24]; a5 = *(const LAS f32x4*)(AB + 1644);
            asm volatile("" ::: "memory"); T[56] -= a6.x * T[24]; T[57] -= a6.y * T[24]; T[58] -= a6.z * T[24]; T[59] -= a6.w * T[24]; a6 = *(const LAS f32x4*)(AB + 1648);
            asm volatile("" ::: "memory"); T[60] -= a7.x * T[24]; T[61] -= a7.y * T[24]; T[62] -= a7.z * T[24]; T[63] -= a7.w * T[24]; a7 = *(const LAS f32x4*)(AB + 1652);
            asm volatile("" ::: "memory"); T[26] -= a0.z * T[25]; T[27] -= a0.w * T[25]; a0 = *(const LAS f32x4*)(AB + 1656);
            asm volatile("" ::: "memory"); T[28] -= a1.x * T[25]; T[29] -= a1.y * T[25]; T[30] -= a1.z * T[25]; T[31] -= a1.w * T[25]; a1 = *(const LAS f32x4*)(AB + 1660);
            asm volatile("" ::: "memory"); T[32] -= a2.x * T[25]; T[33] -= a2.y * T[25]; T[34] -= a2.z * T[25]; T[35] -= a2.w * T[25]; a2 = *(const LAS f32x4*)(AB + 1688);
            asm volatile("" ::: "memory"); T[36] -= a3.x * T[25]; T[37] -= a3.y * T[25]; T[38] -= a3.z * T[25]; T[39] -= a3.w * T[25]; a3 = *(const LAS f32x4*)(AB + 1692);
            asm volatile("" ::: "memory"); T[40] -= a4.x * T[25]; T[41] -= a4.y * T[25]; T[42] -= a4.z * T[25]; T[43] -= a4.w * T[25]; a4 = *(const LAS f32x4*)(AB + 1696);
            asm volatile("" ::: "memory"); T[44] -= a5.x * T[25]; T[45] -= a5.y * T[25]; T[46] -= a5.z * T[25]; T[47] -= a5.w * T[25]; a5 = *(const LAS f32x4*)(AB + 1700);
            asm volatile("" ::: "memory"); T[48] -= a6.x * T[25]; T[49] -= a6.y * T[25]; T[50] -= a6.z * T[25]; T[51] -= a6.w * T[25]; a6 = *(const LAS f32x4*)(AB + 1704);
            asm volatile("" ::: "memory"); T[52] -= a7.x * T[25]; T[53] -= a7.y * T[25]; T[54] -= a7.z * T[25]; T[55] -= a7.w * T[25]; a7 = *(const LAS f32x4*)(AB + 1708);
            asm volatile("" ::: "memory"); T[56] -= a0.x * T[25]; T[57] -= a0.y * T[25]; T[58] -= a0.z * T[25]; T[59] -= a0.w * T[25]; a0 = *(const LAS f32x4*)(AB + 1712);
            asm volatile("" ::: "memory"); T[60] -= a1.x * T[25]; T[61] -= a1.y * T[25]; T[62] -= a1.z * T[25]; T[63] -= a1.w * T[25]; a1 = *(const LAS f32x4*)(AB + 1716);
            asm volatile("" ::: "memory"); T[27] -= a2.w * T[26]; a2 = *(const LAS f32x4*)(AB + 1720);
            asm volatile("" ::: "memory"); T[28] -= a3.x * T[26]; T[29] -= a3.y * T[26]; T[30] -= a3.z * T[26]; T[31] -= a3.w * T[26]; a3 = *(const LAS f32x4*)(AB + 1724);
            asm volatile("" ::: "memory"); T[32] -= a4.x * T[26]; T[33] -= a4.y * T[26]; T[34] -= a4.z * T[26]; T[35] -= a4.w * T[26]; a4 = *(const LAS f32x4*)(AB + 1756);
            asm volatile("" ::: "memory"); T[36] -= a5.x * T[26]; T[37] -= a5.y * T[26]; T[38] -= a5.z * T[26]; T[39] -= a5.w * T[26]; a5 = *(const LAS f32x4*)(AB + 1760);
            asm volatile("" ::: "memory"); T[40] -= a6.x * T[26]; T[41] -= a6.y * T[26]; T[42] -= a6.z * T[26]; T[43] -= a6.w * T[26]; a6 = *(const LAS f32x4*)(AB + 1764);
            asm volatile("" ::: "memory"); T[44] -= a7.x * T[26]; T[45] -= a7.y * T[26]; T[46] -= a7.z * T[26]; T[47] -= a7.w * T[26]; a7 = *(const LAS f32x4*)(AB + 1768);
            asm volatile("" ::: "memory"); T[48] -= a0.x * T[26]; T[49] -= a0.y * T[26]; T[50] -= a0.z * T[26]; T[51] -= a0.w * T[26]; a0 = *(const LAS f32x4*)(AB + 1772);
            asm volatile("" ::: "memory"); T[52] -= a1.x * T[26]; T[53] -= a1.y * T[26]; T[54] -= a1.z * T[26]; T[55] -= a1.w * T[26]; a1 = *(const LAS f32x4*)(AB + 1776);
            asm volatile("" ::: "memory"); T[56] -= a2.x * T[26]; T[57] -= a2.y * T[26]; T[58] -= a2.z * T[26]; T[59] -= a2.w * T[26]; a2 = *(const LAS f32x4*)(AB + 1780);
            asm volatile("" ::: "memory"); T[60] -= a3.x * T[26]; T[61] -= a3.y * T[26]; T[62] -= a3.z * T[26]; T[63] -= a3.w * T[26]; a3 = *(const LAS f32x4*)(AB + 1784);
            asm volatile("" ::: "memory"); T[28] -= a4.x * T[27]; T[29] -= a4.y * T[27]; T[30] -= a4.z * T[27]; T[31] -= a4.w * T[27]; a4 = *(const LAS f32x4*)(AB + 1788);
            asm volatile("" ::: "memory"); T[32] -= a5.x * T[27]; T[33] -= a5.y * T[27]; T[34] -= a5.z * T[27]; T[35] -= a5.w * T[27]; a5 = *(const LAS f32x4*)(AB + 1820);
            asm volatile("" ::: "memory"); T[36] -= a6.x * T[27]; T[37] -= a6.y * T[27]; T[38] -= a6.z * T[27]; T[39] -= a6.w * T[27]; a6 = *(const LAS f32x4*)(AB + 1824);
            asm volatile("" ::: "memory"); T[40] -= a7.x * T[27]; T[41] -= a7.y * T[27]; T[42] -= a7.z * T[27]; T[43] -= a7.w * T[27]; a7 = *(const LAS f32x4*)(AB + 1828);
            asm volatile("" ::: "memory"); T[44] -= a0.x * T[27]; T[45] -= a0.y * T[27]; T[46] -= a0.z * T[27]; T[47] -= a0.w * T[27]; a0 = *(const LAS f32x4*)(AB + 1832);
            asm volatile("" ::: "memory"); T[48] -= a1.x * T[27]; T[49] -= a1.y * T[27]; T[50] -= a1.z * T[27]; T[51] -= a1.w * T[27]; a1 = *(const LAS f32x4*)(AB + 1836);
            asm volatile("" ::: "memory"); T[52] -= a2.x * T[27]; T[53] -= a2.y * T[27]; T[54] -= a2.z * T[27]; T[55] -= a2.w * T[27]; a2 = *(const LAS f32x4*)(AB + 1840);
            asm volatile("" ::: "memory"); T[56] -= a3.x * T[27]; T[57] -= a3.y * T[27]; T[58] -= a3.z * T[27]; T[59] -= a3.w * T[27]; a3 = *(const LAS f32x4*)(AB + 1844);
            asm volatile("" ::: "memory"); T[60] -= a4.x * T[27]; T[61] -= a4.y * T[27]; T[62] -= a4.z * T[27]; T[63] -= a4.w * T[27]; a4 = *(const LAS f32x4*)(AB + 1848);
            asm volatile("" ::: "memory"); T[29] -= a5.y * T[28]; T[30] -= a5.z * T[28]; T[31] -= a5.w * T[28]; a5 = *(const LAS f32x4*)(AB + 1852);
            asm volatile("" ::: "memory"); T[32] -= a6.x * T[28]; T[33] -= a6.y * T[28]; T[34] -= a6.z * T[28]; T[35] -= a6.w * T[28]; a6 = *(const LAS f32x4*)(AB + 1884);
            asm volatile("" ::: "memory"); T[36] -= a7.x * T[28]; T[37] -= a7.y * T[28]; T[38] -= a7.z * T[28]; T[39] -= a7.w * T[28]; a7 = *(const LAS f32x4*)(AB + 1888);
            asm volatile("" ::: "memory"); T[40] -= a0.x * T[28]; T[41] -= a0.y * T[28]; T[42] -= a0.z * T[28]; T[43] -= a0.w * T[28]; a0 = *(const LAS f32x4*)(AB + 1892);
            asm volatile("" ::: "memory"); T[44] -= a1.x * T[28]; T[45] -= a1.y * T[28]; T[46] -= a1.z * T[28]; T[47] -= a1.w * T[28]; a1 = *(const LAS f32x4*)(AB + 1896);
            asm volatile("" ::: "memory"); T[48] -= a2.x * T[28]; T[49] -= a2.y * T[28]; T[50] -= a2.z * T[28]; T[51] -= a2.w * T[28]; a2 = *(const LAS f32x4*)(AB + 1900);
            asm volatile("" ::: "memory"); T[52] -= a3.x * T[28]; T[53] -= a3.y * T[28]; T[54] -= a3.z * T[28]; T[55] -= a3.w * T[28]; a3 = *(const LAS f32x4*)(AB + 1904);
            asm volatile("" ::: "memory"); T[56] -= a4.x * T[28]; T[57] -= a4.y * T[28]; T[58] -= a4.z * T[28]; T[59] -= a4.w * T[28]; a4 = *(const LAS f32x4*)(AB + 1908);
            asm volatile("" ::: "memory"); T[60] -= a5.x * T[28]; T[61] -= a5.y * T[28]; T[62] -= a5.z * T[28]; T[63] -= a5.w * T[28]; a5 = *(const LAS f32x4*)(AB + 1912);
            asm volatile("" ::: "memory"); T[30] -= a6.z * T[29]; T[31] -= a6.w * T[29]; a6 = *(const LAS f32x4*)(AB + 1916);
            asm volatile("" ::: "memory"); T[32] -= a7.x * T[29]; T[33] -= a7.y * T[29]; T[34] -= a7.z * T[29]; T[35] -= a7.w * T[29]; a7 = *(const LAS f32x4*)(AB + 1948);
            asm volatile("" ::: "memory"); T[36] -= a0.x * T[29]; T[37] -= a0.y * T[29]; T[38] -= a0.z * T[29]; T[39] -= a0.w * T[29]; a0 = *(const LAS f32x4*)(AB + 1952);
            asm volatile("" ::: "memory"); T[40] -= a1.x * T[29]; T[41] -= a1.y * T[29]; T[42] -= a1.z * T[29]; T[43] -= a1.w * T[29]; a1 = *(const LAS f32x4*)(AB + 1956);
            asm volatile("" ::: "memory"); T[44] -= a2.x * T[29]; T[45] -= a2.y * T[29]; T[46] -= a2.z * T[29]; T[47] -= a2.w * T[29]; a2 = *(const LAS f32x4*)(AB + 1960);
            asm volatile("" ::: "memory"); T[48] -= a3.x * T[29]; T[49] -= a3.y * T[29]; T[50] -= a3.z * T[29]; T[51] -= a3.w * T[29]; a3 = *(const LAS f32x4*)(AB + 1964);
            asm volatile("" ::: "memory"); T[52] -= a4.x * T[29]; T[53] -= a4.y * T[29]; T[54] -= a4.z * T[29]; T[55] -= a4.w * T[29]; a4 = *(const LAS f32x4*)(AB + 1968);
            asm volatile("" ::: "memory"); T[56] -= a5.x * T[29]; T[57] -= a5.y * T[29]; T[58] -= a5.z * T[29]; T[59] -= a5.w * T[29]; a5 = *(const LAS f32x4*)(AB + 1972);
            asm volatile("" ::: "memory"); T[60] -= a6.x * T[29]; T[61] -= a6.y * T[29]; T[62] -= a6.z * T[29]; T[63] -= a6.w * T[29]; a6 = *(const LAS f32x4*)(AB + 1976);
            asm volatile("" ::: "memory"); T[31] -= a7.w * T[30]; a7 = *(const LAS f32x4*)(AB + 1980);
            asm volatile("" ::: "memory"); T[32] -= a0.x * T[30]; T[33] -= a0.y * T[30]; T[34] -= a0.z * T[30]; T[35] -= a0.w * T[30]; a0 = *(const LAS f32x4*)(AB + 2016);
            asm volatile("" ::: "memory"); T[36] -= a1.x * T[30]; T[37] -= a1.y * T[30]; T[38] -= a1.z * T[30]; T[39] -= a1.w * T[30]; a1 = *(const LAS f32x4*)(AB + 2020);
            asm volatile("" ::: "memory"); T[40] -= a2.x * T[30]; T[41] -= a2.y * T[30]; T[42] -= a2.z * T[30]; T[43] -= a2.w * T[30]; a2 = *(const LAS f32x4*)(AB + 2024);
            asm volatile("" ::: "memory"); T[44] -= a3.x * T[30]; T[45] -= a3.y * T[30]; T[46] -= a3.z * T[30]; T[47] -= a3.w * T[30]; a3 = *(const LAS f32x4*)(AB + 2028);
            asm volatile("" ::: "memory"); T[48] -= a4.x * T[30]; T[49] -= a4.y * T[30]; T[50] -= a4.z * T[30]; T[51] -= a4.w * T[30]; a4 = *(const LAS f32x4*)(AB + 2032);
            asm volatile("" ::: "memory"); T[52] -= a5.x * T[30]; T[53] -= a5.y * T[30]; T[54] -= a5.z * T[30]; T[55] -= a5.w * T[30]; a5 = *(const LAS f32x4*)(AB + 2036);
            asm volatile("" ::: "memory"); T[56] -= a6.x * T[30]; T[57] -= a6.y * T[30]; T[58] -= a6.z * T[30]; T[59] -= a6.w * T[30]; a6 = *(const LAS f32x4*)(AB + 2040);
            asm volatile("" ::: "memory"); T[60] -= a7.x * T[30]; T[61] -= a7.y * T[30]; T[62] -= a7.z * T[30]; T[63] -= a7.w * T[30]; a7 = *(const LAS f32x4*)(AB + 2044);
            asm volatile("" ::: "memory"); T[32] -= a0.x * T[31]; T[33] -= a0.y * T[31]; T[34] -= a0.z * T[31]; T[35] -= a0.w * T[31]; a0 = *(const LAS f32x4*)(AB + 2080);
            asm volatile("" ::: "memory"); T[36] -= a1.x * T[31]; T[37] -= a1.y * T[31]; T[38] -= a1.z * T[31]; T[39] -= a1.w * T[31]; a1 = *(const LAS f32x4*)(AB + 2084);
            asm volatile("" ::: "memory"); T[40] -= a2.x * T[31]; T[41] -= a2.y * T[31]; T[42] -= a2.z * T[31]; T[43] -= a2.w * T[31]; a2 = *(const LAS f32x4*)(AB + 2088);
            asm volatile("" ::: "memory"); T[44] -= a3.x * T[31]; T[45] -= a3.y * T[31]; T[46] -= a3.z * T[31]; T[47] -= a3.w * T[31]; a3 = *(const LAS f32x4*)(AB + 2092);
            asm volatile("" ::: "memory"); T[48] -= a4.x * T[31]; T[49] -= a4.y * T[31]; T[50] -= a4.z * T[31]; T[51] -= a4.w * T[31]; a4 = *(const LAS f32x4*)(AB + 2096);
            asm volatile("" ::: "memory"); T[52] -= a5.x * T[31]; T[53] -= a5.y * T[31]; T[54] -= a5.z * T[31]; T[55] -= a5.w * T[31]; a5 = *(const LAS f32x4*)(AB + 2100);
            asm volatile("" ::: "memory"); T[56] -= a6.x * T[31]; T[57] -= a6.y * T[31]; T[58] -= a6.z * T[31]; T[59] -= a6.w * T[31]; a6 = *(const LAS f32x4*)(AB + 2104);
            asm volatile("" ::: "memory"); T[60] -= a7.x * T[31]; T[61] -= a7.y * T[31]; T[62] -= a7.z * T[31]; T[63] -= a7.w * T[31]; a7 = *(const LAS f32x4*)(AB + 2108);
            asm volatile("" ::: "memory"); T[33] -= a0.y * T[32]; T[34] -= a0.z * T[32]; T[35] -= a0.w * T[32]; a0 = *(const LAS f32x4*)(AB + 2144);
            asm volatile("" ::: "memory"); T[36] -= a1.x * T[32]; T[37] -= a1.y * T[32]; T[38] -= a1.z * T[32]; T[39] -= a1.w * T[32]; a1 = *(const LAS f32x4*)(AB + 2148);
            asm volatile("" ::: "memory"); T[40] -= a2.x * T[32]; T[41] -= a2.y * T[32]; T[42] -= a2.z * T[32]; T[43] -= a2.w * T[32]; a2 = *(const LAS f32x4*)(AB + 2152);
            asm volatile("" ::: "memory"); T[44] -= a3.x * T[32]; T[45] -= a3.y * T[32]; T[46] -= a3.z * T[32]; T[47] -= a3.w * T[32]; a3 = *(const LAS f32x4*)(AB + 2156);
            asm volatile("" ::: "memory"); T[48] -= a4.x * T[32]; T[49] -= a4.y * T[32]; T[50] -= a4.z * T[32]; T[51] -= a4.w * T[32]; a4 = *(const LAS f32x4*)(AB + 2160);
            asm volatile("" ::: "memory"); T[52] -= a5.x * T[32]; T[53] -= a5.y * T[32]; T[54] -= a5.z * T[32]; T[55] -= a5.w * T[32]; a5 = *(const LAS f32x4*)(AB + 2164);
            asm volatile("" ::: "memory"); T[56] -= a6.x * T[32]; T[57] -= a6.y * T[32]; T[58] -= a6.z * T[32]; T[59] -= a6.w * T[32]; a6 = *(const LAS f32x4*)(AB + 2168);
            asm volatile("" ::: "memory"); T[60] -= a7.x * T[32]; T[61] -= a7.y * T[32]; T[62] -= a7.z * T[32]; T[63] -= a7.w * T[32]; a7 = *(const LAS f32x4*)(AB + 2172);
            asm volatile("" ::: "memory"); T[34] -= a0.z * T[33]; T[35] -= a0.w * T[33]; a0 = *(const LAS f32x4*)(AB + 2208);
            asm volatile("" ::: "memory"); T[36] -= a1.x * T[33]; T[37] -= a1.y * T[33]; T[38] -= a1.z * T[33]; T[39] -= a1.w * T[33]; a1 = *(const LAS f32x4*)(AB + 2212);
            asm volatile("" ::: "memory"); T[40] -= a2.x * T[33]; T[41] -= a2.y * T[33]; T[42] -= a2.z * T[33]; T[43] -= a2.w * T[33]; a2 = *(const LAS f32x4*)(AB + 2216);
            asm volatile("" ::: "memory"); T[44] -= a3.x * T[33]; T[45] -= a3.y * T[33]; T[46] -= a3.z * T[33]; T[47] -= a3.w * T[33]; a3 = *(const LAS f32x4*)(AB + 2220);
            asm volatile("" ::: "memory"); T[48] -= a4.x * T[33]; T[49] -= a4.y * T[33]; T[50] -= a4.z * T[33]; T[51] -= a4.w * T[33]; a4 = *(const LAS f32x4*)(AB + 2224);
            asm volatile("" ::: "memory"); T[52] -= a5.x * T[33]; T[53] -= a5.y * T[33]; T[54] -= a5.z * T[33]; T[55] -= a5.w * T[33]; a5 = *(const LAS f32x4*)(AB + 2228);
            asm volatile("" ::: "memory"); T[56] -= a6.x * T[33]; T[57] -= a6.y * T[33]; T[58] -= a6.z * T[33]; T[59] -= a6.w * T[33]; a6 = *(const LAS f32x4*)(AB + 2232);
            asm volatile("" ::: "memory"); T[60] -= a7.x * T[33]; T[61] -= a7.y * T[33]; T[62] -= a7.z * T[33]; T[63] -= a7.w * T[33]; a7 = *(const LAS f32x4*)(AB + 2236);
            asm volatile("" ::: "memory"); T[35] -= a0.w * T[34]; a0 = *(const LAS f32x4*)(AB + 2276);
            asm volatile("" ::: "memory"); T[36] -= a1.x * T[34]; T[37] -= a1.y * T[34]; T[38] -= a1.z * T[34]; T[39] -= a1.w * T[34]; a1 = *(const LAS f32x4*)(AB + 2280);
            asm volatile("" ::: "memory"); T[40] -= a2.x * T[34]; T[41] -= a2.y * T[34]; T[42] -= a2.z * T[34]; T[43] -= a2.w * T[34]; a2 = *(const LAS f32x4*)(AB + 2284);
            asm volatile("" ::: "memory"); T[44] -= a3.x * T[34]; T[45] -= a3.y * T[34]; T[46] -= a3.z * T[34]; T[47] -= a3.w * T[34]; a3 = *(const LAS f32x4*)(AB + 2288);
            asm volatile("" ::: "memory"); T[48] -= a4.x * T[34]; T[49] -= a4.y * T[34]; T[50] -= a4.z * T[34]; T[51] -= a4.w * T[34]; a4 = *(const LAS f32x4*)(AB + 2292);
            asm volatile("" ::: "memory"); T[52] -= a5.x * T[34]; T[53] -= a5.y * T[34]; T[54] -= a5.z * T[34]; T[55] -= a5.w * T[34]; a5 = *(const LAS f32x4*)(AB + 2296);
            asm volatile("" ::: "memory"); T[56] -= a6.x * T[34]; T[57] -= a6.y * T[34]; T[58] -= a6.z * T[34]; T[59] -= a6.w * T[34]; a6 = *(const LAS f32x4*)(AB + 2300);
            asm volatile("" ::: "memory"); T[60] -= a7.x * T[34]; T[61] -= a7.y * T[34]; T[62] -= a7.z * T[34]; T[63] -= a7.w * T[34]; a7 = *(const LAS f32x4*)(AB + 2340);
            asm volatile("" ::: "memory"); T[36] -= a0.x * T[35]; T[37] -= a0.y * T[35]; T[38] -= a0.z * T[35]; T[39] -= a0.w * T[35]; a0 = *(const LAS f32x4*)(AB + 2344);
            asm volatile("" ::: "memory"); T[40] -= a1.x * T[35]; T[41] -= a1.y * T[35]; T[42] -= a1.z * T[35]; T[43] -= a1.w * T[35]; a1 = *(const LAS f32x4*)(AB + 2348);
            asm volatile("" ::: "memory"); T[44] -= a2.x * T[35]; T[45] -= a2.y * T[35]; T[46] -= a2.z * T[35]; T[47] -= a2.w * T[35]; a2 = *(const LAS f32x4*)(AB + 2352);
            asm volatile("" ::: "memory"); T[48] -= a3.x * T[35]; T[49] -= a3.y * T[35]; T[50] -= a3.z * T[35]; T[51] -= a3.w * T[35]; a3 = *(const LAS f32x4*)(AB + 2356);
            asm volatile("" ::: "memory"); T[52] -= a4.x * T[35]; T[53] -= a4.y * T[35]; T[54] -= a4.z * T[35]; T[55] -= a4.w * T[35]; a4 = *(const LAS f32x4*)(AB + 2360);
            asm volatile("" ::: "memory"); T[56] -= a5.x * T[35]; T[57] -= a5.y * T[35]; T[58] -= a5.z * T[35]; T[59] -= a5.w * T[35]; a5 = *(const LAS f32x4*)(AB + 2364);
            asm volatile("" ::: "memory"); T[60] -= a6.x * T[35]; T[61] -= a6.y * T[35]; T[62] -= a6.z * T[35]; T[63] -= a6.w * T[35]; a6 = *(const LAS f32x4*)(AB + 2404);
            asm volatile("" ::: "memory"); T[37] -= a7.y * T[36]; T[38] -= a7.z * T[36]; T[39] -= a7.w * T[36]; a7 = *(const LAS f32x4*)(AB + 2408);
            asm volatile("" ::: "memory"); T[40] -= a0.x * T[36]; T[41] -= a0.y * T[36]; T[42] -= a0.z * T[36]; T[43] -= a0.w * T[36]; a0 = *(const LAS f32x4*)(AB + 2412);
            asm volatile("" ::: "memory"); T[44] -= a1.x * T[36]; T[45] -= a1.y * T[36]; T[46] -= a1.z * T[36]; T[47] -= a1.w * T[36]; a1 = *(const LAS f32x4*)(AB + 2416);
            asm volatile("" ::: "memory"); T[48] -= a2.x * T[36]; T[49] -= a2.y * T[36]; T[50] -= a2.z * T[36]; T[51] -= a2.w * T[36]; a2 = *(const LAS f32x4*)(AB + 2420);
            asm volatile("" ::: "memory"); T[52] -= a3.x * T[36]; T[53] -= a3.y * T[36]; T[54] -= a3.z * T[36]; T[55] -= a3.w * T[36]; a3 = *(const LAS f32x4*)(AB + 2424);
            asm volatile("" ::: "memory"); T[56] -= a4.x * T[36]; T[57] -= a4.y * T[36]; T[58] -= a4.z * T[36]; T[59] -= a4.w * T[36]; a4 = *(const LAS f32x4*)(AB + 2428);
            asm volatile("" ::: "memory"); T[60] -= a5.x * T[36]; T[61] -= a5.y * T[36]; T[62] -= a5.z * T[36]; T[63] -= a5.w * T[36]; a5 = *(const LAS f32x4*)(AB + 2468);
            asm volatile("" ::: "memory"); T[38] -= a6.z * T[37]; T[39] -= a6.w * T[37]; a6 = *(const LAS f32x4*)(AB + 2472);
            asm volatile("" ::: "memory"); T[40] -= a7.x * T[37]; T[41] -= a7.y * T[37]; T[42] -= a7.z * T[37]; T[43] -= a7.w * T[37]; a7 = *(const LAS f32x4*)(AB + 2476);
            asm volatile("" ::: "memory"); T[44] -= a0.x * T[37]; T[45] -= a0.y * T[37]; T[46] -= a0.z * T[37]; T[47] -= a0.w * T[37]; a0 = *(const LAS f32x4*)(AB + 2480);
            asm volatile("" ::: "memory"); T[48] -= a1.x * T[37]; T[49] -= a1.y * T[37]; T[50] -= a1.z * T[37]; T[51] -= a1.w * T[37]; a1 = *(const LAS f32x4*)(AB + 2484);
            asm volatile("" ::: "memory"); T[52] -= a2.x * T[37]; T[53] -= a2.y * T[37]; T[54] -= a2.z * T[37]; T[55] -= a2.w * T[37]; a2 = *(const LAS f32x4*)(AB + 2488);
            asm volatile("" ::: "memory"); T[56] -= a3.x * T[37]; T[57] -= a3.y * T[37]; T[58] -= a3.z * T[37]; T[59] -= a3.w * T[37]; a3 = *(const LAS f32x4*)(AB + 2492);
            asm volatile("" ::: "memory"); T[60] -= a4.x * T[37]; T[61] -= a4.y * T[37]; T[62] -= a4.z * T[37]; T[63] -= a4.w * T[37]; a4 = *(const LAS f32x4*)(AB + 2536);
            asm volatile("" ::: "memory"); T[39] -= a5.w * T[38]; a5 = *(const LAS f32x4*)(AB + 2540);
            asm volatile("" ::: "memory"); T[40] -= a6.x * T[38]; T[41] -= a6.y * T[38]; T[42] -= a6.z * T[38]; T[43] -= a6.w * T[38]; a6 = *(const LAS f32x4*)(AB + 2544);
            asm volatile("" ::: "memory"); T[44] -= a7.x * T[38]; T[45] -= a7.y * T[38]; T[46] -= a7.z * T[38]; T[47] -= a7.w * T[38]; a7 = *(const LAS f32x4*)(AB + 2548);
            asm volatile("" ::: "memory"); T[48] -= a0.x * T[38]; T[49] -= a0.y * T[38]; T[50] -= a0.z * T[38]; T[51] -= a0.w * T[38]; a0 = *(const LAS f32x4*)(AB + 2552);
            asm volatile("" ::: "memory"); T[52] -= a1.x * T[38]; T[53] -= a1.y * T[38]; T[54] -= a1.z * T[38]; T[55] -= a1.w * T[38]; a1 = *(const LAS f32x4*)(AB + 2556);
            asm volatile("" ::: "memory"); T[56] -= a2.x * T[38]; T[57] -= a2.y * T[38]; T[58] -= a2.z * T[38]; T[59] -= a2.w * T[38]; a2 = *(const LAS f32x4*)(AB + 2600);
            asm volatile("" ::: "memory"); T[60] -= a3.x * T[38]; T[61] -= a3.y * T[38]; T[62] -= a3.z * T[38]; T[63] -= a3.w * T[38]; a3 = *(const LAS f32x4*)(AB + 2604);
            asm volatile("" ::: "memory"); T[40] -= a4.x * T[39]; T[41] -= a4.y * T[39]; T[42] -= a4.z * T[39]; T[43] -= a4.w * T[39]; a4 = *(const LAS f32x4*)(AB + 2608);
            asm volatile("" ::: "memory"); T[44] -= a5.x * T[39]; T[45] -= a5.y * T[39]; T[46] -= a5.z * T[39]; T[47] -= a5.w * T[39]; a5 = *(const LAS f32x4*)(AB + 2612);
            asm volatile("" ::: "memory"); T[48] -= a6.x * T[39]; T[49] -= a6.y * T[39]; T[50] -= a6.z * T[39]; T[51] -= a6.w * T[39]; a6 = *(const LAS f32x4*)(AB + 2616);
            asm volatile("" ::: "memory"); T[52] -= a7.x * T[39]; T[53] -= a7.y * T[39]; T[54] -= a7.z * T[39]; T[55] -= a7.w * T[39]; a7 = *(const LAS f32x4*)(AB + 2620);
            asm volatile("" ::: "memory"); T[56] -= a0.x * T[39]; T[57] -= a0.y * T[39]; T[58] -= a0.z * T[39]; T[59] -= a0.w * T[39]; a0 = *(const LAS f32x4*)(AB + 2664);
            asm volatile("" ::: "memory"); T[60] -= a1.x * T[39]; T[61] -= a1.y * T[39]; T[62] -= a1.z * T[39]; T[63] -= a1.w * T[39]; a1 = *(const LAS f32x4*)(AB + 2668);
            asm volatile("" ::: "memory"); T[41] -= a2.y * T[40]; T[42] -= a2.z * T[40]; T[43] -= a2.w * T[40]; a2 = *(const LAS f32x4*)(AB + 2672);
            asm volatile("" ::: "memory"); T[44] -= a3.x * T[40]; T[45] -= a3.y * T[40]; T[46] -= a3.z * T[40]; T[47] -= a3.w * T[40]; a3 = *(const LAS f32x4*)(AB + 2676);
            asm volatile("" ::: "memory"); T[48] -= a4.x * T[40]; T[49] -= a4.y * T[40]; T[50] -= a4.z * T[40]; T[51] -= a4.w * T[40]; a4 = *(const LAS f32x4*)(AB + 2680);
            asm volatile("" ::: "memory"); T[52] -= a5.x * T[40]; T[53] -= a5.y * T[40]; T[54] -= a5.z * T[40]; T[55] -= a5.w * T[40]; a5 = *(const LAS f32x4*)(AB + 2684);
            asm volatile("" ::: "memory"); T[56] -= a6.x * T[40]; T[57] -= a6.y * T[40]; T[58] -= a6.z * T[40]; T[59] -= a6.w * T[40]; a6 = *(const LAS f32x4*)(AB + 2728);
            asm volatile("" ::: "memory"); T[60] -= a7.x * T[40]; T[61] -= a7.y * T[40]; T[62] -= a7.z * T[40]; T[63] -= a7.w * T[40]; a7 = *(const LAS f32x4*)(AB + 2732);
            asm volatile("" ::: "memory"); T[42] -= a0.z * T[41]; T[43] -= a0.w * T[41]; a0 = *(const LAS f32x4*)(AB + 2736);
            asm volatile("" ::: "memory"); T[44] -= a1.x * T[41]; T[45] -= a1.y * T[41]; T[46] -= a1.z * T[41]; T[47] -= a1.w * T[41]; a1 = *(const LAS f32x4*)(AB + 2740);
            asm volatile("" ::: "memory"); T[48] -= a2.x * T[41]; T[49] -= a2.y * T[41]; T[50] -= a2.z * T[41]; T[51] -= a2.w * T[41]; a2 = *(const LAS f32x4*)(AB + 2744);
            asm volatile("" ::: "memory"); T[52] -= a3.x * T[41]; T[53] -= a3.y * T[41]; T[54] -= a3.z * T[41]; T[55] -= a3.w * T[41]; a3 = *(const LAS f32x4*)(AB + 2748);
            asm volatile("" ::: "memory"); T[56] -= a4.x * T[41]; T[57] -= a4.y * T[41]; T[58] -= a4.z * T[41]; T[59] -= a4.w * T[41]; a4 = *(const LAS f32x4*)(AB + 2796);
            asm volatile("" ::: "memory"); T[60] -= a5.x * T[41]; T[61] -= a5.y * T[41]; T[62] -= a5.z * T[41]; T[63] -= a5.w * T[41]; a5 = *(const LAS f32x4*)(AB + 2800);
            asm volatile("" ::: "memory"); T[43] -= a6.w * T[42]; a6 = *(const LAS f32x4*)(AB + 2804);
            asm volatile("" ::: "memory"); T[44] -= a7.x * T[42]; T[45] -= a7.y * T[42]; T[46] -= a7.z * T[42]; T[47] -= a7.w * T[42]; a7 = *(const LAS f32x4*)(AB + 2808);
            asm volatile("" ::: "memory"); T[48] -= a0.x * T[42]; T[49] -= a0.y * T[42]; T[50] -= a0.z * T[42]; T[51] -= a0.w * T[42]; a0 = *(const LAS f32x4*)(AB + 2812);
            asm volatile("" ::: "memory"); T[52] -= a1.x * T[42]; T[53] -= a1.y * T[42]; T[54] -= a1.z * T[42]; T[55] -= a1.w * T[42]; a1 = *(const LAS f32x4*)(AB + 2860);
            asm volatile("" ::: "memory"); T[56] -= a2.x * T[42]; T[57] -= a2.y * T[42]; T[58] -= a2.z * T[42]; T[59] -= a2.w * T[42]; a2 = *(const LAS f32x4*)(AB + 2864);
            asm volatile("" ::: "memory"); T[60] -= a3.x * T[42]; T[61] -= a3.y * T[42]; T[62] -= a3.z * T[42]; T[63] -= a3.w * T[42]; a3 = *(const LAS f32x4*)(AB + 2868);
            asm volatile("" ::: "memory"); T[44] -= a4.x * T[43]; T[45] -= a4.y * T[43]; T[46] -= a4.z * T[43]; T[47] -= a4.w * T[43]; a4 = *(const LAS f32x4*)(AB + 2872);
            asm volatile("" ::: "memory"); T[48] -= a5.x * T[43]; T[49] -= a5.y * T[43]; T[50] -= a5.z * T[43]; T[51] -= a5.w * T[43]; a5 = *(const LAS f32x4*)(AB + 2876);
            asm volatile("" ::: "memory"); T[52] -= a6.x * T[43]; T[53] -= a6.y * T[43]; T[54] -= a6.z * T[43]; T[55] -= a6.w * T[43]; a6 = *(const LAS f32x4*)(AB + 2924);
            asm volatile("" ::: "memory"); T[56] -= a7.x * T[43]; T[57] -= a7.y * T[43]; T[58] -= a7.z * T[43]; T[59] -= a7.w * T[43]; a7 = *(const LAS f32x4*)(AB + 2928);
            asm volatile("" ::: "memory"); T[60] -= a0.x * T[43]; T[61] -= a0.y * T[43]; T[62] -= a0.z * T[43]; T[63] -= a0.w * T[43]; a0 = *(const LAS f32x4*)(AB + 2932);
            asm volatile("" ::: "memory"); T[45] -= a1.y * T[44]; T[46] -= a1.z * T[44]; T[47] -= a1.w * T[44]; a1 = *(const LAS f32x4*)(AB + 2936);
            asm volatile("" ::: "memory"); T[48] -= a2.x * T[44]; T[49] -= a2.y * T[44]; T[50] -= a2.z * T[44]; T[51] -= a2.w * T[44]; a2 = *(const LAS f32x4*)(AB + 2940);
            asm volatile("" ::: "memory"); T[52] -= a3.x * T[44]; T[53] -= a3.y * T[44]; T[54] -= a3.z * T[44]; T[55] -= a3.w * T[44]; a3 = *(const LAS f32x4*)(AB + 2988);
            asm volatile("" ::: "memory"); T[56] -= a4.x * T[44]; T[57] -= a4.y * T[44]; T[58] -= a4.z * T[44]; T[59] -= a4.w * T[44]; a4 = *(const LAS f32x4*)(AB + 2992);
            asm volatile("" ::: "memory"); T[60] -= a5.x * T[44]; T[61] -= a5.y * T[44]; T[62] -= a5.z * T[44]; T[63] -= a5.w * T[44]; a5 = *(const LAS f32x4*)(AB + 2996);
            asm volatile("" ::: "memory"); T[46] -= a6.z * T[45]; T[47] -= a6.w * T[45]; a6 = *(const LAS f32x4*)(AB + 3000);
            asm volatile("" ::: "memory"); T[48] -= a7.x * T[45]; T[49] -= a7.y * T[45]; T[50] -= a7.z * T[45]; T[51] -= a7.w * T[45]; a7 = *(const LAS f32x4*)(AB + 3004);
            asm volatile("" ::: "memory"); T[52] -= a0.x * T[45]; T[53] -= a0.y * T[45]; T[54] -= a0.z * T[45]; T[55] -= a0.w * T[45]; a0 = *(const LAS f32x4*)(AB + 3056);
            asm volatile("" ::: "memory"); T[56] -= a1.x * T[45]; T[57] -= a1.y * T[45]; T[58] -= a1.z * T[45]; T[59] -= a1.w * T[45]; a1 = *(const LAS f32x4*)(AB + 3060);
            asm volatile("" ::: "memory"); T[60] -= a2.x * T[45]; T[61] -= a2.y * T[45]; T[62] -= a2.z * T[45]; T[63] -= a2.w * T[45]; a2 = *(const LAS f32x4*)(AB + 3064);
            asm volatile("" ::: "memory"); T[47] -= a3.w * T[46]; a3 = *(const LAS f32x4*)(AB + 3068);
            asm volatile("" ::: "memory"); T[48] -= a4.x * T[46]; T[49] -= a4.y * T[46]; T[50] -= a4.z * T[46]; T[51] -= a4.w * T[46]; a4 = *(const LAS f32x4*)(AB + 3120);
            asm volatile("" ::: "memory"); T[52] -= a5.x * T[46]; T[53] -= a5.y * T[46]; T[54] -= a5.z * T[46]; T[55] -= a5.w * T[46]; a5 = *(const LAS f32x4*)(AB + 3124);
            asm volatile("" ::: "memory"); T[56] -= a6.x * T[46]; T[57] -= a6.y * T[46]; T[58] -= a6.z * T[46]; T[59] -= a6.w * T[46]; a6 = *(const LAS f32x4*)(AB + 3128);
            asm volatile("" ::: "memory"); T[60] -= a7.x * T[46]; T[61] -= a7.y * T[46]; T[62] -= a7.z * T[46]; T[63] -= a7.w * T[46]; a7 = *(const LAS f32x4*)(AB + 3132);
            asm volatile("" ::: "memory"); T[48] -= a0.x * T[47]; T[49] -= a0.y * T[47]; T[50] -= a0.z * T[47]; T[51] -= a0.w * T[47]; a0 = *(const LAS f32x4*)(AB + 3184);
            asm volatile("" ::: "memory"); T[52] -= a1.x * T[47]; T[53] -= a1.y * T[47]; T[54] -= a1.z * T[47]; T[55] -= a1.w * T[47]; a1 = *(const LAS f32x4*)(AB + 3188);
            asm volatile("" ::: "memory"); T[56] -= a2.x * T[47]; T[57] -= a2.y * T[47]; T[58] -= a2.z * T[47]; T[59] -= a2.w * T[47]; a2 = *(const LAS f32x4*)(AB + 3192);
            asm volatile("" ::: "memory"); T[60] -= a3.x * T[47]; T[61] -= a3.y * T[47]; T[62] -= a3.z * T[47]; T[63] -= a3.w * T[47]; a3 = *(const LAS f32x4*)(AB + 3196);
            asm volatile("" ::: "memory"); T[49] -= a4.y * T[48]; T[50] -= a4.z * T[48]; T[51] -= a4.w * T[48]; a4 = *(const LAS f32x4*)(AB + 3248);
            asm volatile("" ::: "memory"); T[52] -= a5.x * T[48]; T[53] -= a5.y * T[48]; T[54] -= a5.z * T[48]; T[55] -= a5.w * T[48]; a5 = *(const LAS f32x4*)(AB + 3252);
            asm volatile("" ::: "memory"); T[56] -= a6.x * T[48]; T[57] -= a6.y * T[48]; T[58] -= a6.z * T[48]; T[59] -= a6.w * T[48]; a6 = *(const LAS f32x4*)(AB + 3256);
            asm volatile("" ::: "memory"); T[60] -= a7.x * T[48]; T[61] -= a7.y * T[48]; T[62] -= a7.z * T[48]; T[63] -= a7.w * T[48]; a7 = *(const LAS f32x4*)(AB + 3260);
            asm volatile("" ::: "memory"); T[50] -= a0.z * T[49]; T[51] -= a0.w * T[49]; a0 = *(const LAS f32x4*)(AB + 3316);
            asm volatile("" ::: "memory"); T[52] -= a1.x * T[49]; T[53] -= a1.y * T[49]; T[54] -= a1.z * T[49]; T[55] -= a1.w * T[49]; a1 = *(const LAS f32x4*)(AB + 3320);
            asm volatile("" ::: "memory"); T[56] -= a2.x * T[49]; T[57] -= a2.y * T[49]; T[58] -= a2.z * T[49]; T[59] -= a2.w * T[49]; a2 = *(const LAS f32x4*)(AB + 3324);
            asm volatile("" ::: "memory"); T[60] -= a3.x * T[49]; T[61] -= a3.y * T[49]; T[62] -= a3.z * T[49]; T[63] -= a3.w * T[49]; a3 = *(const LAS f32x4*)(AB + 3380);
            asm volatile("" ::: "memory"); T[51] -= a4.w * T[50]; a4 = *(const LAS f32x4*)(AB + 3384);
            asm volatile("" ::: "memory"); T[52] -= a5.x * T[50]; T[53] -= a5.y * T[50]; T[54] -= a5.z * T[50]; T[55] -= a5.w * T[50]; a5 = *(const LAS f32x4*)(AB + 3388);
            asm volatile("" ::: "memory"); T[56] -= a6.x * T[50]; T[57] -= a6.y * T[50]; T[58] -= a6.z * T[50]; T[59] -= a6.w * T[50]; a6 = *(const LAS f32x4*)(AB + 3444);
            asm volatile("" ::: "memory"); T[60] -= a7.x * T[50]; T[61] -= a7.y * T[50]; T[62] -= a7.z * T[50]; T[63] -= a7.w * T[50]; a7 = *(const LAS f32x4*)(AB + 3448);
            asm volatile("" ::: "memory"); T[52] -= a0.x * T[51]; T[53] -= a0.y * T[51]; T[54] -= a0.z * T[51]; T[55] -= a0.w * T[51]; a0 = *(const LAS f32x4*)(AB + 3452);
            asm volatile("" ::: "memory"); T[56] -= a1.x * T[51]; T[57] -= a1.y * T[51]; T[58] -= a1.z * T[51]; T[59] -= a1.w * T[51]; a1 = *(const LAS f32x4*)(AB + 3508);
            asm volatile("" ::: "memory"); T[60] -= a2.x * T[51]; T[61] -= a2.y * T[51]; T[62] -= a2.z * T[51]; T[63] -= a2.w * T[51]; a2 = *(const LAS f32x4*)(AB + 3512);
            asm volatile("" ::: "memory"); T[53] -= a3.y * T[52]; T[54] -= a3.z * T[52]; T[55] -= a3.w * T[52]; a3 = *(const LAS f32x4*)(AB + 3516);
            asm volatile("" ::: "memory"); T[56] -= a4.x * T[52]; T[57] -= a4.y * T[52]; T[58] -= a4.z * T[52]; T[59] -= a4.w * T[52]; a4 = *(const LAS f32x4*)(AB + 3576);
            asm volatile("" ::: "memory"); T[60] -= a5.x * T[52]; T[61] -= a5.y * T[52]; T[62] -= a5.z * T[52]; T[63] -= a5.w * T[52]; a5 = *(const LAS f32x4*)(AB + 3580);
            asm volatile("" ::: "memory"); T[54] -= a6.z * T[53]; T[55] -= a6.w * T[53]; a6 = *(const LAS f32x4*)(AB + 3640);
            asm volatile("" ::: "memory"); T[56] -= a7.x * T[53]; T[57] -= a7.y * T[53]; T[58] -= a7.z * T[53]; T[59] -= a7.w * T[53]; a7 = *(const LAS f32x4*)(AB + 3644);
            asm volatile("" ::: "memory"); T[60] -= a0.x * T[53]; T[61] -= a0.y * T[53]; T[62] -= a0.z * T[53]; T[63] -= a0.w * T[53]; a0 = *(const LAS f32x4*)(AB + 3704);
            asm volatile("" ::: "memory"); T[55] -= a1.w * T[54]; a1 = *(const LAS f32x4*)(AB + 3708);
            asm volatile("" ::: "memory"); T[56] -= a2.x * T[54]; T[57] -= a2.y * T[54]; T[58] -= a2.z * T[54]; T[59] -= a2.w * T[54]; a2 = *(const LAS f32x4*)(AB + 3768);
            asm volatile("" ::: "memory"); T[60] -= a3.x * T[54]; T[61] -= a3.y * T[54]; T[62] -= a3.z * T[54]; T[63] -= a3.w * T[54]; a3 = *(const LAS f32x4*)(AB + 3772);
            asm volatile("" ::: "memory"); T[56] -= a4.x * T[55]; T[57] -= a4.y * T[55]; T[58] -= a4.z * T[55]; T[59] -= a4.w * T[55]; a4 = *(const LAS f32x4*)(AB + 3836);
            asm volatile("" ::: "memory"); T[60] -= a5.x * T[55]; T[61] -= a5.y * T[55]; T[62] -= a5.z * T[55]; T[63] -= a5.w * T[55]; a5 = *(const LAS f32x4*)(AB + 3900);
            asm volatile("" ::: "memory"); T[57] -= a6.y * T[56]; T[58] -= a6.z * T[56]; T[59] -= a6.w * T[56]; a6 = *(const LAS f32x4*)(AB + 3964);
            asm volatile("" ::: "memory"); T[60] -= a7.x * T[56]; T[61] -= a7.y * T[56]; T[62] -= a7.z * T[56]; T[63] -= a7.w * T[56]; a7 = *(const LAS f32x4*)(AB + 4028);
            asm volatile("" ::: "memory"); T[58] -= a0.z * T[57]; T[59] -= a0.w * T[57];
            asm volatile("" ::: "memory"); T[60] -= a1.x * T[57]; T[61] -= a1.y * T[57]; T[62] -= a1.z * T[57]; T[63] -= a1.w * T[57];
            asm volatile("" ::: "memory"); T[59] -= a2.w * T[58];
            asm volatile("" ::: "memory"); T[60] -= a3.x * T[58]; T[61] -= a3.y * T[58]; T[62] -= a3.z * T[58]; T[63] -= a3.w * T[58];
            asm volatile("" ::: "memory"); T[60] -= a4.x * T[59]; T[61] -= a4.y * T[59]; T[62] -= a4.z * T[59]; T[63] -= a4.w * T[59];
            asm volatile("" ::: "memory"); T[61] -= a5.y * T[60]; T[62] -= a5.z * T[60]; T[63] -= a5.w * T[60];
            asm volatile("" ::: "memory"); T[62] -= a6.z * T[61]; T[63] -= a6.w * T[61];
            asm volatile("" ::: "memory"); T[63] -= a7.w * T[62];
#pragma unroll
            for (int i = 0; i < 64; ++i) *(LAS unsigned short*)(L + PL_TB + i * TP + 2 * lane) = (unsigned short)f2bf(T[i]);
        }
        __syncthreads();
        { const int kt = w >> 1, ct = w & 1;
          f32x16 aw, au;
#pragma unroll
          for (int r = 0; r < 16; ++r) { aw[r] = 0.f; au[r] = 0.f; }
          const LAS unsigned char* kp = L + PL_KBGT + (32 * kt + l31) * TP + hh * 16; const LAS unsigned char* tp = L + PL_TB + (32 * ct + l31) * TP + hh * 16;
          const LAS unsigned char* vp = L + PL_VBT + (32 * kt + l31) * TP + hh * 16;
#pragma unroll
          for (int s = 0; s < 4; ++s) { const bf16x8 tf = *(const LAS bf16x8*)(tp + 32 * s);
              aw = MFMA32(*(const LAS bf16x8*)(kp + 32 * s), tf, aw);
              au = MFMA32(tf, *(const LAS bf16x8*)(vp + 32 * s), au); }
          { const int c = 32 * ct + l31;
#pragma unroll
            for (int g = 0; g < 4; ++g) { u32x2 o; o.x = cvtpk(aw[4 * g], aw[4 * g + 1]); o.y = cvtpk(aw[4 * g + 2], aw[4 * g + 3]);
                *(u32x2*)(Wimg + c * RP + (32 * kt + 16 * (g >> 1) + 8 * hh + 4 * (g & 1)) * 2) = o; } }
          { const int dv = 32 * kt + l31;
#pragma unroll
            for (int g = 0; g < 4; ++g) { u32x2 o; o.x = cvtpk(au[4 * g], au[4 * g + 1]); o.y = cvtpk(au[4 * g + 2], au[4 * g + 3]);
                *(u32x2*)(UT + dv * 128 + (32 * ct + 8 * g + 4 * hh) * 2) = o; } } }
        __syncthreads();
    }
}

constexpr int SC_BUF = IMG_BYTES, SC_OBUF = 2 * SC_BUF, SC_OB = 64 * RP, SC_NW = SC_OBUF + 2 * SC_OB;
static_assert(SC_NW + 512 <= LDSCTL_OFF, "scan LDS map");
__device__ __forceinline__ void gdn_scan_phase(Frame& F) {
    const bf16* P = (const bf16*)(F.ws + WS_P); bf16* MIX = (bf16*)(F.ws + WS_MIXIN); const float* nw = F.in[13]; const float* CD = (const float*)(F.ws + WS_CD);
    const int lane = F.lane, l31 = lane & 31, hh = lane >> 5;
    LAS unsigned char* L = F.lds + RING_OFF;
    for (int item = blockIdx.x; item < BATCH * NH; item += F.G) {
        const int b = item >> 2, h = item & 3; const size_t ci0 = (size_t)item * 32;
        const unsigned char* Ig = F.ws + WS_IMG + ci0 * IMG_BYTES; const unsigned char* Ug = F.ws + WS_UT + ci0 * 16384;
        const bool comp = F.wave < 4; const int w = F.wave & 3;
#define SC_LOAD(chunk, bufi) do { const unsigned char* src_ = Ig + (size_t)(chunk) * IMG_BYTES; _Pragma("unroll") for (int p_ = 0; p_ < 8; ++p_) { const int piece = 8 * p_ + F.wave; \
            if (piece < IMG_BYTES / 1024) __builtin_amdgcn_global_load_lds((const unsigned*)(src_ + piece * 1024 + ln * 16), (LAS unsigned*)(L + (bufi) * SC_BUF + piece * 1024), 16, 0, 0); } } while (0)
#define SC_ZLOAD(dst, chunk) do { const bf16* zp_ = P + (size_t)(b * SEQ + (chunk) * CL + 16 * w + (ln >> 2)) * NIN_G + PC_Z + h * HD + 32 * (ln & 3); \
            _Pragma("unroll") for (int j_ = 0; j_ < 4; ++j_) dst[j_] = *(const v4u*)(zp_ + 8 * j_); } while (0)
#define SC_FINAL(chunk) do { const int tok_ = 16 * w + (ln >> 2), q_ = ln & 3; const LAS unsigned char* op_ = L + SC_OBUF + ((chunk) & 1) * SC_OB + tok_ * RP + q_ * 64; \
            v4u o4_[4]; _Pragma("unroll") for (int j_ = 0; j_ < 4; ++j_) o4_[j_] = *(const LAS v4u*)(op_ + 16 * j_); \
            float ss_ = 0.f; _Pragma("unroll") for (int j_ = 0; j_ < 4; ++j_) _Pragma("unroll") for (int e_ = 0; e_ < 4; ++e_) { const float lo_ = bf_lo(o4_[j_][e_]), hi_ = bf_hi(o4_[j_][e_]); ss_ += lo_ * lo_ + hi_ * hi_; } \
            ss_ += dppf<0xB1>(ss_); ss_ += dppf<0x4E>(ss_); const float rr_ = rsqrtf_(ss_ * (1.f / HD) + EPS); \
            bf16* mp_ = MIX + (size_t)(b * SEQ + (chunk) * CL + tok_) * D + GW + h * HD + 32 * q_; const LAS float* nwp_ = (const LAS float*)(L + SC_NW) + 32 * q_; \
            _Pragma("unroll") for (int j_ = 0; j_ < 4; ++j_) { const f32x4 na_ = *(const LAS f32x4*)(nwp_ + 8 * j_), nb_ = *(const LAS f32x4*)(nwp_ + 8 * j_ + 4); v4u r_; \
                r_.x = cvtpk(bf_lo(o4_[j_].x) * rr_ * na_.x * bf_lo(zc[j_].x), bf_hi(o4_[j_].x) * rr_ * na_.y * bf_hi(zc[j_].x)); r_.y = cvtpk(bf_lo(o4_[j_].y) * rr_ * na_.z * bf_lo(zc[j_].y), bf_hi(o4_[j_].y) * rr_ * na_.w * bf_hi(zc[j_].y)); \
                r_.z = cvtpk(bf_lo(o4_[j_].z) * rr_ * nb_.x * bf_lo(zc[j_].z), bf_hi(o4_[j_].z) * rr_ * nb_.y * bf_hi(zc[j_].z)); r_.w = cvtpk(bf_lo(o4_[j_].w) * rr_ * nb_.z * bf_lo(zc[j_].w), bf_hi(o4_[j_].w) * rr_ * nb_.w * bf_hi(zc[j_].w)); \
                *(v4u*)(mp_ + 8 * j_) = r_; } } while (0)
        v4u zc[4], zn[4];
        f32x16 S[4];
#pragma unroll
        for (int kt = 0; kt < 4; ++kt)
#pragma unroll
            for (int r = 0; r < 16; ++r) S[kt][r] = 0.f;
        u32x2 ucur[8]; float cdc = 0.f;
        const unsigned char* up = Ug + (32 * w + l31) * 128 + 8 * hh;
        if (comp) {
#pragma unroll
            for (int q = 0; q < 8; ++q) ucur[q] = *(const u32x2*)(up + (32 * (q >> 2) + 8 * (q & 3)) * 2);
            cdc = CD[ci0];
        }
        int ln = lane; asm volatile("" : "+v"(ln)); SC_LOAD(0, 0); if (!comp) { SC_ZLOAD(zc, 0); if (w == 0) { ((LAS float*)(L + SC_NW))[ln] = nw[ln]; ((LAS float*)(L + SC_NW))[64 + ln] = nw[64 + ln]; } }
        asm volatile("s_waitcnt vmcnt(0)" ::: "memory");
        __syncthreads();
        if (comp) {
        for (int i = 0; i < SEQ / CL; ++i) {
                if (i + 1 < SEQ / CL) SC_LOAD(i + 1, (i + 1) & 1);
                const LAS unsigned char* B = L + (i & 1) * SC_BUF;
                const float cd = cdc, cdn = CD[ci0 + ((i + 1 < SEQ / CL) ? i + 1 : i)];
                bf16x8 FA[4], FB[4];
                const LAS unsigned char* fw = B + l31 * RP + hh * 16; const LAS unsigned char* fr = B + l31 * TP + hh * 16;
#define LDWQ(F, base, tt, kp) do { _Pragma("unroll") for (int k_ = 0; k_ < 2; ++k_) _Pragma("unroll") for (int s_ = 0; s_ < 2; ++s_) \
                    F[k_ * 2 + s_] = *(const LAS bf16x8*)(fw + (base) + (tt) * 32 * RP + 64 * ((kp) * 2 + k_) + 32 * s_); } while (0)
#define LDROW128(F, base, rt) do { _Pragma("unroll") for (int t_ = 0; t_ < 2; ++t_) _Pragma("unroll") for (int s_ = 0; s_ < 2; ++s_) \
                    F[t_ * 2 + s_] = *(const LAS bf16x8*)(fr + (base) + (rt) * 32 * TP + 64 * t_ + 32 * s_); } while (0)
#define SBAR() __builtin_amdgcn_sched_barrier(0)
#define MKSB(kp) do { _Pragma("unroll") for (int k_ = 0; k_ < 2; ++k_) _Pragma("unroll") for (int s_ = 0; s_ < 2; ++s_) { const f32x16& s16 = S[(kp) * 2 + k_]; \
                    Sb[k_][s_] = pack8(s16[8 * s_], s16[8 * s_ + 1], s16[8 * s_ + 2], s16[8 * s_ + 3], s16[8 * s_ + 4], s16[8 * s_ + 5], s16[8 * s_ + 6], s16[8 * s_ + 7]); } } while (0)
#define MMWQ(F, ACC) do { _Pragma("unroll") for (int k_ = 0; k_ < 2; ++k_) _Pragma("unroll") for (int s_ = 0; s_ < 2; ++s_) ACC = MFMA32(F[k_ * 2 + s_], Sb[k_][s_], ACC); } while (0)
#define MMROW(F, ACC) do { _Pragma("unroll") for (int t_ = 0; t_ < 2; ++t_) _Pragma("unroll") for (int s_ = 0; s_ < 2; ++s_) ACC = MFMA32(F[t_ * 2 + s_], Vb[t_][s_], ACC); } while (0)
                f32x16 VN[2], O[2];
                LDWQ(FA, IMG_W, 0, 0); SBAR();
#pragma unroll
                for (int tt = 0; tt < 2; ++tt)
#pragma unroll
                    for (int g = 0; g < 4; ++g) { const u32x2 u = ucur[tt * 4 + g]; VN[tt][4 * g] = bf_lo(u.x); VN[tt][4 * g + 1] = bf_hi(u.x); VN[tt][4 * g + 2] = bf_lo(u.y); VN[tt][4 * g + 3] = bf_hi(u.y);
                        O[tt][4 * g] = 0.f; O[tt][4 * g + 1] = 0.f; O[tt][4 * g + 2] = 0.f; O[tt][4 * g + 3] = 0.f; }
                bf16x8 Sb[2][2];
                MKSB(0);
                LDWQ(FB, IMG_W, 1, 0); SBAR(); MMWQ(FA, VN[0]); SBAR();
                LDWQ(FA, IMG_Q, 0, 0); SBAR(); MMWQ(FB, VN[1]); SBAR();
                LDWQ(FB, IMG_Q, 1, 0); SBAR(); MMWQ(FA, O[0]); SBAR();
                LDWQ(FA, IMG_W, 0, 1); SBAR(); MMWQ(FB, O[1]); SBAR();
                MKSB(1);
                LDWQ(FB, IMG_W, 1, 1); SBAR(); MMWQ(FA, VN[0]); SBAR();
                LDWQ(FA, IMG_Q, 0, 1); SBAR(); MMWQ(FB, VN[1]); SBAR();
                LDWQ(FB, IMG_Q, 1, 1); SBAR(); MMWQ(FA, O[0]); SBAR();
                LDROW128(FA, IMG_QK, 0); SBAR(); MMWQ(FB, O[1]); SBAR();
                bf16x8 Vb[2][2];
#pragma unroll
                for (int tt = 0; tt < 2; ++tt)
#pragma unroll
                    for (int s = 0; s < 2; ++s) Vb[tt][s] = pack8(VN[tt][8 * s], VN[tt][8 * s + 1], VN[tt][8 * s + 2], VN[tt][8 * s + 3], VN[tt][8 * s + 4], VN[tt][8 * s + 5], VN[tt][8 * s + 6], VN[tt][8 * s + 7]);
                LDROW128(FB, IMG_QK, 1); SBAR(); MMROW(FA, O[0]); SBAR();
                { const unsigned char* upn = up + (size_t)((i + 1 < SEQ / CL) ? i + 1 : i) * 16384;
#pragma unroll
                  for (int q = 0; q < 8; ++q) ucur[q] = *(const u32x2*)(upn + (32 * (q >> 2) + 8 * (q & 3)) * 2); }
#pragma unroll
                for (int kt = 0; kt < 4; ++kt)
#pragma unroll
                    for (int r = 0; r < 16; ++r) S[kt][r] *= cd;
                LDROW128(FA, IMG_KT, 0); SBAR(); MMROW(FB, O[1]); SBAR();
                LDROW128(FB, IMG_KT, 1); SBAR(); MMROW(FA, S[0]); SBAR();
                LDROW128(FA, IMG_KT, 2); SBAR(); MMROW(FB, S[1]); SBAR();
                LDROW128(FB, IMG_KT, 3); SBAR(); MMROW(FA, S[2]); SBAR();
                MMROW(FB, S[3]); SBAR();
#undef LDWQ
#undef LDROW128
#undef MKSB
#undef MMWQ
#undef MMROW
#undef SBAR
                { LAS unsigned char* ob = L + SC_OBUF + (i & 1) * SC_OB + (32 * w + l31) * 2;
#pragma unroll
                  for (int tt = 0; tt < 2; ++tt)
#pragma unroll
                      for (int r = 0; r < 16; ++r) { const int tok = 32 * tt + (r & 3) + 8 * (r >> 2) + 4 * hh; *(LAS unsigned short*)(ob + tok * RP) = (unsigned short)(cvtpk(O[tt][r], 0.f) & 0xffffu); } }
                cdc = cdn;
            asm volatile("s_waitcnt vmcnt(0)" ::: "memory");
            __syncthreads();
        }
        } else {
        asm volatile("" : "+v"(ln));
        for (int i = 0; i < SEQ / CL; ++i) {
                if (i >= 1) SC_ZLOAD(zn, i);
                if (i + 1 < SEQ / CL) SC_LOAD(i + 1, (i + 1) & 1);
                if (i >= 1) { SC_FINAL(i - 1);
#pragma unroll
                    for (int r_ = 0; r_ < 4; ++r_) zc[r_] = zn[r_]; }
            asm volatile("s_waitcnt vmcnt(0)" ::: "memory");
            __syncthreads();
        }
        }
        if (!comp) { SC_FINAL(SEQ / CL - 1); }
        asm volatile("s_waitcnt vmcnt(0)" ::: "memory");
        __syncthreads();
#undef SC_LOAD
#undef SC_FINAL
#undef SC_ZLOAD
    }
}
struct Args { const float* in[19]; float* out; unsigned char* ws; int ph_lo, ph_hi, li, pad; };
__global__ void __launch_bounds__(NWAVES * 64, 2) fwd_kernel(Args args) {
    extern __shared__ __attribute__((aligned(16))) unsigned char lds[];
    Frame F;
    F.lds = (LAS unsigned char*)lds;
    F.MISC = (volatile LAS unsigned*)(F.lds + MISC_OFF);
    F.tid = threadIdx.x; F.lane = F.tid & 63; F.wave = __builtin_amdgcn_readfirstlane(F.tid >> 6);
    F.G = gridDim.x; { const int bx = blockIdx.x; F.vcu = (F.G % 8 == 0) ? (bx % 8) * (F.G / 8) + bx / 8 : bx; }
#pragma unroll
    for (int i = 0; i < 19; ++i) F.in[i] = args.in[i];
    F.out = args.out; F.ws = args.ws;
    F.ctl = (gu32*)(F.ws + WS_CTL);
    for (int u = F.tid; u < (LDS_BYTES - LDSCTL_OFF) / 4; u += NWAVES * 64) ((LAS unsigned*)(F.lds + LDSCTL_OFF))[u] = 0u;
    __syncthreads();
    XcdBarrier bar; bar.bar = (unsigned*)(F.ctl + CW_BAR) + args.li * XCD_BAR_WORDS; bar.x = 0; bar.st = nullptr;
    if (MK_ONE_LAUNCH) bar = xcd_barrier_post((unsigned*)(F.ctl + CW_BAR) + args.li * XCD_BAR_WORDS, F.MISC + 8);
#define GRID_BAR() do { if (MK_ONE_LAUNCH) xcd_barrier(bar); } while (0)
    const int lo = args.ph_lo, hi = args.ph_hi;
#define IN(k) (lo <= (k) && (k) < hi)
#define BOTH(k) (IN(k) && IN((k) + 1))
    float* MOD = (float*)(F.ws + WS_MOD);
    bf16* XN = (bf16*)(F.ws + WS_XN); bf16* Pb = (bf16*)(F.ws + WS_P); bf16* MIX = (bf16*)(F.ws + WS_MIXIN); bf16* HID = (bf16*)(F.ws + WS_HID);

    if (IN(0)) { p0_prologue(F); if (BOTH(0)) GRID_BAR(); }
    if (IN(1)) { norm_mod_phase<true>(F, F.in[0], F.in[4], MOD + 0 * D, MOD + 1 * D, XN); if (BOTH(1)) GRID_BAR(); }
    if (IN(2)) {
        pg8::Gemm g{XN, (const bf16*)(F.ws + WS_WIN), M, NIN_G, D}; pg8::StaticOrder S; S.init(M, NIN_G, F.G, (int)blockIdx.x);
        pg8::EpiP E{Pb, NIN_G, PC_GATE / 256, PC_Q / 256, PC_Z / 256, NIN_G / 256};
        pg8::gemm_phase<pg8::EpiP, pg8::StaticOrder, PG8_ALIGN, PG8_SP2>(F.lds + RING_OFF, g, S, E);
        if (BOTH(2)) GRID_BAR();
    }
#if GDN_SIMPLE
    if (IN(3)) { conformer_phase(F); gdn_prep_simple(F); if (BOTH(3)) GRID_BAR(); }
#else
    if (IN(3)) { gdn_prep_phase(F); if (BOTH(3)) GRID_BAR(); }
#endif
#if GDN_SIMPLE
    if (IN(4)) { gdn_recurrent_simple(F); if (BOTH(4)) GRID_BAR(); }
#else
    if (IN(4)) { if (blockIdx.x < BATCH * NH) gdn_scan_phase(F); else conformer_phase(F); if (BOTH(4)) GRID_BAR(); }
#endif
    if (IN(5)) {
        pg8::Gemm g{MIX, (const bf16*)(F.ws + WS_WOUT), M, D, D}; pg8::StaticOrder S; S.init(M, D, F.G, (int)blockIdx.x);
        pg8::EpiResGate E{F.in[0], F.out, D, MOD + 2 * D, NMOD * D, SEQ / 256};
        pg8::gemm_phase<pg8::EpiResGate, pg8::StaticOrder, PG8_ALIGN, PG8_SP2>(F.lds + RING_OFF, g, S, E);
        if (BOTH(5)) GRID_BAR();
    }
    if (IN(6)) { norm_mod_phase<false>(F, F.out, F.in[15], MOD + 3 * D, MOD + 4 * D, XN); if (BOTH(6)) GRID_BAR(); }
    if (IN(7)) {
        pg8::Gemm g{XN, (const bf16*)(F.ws + WS_WFI), M, 2 * FF, D}; pg8::StaticOrder S; S.init(M, 2 * FF, F.G, (int)blockIdx.x);
        pg8::EpiSwiGLU E{HID, FF};
        pg8::gemm_phase<pg8::EpiSwiGLU, pg8::StaticOrder, PG8_ALIGN, PG8_SP2>(F.lds + RING_OFF, g, S, E);
        if (BOTH(7)) GRID_BAR();
    }
    if (IN(8)) {
        pg8::Gemm g{HID, (const bf16*)(F.ws + WS_WFO), M, D, FF}; pg8::StaticOrder S; S.init(M, D, F.G, (int)blockIdx.x);
        pg8::EpiResGate E{F.out, F.out, D, MOD + 5 * D, NMOD * D, SEQ / 256};
        pg8::gemm_phase<pg8::EpiResGate, pg8::StaticOrder, PG8_ALIGN, PG8_SP2>(F.lds + RING_OFF, g, S, E);
        if (BOTH(8)) GRID_BAR();
    }
    if (IN(9)) { final_norm_phase(F, F.out, F.in[18]); }
#undef IN
#undef BOTH
}

extern "C" void kernel_launch(void* const* d_in, const int* in_sizes, int n_in, void* d_out, int out_size, void* d_ws, size_t ws_size, hipStream_t stream) {
    static int grid = 0;
    if (grid == 0) {
        if (n_in != 19 || in_sizes[0] != M * D || out_size != M * D || ws_size < WS_END) { fprintf(stderr, "kernel_launch: unexpected shapes (n_in %d, in0 %d, out %d, ws %zu); nothing launched\n", n_in, n_in > 0 ? in_sizes[0] : -1, out_size, ws_size); grid = -1; return; }
        int dev = 0, cus = 0, per_cu = 0;
        if (hipGetDevice(&dev) != hipSuccess || hipDeviceGetAttribute(&cus, hipDeviceAttributeMultiprocessorCount, dev) != hipSuccess) { grid = -1; return; }
        if (hipFuncSetAttribute((const void*)fwd_kernel, hipFuncAttributeMaxDynamicSharedMemorySize, LDS_BYTES) != hipSuccess) { fprintf(stderr, "kernel_launch: hipFuncSetAttribute failed\n"); grid = -1; return; }
        if (hipOccupancyMaxActiveBlocksPerMultiprocessor(&per_cu, (const void*)fwd_kernel, NWAVES * 64, LDS_BYTES) != hipSuccess || per_cu < 1) { fprintf(stderr, "kernel_launch: occupancy query says %d blocks per CU\n", per_cu); per_cu = 1; }
        (void)hipGetLastError();
        grid = cus;
    }
    if (grid < 0) return;
    (void)hipMemsetAsync((char*)d_ws + WS_CTL, 0, CTL_ZERO_BYTES, stream);
    Args a{};
    for (int i = 0; i < 19; ++i) a.in[i] = (const float*)d_in[i];
    a.out = (float*)d_out; a.ws = (unsigned char*)d_ws;
#if MK_ONE_LAUNCH
#if PROBE_REP >= 0
    a.ph_lo = 0; a.ph_hi = PROBE_REP + 1; a.li = 0;
    hipLaunchKernelGGL(fwd_kernel, dim3(grid), dim3(NWAVES * 64), LDS_BYTES, stream, a);
    a.ph_lo = PROBE_REP; a.ph_hi = N_PHASES; a.li = 1;
    hipLaunchKernelGGL(fwd_kernel, dim3(grid), dim3(NWAVES * 64), LDS_BYTES, stream, a);
#else
    a.ph_lo = 0; a.ph_hi = N_PHASES; a.li = 0;
    hipLaunchKernelGGL(fwd_kernel, dim3(grid), dim3(NWAVES * 64), LDS_BYTES, stream, a);
#endif
#else
    for (int p = 0; p < N_PHASES; ++p) { a.ph_lo = p; a.ph_hi = p + 1; a.li = 0; hipLaunchKernelGGL(fwd_kernel, dim3(grid), dim3(NWAVES * 64), LDS_BYTES, stream, a); }
#endif
}
```
